# Optimizing an MI355X kernel written in HIP

```python
import math
import jax
import jax.numpy as jnp
from jax import lax
import numpy as np

D_MODEL = 1024
BATCH = 8
SEQ = 8192
DEPTH = 2

HEAD_DIM = 64
MIX_HALF = D_MODEL // 2
GLA_HEADS = MIX_HALF // HEAD_DIM
FOX_HEADS = MIX_HALF // HEAD_DIM
GLA_RANK = 16
GLA_TAU = 16.0
GLA_CHUNK = 64
FOX_BLOCK = 128
S5_GROUP_WIDTH = 16
S5_GROUPS = MIX_HALF // S5_GROUP_WIDTH
S5_STATE = 64
S5_CHUNK = 128
SGU_GROUPS = 8
SGU_GROUP_WIDTH = MIX_HALF // SGU_GROUPS
SGU_CHUNK = 128
D_FF = 4 * D_MODEL
N_EVEN = (DEPTH + 1) // 2
N_ODD = DEPTH // 2
EPS = 1e-6
EVEN_SIZES = (MIX_HALF, MIX_HALF, MIX_HALF, MIX_HALF, GLA_RANK, MIX_HALF, MIX_HALF, MIX_HALF, FOX_HEADS)
EVEN_SPLITS = tuple(int(v) for v in np.cumsum(EVEN_SIZES)[:-1])
EVEN_WIDTH = int(sum(EVEN_SIZES))
ODD_WIDTH = 3 * MIX_HALF

kernel_name = "hybrid_gla_fox_s5_sgu_adaln_trunk"


def _rms(x):
    x = x.astype(jnp.float32)
    return x * lax.rsqrt(jnp.mean(x * x, axis=-1, keepdims=True) + EPS)


def _gla(q, k, v, log_a):
    B, S, H, Dh = q.shape
    n = S // GLA_CHUNK

    def chunks(t):
        return t.astype(jnp.float32).reshape(B, n, GLA_CHUNK, H, Dh).transpose(1, 0, 3, 2, 4)

    q = q.astype(jnp.float32) * (Dh ** -0.5)
    mask = jnp.tril(jnp.ones((GLA_CHUNK, GLA_CHUNK), dtype=bool))

    def step(state, inp):
        qc, kc, vc, lc = inp
        bc = jnp.cumsum(lc, axis=2)
        o_inter = jnp.einsum('bhtk,bhkv->bhtv', qc * jnp.exp(bc), state)
        diff = bc[:, :, :, None, :] - bc[:, :, None, :, :]
        decay = jnp.exp(jnp.where(mask[:, :, None], diff, -jnp.inf))
        scores = jnp.einsum('bhtk,bhtsk,bhsk->bhts', qc, decay, kc)
        o = o_inter + jnp.einsum('bhts,bhsv->bhtv', scores, vc)
        b_last = bc[:, :, -1:, :]
        state = (jnp.exp(b_last[:, :, 0, :])[..., None] * state
                 + jnp.einsum('bhsk,bhsv->bhkv', kc * jnp.exp(b_last - bc), vc))
        return state, o

    state0 = jnp.zeros((B, H, Dh, Dh), jnp.float32)
    _, o = lax.scan(step, state0, (chunks(q), chunks(k), chunks(v), chunks(log_a)))
    return o.transpose(1, 0, 3, 2, 4).reshape(B, S, H, Dh)


def _fox(q, k, v, f_logit, q_gain, k_gain):
    B, S, H, Dh = q.shape
    q = (_rms(q) * q_gain).transpose(0, 2, 1, 3)
    k = (_rms(k) * k_gain).transpose(0, 2, 1, 3)
    v = v.astype(jnp.float32).transpose(0, 2, 1, 3)
    cum = jnp.cumsum(jax.nn.log_sigmoid(f_logit.astype(jnp.float32)), axis=1).transpose(0, 2, 1)
    nb = S // FOX_BLOCK
    qb = q.reshape(B, H, nb, FOX_BLOCK, Dh).transpose(2, 0, 1, 3, 4)
    cb = cum.reshape(B, H, nb, FOX_BLOCK).transpose(2, 0, 1, 3)
    pos = jnp.arange(S, dtype=jnp.int32)
    pb = pos.reshape(nb, FOX_BLOCK)
    scale = Dh ** -0.5

    def block(args):
        qi, ci, pi = args
        logits = (jnp.einsum('bhqd,bhkd->bhqk', qi, k) * scale
                  + ci[..., None] - cum[:, :, None, :])
        logits = jnp.where(pi[:, None] >= pos[None, :], logits, -jnp.inf)
        return jnp.einsum('bhqk,bhkd->bhqd', jax.nn.softmax(logits, axis=-1), v)

    out = lax.map(block, (qb, cb, pb))
    return out.transpose(1, 0, 3, 2, 4).reshape(B, S, H, Dh)


def _ssm_combine(e1, e2):
    a1r, a1i, b1r, b1i = e1
    a2r, a2i, b2r, b2i = e2
    return (a2r * a1r - a2i * a1i,
            a2r * a1i + a2i * a1r,
            a2r * b1r - a2i * b1i + b2r,
            a2r * b1i + a2i * b1r + b2i)


def _s5(u, lam_re, lam_im, log_dt, b_re, b_im, c_re, c_im, d_skip):
    B, S, _ = u.shape
    f32 = jnp.float32
    lam_re, lam_im, b_re, b_im, c_re, c_im, d_skip = (
        t.astype(f32) for t in (lam_re, lam_im, b_re, b_im, c_re, c_im, d_skip))
    dt = jnp.exp(log_dt.astype(f32))[:, None]
    mag = jnp.exp(lam_re * dt)
    ang = lam_im * dt
    abar_re = mag * jnp.cos(ang)
    abar_im = mag * jnp.sin(ang)
    den = lam_re * lam_re + lam_im * lam_im
    coef_re = ((abar_re - 1.0) * lam_re + abar_im * lam_im) / den
    coef_im = (abar_im * lam_re - (abar_re - 1.0) * lam_im) / den
    bbar_re = coef_re[..., None] * b_re - coef_im[..., None] * b_im
    bbar_im = coef_re[..., None] * b_im + coef_im[..., None] * b_re
    n = S // S5_CHUNK
    uc = u.astype(f32).reshape(B, n, S5_CHUNK, S5_GROUPS, S5_GROUP_WIDTH).transpose(1, 0, 2, 3, 4)

    def step(carry, u_chunk):
        x_re0, x_im0 = carry
        bu_re = jnp.einsum('bcgi,gpi->bcgp', u_chunk, bbar_re)
        bu_im = jnp.einsum('bcgi,gpi->bcgp', u_chunk, bbar_im)
        a_re = jnp.broadcast_to(abar_re, bu_re.shape)
        a_im = jnp.broadcast_to(abar_im, bu_re.shape)
        acc_re, acc_im, x_re, x_im = lax.associative_scan(
            _ssm_combine, (a_re, a_im, bu_re, bu_im), axis=1)
        x_re = x_re + acc_re * x_re0[:, None] - acc_im * x_im0[:, None]
        x_im = x_im + acc_re * x_im0[:, None] + acc_im * x_re0[:, None]
        y = (jnp.einsum('bcgp,gip->bcgi', x_re, c_re)
             - jnp.einsum('bcgp,gip->bcgi', x_im, c_im)
             + d_skip * u_chunk)
        return (x_re[:, -1], x_im[:, -1]), y

    zeros = jnp.zeros((B, S5_GROUPS, S5_STATE), f32)
    _, y = lax.scan(step, (zeros, zeros), uc)
    return y.transpose(1, 0, 2, 3, 4).reshape(B, S, MIX_HALF)


def _sgu(z, ln_gain, ln_bias, w_s, b_s):
    B, S, _ = z.shape
    z = jax.nn.gelu(z.astype(jnp.float32))
    u, v = z[..., :MIX_HALF], z[..., MIX_HALF:]
    mu = jnp.mean(v, axis=-1, keepdims=True)
    var = jnp.mean(jnp.square(v - mu), axis=-1, keepdims=True)
    v = (v - mu) * lax.rsqrt(var + EPS) * ln_gain + ln_bias
    n = S // SGU_CHUNK
    v = v.reshape(B, n, SGU_CHUNK, SGU_GROUPS, SGU_GROUP_WIDTH)
    mask = jnp.tril(jnp.ones((SGU_CHUNK, SGU_CHUNK), dtype=bool))
    w = jnp.where(mask[None], w_s.astype(jnp.float32), 0.0)
    mixed = jnp.einsum('gts,bnsgc->bntgc', w, v) + b_s.astype(jnp.float32).T[None, None, :, :, None]
    return u * mixed.reshape(B, S, MIX_HALF)


def _even_mixer(h, w_in, w_out, w_lr, b_lr, gla_gain, b_f, q_gain, k_gain):
    B, S, _ = h.shape
    proj = jnp.einsum('bsd,de->bse', h, w_in)
    gq, gk, gv, gg, glr, fq, fk, fv, ff = jnp.split(proj, EVEN_SPLITS, axis=-1)

    def heads(t):
        return t.reshape(B, S, -1, HEAD_DIM)

    log_a = jax.nn.log_sigmoid((jnp.einsum('bsr,re->bse', glr, w_lr) + b_lr).astype(jnp.float32)) / GLA_TAU
    o_gla = _gla(heads(gq), heads(gk), heads(gv), heads(log_a))
    o_gla = _rms(o_gla) * gla_gain * jax.nn.silu(heads(gg).astype(jnp.float32))
    o_fox = _fox(heads(fq), heads(fk), heads(fv), ff + b_f, q_gain, k_gain)
    mixed = jnp.concatenate([o_gla.reshape(B, S, -1), o_fox.reshape(B, S, -1)], axis=-1)
    return jnp.einsum('bse,ed->bsd', mixed.astype(h.dtype), w_out)


def _odd_mixer(h, w_in, w_out, lam_re, lam_im, log_dt, b_re, b_im, c_re, c_im, d_skip,
               w_glu, b_glu, ln_gain, ln_bias, w_s, b_s):
    proj = jnp.einsum('bsd,de->bse', h, w_in)
    s5_in, sgu_z = proj[..., :MIX_HALF], proj[..., MIX_HALF:]
    y = jax.nn.gelu(_s5(s5_in, lam_re, lam_im, log_dt, b_re, b_im, c_re, c_im, d_skip))
    y = y * jax.nn.sigmoid(jnp.einsum('bse,ef->bsf', y, w_glu.astype(jnp.float32)) + b_glu)
    y_sgu = _sgu(sgu_z, ln_gain, ln_bias, w_s, b_s)
    mixed = jnp.concatenate([y, y_sgu], axis=-1)
    return jnp.einsum('bse,ed->bsd', mixed.astype(h.dtype), w_out)


def setup_inputs(seed: int = 0) -> dict:
    key = jax.random.key(seed)
    ks = jax.random.split(key, 30)
    f32 = jnp.float32

    def nrm(k, shape, scale):
        return jax.random.normal(k, shape, f32) * scale

    n_idx = jnp.arange(S5_STATE, dtype=f32)
    return {
        "x": nrm(ks[0], (BATCH, SEQ, D_MODEL), 1.0),
        "c": nrm(ks[1], (BATCH, D_MODEL), 1.0),
        "ada_w": nrm(ks[2], (DEPTH, D_MODEL, 6 * D_MODEL), D_MODEL ** -0.5),
        "ada_b": nrm(ks[3], (DEPTH, 6 * D_MODEL), 0.01),
        "even_w_in": nrm(ks[4], (N_EVEN, D_MODEL, EVEN_WIDTH), D_MODEL ** -0.5),
        "even_w_out": nrm(ks[5], (N_EVEN, D_MODEL, D_MODEL), D_MODEL ** -0.5),
        "gla_w_lr": nrm(ks[6], (N_EVEN, GLA_RANK, MIX_HALF), GLA_RANK ** -0.5),
        "gla_b_lr": nrm(ks[7], (N_EVEN, MIX_HALF), 0.01),
        "gla_gain": 1.0 + nrm(ks[8], (N_EVEN, GLA_HEADS, HEAD_DIM), 0.01),
        "fox_b_f": nrm(ks[9], (N_EVEN, FOX_HEADS), 0.01),
        "fox_q_gain": 1.0 + nrm(ks[10], (N_EVEN, FOX_HEADS, HEAD_DIM), 0.01),
        "fox_k_gain": 1.0 + nrm(ks[11], (N_EVEN, FOX_HEADS, HEAD_DIM), 0.01),
        "odd_w_in": nrm(ks[12], (N_ODD, D_MODEL, ODD_WIDTH), D_MODEL ** -0.5),
        "odd_w_out": nrm(ks[13], (N_ODD, D_MODEL, D_MODEL), D_MODEL ** -0.5),
        "s5_lam_re": -0.5 + nrm(ks[14], (N_ODD, S5_GROUPS, S5_STATE), 0.01),
        "s5_lam_im": jnp.pi * n_idx + nrm(ks[15], (N_ODD, S5_GROUPS, S5_STATE), 0.01),
        "s5_log_dt": jax.random.uniform(ks[16], (N_ODD, S5_GROUPS), f32,
                                        minval=math.log(1e-3), maxval=math.log(1e-1)),
        "s5_b_re": nrm(ks[17], (N_ODD, S5_GROUPS, S5_STATE, S5_GROUP_WIDTH), (2 * S5_GROUP_WIDTH) ** -0.5),
        "s5_b_im": nrm(ks[18], (N_ODD, S5_GROUPS, S5_STATE, S5_GROUP_WIDTH), (2 * S5_GROUP_WIDTH) ** -0.5),
        "s5_c_re": nrm(ks[19], (N_ODD, S5_GROUPS, S5_GROUP_WIDTH, S5_STATE), (2 * S5_STATE) ** -0.5),
        "s5_c_im": nrm(ks[20], (N_ODD, S5_GROUPS, S5_GROUP_WIDTH, S5_STATE), (2 * S5_STATE) ** -0.5),
        "s5_d": nrm(ks[21], (N_ODD, S5_GROUPS, S5_GROUP_WIDTH), 1.0),
        "s5_w_glu": nrm(ks[22], (N_ODD, MIX_HALF, MIX_HALF), MIX_HALF ** -0.5),
        "s5_b_glu": nrm(ks[23], (N_ODD, MIX_HALF), 0.01),
        "sgu_ln_gain": 1.0 + nrm(ks[24], (N_ODD, MIX_HALF), 0.01),
        "sgu_ln_bias": nrm(ks[25], (N_ODD, MIX_HALF), 0.01),
        "sgu_w_s": nrm(ks[26], (N_ODD, SGU_GROUPS, SGU_CHUNK, SGU_CHUNK), SGU_CHUNK ** -0.5),
        "sgu_b_s": 1.0 + nrm(ks[27], (N_ODD, SGU_GROUPS, SGU_CHUNK), 0.01),
        "mlp_w1": nrm(ks[28], (DEPTH, D_MODEL, D_FF), D_MODEL ** -0.5),
        "mlp_w2": nrm(ks[29], (DEPTH, D_FF, D_MODEL), D_FF ** -0.5),
    }


def reference(x, c, ada_w, ada_b, even_w_in, even_w_out, gla_w_lr, gla_b_lr, gla_gain,
              fox_b_f, fox_q_gain, fox_k_gain, odd_w_in, odd_w_out, s5_lam_re, s5_lam_im,
              s5_log_dt, s5_b_re, s5_b_im, s5_c_re, s5_c_im, s5_d, s5_w_glu, s5_b_glu,
              sgu_ln_gain, sgu_ln_bias, sgu_w_s, sgu_b_s, mlp_w1, mlp_w2):
    c_act = jax.nn.silu(c)
    for layer in range(DEPTH):
        mod = jnp.einsum('bd,de->be', c_act, ada_w[layer]) + ada_b[layer]
        sh1, sc1, g1, sh2, sc2, g2 = jnp.split(mod.astype(jnp.float32), 6, axis=-1)
        h = (_rms(x) * (1.0 + sc1[:, None]) + sh1[:, None]).astype(x.dtype)
        i = layer // 2
        if layer % 2 == 0:
            y = _even_mixer(h, even_w_in[i], even_w_out[i], gla_w_lr[i], gla_b_lr[i], gla_gain[i],
                            fox_b_f[i], fox_q_gain[i], fox_k_gain[i])
        else:
            y = _odd_mixer(h, odd_w_in[i], odd_w_out[i], s5_lam_re[i], s5_lam_im[i], s5_log_dt[i],
                           s5_b_re[i], s5_b_im[i], s5_c_re[i], s5_c_im[i], s5_d[i], s5_w_glu[i],
                           s5_b_glu[i], sgu_ln_gain[i], sgu_ln_bias[i], sgu_w_s[i], sgu_b_s[i])
        x = x + (g1[:, None] * y).astype(x.dtype)
        h = (_rms(x) * (1.0 + sc2[:, None]) + sh2[:, None]).astype(x.dtype)
        hid = jnp.square(jax.nn.relu(jnp.einsum('bsd,df->bsf', h, mlp_w1[layer])))
        x = x + (g2[:, None] * jnp.einsum('bsf,fd->bsd', hid, mlp_w2[layer])).astype(x.dtype)
    return x
```

```cpp
#include <hip/hip_runtime.h>
#include <hip/hip_cooperative_groups.h>
#include <cstdio>
namespace cg = cooperative_groups;

#define LAS __attribute__((address_space(3)))
typedef unsigned short bf16_t;
typedef short bf16x8 __attribute__((ext_vector_type(8)));
typedef short bf16x4 __attribute__((ext_vector_type(4)));
typedef float f32x4 __attribute__((ext_vector_type(4)));
typedef float f32x2 __attribute__((ext_vector_type(2)));
typedef unsigned u32x4 __attribute__((ext_vector_type(4)));
typedef unsigned u32x2 __attribute__((ext_vector_type(2)));

constexpr int T = 65536, SEQ = 8192, D = 1024, FFD = 4096;
constexpr int LD0 = 3840, LD1 = 1536;
constexpr int C_GQ = 0, C_GK = 512, C_GV = 1024, C_GG = 1536, C_FQ = 2048, C_FK = 2560, C_FV = 3072, C_LR = 3584, C_FF = 3600;
constexpr float EPS = 1e-6f;
constexpr size_t MiB = 1u << 20;
constexpr size_t WS_CTL = 0, WS_WIN0 = 2 * MiB, WS_WOUT0 = 10 * MiB, WS_W1_0 = 12 * MiB, WS_W2_0 = 20 * MiB, WS_WIN1 = 28 * MiB, WS_WOUT1 = 31 * MiB,
                 WS_WGLU = 33 * MiB, WS_W1_1 = 34 * MiB, WS_W2_1 = 42 * MiB, WS_WSB = 50 * MiB, WS_MOD = 51 * MiB, WS_S5P = 52 * MiB, WS_CUM = 53 * MiB,
                 WS_H = 64 * MiB, WS_MIX = 192 * MiB, WS_BIG = 320 * MiB, WS_END = 832 * MiB;
constexpr size_t WS_PRM = 56 * MiB;
constexpr int PR_WLR = 0, PR_BLR = 8192, PR_GGAIN = 8704, PR_BF = 9216, PR_QG = 9280, PR_KG = 9792, PR_S5D = 10304, PR_BGLU = 10816, PR_LNG = 11328, PR_LNB = 11840, PR_BS = 12352;
constexpr size_t S5_ABAR = 0, S5_BB = 16384, S5_CM = 16384 + 131072;
constexpr int LDS_BYTES = 147456;
constexpr int NT = 512;

struct Args { const float* in[30]; float* out; unsigned char* ws; };

typedef __bf16 bf16x2_t __attribute__((ext_vector_type(2)));
__device__ __forceinline__ unsigned pkbf(float lo, float hi) { f32x2 v = {lo, hi}; bf16x2_t b = __builtin_convertvector(v, bf16x2_t); return __builtin_bit_cast(unsigned, b); }
__device__ __forceinline__ float bflo(unsigned w) { return __uint_as_float(w << 16); }
__device__ __forceinline__ float bfhi(unsigned w) { return __uint_as_float(w & 0xffff0000u); }
__device__ __forceinline__ void unpack8(u32x4 w, float* f) { f[0] = bflo(w.x); f[1] = bfhi(w.x); f[2] = bflo(w.y); f[3] = bfhi(w.y); f[4] = bflo(w.z); f[5] = bfhi(w.z); f[6] = bflo(w.w); f[7] = bfhi(w.w); }
__device__ __forceinline__ float sigmoidf_(float x) { return 1.0f / (1.0f + __expf(-x)); }
__device__ __forceinline__ float siluf_(float x) { return x * sigmoidf_(x); }
__device__ __forceinline__ float gelu_tanh(float x) { const float u = 1.5957691216057308f * (x + 0.044715f * x * x * x); return x * sigmoidf_(u); }
__device__ __forceinline__ float logsig(float x) { return fminf(x, 0.f) - __logf(1.0f + __expf(-fabsf(x))); }
__device__ __forceinline__ int otid() { int t = threadIdx.x; asm volatile("" : "+v"(t)); return t; }
#define LDS_WAIT() asm volatile("s_waitcnt lgkmcnt(0)" ::: "memory")
#define MFMA16(a, b, c) __builtin_amdgcn_mfma_f32_16x16x32_bf16((a), (b), (c), 0, 0, 0)
__device__ __forceinline__ bf16x8 as_bf16x8(u32x4 v) { return __builtin_bit_cast(bf16x8, v); }

namespace pg8 {
constexpr int BM = 256, BK = 64, HALF = 128, HTB = HALF * BK * 2, STAGE_BYTES = 8 * HTB, NXCD = 8, WGM = 8;
__device__ __forceinline__ int lds_byte(int r, int c) { const int st = (r >> 4) * 2 + (c >> 5), rr = r & 15, cc = c & 31, ob = rr * 64 + cc * 2; return st * 1024 + (ob ^ (((ob >> 9) & 1) << 5)); }
__device__ __forceinline__ void stage_rc(int b, int& R, int& C) { const int st = b / 1024, sb = b % 1024, swz = sb ^ (((sb >> 9) & 1) << 5); R = (st >> 1) * 16 + swz / 64; C = (st & 1) * 32 + (swz % 64) / 2; }
__device__ __forceinline__ int perm32(int rho) { const int n = rho >> 4, i = rho & 15; return 8 * (i >> 2) + 4 * n + (i & 3); }
struct Unit { int pm, pn; };
struct Gemm { const bf16_t* A; const bf16_t* Bt; int M, N, K; };
struct StaticOrder {
    int nM, nN, nwg, G, c;
    __device__ void init(int M, int N, int G_, int c_) { nM = M / BM; nN = N / BM; nwg = nM * nN; G = G_; c = c_; }
    __device__ bool next(int i, Unit& u) const {
        const long L = (long)i * G + c; if (L >= nwg) return false;
        int wgid = (int)L; { const int q = nwg / NXCD, r = nwg % NXCD, xcd = wgid % NXCD, off = wgid / NXCD; wgid = (xcd < r ? xcd * (q + 1) : r * (q + 1) + (xcd - r) * q) + off; }
        const int nig = WGM * nN, gid = wgid / nig, fm = gid * WGM, gsz = (nM - fm) < WGM ? (nM - fm) : WGM;
        u.pm = fm + ((wgid % nig) % gsz); u.pn = (wgid % nig) / gsz; return true;
    }
};

struct Epi {
    int mode; bf16_t* O; int ldc; const float* base; float* out; const float* gate; const bf16_t* Y; const float* bias;
    __device__ __forceinline__ void operator()(const f32x4 (&acc)[2][2][4][2], const Unit& u, int wr, int wc, int fr, int fq) const {
        if (mode == 4) {
            const int row0 = u.pm * BM + wr * 64 + fr, col0 = u.pn * BM + wc * 32 + 4 * fq;
            const float* gp = gate + (size_t)((u.pm * BM) >> 13) * 6144 + col0;
#pragma unroll
            for (int ai = 0; ai < 2; ++ai)
#pragma unroll
                for (int m = 0; m < 4; ++m) { const size_t off = (size_t)(row0 + ai * HALF + m * 16) * D + col0;
#pragma unroll
                    for (int bj = 0; bj < 2; ++bj)
#pragma unroll
                        for (int n = 0; n < 2; ++n) { const f32x4 gv = *(const f32x4*)(gp + bj * HALF + n * 16); const f32x4 bs = *(const f32x4*)(base + off + bj * HALF + n * 16); *(f32x4*)(out + off + bj * HALF + n * 16) = bs + gv * acc[ai][bj][m][n]; }
                    asm volatile("" ::: "memory"); }
        } else if (mode == 3) {
            const int row0 = u.pm * BM + wr * 64 + fr, col0 = u.pn * BM + wc * 32 + 8 * fq;
#pragma unroll
            for (int bj = 0; bj < 2; ++bj) {
                const f32x4 b0 = *(const f32x4*)(bias + col0 + bj * HALF), b1 = *(const f32x4*)(bias + col0 + bj * HALF + 4);
#pragma unroll
                for (int ai = 0; ai < 2; ++ai)
#pragma unroll
                    for (int m = 0; m < 4; ++m) { const size_t row = (size_t)(row0 + ai * HALF + m * 16);
                        const u32x4 yw = *(const u32x4*)(Y + row * 512 + col0 + bj * HALF); float y[8]; unpack8(yw, y);
                        const f32x4 v0 = acc[ai][bj][m][0] + b0, v1 = acc[ai][bj][m][1] + b1; float o[8];
#pragma unroll
                        for (int j = 0; j < 4; ++j) { o[j] = y[j] * sigmoidf_(v0[j]); o[4 + j] = y[4 + j] * sigmoidf_(v1[j]); }
                        u32x4 w; w.x = pkbf(o[0], o[1]); w.y = pkbf(o[2], o[3]); w.z = pkbf(o[4], o[5]); w.w = pkbf(o[6], o[7]);
                        *(u32x4*)(O + row * D + col0 + bj * HALF) = w; asm volatile("" ::: "memory"); } }
        } else {
            const int row0 = u.pm * BM + wr * 64 + fr, col0 = u.pn * BM + wc * 32 + 8 * fq;
            const bool act2 = (mode == 2) && (u.pn >= 2);
#pragma unroll
            for (int ai = 0; ai < 2; ++ai)
#pragma unroll
                for (int m = 0; m < 4; ++m) { bf16_t* rowp = O + (size_t)(row0 + ai * HALF + m * 16) * ldc + col0;
#pragma unroll
                    for (int bj = 0; bj < 2; ++bj) { f32x4 v0 = acc[ai][bj][m][0], v1 = acc[ai][bj][m][1];
                        if (mode == 1) {
#pragma unroll
                            for (int j = 0; j < 4; ++j) { const float a0 = fmaxf(v0[j], 0.f), a1 = fmaxf(v1[j], 0.f); v0[j] = a0 * a0; v1[j] = a1 * a1; } }
                        if (act2) {
#pragma unroll
                            for (int j = 0; j < 4; ++j) { v0[j] = gelu_tanh(v0[j]); v1[j] = gelu_tanh(v1[j]); } }
                        u32x4 w; w.x = pkbf(v0[0], v0[1]); w.y = pkbf(v0[2], v0[3]); w.z = pkbf(v1[0], v1[1]); w.w = pkbf(v1[2], v1[3]);
                        *(u32x4*)(rowp + bj * HALF) = w; }
                    asm volatile("" ::: "memory"); }
        }
    }
};

__device__ __forceinline__ void gemm_phase(LAS unsigned char* lds, const Gemm g, const StaticOrder& S, const Epi& E) {

    const int tid = otid(), wid = __builtin_amdgcn_readfirstlane(tid >> 6), lane = tid & 63, wr = wid >> 2, wc = wid & 3, fr = lane & 15, fq = lane >> 4;
    const int K = g.K, nt = K / BK;
    unsigned voffA[2], voffB[2];
#pragma unroll
    for (int i = 0; i < 2; ++i) { int R, C; stage_rc(tid * 16 + i * 8192, R, C); const int Rb = (E.mode != 4) ? ((R & ~31) + perm32(R & 31)) : R;
        voffA[i] = (unsigned)(R * K + C) * 2u; voffB[i] = (unsigned)(Rb * K + C) * 2u; }
    const size_t kstep = (size_t)(BK * 2);
    const size_t hstep = (size_t)HALF * K * 2;
    const size_t tstep = 2 * hstep;
    const unsigned ldsw = (unsigned)wid * 1024u;
    const int aoff = lds_byte(wr * 64 + fr, fq * 8), boff = lds_byte(wc * 32 + fr, fq * 8);
#define PG8_SA(b, h) (((b) * 2 + (h)) * HTB)
#define PG8_SB(b, h) ((4 + (b) * 2 + (h)) * HTB)
#define PG8_STAGE(bufoff, gbase, voff) do { _Pragma("unroll") for (int _i = 0; _i < 2; ++_i) \
        __builtin_amdgcn_global_load_lds((const unsigned*)((const char*)(gbase) + (voff)[_i]), (LAS unsigned*)(lds + (bufoff) + ldsw + _i * 8192), 16, 0, 0); } while (0)
#define PG8_LDA(dst, b, h) do { _Pragma("unroll") for (int m = 0; m < 4; ++m) _Pragma("unroll") for (int k = 0; k < 2; ++k) dst[m][k] = *(const LAS bf16x8*)(lds + PG8_SA(b, h) + aoff + m * 2048 + k * 1024); } while (0)
#define PG8_LDB(dst, b, h) do { _Pragma("unroll") for (int n = 0; n < 2; ++n) _Pragma("unroll") for (int k = 0; k < 2; ++k) dst[n][k] = *(const LAS bf16x8*)(lds + PG8_SB(b, h) + boff + n * 2048 + k * 1024); } while (0)
#define PG8_MMA(ai, bj, At, Bt) do { __builtin_amdgcn_s_setprio(1); _Pragma("unroll") for (int m = 0; m < 4; ++m) _Pragma("unroll") for (int n = 0; n < 2; ++n) _Pragma("unroll") for (int k = 0; k < 2; ++k) \
        acc[ai][bj][m][n] = __builtin_amdgcn_mfma_f32_16x16x32_bf16(Bt[n][k], At[m][k], acc[ai][bj][m][n], 0, 0, 0); __builtin_amdgcn_s_setprio(0); } while (0)
#define PG8_WAIT_V(n) asm volatile("s_waitcnt vmcnt(" #n ")" ::: "memory")
#define PG8_WAIT_L(n) asm volatile("s_waitcnt lgkmcnt(" #n ")" ::: "memory")
#define PG8_BAR __builtin_amdgcn_s_barrier()
#define PG8_SCHED __builtin_amdgcn_sched_barrier(0)
    Unit cur, nxt; int ui = 0;
    if (!S.next(0, cur)) return;
    f32x4 acc[2][2][4][2];
#pragma unroll
    for (int a = 0; a < 2; ++a)
#pragma unroll
        for (int b = 0; b < 2; ++b)
#pragma unroll
            for (int m = 0; m < 4; ++m)
#pragma unroll
                for (int n = 0; n < 2; ++n) acc[a][b][m][n] = (f32x4){0.f, 0.f, 0.f, 0.f};
    bf16x8 At[4][2], B0[2][2], B1[2][2];
    const char* cA = (const char*)g.A + (size_t)cur.pm * tstep; const char* cB = (const char*)g.Bt + (size_t)cur.pn * tstep;
    PG8_STAGE(PG8_SB(0, 0), cB, voffB); PG8_STAGE(PG8_SA(0, 0), cA, voffA); PG8_STAGE(PG8_SB(0, 1), cB + hstep, voffB); PG8_STAGE(PG8_SA(0, 1), cA + hstep, voffA);
    if (wr == 1) PG8_BAR;
    PG8_WAIT_V(4); PG8_BAR;
    PG8_STAGE(PG8_SB(1, 0), cB + kstep, voffB); PG8_STAGE(PG8_SA(1, 0), cA + kstep, voffA); PG8_STAGE(PG8_SB(1, 1), cB + hstep + kstep, voffB);
    PG8_WAIT_V(6); PG8_BAR;
    for (;;) {
        const bool has_next = S.next(ui + 1, nxt);
        const char* nA = has_next ? (const char*)g.A + (size_t)nxt.pm * tstep : cA; const char* nB = has_next ? (const char*)g.Bt + (size_t)nxt.pn * tstep : cB;
        for (int t = 0; t < nt; t += 2) {
            const bool last = (t == nt - 2);
            const char* a1 = cA + (size_t)(t + 1) * kstep;
            const char* a2 = last ? nA : cA + (size_t)(t + 2) * kstep; const char* b2 = last ? nB : cB + (size_t)(t + 2) * kstep;
            const char* a3 = a2 + kstep; const char* b3 = b2 + kstep;
            PG8_LDB(B0, 0, 0); PG8_SCHED; PG8_LDA(At, 0, 0); PG8_STAGE(PG8_SA(1, 1), a1 + hstep, voffA);
            PG8_WAIT_L(8); PG8_BAR; PG8_WAIT_L(0); PG8_MMA(0, 0, At, B0); PG8_BAR; PG8_SCHED;
            PG8_LDB(B1, 0, 1); PG8_STAGE(PG8_SB(0, 0), b2, voffB);
            PG8_BAR; PG8_WAIT_L(0); PG8_MMA(0, 1, At, B1); PG8_BAR;
            PG8_LDA(At, 0, 1); PG8_STAGE(PG8_SA(0, 0), a2, voffA);
            PG8_BAR; PG8_WAIT_L(0); PG8_MMA(1, 0, At, B0); PG8_BAR; PG8_SCHED;
            PG8_STAGE(PG8_SB(0, 1), b2 + hstep, voffB);
            PG8_WAIT_V(6); PG8_BAR; PG8_MMA(1, 1, At, B1); PG8_BAR;
            PG8_LDB(B0, 1, 0); PG8_SCHED; PG8_LDA(At, 1, 0); PG8_STAGE(PG8_SA(0, 1), a2 + hstep, voffA);
            PG8_WAIT_L(8); PG8_BAR; PG8_WAIT_L(0); PG8_MMA(0, 0, At, B0); PG8_BAR; PG8_SCHED;
            PG8_LDB(B1, 1, 1); PG8_STAGE(PG8_SB(1, 0), b3, voffB);
            PG8_BAR; PG8_WAIT_L(0); PG8_MMA(0, 1, At, B1); PG8_BAR;
            PG8_LDA(At, 1, 1); PG8_STAGE(PG8_SA(1, 0), a3, voffA);
            PG8_BAR; PG8_WAIT_L(0); PG8_MMA(1, 0, At, B0); PG8_BAR; PG8_SCHED;
            PG8_STAGE(PG8_SB(1, 1), b3 + hstep, voffB);
            PG8_WAIT_V(6); PG8_BAR; PG8_MMA(1, 1, At, B1); PG8_BAR;
        }
        E(acc, cur, wr, wc, fr, fq);
        if (!has_next) break;
#pragma unroll
        for (int a = 0; a < 2; ++a)
#pragma unroll
            for (int b = 0; b < 2; ++b)
#pragma unroll
                for (int m = 0; m < 4; ++m)
#pragma unroll
                    for (int n = 0; n < 2; ++n) acc[a][b][m][n] = (f32x4){0.f, 0.f, 0.f, 0.f};
        cur = nxt; cA = nA; cB = nB; ++ui;
    }
    PG8_WAIT_V(0);
    if (wr == 0) PG8_BAR;
    PG8_BAR;
#undef PG8_SA
#undef PG8_SB
#undef PG8_STAGE
#undef PG8_LDA
#undef PG8_LDB
#undef PG8_MMA
#undef PG8_WAIT_V
#undef PG8_WAIT_L
#undef PG8_BAR
#undef PG8_SCHED
}

}

__device__ __forceinline__ void tr_item(const float* W, int ldw, int ncol0, int K, int nblk, bf16_t* WT, int row_off, LAS float* scr, int item, int lane) {
    const int kb = item / nblk, nb = item % nblk, k0 = 64 * kb, n0 = 32 * nb;
#pragma unroll 8
    for (int i = 0; i < 32; ++i) { const int kk = 2 * i + (lane >> 5); scr[kk * 33 + (lane & 31)] = W[(size_t)(k0 + kk) * ldw + ncol0 + n0 + (lane & 31)]; }
    LDS_WAIT();
    const int c = lane & 7;
#pragma unroll
    for (int j = 0; j < 4; ++j) { const int n = (lane >> 3) + 8 * j; const LAS float* s = scr + (8 * c) * 33 + n;
        u32x4 o; o.x = pkbf(s[0 * 33], s[1 * 33]); o.y = pkbf(s[2 * 33], s[3 * 33]); o.z = pkbf(s[4 * 33], s[5 * 33]); o.w = pkbf(s[6 * 33], s[7 * 33]);
        *(u32x4*)(WT + (size_t)(row_off + n0 + n) * K + k0 + 8 * c) = o; }
    LDS_WAIT();
}

__device__ __forceinline__ void p0_prologue(const Args& a, LAS unsigned char* lds) {
    const int tid = otid(), lane = tid & 63, wave = __builtin_amdgcn_readfirstlane(tid >> 6);
    unsigned char* ws = a.ws;
    if (blockIdx.x < 192) {
        LAS float* cact = (LAS float*)lds;
        LAS float* red = (LAS float*)(lds + 32768);
        const float* c = a.in[1];
        for (int i = tid; i < 8192; i += NT) cact[i] = siluf_(c[i]);
        __syncthreads();
        const int item = blockIdx.x, layer = item / 96, e = 64 * (item % 96) + lane;
        const float* wp = a.in[2] + (size_t)layer * D * 6144 + e;
        float acc[8];
#pragma unroll
        for (int b = 0; b < 8; ++b) acc[b] = 0.f;
        for (int k0 = wave * 128; k0 < wave * 128 + 128; k0 += 8) {
            float wv[8];
#pragma unroll
            for (int i = 0; i < 8; ++i) wv[i] = wp[(size_t)(k0 + i) * 6144];
#pragma unroll
            for (int i = 0; i < 8; ++i)
#pragma unroll
                for (int b = 0; b < 8; ++b) acc[b] += cact[b * 1024 + k0 + i] * wv[i];
        }
#pragma unroll
        for (int b = 0; b < 8; ++b) red[(wave * 8 + b) * 64 + lane] = acc[b];
        __syncthreads();
        { const int b = tid >> 6; float s = 0.f;
#pragma unroll
          for (int w = 0; w < 8; ++w) s += red[(w * 8 + b) * 64 + lane];
          ((float*)(ws + WS_MOD))[(size_t)(layer * 8 + b) * 6144 + e] = s + a.in[3][layer * 6144 + e]; }
        __syncthreads();
    }
    {
        LAS float* scr = (LAS float*)(lds + wave * 16384);
        const int gw = blockIdx.x * 8 + wave, NGW = gridDim.x * 8;
        constexpr int I0 = 16 * 64, I1 = 16 * 48, I2 = 16 * 32, I3 = 16 * 128, I4 = 64 * 32, I5 = 16 * 48, I6 = 16 * 32, I7 = 8 * 16, I8 = I3, I9 = I4;
        constexpr int NIT = I0 + I1 + I2 + I3 + I4 + I5 + I6 + I7 + I8 + I9;
        for (int it = gw; it < NIT; it += NGW) {
            int r = it;
            if (r < I0) { tr_item(a.in[4], 3608, 0, 1024, 64, (bf16_t*)(ws + WS_WIN0), 0, scr, r, lane); continue; } r -= I0;
            if (r < I1) { tr_item(a.in[4], 3608, 2064, 1024, 48, (bf16_t*)(ws + WS_WIN0), 2048, scr, r, lane); continue; } r -= I1;
            if (r < I2) { tr_item(a.in[5], 1024, 0, 1024, 32, (bf16_t*)(ws + WS_WOUT0), 0, scr, r, lane); continue; } r -= I2;
            if (r < I3) { tr_item(a.in[28], 4096, 0, 1024, 128, (bf16_t*)(ws + WS_W1_0), 0, scr, r, lane); continue; } r -= I3;
            if (r < I4) { tr_item(a.in[29], 1024, 0, 4096, 32, (bf16_t*)(ws + WS_W2_0), 0, scr, r, lane); continue; } r -= I4;
            if (r < I5) { tr_item(a.in[12], 1536, 0, 1024, 48, (bf16_t*)(ws + WS_WIN1), 0, scr, r, lane); continue; } r -= I5;
            if (r < I6) { tr_item(a.in[13], 1024, 0, 1024, 32, (bf16_t*)(ws + WS_WOUT1), 0, scr, r, lane); continue; } r -= I6;
            if (r < I7) { tr_item(a.in[22], 512, 0, 512, 16, (bf16_t*)(ws + WS_WGLU), 0, scr, r, lane); continue; } r -= I7;
            if (r < I8) { tr_item(a.in[28] + (size_t)D * FFD, 4096, 0, 1024, 128, (bf16_t*)(ws + WS_W1_1), 0, scr, r, lane); continue; } r -= I8;
            tr_item(a.in[29] + (size_t)D * FFD, 1024, 0, 4096, 32, (bf16_t*)(ws + WS_W2_1), 0, scr, r, lane);
        }
    }
    {
        if (blockIdx.x == 0 && tid == 0) { unsigned* ctl = (unsigned*)(ws + WS_CTL); __hip_atomic_store(ctl, 0u, __ATOMIC_RELAXED, __HIP_MEMORY_SCOPE_AGENT); __hip_atomic_store(ctl + 64, 0u, __ATOMIC_RELAXED, __HIP_MEMORY_SCOPE_AGENT); }
        const int gt = blockIdx.x * NT + tid, NGT = gridDim.x * NT;
        bf16_t* win0 = (bf16_t*)(ws + WS_WIN0);
        for (int i = gt; i < 256 * 1024; i += NGT) { const int n = i >> 10, k = i & 1023; float v = 0.f;
            if (n < 16) v = a.in[4][(size_t)k * 3608 + 2048 + n]; else if (n < 24) v = a.in[4][(size_t)k * 3608 + 3600 + (n - 16)];
            win0[(size_t)(3584 + n) * 1024 + k] = (bf16_t)(pkbf(v, 0.f) & 0xffffu); }
        bf16_t* wsb = (bf16_t*)(ws + WS_WSB);
        for (int i = gt; i < 8 * 128 * 128; i += NGT) { const int t = (i >> 7) & 127, s = i & 127; const float v = (s <= t) ? a.in[26][i] : 0.f; wsb[i] = (bf16_t)(pkbf(v, 0.f) & 0xffffu); }
        { float* prm = (float*)(ws + WS_PRM);
          for (int i = gt; i < 8192; i += NGT) prm[PR_WLR + i] = a.in[6][i];
          for (int i = gt; i < 1024; i += NGT) prm[PR_BS + i] = a.in[27][i];
          for (int i = gt; i < 512; i += NGT) { prm[PR_BLR + i] = a.in[7][i]; prm[PR_GGAIN + i] = a.in[8][i]; prm[PR_QG + i] = a.in[10][i]; prm[PR_KG + i] = a.in[11][i]; prm[PR_S5D + i] = a.in[21][i];
              prm[PR_BGLU + i] = a.in[23][i]; prm[PR_LNG + i] = a.in[24][i]; prm[PR_LNB + i] = a.in[25][i]; }
          for (int i = gt; i < 8; i += NGT) prm[PR_BF + i] = a.in[9][i]; }
        float* abar = (float*)(ws + WS_S5P + S5_ABAR); bf16_t* Bb = (bf16_t*)(ws + WS_S5P + S5_BB); bf16_t* Cm = (bf16_t*)(ws + WS_S5P + S5_CM);
        for (int i = gt; i < 32 * 64; i += NGT) { const int g = i >> 6, p = i & 63;
            const float lr = a.in[14][i], li = a.in[15][i], dt = expf(a.in[16][g]);
            const float mag = expf(lr * dt), ang = li * dt, ar = mag * cosf(ang), ai = mag * sinf(ang), den = lr * lr + li * li;
            const float cr = ((ar - 1.0f) * lr + ai * li) / den, ci = (ai * lr - (ar - 1.0f) * li) / den;
            abar[2 * i] = ar; abar[2 * i + 1] = ai;
            for (int k = 0; k < 16; ++k) { const float br = a.in[17][(size_t)i * 16 + k], bi = a.in[18][(size_t)i * 16 + k];
                Bb[((size_t)g * 128 + p) * 16 + k] = (bf16_t)(pkbf(cr * br - ci * bi, 0.f) & 0xffffu);
                Bb[((size_t)g * 128 + 64 + p) * 16 + k] = (bf16_t)(pkbf(cr * bi + ci * br, 0.f) & 0xffffu); } }
        for (int i = gt; i < 32 * 16 * 64; i += NGT) { const int gi = i >> 6, p = i & 63;
            Cm[(size_t)gi * 128 + p] = (bf16_t)(pkbf(a.in[19][i], 0.f) & 0xffffu); Cm[(size_t)gi * 128 + 64 + p] = (bf16_t)(pkbf(-a.in[20][i], 0.f) & 0xffffu); }
    }
}

__device__ __forceinline__ void norm_phase(const float* x, const float* mod, int off_sh, int off_sc, bf16_t* H) {
    const int tid_ = otid(); const int lane = tid_ & 63, gw = blockIdx.x * 8 + (tid_ >> 6), NGW = gridDim.x * 8;
    for (int m = gw; m < T; m += NGW) {
        const f32x4* xr = (const f32x4*)(x + (size_t)m * D) + lane;
        const float* mp = mod + (size_t)(m >> 13) * 6144;
        f32x4 v[4]; float s = 0.f;
#pragma unroll
        for (int j = 0; j < 4; ++j) { v[j] = xr[64 * j]; s += (v[j].x * v[j].x + v[j].y * v[j].y) + (v[j].z * v[j].z + v[j].w * v[j].w); }
#pragma unroll
        for (int o = 1; o < 64; o <<= 1) s += __shfl_xor(s, o);
        const float r = rsqrtf(s * (1.0f / D) + EPS);
        u32x2* o8 = (u32x2*)(H + (size_t)m * D) + lane;
#pragma unroll
        for (int j = 0; j < 4; ++j) { const f32x4 sc = *((const f32x4*)(mp + off_sc) + lane + 64 * j), sh = *((const f32x4*)(mp + off_sh) + lane + 64 * j);
            const f32x4 y = v[j] * r * (sc + 1.0f) + sh; u32x2 w; w.x = pkbf(y.x, y.y); w.y = pkbf(y.z, y.w); o8[64 * j] = w; }
    }
}

__device__ __forceinline__ void cum_phase(unsigned char* ws, LAS unsigned char* lds) {
    if (blockIdx.x >= 8) return;
    const int b = blockIdx.x, tid = otid(), lane = tid & 63, wave = tid >> 6;
    const bf16_t* P0 = (const bf16_t*)(ws + WS_BIG); float* cum = (float*)(ws + WS_CUM);
    LAS float* wt = (LAS float*)lds;
    float bf[8];
#pragma unroll
    for (int h = 0; h < 8; ++h) bf[h] = ((const float*)(ws + WS_PRM))[PR_BF + h];
    float run[8];
#pragma unroll
    for (int h = 0; h < 8; ++h) run[h] = 0.f;
    const size_t m0 = (size_t)b * SEQ + 16 * tid;
    for (int i = 0; i < 16; ++i) { const u32x4 w = *(const u32x4*)(P0 + (m0 + i) * LD0 + C_FF); float f[8]; unpack8(w, f);
#pragma unroll
        for (int h = 0; h < 8; ++h) run[h] += logsig(f[h] + bf[h]); }
    float incl[8];
#pragma unroll
    for (int h = 0; h < 8; ++h) { float v = run[h];
#pragma unroll
        for (int d = 1; d < 64; d <<= 1) { const float o = __shfl_up(v, d); if (lane >= d) v += o; }
        incl[h] = v; }
    if (lane == 63) {
#pragma unroll
        for (int h = 0; h < 8; ++h) wt[wave * 8 + h] = incl[h]; }
    __syncthreads();
    float off[8];
#pragma unroll
    for (int h = 0; h < 8; ++h) { float o = incl[h] - run[h]; for (int w = 0; w < wave; ++w) o += wt[w * 8 + h]; off[h] = o; }
    for (int i = 0; i < 16; ++i) { const u32x4 w = *(const u32x4*)(P0 + (m0 + i) * LD0 + C_FF); float f[8]; unpack8(w, f);
#pragma unroll
        for (int h = 0; h < 8; ++h) { off[h] += logsig(f[h] + bf[h]); cum[(size_t)(b * 8 + h) * SEQ + 16 * tid + i] = off[h]; } }
}

__device__ __forceinline__ int q_next(unsigned* ctr, LAS int* slot) {
    __syncthreads();
    if (threadIdx.x == 0) *slot = (int)atomicAdd(ctr, 1u);
    __syncthreads();
    return *slot;
}

__device__ __forceinline__ void gla_item(unsigned char* ws, LAS unsigned char* lds, int b, int h) {
    const int tid = otid(), lane = tid & 63, w = __builtin_amdgcn_readfirstlane(tid >> 6), c = lane & 15, q = lane >> 4;
    const bf16_t* P0 = (const bf16_t*)(ws + WS_BIG); bf16_t* MIX = (bf16_t*)(ws + WS_MIX);
    LAS bf16_t* Qp = (LAS bf16_t*)(lds); LAS bf16_t* Kp = (LAS bf16_t*)(lds + 9216); LAS bf16_t* Kt = (LAS bf16_t*)(lds + 18432); LAS bf16_t* Vt = (LAS bf16_t*)(lds + 27648);
    LAS bf16_t* Pm = (LAS bf16_t*)(lds + 36864); LAS bf16_t* St = (LAS bf16_t*)(lds + 46080); LAS float* dec = (LAS float*)(lds + 55296);
    LAS float* wl = (LAS float*)(lds + 55552); LAS float* blr = (LAS float*)(lds + 59648);
    for (int i = tid; i < 2304; i += NT) ((LAS unsigned*)St)[i] = 0u;
    for (int i = tid; i < 1024; i += NT) wl[i] = ((const float*)(ws + WS_PRM))[PR_WLR + (i >> 6) * 512 + 64 * h + (i & 63)];
    if (tid < 64) blr[tid] = ((const float*)(ws + WS_PRM))[PR_BLR + 64 * h + tid];
    float gain[16];
#pragma unroll
    for (int vi = 0; vi < 4; ++vi)
#pragma unroll
        for (int j = 0; j < 4; ++j) gain[vi * 4 + j] = ((const float*)(ws + WS_PRM))[PR_GGAIN + h * 64 + 16 * vi + 4 * q + j];
    f32x4 sacc[4];
#pragma unroll
    for (int vi = 0; vi < 4; ++vi) sacc[vi] = (f32x4){0.f, 0.f, 0.f, 0.f};
    const size_t rowbase = (size_t)b * SEQ;
    u32x4 rq, rk, rv, rl0, rl1;
    { const bf16_t* p = P0 + (rowbase + lane) * LD0; rq = *(const u32x4*)(p + C_GQ + 64 * h + 8 * w); rk = *(const u32x4*)(p + C_GK + 64 * h + 8 * w); rv = *(const u32x4*)(p + C_GV + 64 * h + 8 * w);
      rl0 = *(const u32x4*)(p + C_LR); rl1 = *(const u32x4*)(p + C_LR + 8); }
    __syncthreads();
    for (int ch = 0; ch < 128; ++ch) {
        {
            float glr[16]; unpack8(rl0, glr); unpack8(rl1, glr + 8);
            f32x4 z0 = *(const LAS f32x4*)(blr + 8 * w), z1 = *(const LAS f32x4*)(blr + 8 * w + 4);
#pragma unroll
            for (int r = 0; r < 16; ++r) { const f32x4 w0 = *(const LAS f32x4*)(wl + r * 64 + 8 * w), w1 = *(const LAS f32x4*)(wl + r * 64 + 8 * w + 4); z0 += w0 * glr[r]; z1 += w1 * glr[r]; }
            float bc[8];
#pragma unroll
            for (int j = 0; j < 4; ++j) { bc[j] = logsig(z0[j]) * 0.0625f; bc[4 + j] = logsig(z1[j]) * 0.0625f; }
#pragma unroll
            for (int d = 1; d < 64; d <<= 1) {
#pragma unroll
                for (int j = 0; j < 8; ++j) { const float o = __shfl_up(bc[j], d); if (lane >= d) bc[j] += o; } }
            float qf[8], kf[8]; unpack8(rq, qf); unpack8(rk, kf);
            float qp[8], kp[8], kpp[8], bl[8];
#pragma unroll
            for (int j = 0; j < 8; ++j) { bl[j] = __shfl(bc[j], 63); qp[j] = qf[j] * 0.125f * __expf(bc[j]); kp[j] = kf[j] * __expf(-bc[j]); kpp[j] = kf[j] * __expf(bl[j] - bc[j]); }
            u32x4 wq, wk; wq.x = pkbf(qp[0], qp[1]); wq.y = pkbf(qp[2], qp[3]); wq.z = pkbf(qp[4], qp[5]); wq.w = pkbf(qp[6], qp[7]);
            wk.x = pkbf(kp[0], kp[1]); wk.y = pkbf(kp[2], kp[3]); wk.z = pkbf(kp[4], kp[5]); wk.w = pkbf(kp[6], kp[7]);
            *(LAS u32x4*)(Qp + lane * 72 + 8 * w) = wq; *(LAS u32x4*)(Kp + lane * 72 + 8 * w) = wk;
            const unsigned vv[4] = {rv.x, rv.y, rv.z, rv.w};
#pragma unroll
            for (int j = 0; j < 8; ++j) { Kt[(8 * w + j) * 72 + lane] = (bf16_t)(pkbf(kpp[j], 0.f) & 0xffffu); Vt[(8 * w + j) * 72 + lane] = (bf16_t)((j & 1) ? (vv[j >> 1] >> 16) : (vv[j >> 1] & 0xffffu)); }
            if (lane == 63) {
#pragma unroll
                for (int j = 0; j < 8; ++j) dec[8 * w + j] = __expf(bl[j]); }
        }
        if (ch + 1 < 128) { const bf16_t* p = P0 + (rowbase + 64 * (ch + 1) + lane) * LD0; rq = *(const u32x4*)(p + C_GQ + 64 * h + 8 * w); rk = *(const u32x4*)(p + C_GK + 64 * h + 8 * w); rv = *(const u32x4*)(p + C_GV + 64 * h + 8 * w);
            rl0 = *(const u32x4*)(p + C_LR); rl1 = *(const u32x4*)(p + C_LR + 8); }
        __syncthreads();
        f32x4 oacc[4];
        {
            const int ti = w & 3;
            const bf16x8 qf0 = *(const LAS bf16x8*)(Qp + (16 * ti + c) * 72 + 8 * q), qf1 = *(const LAS bf16x8*)(Qp + (16 * ti + c) * 72 + 8 * q + 32);
#pragma unroll
            for (int u = 0; u < 2; ++u) { const int si = 2 * (w >> 2) + u; f32x4 acc = (f32x4){0.f, 0.f, 0.f, 0.f};
                if (si <= ti) { const bf16x8 k0 = *(const LAS bf16x8*)(Kp + (16 * si + c) * 72 + 8 * q), k1 = *(const LAS bf16x8*)(Kp + (16 * si + c) * 72 + 8 * q + 32);
                    acc = MFMA16(k0, qf0, acc); acc = MFMA16(k1, qf1, acc);
#pragma unroll
                    for (int j = 0; j < 4; ++j) if (16 * si + 4 * q + j > 16 * ti + c) acc[j] = 0.f; }
                u32x2 pw; pw.x = pkbf(acc[0], acc[1]); pw.y = pkbf(acc[2], acc[3]);
                *(LAS u32x2*)(Pm + (16 * ti + c) * 72 + 16 * si + 4 * q) = pw; }
            if (w < 4) {
#pragma unroll
                for (int vi = 0; vi < 4; ++vi) { const bf16x8 s0 = *(const LAS bf16x8*)(St + (16 * vi + c) * 72 + 8 * q), s1 = *(const LAS bf16x8*)(St + (16 * vi + c) * 72 + 8 * q + 32);
                    f32x4 acc = (f32x4){0.f, 0.f, 0.f, 0.f}; acc = MFMA16(s0, qf0, acc); acc = MFMA16(s1, qf1, acc); oacc[vi] = acc; } }
        }
        __syncthreads();
        if (w < 4) {
            const bf16x8 p0 = *(const LAS bf16x8*)(Pm + (16 * w + c) * 72 + 8 * q), p1 = *(const LAS bf16x8*)(Pm + (16 * w + c) * 72 + 8 * q + 32);
            float ssq = 0.f;
#pragma unroll
            for (int vi = 0; vi < 4; ++vi) { const bf16x8 v0 = *(const LAS bf16x8*)(Vt + (16 * vi + c) * 72 + 8 * q), v1 = *(const LAS bf16x8*)(Vt + (16 * vi + c) * 72 + 8 * q + 32);
                oacc[vi] = MFMA16(v0, p0, oacc[vi]); oacc[vi] = MFMA16(v1, p1, oacc[vi]);
#pragma unroll
                for (int j = 0; j < 4; ++j) ssq += oacc[vi][j] * oacc[vi][j]; }
            ssq += __shfl_xor(ssq, 16); ssq += __shfl_xor(ssq, 32);
            const float r = rsqrtf(ssq * (1.0f / 64.0f) + EPS);
            const size_t m = rowbase + 64 * ch + 16 * w + c;
#pragma unroll
            for (int vi = 0; vi < 4; ++vi) { const u32x2 gw = *(const u32x2*)(P0 + m * LD0 + C_GG + 64 * h + 16 * vi + 4 * q);
                const float g0 = bflo(gw.x), g1 = bfhi(gw.x), g2 = bflo(gw.y), g3 = bfhi(gw.y);
                u32x2 ow; ow.x = pkbf(oacc[vi][0] * r * gain[vi * 4 + 0] * siluf_(g0), oacc[vi][1] * r * gain[vi * 4 + 1] * siluf_(g1));
                ow.y = pkbf(oacc[vi][2] * r * gain[vi * 4 + 2] * siluf_(g2), oacc[vi][3] * r * gain[vi * 4 + 3] * siluf_(g3));
                *(u32x2*)(MIX + m * D + 64 * h + 16 * vi + 4 * q) = ow; }
        } else {
            const int ki = w - 4;
            const f32x4 d4 = *(const LAS f32x4*)(dec + 16 * ki + 4 * q);
            const bf16x8 k0 = *(const LAS bf16x8*)(Kt + (16 * ki + c) * 72 + 8 * q), k1 = *(const LAS bf16x8*)(Kt + (16 * ki + c) * 72 + 8 * q + 32);
#pragma unroll
            for (int vi = 0; vi < 4; ++vi) { const bf16x8 v0 = *(const LAS bf16x8*)(Vt + (16 * vi + c) * 72 + 8 * q), v1 = *(const LAS bf16x8*)(Vt + (16 * vi + c) * 72 + 8 * q + 32);
                f32x4 s = sacc[vi] * d4; s = MFMA16(k0, v0, s); s = MFMA16(k1, v1, s); sacc[vi] = s;
                u32x2 sw; sw.x = pkbf(s[0], s[1]); sw.y = pkbf(s[2], s[3]);
                *(LAS u32x2*)(St + (16 * vi + c) * 72 + 16 * ki + 4 * q) = sw; }
        }
        __syncthreads();
    }
}

__device__ __forceinline__ void fox_item(unsigned char* ws, LAS unsigned char* lds, int b, int h, int qi) {
    const int tid = otid(), lane = tid & 63, w = __builtin_amdgcn_readfirstlane(tid >> 6), c = lane & 15, q = lane >> 4;
    const bf16_t* P0 = (const bf16_t*)(ws + WS_BIG); bf16_t* MIX = (bf16_t*)(ws + WS_MIX);
    const float* cumb = (const float*)(ws + WS_CUM) + (size_t)(b * 8 + h) * SEQ;
    LAS bf16_t* Kn = (LAS bf16_t*)(lds); LAS bf16_t* Vt = (LAS bf16_t*)(lds + 9216); LAS float* cumk = (LAS float*)(lds + 18432);
    const float* gq = (const float*)(ws + WS_PRM) + PR_QG + h * 64; const float* gk = (const float*)(ws + WS_PRM) + PR_KG + h * 64;
    float mq = fabsf(gq[lane]), mk = fabsf(gk[lane]);
#pragma unroll
    for (int o = 1; o < 64; o <<= 1) { mq = fmaxf(mq, __shfl_xor(mq, o)); mk = fmaxf(mk, __shfl_xor(mk, o)); }
    const float B2 = 16.0f * mq * mk * 1.001f;
    const int t0 = 128 * qi, t = t0 + 16 * w + c; const size_t rowbase = (size_t)b * SEQ, m = rowbase + t;
    const float cum_t0 = cumb[t0], cum_t = cumb[t];
    bf16x8 qf[2];
    { const u32x4 r0 = *(const u32x4*)(P0 + m * LD0 + C_FQ + 64 * h + 8 * q), r1 = *(const u32x4*)(P0 + m * LD0 + C_FQ + 64 * h + 8 * q + 32);
      float f[16]; unpack8(r0, f); unpack8(r1, f + 8); float ss = 0.f;
#pragma unroll
      for (int e = 0; e < 16; ++e) ss += f[e] * f[e];
      ss += __shfl_xor(ss, 16); ss += __shfl_xor(ss, 32);
      const float r = rsqrtf(ss * (1.0f / 64.0f) + EPS) * 0.125f;
#pragma unroll
      for (int kk = 0; kk < 2; ++kk) { float g[8];
#pragma unroll
          for (int e = 0; e < 8; ++e) g[e] = f[8 * kk + e] * r * gq[8 * q + 32 * kk + e];
          u32x4 pw; pw.x = pkbf(g[0], g[1]); pw.y = pkbf(g[2], g[3]); pw.z = pkbf(g[4], g[5]); pw.w = pkbf(g[6], g[7]); qf[kk] = as_bf16x8(pw); } }
    f32x4 oacc[4];
#pragma unroll
    for (int di = 0; di < 4; ++di) oacc[di] = (f32x4){0.f, 0.f, 0.f, 0.f};
    float mrun = -1e30f, lpart = 0.f;
    const int srow = tid >> 3, dc = tid & 7;
    float gkr[8];
#pragma unroll
    for (int e = 0; e < 8; ++e) gkr[e] = gk[8 * dc + e];
    int j = 2 * qi + 1;
    u32x4 rk, rv; float rc;
    { const size_t ms = rowbase + 64 * j + srow; rk = *(const u32x4*)(P0 + ms * LD0 + C_FK + 64 * h + 8 * dc); rv = *(const u32x4*)(P0 + ms * LD0 + C_FV + 64 * h + 8 * dc); rc = cumb[64 * j + srow]; }
    for (;;) {
        { float f[8]; unpack8(rk, f); float ss = 0.f;
#pragma unroll
          for (int e = 0; e < 8; ++e) ss += f[e] * f[e];
          ss += __shfl_xor(ss, 1); ss += __shfl_xor(ss, 2); ss += __shfl_xor(ss, 4);
          const float r = rsqrtf(ss * (1.0f / 64.0f) + EPS);
#pragma unroll
          for (int e = 0; e < 8; ++e) f[e] = f[e] * r * gkr[e];
          u32x4 pw; pw.x = pkbf(f[0], f[1]); pw.y = pkbf(f[2], f[3]); pw.z = pkbf(f[4], f[5]); pw.w = pkbf(f[6], f[7]);
          *(LAS u32x4*)(Kn + srow * 72 + 8 * dc) = pw;
          const unsigned vv[4] = {rv.x, rv.y, rv.z, rv.w};
#pragma unroll
          for (int e = 0; e < 8; ++e) Vt[(8 * dc + e) * 72 + srow] = (bf16_t)((e & 1) ? (vv[e >> 1] >> 16) : (vv[e >> 1] & 0xffffu));
          if (dc == 0) cumk[srow] = rc; }
        const int jn = j - 1;
        bool cont = jn >= 0;
        if (cont && jn < 2 * qi) cont = (B2 + cum_t0 - cumb[64 * jn + 63]) >= -110.0f;
        if (cont) { const size_t ms = rowbase + 64 * jn + srow; rk = *(const u32x4*)(P0 + ms * LD0 + C_FK + 64 * h + 8 * dc); rv = *(const u32x4*)(P0 + ms * LD0 + C_FV + 64 * h + 8 * dc); rc = cumb[64 * jn + srow]; }
        __syncthreads();
        if (!(j == 2 * qi + 1 && w < 4)) {
            float sv[4][4]; float mx = -1e30f;
#pragma unroll
            for (int si = 0; si < 4; ++si) { f32x4 acc = (f32x4){0.f, 0.f, 0.f, 0.f};
                const bf16x8 k0 = *(const LAS bf16x8*)(Kn + (16 * si + c) * 72 + 8 * q), k1 = *(const LAS bf16x8*)(Kn + (16 * si + c) * 72 + 8 * q + 32);
                acc = MFMA16(k0, qf[0], acc); acc = MFMA16(k1, qf[1], acc);
                const f32x4 ck = *(const LAS f32x4*)(cumk + 16 * si + 4 * q);
#pragma unroll
                for (int jj = 0; jj < 4; ++jj) { float lg = acc[jj] + (cum_t - ck[jj]); if (j >= 2 * qi && (64 * j + 16 * si + 4 * q + jj) > t) lg = -1e30f; sv[si][jj] = lg; mx = fmaxf(mx, lg); } }
            mx = fmaxf(mx, __shfl_xor(mx, 16)); mx = fmaxf(mx, __shfl_xor(mx, 32));
            const float mnew = fmaxf(mrun, mx), alpha = __expf(mrun - mnew); mrun = mnew;
            float ps = 0.f;
#pragma unroll
            for (int si = 0; si < 4; ++si)
#pragma unroll
                for (int jj = 0; jj < 4; ++jj) { sv[si][jj] = __expf(sv[si][jj] - mnew); ps += sv[si][jj]; }
            lpart = lpart * alpha + ps;
#pragma unroll
            for (int di = 0; di < 4; ++di) oacc[di] *= alpha;
#pragma unroll
            for (int kk = 0; kk < 2; ++kk) { u32x4 pw; pw.x = pkbf(sv[2 * kk][0], sv[2 * kk][1]); pw.y = pkbf(sv[2 * kk][2], sv[2 * kk][3]); pw.z = pkbf(sv[2 * kk + 1][0], sv[2 * kk + 1][1]); pw.w = pkbf(sv[2 * kk + 1][2], sv[2 * kk + 1][3]);
                const bf16x8 pf = as_bf16x8(pw);
#pragma unroll
                for (int di = 0; di < 4; ++di) { const u32x2 va = *(const LAS u32x2*)(Vt + (16 * di + c) * 72 + 32 * kk + 4 * q), vb = *(const LAS u32x2*)(Vt + (16 * di + c) * 72 + 32 * kk + 16 + 4 * q);
                    u32x4 vw; vw.x = va.x; vw.y = va.y; vw.z = vb.x; vw.w = vb.y; oacc[di] = MFMA16(as_bf16x8(vw), pf, oacc[di]); } }
        }
        __syncthreads();
        if (!cont) break;
        j = jn;
    }
    float l = lpart; l += __shfl_xor(l, 16); l += __shfl_xor(l, 32);
    const float inv = 1.0f / l;
#pragma unroll
    for (int di = 0; di < 4; ++di) { u32x2 ow; ow.x = pkbf(oacc[di][0] * inv, oacc[di][1] * inv); ow.y = pkbf(oacc[di][2] * inv, oacc[di][3] * inv);
        *(u32x2*)(MIX + m * D + 512 + 64 * h + 16 * di + 4 * q) = ow; }
}

__device__ __forceinline__ void s5_item(unsigned char* ws, LAS unsigned char* lds, int b, int g) {
    const int tid = otid(), lane = tid & 63, w = __builtin_amdgcn_readfirstlane(tid >> 6), c = lane & 15, q = lane >> 4;
    const bf16_t* P1 = (const bf16_t*)(ws + WS_BIG); bf16_t* YS = (bf16_t*)(ws + WS_H);
    const float* abar = (const float*)(ws + WS_S5P + S5_ABAR); const bf16_t* Bb = (const bf16_t*)(ws + WS_S5P + S5_BB); const bf16_t* Cm = (const bf16_t*)(ws + WS_S5P + S5_CM);
    LAS float* bu = (LAS float*)(lds + w * 12800); LAS bf16_t* xs = (LAS bf16_t*)(lds + w * 12800 + 8448); LAS float* E = (LAS float*)(lds + 102400);
    const float ar = abar[(g * 64 + lane) * 2], ai = abar[(g * 64 + lane) * 2 + 1];
    float pr = ar, pi = ai;
#pragma unroll
    for (int i = 0; i < 10; ++i) { const float nr = pr * pr - pi * pi, ni = 2.0f * pr * pi; pr = nr; pi = ni; }
    bf16x8 bfr[8], cfr[4];
    const bf16x8 zero8 = (bf16x8){0, 0, 0, 0, 0, 0, 0, 0};
#pragma unroll
    for (int pt = 0; pt < 8; ++pt) bfr[pt] = (q < 2) ? *(const bf16x8*)(Bb + ((size_t)(g * 128 + 16 * pt + c)) * 16 + 8 * q) : zero8;
#pragma unroll
    for (int kk = 0; kk < 4; ++kk) cfr[kk] = *(const bf16x8*)(Cm + (size_t)(g * 16 + c) * 128 + 32 * kk + 8 * q);
    float dsk[4];
#pragma unroll
    for (int j = 0; j < 4; ++j) dsk[j] = ((const float*)(ws + WS_PRM))[PR_S5D + g * 16 + 4 * q + j];
    float xr = 0.f, xi = 0.f;
    for (int pass = 0; pass < 2; ++pass) {
        for (int sc = 0; sc < 64; ++sc) {
            const size_t m = (size_t)b * SEQ + 1024 * w + 16 * sc + c;
            const bf16x8 uf = (q < 2) ? *(const bf16x8*)(P1 + m * LD1 + 16 * g + 8 * q) : zero8;
#pragma unroll
            for (int pt = 0; pt < 8; ++pt) { f32x4 acc = (f32x4){0.f, 0.f, 0.f, 0.f}; acc = MFMA16(bfr[pt], uf, acc); *(LAS f32x4*)(bu + c * 132 + 16 * pt + 4 * q) = acc; }
            LDS_WAIT();
#pragma unroll
            for (int tt = 0; tt < 16; ++tt) { const float br = bu[tt * 132 + lane], bi = bu[tt * 132 + 64 + lane];
                const float nr = ar * xr - ai * xi + br, ni = ar * xi + ai * xr + bi; xr = nr; xi = ni;
                if (pass) { xs[tt * 136 + lane] = (bf16_t)(pkbf(xr, 0.f) & 0xffffu); xs[tt * 136 + 64 + lane] = (bf16_t)(pkbf(xi, 0.f) & 0xffffu); } }
            if (pass) {
                LDS_WAIT();
                f32x4 acc = (f32x4){0.f, 0.f, 0.f, 0.f};
#pragma unroll
                for (int kk = 0; kk < 4; ++kk) { const bf16x8 xf = *(const LAS bf16x8*)(xs + c * 136 + 32 * kk + 8 * q); acc = MFMA16(cfr[kk], xf, acc); }
                const u32x2 uw = *(const u32x2*)(P1 + m * LD1 + 16 * g + 4 * q);
                const float y0 = gelu_tanh(acc[0] + dsk[0] * bflo(uw.x)), y1 = gelu_tanh(acc[1] + dsk[1] * bfhi(uw.x)), y2 = gelu_tanh(acc[2] + dsk[2] * bflo(uw.y)), y3 = gelu_tanh(acc[3] + dsk[3] * bfhi(uw.y));
                u32x2 ow; ow.x = pkbf(y0, y1); ow.y = pkbf(y2, y3);
                *(u32x2*)(YS + m * 512 + 16 * g + 4 * q) = ow;
            }
            LDS_WAIT();
        }
        if (pass == 0) {
            E[w * 128 + lane] = xr; E[w * 128 + 64 + lane] = xi;
            __syncthreads();
            float cr = 0.f, ci = 0.f;
            for (int w2 = 0; w2 < w; ++w2) { const float er = E[w2 * 128 + lane], ei = E[w2 * 128 + 64 + lane]; const float nr = pr * cr - pi * ci + er, ni = pr * ci + pi * cr + ei; cr = nr; ci = ni; }
            xr = cr; xi = ci;
        }
    }
}

__device__ __forceinline__ void sgu_item(unsigned char* ws, LAS unsigned char* lds, int b, int n) {
    const int tid = otid(), lane = tid & 63, w = __builtin_amdgcn_readfirstlane(tid >> 6), c = lane & 15, q = lane >> 4;
    const bf16_t* P1 = (const bf16_t*)(ws + WS_BIG); bf16_t* MIX = (bf16_t*)(ws + WS_MIX); const bf16_t* wsb = (const bf16_t*)(ws + WS_WSB);
    LAS bf16_t* Vt = (LAS bf16_t*)lds;
    const size_t m0 = (size_t)b * SEQ + 128 * n;
    {
        const int s = tid >> 2, qq = tid & 3; const bf16_t* vp = P1 + (m0 + s) * LD1 + 1024 + 128 * qq;
        u32x4 rv[16]; float sum = 0.f, ssq = 0.f;
#pragma unroll
        for (int i = 0; i < 16; ++i) { rv[i] = *(const u32x4*)(vp + 8 * i); float f[8]; unpack8(rv[i], f);
#pragma unroll
            for (int e = 0; e < 8; ++e) { sum += f[e]; ssq += f[e] * f[e]; } }
        sum += __shfl_xor(sum, 1); sum += __shfl_xor(sum, 2); ssq += __shfl_xor(ssq, 1); ssq += __shfl_xor(ssq, 2);
        const float mu = sum * (1.0f / 512.0f), var = fmaxf(ssq * (1.0f / 512.0f) - mu * mu, 0.f), rstd = rsqrtf(var + EPS);
        const float* lg = (const float*)(ws + WS_PRM) + PR_LNG + 128 * qq; const float* lb = (const float*)(ws + WS_PRM) + PR_LNB + 128 * qq;
#pragma unroll
        for (int i = 0; i < 16; ++i) { float f[8]; unpack8(rv[i], f);
            const f32x4 g0 = *(const f32x4*)(lg + 8 * i), g1 = *(const f32x4*)(lg + 8 * i + 4), b0 = *(const f32x4*)(lb + 8 * i), b1 = *(const f32x4*)(lb + 8 * i + 4);
#pragma unroll
            for (int e = 0; e < 8; ++e) { const float gg = e < 4 ? g0[e & 3] : g1[e & 3], bb = e < 4 ? b0[e & 3] : b1[e & 3]; const float y = (f[e] - mu) * rstd * gg + bb;
                Vt[(128 * qq + 8 * i + e) * 136 + s] = (bf16_t)(pkbf(y, 0.f) & 0xffffu); } }
    }
    __syncthreads();
    const int nk = (w >> 1) + 1; const int trow = 16 * w + c; const size_t m = m0 + trow;
    for (int g = 0; g < 8; ++g) {
        f32x4 acc[4];
#pragma unroll
        for (int ct = 0; ct < 4; ++ct) acc[ct] = (f32x4){0.f, 0.f, 0.f, 0.f};
        for (int kk = 0; kk < nk; ++kk) { const bf16x8 wf = *(const bf16x8*)(wsb + ((size_t)g * 128 + trow) * 128 + 32 * kk + 8 * q);
#pragma unroll
            for (int ct = 0; ct < 4; ++ct) { const bf16x8 vf = *(const LAS bf16x8*)(Vt + (64 * g + 16 * ct + c) * 136 + 32 * kk + 8 * q); acc[ct] = MFMA16(vf, wf, acc[ct]); } }
        const float bs = ((const float*)(ws + WS_PRM))[PR_BS + g * 128 + trow];
#pragma unroll
        for (int ct = 0; ct < 4; ++ct) { const u32x2 uw = *(const u32x2*)(P1 + m * LD1 + 512 + 64 * g + 16 * ct + 4 * q);
            u32x2 ow; ow.x = pkbf(bflo(uw.x) * (acc[ct][0] + bs), bfhi(uw.x) * (acc[ct][1] + bs)); ow.y = pkbf(bflo(uw.y) * (acc[ct][2] + bs), bfhi(uw.y) * (acc[ct][3] + bs));
            *(u32x2*)(MIX + m * D + 512 + 64 * g + 16 * ct + 4 * q) = ow; }
    }
}

__device__ __forceinline__ void grid_bar(unsigned* bar, unsigned k) {
    __builtin_amdgcn_fence(__ATOMIC_RELEASE, "agent"); asm volatile("s_waitcnt vmcnt(0) lgkmcnt(0)" ::: "memory");
    __syncthreads();
    if (threadIdx.x == 0) {
        const unsigned target = (k + 1u) * gridDim.x;
        __hip_atomic_fetch_add(bar, 1u, __ATOMIC_RELEASE, __HIP_MEMORY_SCOPE_AGENT);
        while (__hip_atomic_load(bar, __ATOMIC_RELAXED, __HIP_MEMORY_SCOPE_AGENT) < target) __builtin_amdgcn_s_sleep(2);
    }
    __syncthreads();
    __builtin_amdgcn_fence(__ATOMIC_ACQUIRE, "agent"); asm volatile("s_waitcnt vmcnt(0)" ::: "memory");
}
#define GSYNC(k) grid_bar((unsigned*)(a.ws + WS_CTL) + 128, (unsigned)(k))
__global__ void __launch_bounds__(NT, 2) mega_fwd(Args a) {
    extern __shared__ __attribute__((aligned(16))) unsigned char lds_raw[];
    LAS unsigned char* lds = (LAS unsigned char*)lds_raw;
    cg::grid_group grid = cg::this_grid();
    LAS int* slot = (LAS int*)(lds + LDS_BYTES - 64);
    grid.sync();
#ifndef NO_P0
    p0_prologue(a, lds);
#endif
    GSYNC(0);
    unsigned char* const ws0 = a.ws; const float* const x00 = a.in[0]; float* const xout0 = a.out;
#ifndef LAST_PH
#define LAST_PH 16
#endif
    for (int ph = 1; ph <= LAST_PH; ++ph) {
        unsigned char* ws = ws0; const float* x0 = x00; float* xout = xout0;
        asm volatile("" : "+s"(ws), "+s"(x0), "+s"(xout));

        const float* mod = (const float*)(ws + WS_MOD);
        bf16_t* H = (bf16_t*)(ws + WS_H); bf16_t* MIX = (bf16_t*)(ws + WS_MIX); bf16_t* BIG = (bf16_t*)(ws + WS_BIG);
        unsigned* ctl = (unsigned*)(ws + WS_CTL);
        const int layer = ph >= 9;
        const float* modl = mod + (size_t)layer * 8 * 6144;
        const float* xin = (layer == 0) ? x0 : xout;
        pg8::Gemm g{nullptr, nullptr, T, 0, 0}; pg8::Epi E{0, nullptr, 0, nullptr, nullptr, nullptr, nullptr, nullptr};
        switch (ph) {
#ifndef NO_NORM
        case 1: case 9: norm_phase(xin, modl, 0, 1024, H); break;
        case 6: case 14: norm_phase(xout, modl, 3072, 4096, H); break;
#endif
#ifndef NO_CUM
        case 3: cum_phase(ws, lds); break;
#endif
        case 4:
            for (;;) { const int it = q_next(ctl, slot); if (it >= 64 + 4096) break;

#ifndef NO_GLA
                if (it < 64) gla_item(ws, lds, it >> 3, it & 7);
#endif
#ifndef NO_FOX
                if (it >= 64) { const int f = it - 64; fox_item(ws, lds, f >> 9, (f >> 6) & 7, f & 63); }
#endif
 }
            break;
        case 11:
            for (;;) { const int it = q_next(ctl + 64, slot); if (it >= 256 + 512) break;

#ifndef NO_S5
                if (it < 256) s5_item(ws, lds, it >> 5, it & 31);
#endif
#ifndef NO_SGU
                if (it >= 256) { const int f = it - 256; sgu_item(ws, lds, f >> 6, f & 63); }
#endif
 }
            break;
        case 2: g.A = H; g.Bt = (const bf16_t*)(ws + WS_WIN0); g.N = LD0; g.K = D; E.mode = 0; E.O = BIG; E.ldc = LD0; break;
        case 5: g.A = MIX; g.Bt = (const bf16_t*)(ws + WS_WOUT0); g.N = D; g.K = D; E.mode = 4; E.base = xin; E.out = xout; E.gate = modl + 2048; break;
        case 7: g.A = H; g.Bt = (const bf16_t*)(ws + WS_W1_0); g.N = FFD; g.K = D; E.mode = 1; E.O = BIG; E.ldc = FFD; break;
        case 8: g.A = BIG; g.Bt = (const bf16_t*)(ws + WS_W2_0); g.N = D; g.K = FFD; E.mode = 4; E.base = xout; E.out = xout; E.gate = modl + 5120; break;
        case 10: g.A = H; g.Bt = (const bf16_t*)(ws + WS_WIN1); g.N = LD1; g.K = D; E.mode = 2; E.O = BIG; E.ldc = LD1; break;
        case 12: g.A = H; g.Bt = (const bf16_t*)(ws + WS_WGLU); g.N = 512; g.K = 512; E.mode = 3; E.O = MIX; E.Y = H; E.bias = (const float*)(ws + WS_PRM) + PR_BGLU; break;
        case 13: g.A = MIX; g.Bt = (const bf16_t*)(ws + WS_WOUT1); g.N = D; g.K = D; E.mode = 4; E.base = xout; E.out = xout; E.gate = modl + 2048; break;
        case 15: g.A = H; g.Bt = (const bf16_t*)(ws + WS_W1_1); g.N = FFD; g.K = D; E.mode = 1; E.O = BIG; E.ldc = FFD; break;
        case 16: g.A = BIG; g.Bt = (const bf16_t*)(ws + WS_W2_1); g.N = D; g.K = FFD; E.mode = 4; E.base = xout; E.out = xout; E.gate = modl + 5120; break;
        default: break;
        }
#ifndef NO_GEMM
        if (g.K != 0) { pg8::StaticOrder S; S.init(T, g.N, gridDim.x, blockIdx.x); pg8::gemm_phase(lds, g, S, E); }
#endif
        if (ph != LAST_PH) GSYNC(ph);
    }
}

extern "C" void kernel_launch(void* const* d_in, const int* in_sizes, int n_in, void* d_out, int out_size, void* d_ws, size_t ws_size, hipStream_t stream) {
    static int grid = 0;
    if (grid == 0) {
        if (n_in != 30 || out_size != T * D || ws_size < WS_END) { fprintf(stderr, "kernel_launch: unexpected shapes (n_in %d out %d ws %zu)\n", n_in, out_size, ws_size); grid = -1; return; }
        int dev = 0, cus = 0, per_cu = 0;
        hipGetDevice(&dev); hipDeviceGetAttribute(&cus, hipDeviceAttributeMultiprocessorCount, dev);
        hipFuncSetAttribute((const void*)mega_fwd, hipFuncAttributeMaxDynamicSharedMemorySize, LDS_BYTES);
        hipOccupancyMaxActiveBlocksPerMultiprocessor(&per_cu, (const void*)mega_fwd, NT, LDS_BYTES);
        if (per_cu < 1) { fprintf(stderr, "kernel_launch: occupancy query says %d blocks/CU\n", per_cu); per_cu = 1; }
        grid = cus * 1;
        (void)hipGetLastError();
    }
    if (grid < 0) return;
    (void)hipMemsetAsync((char*)d_ws + WS_CTL, 0, 4096, stream);
    Args a{};
    for (int i = 0; i < 30; ++i) a.in[i] = (const float*)d_in[i];
    a.out = (float*)d_out; a.ws = (unsigned char*)d_ws;
    void* args[] = {&a};
    hipError_t e = hipLaunchCooperativeKernel((const void*)mega_fwd, dim3(grid), dim3(NT), args, LDS_BYTES, stream);
    if (e != hipSuccess) fprintf(stderr, "cooperative launch failed: %s (grid %d)\n", hipGetErrorString(e), grid);
}
```

```cpp
#include <hip/hip_runtime.h>
#include <hip/hip_cooperative_groups.h>
#include <cstdio>
namespace cg = cooperative_groups;

#define LAS __attribute__((address_space(3)))
#define GAS __attribute__((address_space(1)))
typedef unsigned short bf16_t;
typedef short bf16x8 __attribute__((ext_vector_type(8)));
typedef short bf16x4 __attribute__((ext_vector_type(4)));
typedef float f32x4 __attribute__((ext_vector_type(4)));
typedef float f32x2 __attribute__((ext_vector_type(2)));
typedef unsigned u32x4 __attribute__((ext_vector_type(4)));
typedef unsigned u32x2 __attribute__((ext_vector_type(2)));

constexpr int T = 65536, SEQ = 8192, D = 1024, FFD = 4096;
constexpr int LD0 = 3840, LD1 = 1536;
constexpr int C_GQ = 0, C_GK = 512, C_GV = 1024, C_GG = 1536, C_FQ = 2048, C_FK = 2560, C_FV = 3072, C_LR = 3584, C_FF = 3600;
constexpr float EPS = 1e-6f;
constexpr size_t MiB = 1u << 20;
constexpr size_t WS_CTL = 0, WS_WIN0 = 2 * MiB, WS_WOUT0 = 10 * MiB, WS_W1_0 = 12 * MiB, WS_W2_0 = 20 * MiB, WS_WIN1 = 28 * MiB, WS_WOUT1 = 31 * MiB,
                 WS_WGLU = 33 * MiB, WS_W1_1 = 34 * MiB, WS_W2_1 = 42 * MiB, WS_WSB = 50 * MiB, WS_MOD = 51 * MiB, WS_S5P = 52 * MiB, WS_CUM = 53 * MiB,
                 WS_H = 64 * MiB, WS_MIX = 192 * MiB, WS_BIG = 320 * MiB, WS_END = 832 * MiB;
constexpr size_t WS_PRM = 56 * MiB;
constexpr int PR_WLR = 0, PR_BLR = 8192, PR_GGAIN = 8704, PR_BF = 9216, PR_QG = 9280, PR_KG = 9792, PR_S5D = 10304, PR_BGLU = 10816, PR_LNG = 11328, PR_LNB = 11840, PR_BS = 12352;
constexpr size_t S5_ABAR = 0, S5_BB = 16384, S5_CM = 16384 + 131072;
constexpr int LDS_BYTES = 147456;
constexpr int NT = 512;

struct Args { const float* in[30]; float* out; unsigned char* ws; };

typedef __bf16 bf16x2_t __attribute__((ext_vector_type(2)));
__device__ __forceinline__ unsigned pkbf(float lo, float hi) { f32x2 v = {lo, hi}; bf16x2_t b = __builtin_convertvector(v, bf16x2_t); return __builtin_bit_cast(unsigned, b); }
__device__ __forceinline__ float bflo(unsigned w) { return __uint_as_float(w << 16); }
__device__ __forceinline__ float bfhi(unsigned w) { return __uint_as_float(w & 0xffff0000u); }
__device__ __forceinline__ void unpack8(u32x4 w, float* f) { f[0] = bflo(w.x); f[1] = bfhi(w.x); f[2] = bflo(w.y); f[3] = bfhi(w.y); f[4] = bflo(w.z); f[5] = bfhi(w.z); f[6] = bflo(w.w); f[7] = bfhi(w.w); }
__device__ __forceinline__ float sigmoidf_(float x) { return 1.0f / (1.0f + __expf(-x)); }
__device__ __forceinline__ float siluf_(float x) { return x * sigmoidf_(x); }
__device__ __forceinline__ float gelu_tanh(float x) { const float u = 1.5957691216057308f * (x + 0.044715f * x * x * x); return x * sigmoidf_(u); }
__device__ __forceinline__ float logsig(float x) { return fminf(x, 0.f) - __logf(1.0f + __expf(-fabsf(x))); }
__device__ __forceinline__ int otid() { int t = threadIdx.x; asm volatile("" : "+v"(t)); return t; }
#define LDS_WAIT() asm volatile("s_waitcnt lgkmcnt(0)" ::: "memory")
#define BAR_LDS() do { asm volatile("s_waitcnt lgkmcnt(0)" ::: "memory"); __builtin_amdgcn_s_barrier(); asm volatile("" ::: "memory"); } while (0)
#define MFMA16(a, b, c) __builtin_amdgcn_mfma_f32_16x16x32_bf16((a), (b), (c), 0, 0, 0)
__device__ __forceinline__ bf16x8 as_bf16x8(u32x4 v) { return __builtin_bit_cast(bf16x8, v); }

namespace pg8 {
constexpr int BM = 256, BK = 64, HALF = 128, HTB = HALF * BK * 2, STAGE_BYTES = 8 * HTB, NXCD = 8, WGM = 8;
__device__ __forceinline__ int lds_byte(int r, int c) { const int st = (r >> 4) * 2 + (c >> 5), rr = r & 15, cc = c & 31, ob = rr * 64 + cc * 2; return st * 1024 + (ob ^ (((ob >> 9) & 1) << 5)); }
__device__ __forceinline__ void stage_rc(int b, int& R, int& C) { const int st = b / 1024, sb = b % 1024, swz = sb ^ (((sb >> 9) & 1) << 5); R = (st >> 1) * 16 + swz / 64; C = (st & 1) * 32 + (swz % 64) / 2; }
__device__ __forceinline__ int perm32(int rho) { const int n = rho >> 4, i = rho & 15; return 8 * (i >> 2) + 4 * n + (i & 3); }
struct Unit { int pm, pn; };
struct Gemm { const bf16_t* A; const bf16_t* Bt; int M, N, K; };
struct StaticOrder {
    int nM, nN, nwg, G, c;
    __device__ void init(int M, int N, int G_, int c_) { nM = M / BM; nN = N / BM; nwg = nM * nN; G = G_; c = c_; }
    __device__ bool next(int i, Unit& u) const {
        const long L = (long)i * G + c; if (L >= nwg) return false;
        int wgid = (int)L; { const int q = nwg / NXCD, r = nwg % NXCD, xcd = wgid % NXCD, off = wgid / NXCD; wgid = (xcd < r ? xcd * (q + 1) : r * (q + 1) + (xcd - r) * q) + off; }
        const int nig = WGM * nN, gid = wgid / nig, fm = gid * WGM, gsz = (nM - fm) < WGM ? (nM - fm) : WGM;
        u.pm = fm + ((wgid % nig) % gsz); u.pn = (wgid % nig) / gsz; return true;
    }
};

struct Epi {
    int mode; bf16_t* O; int ldc; const float* base; float* out; const float* gate; const bf16_t* Y; const float* bias;
    __device__ __forceinline__ void operator()(const f32x4 (&acc)[2][2][4][2], const Unit& u, int wr, int wc, int fr, int fq) const {
        if (mode == 4) {
            const int row0 = u.pm * BM + wr * 64 + fr, col0 = u.pn * BM + wc * 32 + 4 * fq;
            const GAS float* gp = (const GAS float*)gate + (size_t)((u.pm * BM) >> 13) * 6144 + col0;
#pragma unroll
            for (int ai = 0; ai < 2; ++ai)
#pragma unroll
                for (int m = 0; m < 4; ++m) { const size_t off = (size_t)(row0 + ai * HALF + m * 16) * D + col0;
#pragma unroll
                    for (int bj = 0; bj < 2; ++bj)
#pragma unroll
                        for (int n = 0; n < 2; ++n) { const f32x4 gv = *(const GAS f32x4*)(gp + bj * HALF + n * 16); const f32x4 bs = *(const GAS f32x4*)((const GAS float*)base + off + bj * HALF + n * 16); *(GAS f32x4*)((GAS float*)out + off + bj * HALF + n * 16) = bs + gv * acc[ai][bj][m][n]; }
                    asm volatile("" ::: "memory"); }
        } else if (mode == 3) {
            const int row0 = u.pm * BM + wr * 64 + fr, col0 = u.pn * BM + wc * 32 + 8 * fq;
#pragma unroll
            for (int bj = 0; bj < 2; ++bj) {
                const f32x4 b0 = *(const GAS f32x4*)((const GAS float*)bias + col0 + bj * HALF), b1 = *(const GAS f32x4*)((const GAS float*)bias + col0 + bj * HALF + 4);
#pragma unroll
                for (int ai = 0; ai < 2; ++ai)
#pragma unroll
                    for (int m = 0; m < 4; ++m) { const size_t row = (size_t)(row0 + ai * HALF + m * 16);
                        const u32x4 yw = *(const GAS u32x4*)((const GAS bf16_t*)Y + row * 512 + col0 + bj * HALF); float y[8]; unpack8(yw, y);
                        const f32x4 v0 = acc[ai][bj][m][0] + b0, v1 = acc[ai][bj][m][1] + b1; float o[8];
#pragma unroll
                        for (int j = 0; j < 4; ++j) { o[j] = y[j] * sigmoidf_(v0[j]); o[4 + j] = y[4 + j] * sigmoidf_(v1[j]); }
                        u32x4 w; w.x = pkbf(o[0], o[1]); w.y = pkbf(o[2], o[3]); w.z = pkbf(o[4], o[5]); w.w = pkbf(o[6], o[7]);
                        *(GAS u32x4*)((GAS bf16_t*)O + row * D + col0 + bj * HALF) = w; asm volatile("" ::: "memory"); } }
        } else {
            const int row0 = u.pm * BM + wr * 64 + fr, col0 = u.pn * BM + wc * 32 + 8 * fq;
            const bool act2 = (mode == 2) && (u.pn >= 2);
#pragma unroll
            for (int ai = 0; ai < 2; ++ai)
#pragma unroll
                for (int m = 0; m < 4; ++m) { GAS bf16_t* rowp = (GAS bf16_t*)O + (size_t)(row0 + ai * HALF + m * 16) * ldc + col0;
#pragma unroll
                    for (int bj = 0; bj < 2; ++bj) { f32x4 v0 = acc[ai][bj][m][0], v1 = acc[ai][bj][m][1];
                        if (mode == 1) {
#pragma unroll
                            for (int j = 0; j < 4; ++j) { const float a0 = fmaxf(v0[j], 0.f), a1 = fmaxf(v1[j], 0.f); v0[j] = a0 * a0; v1[j] = a1 * a1; } }
                        if (act2) {
#pragma unroll
                            for (int j = 0; j < 4; ++j) { v0[j] = gelu_tanh(v0[j]); v1[j] = gelu_tanh(v1[j]); } }
                        u32x4 w; w.x = pkbf(v0[0], v0[1]); w.y = pkbf(v0[2], v0[3]); w.z = pkbf(v1[0], v1[1]); w.w = pkbf(v1[2], v1[3]);
                        *(GAS u32x4*)(rowp + bj * HALF) = w; }
                    asm volatile("" ::: "memory"); }
        }
    }
};

__device__ __forceinline__ void gemm_phase(LAS unsigned char* lds, const Gemm g, const StaticOrder& S, const Epi& E) {

    const int tid = otid(), wid = __builtin_amdgcn_readfirstlane(tid >> 6), lane = tid & 63, wr = wid >> 2, wc = wid & 3, fr = lane & 15, fq = lane >> 4;
    const int K = g.K, nt = K / BK;
    unsigned voffA[2], voffB[2];
#pragma unroll
    for (int i = 0; i < 2; ++i) { int R, C; stage_rc(tid * 16 + i * 8192, R, C); const int Rb = (E.mode != 4) ? ((R & ~31) + perm32(R & 31)) : R;
        voffA[i] = (unsigned)(R * K + C) * 2u; voffB[i] = (unsigned)(Rb * K + C) * 2u; }
    const size_t kstep = (size_t)(BK * 2);
    const size_t hstep = (size_t)HALF * K * 2;
    const size_t tstep = 2 * hstep;
    const unsigned ldsw = (unsigned)wid * 1024u;
    const int aoff = lds_byte(wr * 64 + fr, fq * 8), boff = lds_byte(wc * 32 + fr, fq * 8);
#define PG8_SA(b, h) (((b) * 2 + (h)) * HTB)
#define PG8_SB(b, h) ((4 + (b) * 2 + (h)) * HTB)
#define PG8_STAGE(bufoff, gbase, voff) do { _Pragma("unroll") for (int _i = 0; _i < 2; ++_i) \
        __builtin_amdgcn_global_load_lds((const unsigned*)((const char*)(gbase) + (voff)[_i]), (LAS unsigned*)(lds + (bufoff) + ldsw + _i * 8192), 16, 0, 0); } while (0)
#define PG8_LDA(dst, b, h) do { _Pragma("unroll") for (int m = 0; m < 4; ++m) _Pragma("unroll") for (int k = 0; k < 2; ++k) dst[m][k] = *(const LAS bf16x8*)(lds + PG8_SA(b, h) + aoff + m * 2048 + k * 1024); } while (0)
#define PG8_LDB(dst, b, h) do { _Pragma("unroll") for (int n = 0; n < 2; ++n) _Pragma("unroll") for (int k = 0; k < 2; ++k) dst[n][k] = *(const LAS bf16x8*)(lds + PG8_SB(b, h) + boff + n * 2048 + k * 1024); } while (0)
#define PG8_MMA(ai, bj, At, Bt) do { __builtin_amdgcn_s_setprio(1); _Pragma("unroll") for (int m = 0; m < 4; ++m) _Pragma("unroll") for (int n = 0; n < 2; ++n) _Pragma("unroll") for (int k = 0; k < 2; ++k) \
        acc[ai][bj][m][n] = __builtin_amdgcn_mfma_f32_16x16x32_bf16(Bt[n][k], At[m][k], acc[ai][bj][m][n], 0, 0, 0); __builtin_amdgcn_s_setprio(0); } while (0)
#define PG8_WAIT_V(n) asm volatile("s_waitcnt vmcnt(" #n ")" ::: "memory")
#define PG8_WAIT_L(n) asm volatile("s_waitcnt lgkmcnt(" #n ")" ::: "memory")
#define PG8_BAR __builtin_amdgcn_s_barrier()
#define PG8_SCHED __builtin_amdgcn_sched_barrier(0)
    Unit cur, nxt; int ui = 0;
    if (!S.next(0, cur)) return;
    f32x4 acc[2][2][4][2];
#pragma unroll
    for (int a = 0; a < 2; ++a)
#pragma unroll
        for (int b = 0; b < 2; ++b)
#pragma unroll
            for (int m = 0; m < 4; ++m)
#pragma unroll
                for (int n = 0; n < 2; ++n) acc[a][b][m][n] = (f32x4){0.f, 0.f, 0.f, 0.f};
    bf16x8 At[4][2], B0[2][2], B1[2][2];
    const char* cA = (const char*)g.A + (size_t)cur.pm * tstep; const char* cB = (const char*)g.Bt + (size_t)cur.pn * tstep;
    PG8_STAGE(PG8_SB(0, 0), cB, voffB); PG8_STAGE(PG8_SA(0, 0), cA, voffA); PG8_STAGE(PG8_SB(0, 1), cB + hstep, voffB); PG8_STAGE(PG8_SA(0, 1), cA + hstep, voffA);
    if (wr == 1) PG8_BAR;
    PG8_WAIT_V(4); PG8_BAR;
    PG8_STAGE(PG8_SB(1, 0), cB + kstep, voffB); PG8_STAGE(PG8_SA(1, 0), cA + kstep, voffA); PG8_STAGE(PG8_SB(1, 1), cB + hstep + kstep, voffB);
    PG8_WAIT_V(6); PG8_BAR;
    for (;;) {
        const bool has_next = S.next(ui + 1, nxt);
        const char* nA = has_next ? (const char*)g.A + (size_t)nxt.pm * tstep : cA; const char* nB = has_next ? (const char*)g.Bt + (size_t)nxt.pn * tstep : cB;
        for (int t = 0; t < nt; t += 2) {
            const bool last = (t == nt - 2);
            const char* a1 = cA + (size_t)(t + 1) * kstep;
            const char* a2 = last ? nA : cA + (size_t)(t + 2) * kstep; const char* b2 = last ? nB : cB + (size_t)(t + 2) * kstep;
            const char* a3 = a2 + kstep; const char* b3 = b2 + kstep;
            PG8_LDB(B0, 0, 0); PG8_SCHED; PG8_LDA(At, 0, 0); PG8_STAGE(PG8_SA(1, 1), a1 + hstep, voffA);
            PG8_WAIT_L(8); PG8_BAR; PG8_WAIT_L(0); PG8_MMA(0, 0, At, B0); PG8_BAR; PG8_SCHED;
            PG8_LDB(B1, 0, 1); PG8_STAGE(PG8_SB(0, 0), b2, voffB);
            PG8_BAR; PG8_WAIT_L(0); PG8_MMA(0, 1, At, B1); PG8_BAR;
            PG8_LDA(At, 0, 1); PG8_STAGE(PG8_SA(0, 0), a2, voffA);
            PG8_BAR; PG8_WAIT_L(0); PG8_MMA(1, 0, At, B0); PG8_BAR; PG8_SCHED;
            PG8_STAGE(PG8_SB(0, 1), b2 + hstep, voffB);
            PG8_WAIT_V(6); PG8_BAR; PG8_MMA(1, 1, At, B1); PG8_BAR;
            PG8_LDB(B0, 1, 0); PG8_SCHED; PG8_LDA(At, 1, 0); PG8_STAGE(PG8_SA(0, 1), a2 + hstep, voffA);
            PG8_WAIT_L(8); PG8_BAR; PG8_WAIT_L(0); PG8_MMA(0, 0, At, B0); PG8_BAR; PG8_SCHED;
            PG8_LDB(B1, 1, 1); PG8_STAGE(PG8_SB(1, 0), b3, voffB);
            PG8_BAR; PG8_WAIT_L(0); PG8_MMA(0, 1, At, B1); PG8_BAR;
            PG8_LDA(At, 1, 1); PG8_STAGE(PG8_SA(1, 0), a3, voffA);
            PG8_BAR; PG8_WAIT_L(0); PG8_MMA(1, 0, At, B0); PG8_BAR; PG8_SCHED;
            PG8_STAGE(PG8_SB(1, 1), b3 + hstep, voffB);
            PG8_WAIT_V(6); PG8_BAR; PG8_MMA(1, 1, At, B1); PG8_BAR;
        }
        E(acc, cur, wr, wc, fr, fq);
        if (!has_next) break;
#pragma unroll
        for (int a = 0; a < 2; ++a)
#pragma unroll
            for (int b = 0; b < 2; ++b)
#pragma unroll
                for (int m = 0; m < 4; ++m)
#pragma unroll
                    for (int n = 0; n < 2; ++n) acc[a][b][m][n] = (f32x4){0.f, 0.f, 0.f, 0.f};
        cur = nxt; cA = nA; cB = nB; ++ui;
    }
    PG8_WAIT_V(0);
    if (wr == 0) PG8_BAR;
    PG8_BAR;
#undef PG8_SA
#undef PG8_SB
#undef PG8_STAGE
#undef PG8_LDA
#undef PG8_LDB
#undef PG8_MMA
#undef PG8_WAIT_V
#undef PG8_WAIT_L
#undef PG8_BAR
#undef PG8_SCHED
}

}

__device__ __forceinline__ void tr_item(const float* W, int ldw, int ncol0, int K, int nblk, bf16_t* WT, int row_off, LAS float* scr, int item, int lane) {
    const int kb = item / nblk, nb = item % nblk, k0 = 64 * kb, n0 = 32 * nb;
#pragma unroll 8
    for (int i = 0; i < 32; ++i) { const int kk = 2 * i + (lane >> 5); scr[kk * 33 + (lane & 31)] = W[(size_t)(k0 + kk) * ldw + ncol0 + n0 + (lane & 31)]; }
    LDS_WAIT();
    const int c = lane & 7;
#pragma unroll
    for (int j = 0; j < 4; ++j) { const int n = (lane >> 3) + 8 * j; const LAS float* s = scr + (8 * c) * 33 + n;
        u32x4 o; o.x = pkbf(s[0 * 33], s[1 * 33]); o.y = pkbf(s[2 * 33], s[3 * 33]); o.z = pkbf(s[4 * 33], s[5 * 33]); o.w = pkbf(s[6 * 33], s[7 * 33]);
        *(u32x4*)(WT + (size_t)(row_off + n0 + n) * K + k0 + 8 * c) = o; }
    LDS_WAIT();
}

__device__ __forceinline__ void p0_prologue(const Args& a, LAS unsigned char* lds) {
    const int tid = otid(), lane = tid & 63, wave = __builtin_amdgcn_readfirstlane(tid >> 6);
    unsigned char* ws = a.ws;
    if (blockIdx.x < 192) {
        LAS float* cact = (LAS float*)lds;
        LAS float* red = (LAS float*)(lds + 32768);
        const float* c = a.in[1];
        for (int i = tid; i < 8192; i += NT) cact[i] = siluf_(c[i]);
        __syncthreads();
        const int item = blockIdx.x, layer = item / 96, e = 64 * (item % 96) + lane;
        const float* wp = a.in[2] + (size_t)layer * D * 6144 + e;
        float acc[8];
#pragma unroll
        for (int b = 0; b < 8; ++b) acc[b] = 0.f;
        for (int k0 = wave * 128; k0 < wave * 128 + 128; k0 += 8) {
            float wv[8];
#pragma unroll
            for (int i = 0; i < 8; ++i) wv[i] = wp[(size_t)(k0 + i) * 6144];
#pragma unroll
            for (int i = 0; i < 8; ++i)
#pragma unroll
                for (int b = 0; b < 8; ++b) acc[b] += cact[b * 1024 + k0 + i] * wv[i];
        }
#pragma unroll
        for (int b = 0; b < 8; ++b) red[(wave * 8 + b) * 64 + lane] = acc[b];
        __syncthreads();
        { const int b = tid >> 6; float s = 0.f;
#pragma unroll
          for (int w = 0; w < 8; ++w) s += red[(w * 8 + b) * 64 + lane];
          ((float*)(ws + WS_MOD))[(size_t)(layer * 8 + b) * 6144 + e] = s + a.in[3][layer * 6144 + e]; }
        __syncthreads();
    }
    {
        LAS float* scr = (LAS float*)(lds + wave * 16384);
        const int gw = blockIdx.x * 8 + wave, NGW = gridDim.x * 8;
        constexpr int I0 = 16 * 64, I1 = 16 * 48, I2 = 16 * 32, I3 = 16 * 128, I4 = 64 * 32, I5 = 16 * 48, I6 = 16 * 32, I7 = 8 * 16, I8 = I3, I9 = I4;
        constexpr int NIT = I0 + I1 + I2 + I3 + I4 + I5 + I6 + I7 + I8 + I9;
        for (int it = gw; it < NIT; it += NGW) {
            int r = it;
            if (r < I0) { tr_item(a.in[4], 3608, 0, 1024, 64, (bf16_t*)(ws + WS_WIN0), 0, scr, r, lane); continue; } r -= I0;
            if (r < I1) { tr_item(a.in[4], 3608, 2064, 1024, 48, (bf16_t*)(ws + WS_WIN0), 2048, scr, r, lane); continue; } r -= I1;
            if (r < I2) { tr_item(a.in[5], 1024, 0, 1024, 32, (bf16_t*)(ws + WS_WOUT0), 0, scr, r, lane); continue; } r -= I2;
            if (r < I3) { tr_item(a.in[28], 4096, 0, 1024, 128, (bf16_t*)(ws + WS_W1_0), 0, scr, r, lane); continue; } r -= I3;
            if (r < I4) { tr_item(a.in[29], 1024, 0, 4096, 32, (bf16_t*)(ws + WS_W2_0), 0, scr, r, lane); continue; } r -= I4;
            if (r < I5) { tr_item(a.in[12], 1536, 0, 1024, 48, (bf16_t*)(ws + WS_WIN1), 0, scr, r, lane); continue; } r -= I5;
            if (r < I6) { tr_item(a.in[13], 1024, 0, 1024, 32, (bf16_t*)(ws + WS_WOUT1), 0, scr, r, lane); continue; } r -= I6;
            if (r < I7) { tr_item(a.in[22], 512, 0, 512, 16, (bf16_t*)(ws + WS_WGLU), 0, scr, r, lane); continue; } r -= I7;
            if (r < I8) { tr_item(a.in[28] + (size_t)D * FFD, 4096, 0, 1024, 128, (bf16_t*)(ws + WS_W1_1), 0, scr, r, lane); continue; } r -= I8;
            tr_item(a.in[29] + (size_t)D * FFD, 1024, 0, 4096, 32, (bf16_t*)(ws + WS_W2_1), 0, scr, r, lane);
        }
    }
    {
        if (blockIdx.x == 0 && tid == 0) { unsigned* ctl = (unsigned*)(ws + WS_CTL); __hip_atomic_store(ctl, 0u, __ATOMIC_RELAXED, __HIP_MEMORY_SCOPE_AGENT); __hip_atomic_store(ctl + 64, 0u, __ATOMIC_RELAXED, __HIP_MEMORY_SCOPE_AGENT); }
        const int gt = blockIdx.x * NT + tid, NGT = gridDim.x * NT;
        bf16_t* win0 = (bf16_t*)(ws + WS_WIN0);
        for (int i = gt; i < 256 * 1024; i += NGT) { const int n = i >> 10, k = i & 1023; float v = 0.f;
            if (n < 16) v = a.in[4][(size_t)k * 3608 + 2048 + n]; else if (n < 24) v = a.in[4][(size_t)k * 3608 + 3600 + (n - 16)];
            win0[(size_t)(3584 + n) * 1024 + k] = (bf16_t)(pkbf(v, 0.f) & 0xffffu); }
        bf16_t* wsb = (bf16_t*)(ws + WS_WSB);
        for (int i = gt; i < 8 * 128 * 128; i += NGT) { const int t = (i >> 7) & 127, s = i & 127; const float v = (s <= t) ? a.in[26][i] : 0.f; wsb[i] = (bf16_t)(pkbf(v, 0.f) & 0xffffu); }
        { float* prm = (float*)(ws + WS_PRM);
          for (int i = gt; i < 8192; i += NGT) prm[PR_WLR + i] = a.in[6][i];
          for (int i = gt; i < 1024; i += NGT) prm[PR_BS + i] = a.in[27][i];
          for (int i = gt; i < 512; i += NGT) { prm[PR_BLR + i] = a.in[7][i]; prm[PR_GGAIN + i] = a.in[8][i]; prm[PR_QG + i] = a.in[10][i]; prm[PR_KG + i] = a.in[11][i]; prm[PR_S5D + i] = a.in[21][i];
              prm[PR_BGLU + i] = a.in[23][i]; prm[PR_LNG + i] = a.in[24][i]; prm[PR_LNB + i] = a.in[25][i]; }
          for (int i = gt; i < 8; i += NGT) prm[PR_BF + i] = a.in[9][i]; }
        float* abar = (float*)(ws + WS_S5P + S5_ABAR); bf16_t* Bb = (bf16_t*)(ws + WS_S5P + S5_BB); bf16_t* Cm = (bf16_t*)(ws + WS_S5P + S5_CM);
        for (int i = gt; i < 32 * 64; i += NGT) { const int g = i >> 6, p = i & 63;
            const float lr = a.in[14][i], li = a.in[15][i], dt = expf(a.in[16][g]);
            const float mag = expf(lr * dt), ang = li * dt, ar = mag * cosf(ang), ai = mag * sinf(ang), den = lr * lr + li * li;
            const float cr = ((ar - 1.0f) * lr + ai * li) / den, ci = (ai * lr - (ar - 1.0f) * li) / den;
            abar[2 * i] = ar; abar[2 * i + 1] = ai;
            for (int k = 0; k < 16; ++k) { const float br = a.in[17][(size_t)i * 16 + k], bi = a.in[18][(size_t)i * 16 + k];
                Bb[((size_t)g * 128 + p) * 16 + k] = (bf16_t)(pkbf(cr * br - ci * bi, 0.f) & 0xffffu);
                Bb[((size_t)g * 128 + 64 + p) * 16 + k] = (bf16_t)(pkbf(cr * bi + ci * br, 0.f) & 0xffffu); } }
        for (int i = gt; i < 32 * 16 * 64; i += NGT) { const int gi = i >> 6, p = i & 63;
            Cm[(size_t)gi * 128 + p] = (bf16_t)(pkbf(a.in[19][i], 0.f) & 0xffffu); Cm[(size_t)gi * 128 + 64 + p] = (bf16_t)(pkbf(-a.in[20][i], 0.f) & 0xffffu); }
    }
}

__device__ __forceinline__ void norm_phase(const float* x, const float* mod, int off_sh, int off_sc, bf16_t* H) {
    const int tid_ = otid(); const int lane = tid_ & 63, gw = blockIdx.x * 8 + (tid_ >> 6), NGW = gridDim.x * 8;
    for (int m = gw; m < T; m += NGW) {
        const GAS f32x4* xr = (const GAS f32x4*)(x + (size_t)m * D) + lane;
        const GAS float* mp = (const GAS float*)mod + (size_t)(m >> 13) * 6144;
        f32x4 v[4]; float s = 0.f;
#pragma unroll
        for (int j = 0; j < 4; ++j) { v[j] = xr[64 * j]; s += (v[j].x * v[j].x + v[j].y * v[j].y) + (v[j].z * v[j].z + v[j].w * v[j].w); }
#pragma unroll
        for (int o = 1; o < 64; o <<= 1) s += __shfl_xor(s, o);
        const float r = rsqrtf(s * (1.0f / D) + EPS);
        GAS u32x2* o8 = (GAS u32x2*)(H + (size_t)m * D) + lane;
#pragma unroll
        for (int j = 0; j < 4; ++j) { const f32x4 sc = *((const GAS f32x4*)(mp + off_sc) + lane + 64 * j), sh = *((const GAS f32x4*)(mp + off_sh) + lane + 64 * j);
            const f32x4 y = v[j] * r * (sc + 1.0f) + sh; u32x2 w; w.x = pkbf(y.x, y.y); w.y = pkbf(y.z, y.w); o8[64 * j] = w; }
    }
}

__device__ __forceinline__ void cum_phase(unsigned char* ws, LAS unsigned char* lds) {
    if (blockIdx.x >= 8) return;
    const int b = blockIdx.x, tid = otid(), lane = tid & 63, wave = tid >> 6;
    const bf16_t* P0 = (const bf16_t*)(ws + WS_BIG); float* cum = (float*)(ws + WS_CUM);
    LAS float* wt = (LAS float*)lds;
    float bf[8];
#pragma unroll
    for (int h = 0; h < 8; ++h) bf[h] = ((const float*)(ws + WS_PRM))[PR_BF + h];
    float run[8];
#pragma unroll
    for (int h = 0; h < 8; ++h) run[h] = 0.f;
    const size_t m0 = (size_t)b * SEQ + 16 * tid;
    for (int i = 0; i < 16; ++i) { const u32x4 w = *(const u32x4*)(P0 + (m0 + i) * LD0 + C_FF); float f[8]; unpack8(w, f);
#pragma unroll
        for (int h = 0; h < 8; ++h) run[h] += logsig(f[h] + bf[h]); }
    float incl[8];
#pragma unroll
    for (int h = 0; h < 8; ++h) { float v = run[h];
#pragma unroll
        for (int d = 1; d < 64; d <<= 1) { const float o = __shfl_up(v, d); if (lane >= d) v += o; }
        incl[h] = v; }
    if (lane == 63) {
#pragma unroll
        for (int h = 0; h < 8; ++h) wt[wave * 8 + h] = incl[h]; }
    __syncthreads();
    float off[8];
#pragma unroll
    for (int h = 0; h < 8; ++h) { float o = incl[h] - run[h]; for (int w = 0; w < wave; ++w) o += wt[w * 8 + h]; off[h] = o; }
    for (int i = 0; i < 16; ++i) { const u32x4 w = *(const u32x4*)(P0 + (m0 + i) * LD0 + C_FF); float f[8]; unpack8(w, f);
#pragma unroll
        for (int h = 0; h < 8; ++h) { off[h] += logsig(f[h] + bf[h]); cum[(size_t)(b * 8 + h) * SEQ + 16 * tid + i] = off[h]; } }
}

__device__ __forceinline__ int q_next(unsigned* ctr, LAS int* slot) {
    __syncthreads();
    if (threadIdx.x == 0) *slot = (int)atomicAdd(ctr, 1u);
    __syncthreads();
    return *slot;
}

__device__ __forceinline__ void gla_item(unsigned char* ws, LAS unsigned char* lds, int b, int h) {
    const int tid = otid(), lane = tid & 63, w = __builtin_amdgcn_readfirstlane(tid >> 6), c = lane & 15, q = lane >> 4;
    const GAS bf16_t* P0 = (const GAS bf16_t*)(ws + WS_BIG); GAS bf16_t* MIX = (GAS bf16_t*)(ws + WS_MIX); const GAS float* prm = (const GAS float*)(ws + WS_PRM);
    LAS bf16_t* Qp = (LAS bf16_t*)(lds); LAS bf16_t* Kp = (LAS bf16_t*)(lds + 9216); LAS bf16_t* Kt = (LAS bf16_t*)(lds + 18432); LAS bf16_t* Vt = (LAS bf16_t*)(lds + 27648);
    LAS bf16_t* Pm = (LAS bf16_t*)(lds + 36864); LAS bf16_t* St = (LAS bf16_t*)(lds + 46080); LAS float* dec = (LAS float*)(lds + 55296);
    LAS float* wl = (LAS float*)(lds + 55552); LAS float* blr = (LAS float*)(lds + 59648);
    for (int i = tid; i < 2304; i += NT) ((LAS unsigned*)St)[i] = 0u;
    for (int i = tid; i < 1024; i += NT) wl[i] = prm[PR_WLR + (i >> 6) * 512 + 64 * h + (i & 63)];
    if (tid < 64) blr[tid] = prm[PR_BLR + 64 * h + tid];
    float gain[16];
#pragma unroll
    for (int vi = 0; vi < 4; ++vi)
#pragma unroll
        for (int j = 0; j < 4; ++j) gain[vi * 4 + j] = prm[PR_GGAIN + h * 64 + 16 * vi + 4 * q + j];
    f32x4 sacc[4];
#pragma unroll
    for (int vi = 0; vi < 4; ++vi) sacc[vi] = (f32x4){0.f, 0.f, 0.f, 0.f};
    const size_t rowbase = (size_t)b * SEQ;
    u32x4 rq, rk, rv, rl0, rl1;
    { const GAS bf16_t* p = P0 + (rowbase + lane) * LD0; rq = *(const GAS u32x4*)(p + C_GQ + 64 * h + 8 * w); rk = *(const GAS u32x4*)(p + C_GK + 64 * h + 8 * w); rv = *(const GAS u32x4*)(p + C_GV + 64 * h + 8 * w);
      rl0 = *(const GAS u32x4*)(p + C_LR); rl1 = *(const GAS u32x4*)(p + C_LR + 8); }
    __syncthreads();
    for (int ch = 0; ch < 128; ++ch) {
        {
            float glr[16]; unpack8(rl0, glr); unpack8(rl1, glr + 8);
            f32x4 z0 = *(const LAS f32x4*)(blr + 8 * w), z1 = *(const LAS f32x4*)(blr + 8 * w + 4);
#pragma unroll
            for (int r = 0; r < 16; ++r) { const f32x4 w0 = *(const LAS f32x4*)(wl + r * 64 + 8 * w), w1 = *(const LAS f32x4*)(wl + r * 64 + 8 * w + 4); z0 += w0 * glr[r]; z1 += w1 * glr[r]; }
            float bc[8];
#pragma unroll
            for (int j = 0; j < 4; ++j) { bc[j] = logsig(z0[j]) * 0.0625f; bc[4 + j] = logsig(z1[j]) * 0.0625f; }
#pragma unroll
            for (int d = 1; d < 64; d <<= 1) {
#pragma unroll
                for (int j = 0; j < 8; ++j) { const float o = __shfl_up(bc[j], d); if (lane >= d) bc[j] += o; } }
            float qf[8], kf[8]; unpack8(rq, qf); unpack8(rk, kf);
            float qp[8], kp[8], kpp[8], bl[8];
#pragma unroll
            for (int j = 0; j < 8; ++j) { bl[j] = __shfl(bc[j], 63); qp[j] = qf[j] * 0.125f * __expf(bc[j]); kp[j] = kf[j] * __expf(-bc[j]); kpp[j] = kf[j] * __expf(bl[j] - bc[j]); }
            u32x4 wq, wk; wq.x = pkbf(qp[0], qp[1]); wq.y = pkbf(qp[2], qp[3]); wq.z = pkbf(qp[4], qp[5]); wq.w = pkbf(qp[6], qp[7]);
            wk.x = pkbf(kp[0], kp[1]); wk.y = pkbf(kp[2], kp[3]); wk.z = pkbf(kp[4], kp[5]); wk.w = pkbf(kp[6], kp[7]);
            *(LAS u32x4*)(Qp + lane * 72 + 8 * w) = wq; *(LAS u32x4*)(Kp + lane * 72 + 8 * w) = wk;
            const unsigned vv[4] = {rv.x, rv.y, rv.z, rv.w};
#pragma unroll
            for (int j = 0; j < 8; ++j) { Kt[(8 * w + j) * 72 + lane] = (bf16_t)(pkbf(kpp[j], 0.f) & 0xffffu); Vt[(8 * w + j) * 72 + lane] = (bf16_t)((j & 1) ? (vv[j >> 1] >> 16) : (vv[j >> 1] & 0xffffu)); }
            if (lane == 63) {
#pragma unroll
                for (int j = 0; j < 8; ++j) dec[8 * w + j] = __expf(bl[j]); }
        }
        if (ch + 1 < 128) { const GAS bf16_t* p = P0 + (rowbase + 64 * (ch + 1) + lane) * LD0; rq = *(const GAS u32x4*)(p + C_GQ + 64 * h + 8 * w); rk = *(const GAS u32x4*)(p + C_GK + 64 * h + 8 * w); rv = *(const GAS u32x4*)(p + C_GV + 64 * h + 8 * w);
            rl0 = *(const GAS u32x4*)(p + C_LR); rl1 = *(const GAS u32x4*)(p + C_LR + 8); }
        BAR_LDS();
        f32x4 oacc[4];
        {
            const int ti = w & 3;
            const bf16x8 qf0 = *(const LAS bf16x8*)(Qp + (16 * ti + c) * 72 + 8 * q), qf1 = *(const LAS bf16x8*)(Qp + (16 * ti + c) * 72 + 8 * q + 32);
#pragma unroll
            for (int u = 0; u < 2; ++u) { const int si = 2 * (w >> 2) + u; f32x4 acc = (f32x4){0.f, 0.f, 0.f, 0.f};
                if (si <= ti) { const bf16x8 k0 = *(const LAS bf16x8*)(Kp + (16 * si + c) * 72 + 8 * q), k1 = *(const LAS bf16x8*)(Kp + (16 * si + c) * 72 + 8 * q + 32);
                    acc = MFMA16(k0, qf0, acc); acc = MFMA16(k1, qf1, acc);
#pragma unroll
                    for (int j = 0; j < 4; ++j) if (16 * si + 4 * q + j > 16 * ti + c) acc[j] = 0.f; }
                u32x2 pw; pw.x = pkbf(acc[0], acc[1]); pw.y = pkbf(acc[2], acc[3]);
                *(LAS u32x2*)(Pm + (16 * ti + c) * 72 + 16 * si + 4 * q) = pw; }
            if (w < 4) {
#pragma unroll
                for (int vi = 0; vi < 4; ++vi) { const bf16x8 s0 = *(const LAS bf16x8*)(St + (16 * vi + c) * 72 + 8 * q), s1 = *(const LAS bf16x8*)(St + (16 * vi + c) * 72 + 8 * q + 32);
                    f32x4 acc = (f32x4){0.f, 0.f, 0.f, 0.f}; acc = MFMA16(s0, qf0, acc); acc = MFMA16(s1, qf1, acc); oacc[vi] = acc; } }
        }
        BAR_LDS();
        if (w < 4) {
            const bf16x8 p0 = *(const LAS bf16x8*)(Pm + (16 * w + c) * 72 + 8 * q), p1 = *(const LAS bf16x8*)(Pm + (16 * w + c) * 72 + 8 * q + 32);
            float ssq = 0.f;
#pragma unroll
            for (int vi = 0; vi < 4; ++vi) { const bf16x8 v0 = *(const LAS bf16x8*)(Vt + (16 * vi + c) * 72 + 8 * q), v1 = *(const LAS bf16x8*)(Vt + (16 * vi + c) * 72 + 8 * q + 32);
                oacc[vi] = MFMA16(v0, p0, oacc[vi]); oacc[vi] = MFMA16(v1, p1, oacc[vi]);
#pragma unroll
                for (int j = 0; j < 4; ++j) ssq += oacc[vi][j] * oacc[vi][j]; }
            ssq += __shfl_xor(ssq, 16); ssq += __shfl_xor(ssq, 32);
            const float r = rsqrtf(ssq * (1.0f / 64.0f) + EPS);
            const size_t m = rowbase + 64 * ch + 16 * w + c;
#pragma unroll
            for (int vi = 0; vi < 4; ++vi) { const u32x2 gw = *(const GAS u32x2*)(P0 + m * LD0 + C_GG + 64 * h + 16 * vi + 4 * q);
                const float g0 = bflo(gw.x), g1 = bfhi(gw.x), g2 = bflo(gw.y), g3 = bfhi(gw.y);
                u32x2 ow; ow.x = pkbf(oacc[vi][0] * r * gain[vi * 4 + 0] * siluf_(g0), oacc[vi][1] * r * gain[vi * 4 + 1] * siluf_(g1));
                ow.y = pkbf(oacc[vi][2] * r * gain[vi * 4 + 2] * siluf_(g2), oacc[vi][3] * r * gain[vi * 4 + 3] * siluf_(g3));
                *(GAS u32x2*)(MIX + m * D + 64 * h + 16 * vi + 4 * q) = ow; }
        } else {
            const int ki = w - 4;
            const f32x4 d4 = *(const LAS f32x4*)(dec + 16 * ki + 4 * q);
            const bf16x8 k0 = *(const LAS bf16x8*)(Kt + (16 * ki + c) * 72 + 8 * q), k1 = *(const LAS bf16x8*)(Kt + (16 * ki + c) * 72 + 8 * q + 32);
#pragma unroll
            for (int vi = 0; vi < 4; ++vi) { const bf16x8 v0 = *(const LAS bf16x8*)(Vt + (16 * vi + c) * 72 + 8 * q), v1 = *(const LAS bf16x8*)(Vt + (16 * vi + c) * 72 + 8 * q + 32);
                f32x4 s = sacc[vi] * d4; s = MFMA16(k0, v0, s); s = MFMA16(k1, v1, s); sacc[vi] = s;
                u32x2 sw; sw.x = pkbf(s[0], s[1]); sw.y = pkbf(s[2], s[3]);
                *(LAS u32x2*)(St + (16 * vi + c) * 72 + 16 * ki + 4 * q) = sw; }
        }
        BAR_LDS();
    }
}

__device__ __forceinline__ void fox_item(unsigned char* ws, LAS unsigned char* lds, int b, int h, int qi) {
    const int tid = otid(), lane = tid & 63, w = __builtin_amdgcn_readfirstlane(tid >> 6), c = lane & 15, q = lane >> 4;
    const GAS bf16_t* P0 = (const GAS bf16_t*)(ws + WS_BIG); GAS bf16_t* MIX = (GAS bf16_t*)(ws + WS_MIX);
    const GAS float* cumb = (const GAS float*)(ws + WS_CUM) + (size_t)(b * 8 + h) * SEQ;
    LAS bf16_t* Kn = (LAS bf16_t*)(lds); LAS bf16_t* Vt = (LAS bf16_t*)(lds + 9216); LAS float* cumk = (LAS float*)(lds + 18432);
    const GAS float* gq = (const GAS float*)(ws + WS_PRM) + PR_QG + h * 64; const GAS float* gk = (const GAS float*)(ws + WS_PRM) + PR_KG + h * 64;
    float mq = fabsf(gq[lane]), mk = fabsf(gk[lane]);
#pragma unroll
    for (int o = 1; o < 64; o <<= 1) { mq = fmaxf(mq, __shfl_xor(mq, o)); mk = fmaxf(mk, __shfl_xor(mk, o)); }
    const float B2 = 16.0f * mq * mk * 1.001f;
    const int t0 = 128 * qi, t = t0 + 16 * w + c; const size_t rowbase = (size_t)b * SEQ, m = rowbase + t;
    const float cum_t0 = cumb[t0], cum_t = cumb[t];
    bf16x8 qf[2];
    { const u32x4 r0 = *(const GAS u32x4*)(P0 + m * LD0 + C_FQ + 64 * h + 8 * q), r1 = *(const GAS u32x4*)(P0 + m * LD0 + C_FQ + 64 * h + 8 * q + 32);
      float f[16]; unpack8(r0, f); unpack8(r1, f + 8); float ss = 0.f;
#pragma unroll
      for (int e = 0; e < 16; ++e) ss += f[e] * f[e];
      ss += __shfl_xor(ss, 16); ss += __shfl_xor(ss, 32);
      const float r = rsqrtf(ss * (1.0f / 64.0f) + EPS) * 0.125f;
#pragma unroll
      for (int kk = 0; kk < 2; ++kk) { float g[8];
#pragma unroll
          for (int e = 0; e < 8; ++e) g[e] = f[8 * kk + e] * r * gq[8 * q + 32 * kk + e];
          u32x4 pw; pw.x = pkbf(g[0], g[1]); pw.y = pkbf(g[2], g[3]); pw.z = pkbf(g[4], g[5]); pw.w = pkbf(g[6], g[7]); qf[kk] = as_bf16x8(pw); } }
    f32x4 oacc[4];
#pragma unroll
    for (int di = 0; di < 4; ++di) oacc[di] = (f32x4){0.f, 0.f, 0.f, 0.f};
    float mrun = -1e30f, lpart = 0.f;
    const int srow = tid >> 3, dc = tid & 7;
    float gkr[8];
#pragma unroll
    for (int e = 0; e < 8; ++e) gkr[e] = gk[8 * dc + e];
    int j = 2 * qi + 1;
    u32x4 rk, rv; float rc;
    { const size_t ms = rowbase + 64 * j + srow; rk = *(const GAS u32x4*)(P0 + ms * LD0 + C_FK + 64 * h + 8 * dc); rv = *(const GAS u32x4*)(P0 + ms * LD0 + C_FV + 64 * h + 8 * dc); rc = cumb[64 * j + srow]; }
    for (;;) {
        { float f[8]; unpack8(rk, f); float ss = 0.f;
#pragma unroll
          for (int e = 0; e < 8; ++e) ss += f[e] * f[e];
          ss += __shfl_xor(ss, 1); ss += __shfl_xor(ss, 2); ss += __shfl_xor(ss, 4);
          const float r = rsqrtf(ss * (1.0f / 64.0f) + EPS);
#pragma unroll
          for (int e = 0; e < 8; ++e) f[e] = f[e] * r * gkr[e];
          u32x4 pw; pw.x = pkbf(f[0], f[1]); pw.y = pkbf(f[2], f[3]); pw.z = pkbf(f[4], f[5]); pw.w = pkbf(f[6], f[7]);
          *(LAS u32x4*)(Kn + srow * 72 + 8 * dc) = pw;
          const unsigned vv[4] = {rv.x, rv.y, rv.z, rv.w};
#pragma unroll
          for (int e = 0; e < 8; ++e) Vt[(8 * dc + e) * 72 + srow] = (bf16_t)((e & 1) ? (vv[e >> 1] >> 16) : (vv[e >> 1] & 0xffffu));
          if (dc == 0) cumk[srow] = rc; }
        const int jn = j - 1;
        bool cont = jn >= 0;
        if (cont && jn < 2 * qi) cont = (B2 + cum_t0 - cumb[64 * jn + 63]) >= -110.0f;
        if (cont) { const size_t ms = rowbase + 64 * jn + srow; rk = *(const GAS u32x4*)(P0 + ms * LD0 + C_FK + 64 * h + 8 * dc); rv = *(const GAS u32x4*)(P0 + ms * LD0 + C_FV + 64 * h + 8 * dc); rc = cumb[64 * jn + srow]; }
        BAR_LDS();
        if (!(j == 2 * qi + 1 && w < 4)) {
            float sv[4][4]; float mx = -1e30f;
#pragma unroll
            for (int si = 0; si < 4; ++si) { f32x4 acc = (f32x4){0.f, 0.f, 0.f, 0.f};
                const bf16x8 k0 = *(const LAS bf16x8*)(Kn + (16 * si + c) * 72 + 8 * q), k1 = *(const LAS bf16x8*)(Kn + (16 * si + c) * 72 + 8 * q + 32);
                acc = MFMA16(k0, qf[0], acc); acc = MFMA16(k1, qf[1], acc);
                const f32x4 ck = *(const LAS f32x4*)(cumk + 16 * si + 4 * q);
#pragma unroll
                for (int jj = 0; jj < 4; ++jj) { float lg = acc[jj] + (cum_t - ck[jj]); if (j >= 2 * qi && (64 * j + 16 * si + 4 * q + jj) > t) lg = -1e30f; sv[si][jj] = lg; mx = fmaxf(mx, lg); } }
            mx = fmaxf(mx, __shfl_xor(mx, 16)); mx = fmaxf(mx, __shfl_xor(mx, 32));
            const float mnew = fmaxf(mrun, mx), alpha = __expf(mrun - mnew); mrun = mnew;
            float ps = 0.f;
#pragma unroll
            for (int si = 0; si < 4; ++si)
#pragma unroll
                for (int jj = 0; jj < 4; ++jj) { sv[si][jj] = __expf(sv[si][jj] - mnew); ps += sv[si][jj]; }
            lpart = lpart * alpha + ps;
#pragma unroll
            for (int di = 0; di < 4; ++di) oacc[di] *= alpha;
#pragma unroll
            for (int kk = 0; kk < 2; ++kk) { u32x4 pw; pw.x = pkbf(sv[2 * kk][0], sv[2 * kk][1]); pw.y = pkbf(sv[2 * kk][2], sv[2 * kk][3]); pw.z = pkbf(sv[2 * kk + 1][0], sv[2 * kk + 1][1]); pw.w = pkbf(sv[2 * kk + 1][2], sv[2 * kk + 1][3]);
                const bf16x8 pf = as_bf16x8(pw);
#pragma unroll
                for (int di = 0; di < 4; ++di) { const u32x2 va = *(const LAS u32x2*)(Vt + (16 * di + c) * 72 + 32 * kk + 4 * q), vb = *(const LAS u32x2*)(Vt + (16 * di + c) * 72 + 32 * kk + 16 + 4 * q);
                    u32x4 vw; vw.x = va.x; vw.y = va.y; vw.z = vb.x; vw.w = vb.y; oacc[di] = MFMA16(as_bf16x8(vw), pf, oacc[di]); } }
        }
        BAR_LDS();
        if (!cont) break;
        j = jn;
    }
    float l = lpart; l += __shfl_xor(l, 16); l += __shfl_xor(l, 32);
    const float inv = 1.0f / l;
#pragma unroll
    for (int di = 0; di < 4; ++di) { u32x2 ow; ow.x = pkbf(oacc[di][0] * inv, oacc[di][1] * inv); ow.y = pkbf(oacc[di][2] * inv, oacc[di][3] * inv);
        *(GAS u32x2*)(MIX + m * D + 512 + 64 * h + 16 * di + 4 * q) = ow; }
}

__device__ __forceinline__ void s5_item(unsigned char* ws, LAS unsigned char* lds, int b, int g) {
    const int tid = otid(), lane = tid & 63, w = __builtin_amdgcn_readfirstlane(tid >> 6), c = lane & 15, q = lane >> 4;
    const GAS bf16_t* P1 = (const GAS bf16_t*)(ws + WS_BIG); GAS bf16_t* YS = (GAS bf16_t*)(ws + WS_H);
    const GAS float* abar = (const GAS float*)(ws + WS_S5P + S5_ABAR); const GAS bf16_t* Bb = (const GAS bf16_t*)(ws + WS_S5P + S5_BB); const GAS bf16_t* Cm = (const GAS bf16_t*)(ws + WS_S5P + S5_CM);
    LAS float* bu = (LAS float*)(lds + w * 12800); LAS bf16_t* xs = (LAS bf16_t*)(lds + w * 12800 + 8448); LAS float* E = (LAS float*)(lds + 102400);
    const float ar = abar[(g * 64 + lane) * 2], ai = abar[(g * 64 + lane) * 2 + 1];
    float pr = ar, pi = ai;
#pragma unroll
    for (int i = 0; i < 10; ++i) { const float nr = pr * pr - pi * pi, ni = 2.0f * pr * pi; pr = nr; pi = ni; }
    bf16x8 bfr[8], cfr[4];
    const bf16x8 zero8 = (bf16x8){0, 0, 0, 0, 0, 0, 0, 0};
#pragma unroll
    for (int pt = 0; pt < 8; ++pt) bfr[pt] = (q < 2) ? *(const GAS bf16x8*)(Bb + ((size_t)(g * 128 + 16 * pt + c)) * 16 + 8 * q) : zero8;
#pragma unroll
    for (int kk = 0; kk < 4; ++kk) cfr[kk] = *(const GAS bf16x8*)(Cm + (size_t)(g * 16 + c) * 128 + 32 * kk + 8 * q);
    float dsk[4];
#pragma unroll
    for (int j = 0; j < 4; ++j) dsk[j] = ((const GAS float*)(ws + WS_PRM))[PR_S5D + g * 16 + 4 * q + j];
    float xr = 0.f, xi = 0.f;
    for (int pass = 0; pass < 2; ++pass) {
        const size_t mbase = (size_t)b * SEQ + 1024 * w + c;
        bf16x8 uf_n = (q < 2) ? *(const GAS bf16x8*)(P1 + mbase * LD1 + 16 * g + 8 * q) : zero8;
        u32x2 uw_n = *(const GAS u32x2*)(P1 + mbase * LD1 + 16 * g + 4 * q);
        for (int sc = 0; sc < 64; ++sc) {
            const size_t m = mbase + 16 * sc;
            const bf16x8 uf = uf_n; const u32x2 uw = uw_n;
            if (sc + 1 < 64) { const size_t mn = m + 16;
                uf_n = (q < 2) ? *(const GAS bf16x8*)(P1 + mn * LD1 + 16 * g + 8 * q) : zero8; uw_n = *(const GAS u32x2*)(P1 + mn * LD1 + 16 * g + 4 * q); }
#pragma unroll
            for (int pt = 0; pt < 8; ++pt) { f32x4 acc = (f32x4){0.f, 0.f, 0.f, 0.f}; acc = MFMA16(bfr[pt], uf, acc); *(LAS f32x4*)(bu + c * 132 + 16 * pt + 4 * q) = acc; }
            LDS_WAIT();
#pragma unroll
            for (int tt = 0; tt < 16; ++tt) { const float br = bu[tt * 132 + lane], bi = bu[tt * 132 + 64 + lane];
                const float nr = ar * xr - ai * xi + br, ni = ar * xi + ai * xr + bi; xr = nr; xi = ni;
                if (pass) { xs[tt * 136 + lane] = (bf16_t)(pkbf(xr, 0.f) & 0xffffu); xs[tt * 136 + 64 + lane] = (bf16_t)(pkbf(xi, 0.f) & 0xffffu); } }
            if (pass) {
                LDS_WAIT();
                f32x4 acc = (f32x4){0.f, 0.f, 0.f, 0.f};
#pragma unroll
                for (int kk = 0; kk < 4; ++kk) { const bf16x8 xf = *(const LAS bf16x8*)(xs + c * 136 + 32 * kk + 8 * q); acc = MFMA16(cfr[kk], xf, acc); }
                const float y0 = gelu_tanh(acc[0] + dsk[0] * bflo(uw.x)), y1 = gelu_tanh(acc[1] + dsk[1] * bfhi(uw.x)), y2 = gelu_tanh(acc[2] + dsk[2] * bflo(uw.y)), y3 = gelu_tanh(acc[3] + dsk[3] * bfhi(uw.y));
                u32x2 ow; ow.x = pkbf(y0, y1); ow.y = pkbf(y2, y3);
                *(GAS u32x2*)(YS + m * 512 + 16 * g + 4 * q) = ow;
            }
            LDS_WAIT();
        }
        if (pass == 0) {
            E[w * 128 + lane] = xr; E[w * 128 + 64 + lane] = xi;
            __syncthreads();
            float cr = 0.f, ci = 0.f;
            for (int w2 = 0; w2 < w; ++w2) { const float er = E[w2 * 128 + lane], ei = E[w2 * 128 + 64 + lane]; const float nr = pr * cr - pi * ci + er, ni = pr * ci + pi * cr + ei; cr = nr; ci = ni; }
            xr = cr; xi = ci;
        }
    }
}

__device__ __forceinline__ void sgu_item(unsigned char* ws, LAS unsigned char* lds, int b, int n) {
    const int tid = otid(), lane = tid & 63, w = __builtin_amdgcn_readfirstlane(tid >> 6), c = lane & 15, q = lane >> 4;
    const GAS bf16_t* P1 = (const GAS bf16_t*)(ws + WS_BIG); GAS bf16_t* MIX = (GAS bf16_t*)(ws + WS_MIX); const GAS bf16_t* wsb = (const GAS bf16_t*)(ws + WS_WSB);
    LAS bf16_t* Vt = (LAS bf16_t*)lds;
    const size_t m0 = (size_t)b * SEQ + 128 * n;
    {
        const int s = tid >> 2, qq = tid & 3; const GAS bf16_t* vp = P1 + (m0 + s) * LD1 + 1024 + 128 * qq;
        u32x4 rv[16]; float sum = 0.f, ssq = 0.f;
#pragma unroll
        for (int i = 0; i < 16; ++i) { rv[i] = *(const GAS u32x4*)(vp + 8 * i); float f[8]; unpack8(rv[i], f);
#pragma unroll
            for (int e = 0; e < 8; ++e) { sum += f[e]; ssq += f[e] * f[e]; } }
        sum += __shfl_xor(sum, 1); sum += __shfl_xor(sum, 2); ssq += __shfl_xor(ssq, 1); ssq += __shfl_xor(ssq, 2);
        const float mu = sum * (1.0f / 512.0f), var = fmaxf(ssq * (1.0f / 512.0f) - mu * mu, 0.f), rstd = rsqrtf(var + EPS);
        const GAS float* lg = (const GAS float*)(ws + WS_PRM) + PR_LNG + 128 * qq; const GAS float* lb = (const GAS float*)(ws + WS_PRM) + PR_LNB + 128 * qq;
#pragma unroll
        for (int i = 0; i < 16; ++i) { float f[8]; unpack8(rv[i], f);
            const f32x4 g0 = *(const GAS f32x4*)(lg + 8 * i), g1 = *(const GAS f32x4*)(lg + 8 * i + 4), b0 = *(const GAS f32x4*)(lb + 8 * i), b1 = *(const GAS f32x4*)(lb + 8 * i + 4);
#pragma unroll
            for (int e = 0; e < 8; ++e) { const float gg = e < 4 ? g0[e & 3] : g1[e & 3], bb = e < 4 ? b0[e & 3] : b1[e & 3]; const float y = (f[e] - mu) * rstd * gg + bb;
                Vt[(128 * qq + 8 * i + e) * 136 + s] = (bf16_t)(pkbf(y, 0.f) & 0xffffu); } }
    }
    __syncthreads();
    const int nk = (w >> 1) + 1; const int trow = 16 * w + c; const size_t m = m0 + trow;
    for (int g = 0; g < 8; ++g) {
        f32x4 acc[4];
#pragma unroll
        for (int ct = 0; ct < 4; ++ct) acc[ct] = (f32x4){0.f, 0.f, 0.f, 0.f};
        for (int kk = 0; kk < nk; ++kk) { const bf16x8 wf = *(const GAS bf16x8*)(wsb + ((size_t)g * 128 + trow) * 128 + 32 * kk + 8 * q);
#pragma unroll
            for (int ct = 0; ct < 4; ++ct) { const bf16x8 vf = *(const LAS bf16x8*)(Vt + (64 * g + 16 * ct + c) * 136 + 32 * kk + 8 * q); acc[ct] = MFMA16(vf, wf, acc[ct]); } }
        const float bs = ((const GAS float*)(ws + WS_PRM))[PR_BS + g * 128 + trow];
#pragma unroll
        for (int ct = 0; ct < 4; ++ct) { const u32x2 uw = *(const GAS u32x2*)(P1 + m * LD1 + 512 + 64 * g + 16 * ct + 4 * q);
            u32x2 ow; ow.x = pkbf(bflo(uw.x) * (acc[ct][0] + bs), bfhi(uw.x) * (acc[ct][1] + bs)); ow.y = pkbf(bflo(uw.y) * (acc[ct][2] + bs), bfhi(uw.y) * (acc[ct][3] + bs));
            *(GAS u32x2*)(MIX + m * D + 512 + 64 * g + 16 * ct + 4 * q) = ow; }
    }
}

__device__ __forceinline__ void grid_bar(unsigned* bar, unsigned k) {
    asm volatile("s_waitcnt vmcnt(0) lgkmcnt(0)" ::: "memory");
    __syncthreads();
    if (threadIdx.x == 0) {
        const unsigned target = (k + 1u) * gridDim.x;
        __builtin_amdgcn_fence(__ATOMIC_RELEASE, "agent"); asm volatile("s_waitcnt vmcnt(0)" ::: "memory");
        __hip_atomic_fetch_add(bar, 1u, __ATOMIC_RELAXED, __HIP_MEMORY_SCOPE_AGENT);
        while (__hip_atomic_load(bar, __ATOMIC_RELAXED, __HIP_MEMORY_SCOPE_AGENT) < target) __builtin_amdgcn_s_sleep(1);
        __builtin_amdgcn_fence(__ATOMIC_ACQUIRE, "agent"); asm volatile("s_waitcnt vmcnt(0)" ::: "memory");
    }
    __syncthreads();
}
#define GSYNC(k) grid_bar((unsigned*)(a.ws + WS_CTL) + 128, (unsigned)(k))
__global__ void __launch_bounds__(NT, 2) mega_fwd(Args a) {
    extern __shared__ __attribute__((aligned(16))) unsigned char lds_raw[];
    LAS unsigned char* lds = (LAS unsigned char*)lds_raw;
    cg::grid_group grid = cg::this_grid();
    LAS int* slot = (LAS int*)(lds + LDS_BYTES - 64);
    grid.sync();
#ifndef NO_P0
    p0_prologue(a, lds);
#endif
    GSYNC(0);
    unsigned char* const ws0 = a.ws; const float* const x00 = a.in[0]; float* const xout0 = a.out;
#ifndef LAST_PH
#define LAST_PH 16
#endif
    for (int ph = 1; ph <= LAST_PH; ++ph) {
        unsigned char* ws = ws0; const float* x0 = x00; float* xout = xout0;
        asm volatile("" : "+s"(ws), "+s"(x0), "+s"(xout));

        const float* mod = (const float*)(ws + WS_MOD);
        bf16_t* H = (bf16_t*)(ws + WS_H); bf16_t* MIX = (bf16_t*)(ws + WS_MIX); bf16_t* BIG = (bf16_t*)(ws + WS_BIG);
        unsigned* ctl = (unsigned*)(ws + WS_CTL);
        const int layer = ph >= 9;
        const float* modl = mod + (size_t)layer * 8 * 6144;
        const float* xin = (layer == 0) ? x0 : xout;
#ifndef REPEAT_PH
#define REPEAT_PH -1
#endif
        for (int rep = 0; rep < ((ph == REPEAT_PH) ? 2 : 1); ++rep) {
        pg8::Gemm g{nullptr, nullptr, T, 0, 0}; pg8::Epi E{0, nullptr, 0, nullptr, nullptr, nullptr, nullptr, nullptr};
        switch (ph) {
#ifndef NO_NORM
        case 1: case 9: norm_phase(xin, modl, 0, 1024, H); break;
        case 6: case 14: norm_phase(xout, modl, 3072, 4096, H); break;
#endif
#ifndef NO_CUM
        case 3: cum_phase(ws, lds); break;
#endif
        case 4:
            for (;;) { const int it = q_next(ctl + 256 * rep, slot); if (it >= 64 + 4096) break;

#ifndef NO_GLA
                if (it < 64) gla_item(ws, lds, it >> 3, it & 7);
#endif
#ifndef NO_FOX
                if (it >= 64) { const int f = it - 64; fox_item(ws, lds, f >> 9, (f >> 6) & 7, f & 63); }
#endif
 }
            break;
        case 11:
            for (;;) { const int it = q_next(ctl + 64 + 256 * rep, slot); if (it >= 256 + 512) break;

#ifndef NO_S5
                if (it < 256) s5_item(ws, lds, it >> 5, it & 31);
#endif
#ifndef NO_SGU
                if (it >= 256) { const int f = it - 256; sgu_item(ws, lds, f >> 6, f & 63); }
#endif
 }
            break;
        case 2: g.A = H; g.Bt = (const bf16_t*)(ws + WS_WIN0); g.N = LD0; g.K = D; E.mode = 0; E.O = BIG; E.ldc = LD0; break;
        case 5: g.A = MIX; g.Bt = (const bf16_t*)(ws + WS_WOUT0); g.N = D; g.K = D; E.mode = 4; E.base = xin; E.out = xout; E.gate = modl + 2048; break;
        case 7: g.A = H; g.Bt = (const bf16_t*)(ws + WS_W1_0); g.N = FFD; g.K = D; E.mode = 1; E.O = BIG; E.ldc = FFD; break;
        case 8: g.A = BIG; g.Bt = (const bf16_t*)(ws + WS_W2_0); g.N = D; g.K = FFD; E.mode = 4; E.base = xout; E.out = xout; E.gate = modl + 5120; break;
        case 10: g.A = H; g.Bt = (const bf16_t*)(ws + WS_WIN1); g.N = LD1; g.K = D; E.mode = 2; E.O = BIG; E.ldc = LD1; break;
        case 12: g.A = H; g.Bt = (const bf16_t*)(ws + WS_WGLU); g.N = 512; g.K = 512; E.mode = 3; E.O = MIX; E.Y = H; E.bias = (const float*)(ws + WS_PRM) + PR_BGLU; break;
        case 13: g.A = MIX; g.Bt = (const bf16_t*)(ws + WS_WOUT1); g.N = D; g.K = D; E.mode = 4; E.base = xout; E.out = xout; E.gate = modl + 2048; break;
        case 15: g.A = H; g.Bt = (const bf16_t*)(ws + WS_W1_1); g.N = FFD; g.K = D; E.mode = 1; E.O = BIG; E.ldc = FFD; break;
        case 16: g.A = BIG; g.Bt = (const bf16_t*)(ws + WS_W2_1); g.N = D; g.K = FFD; E.mode = 4; E.base = xout; E.out = xout; E.gate = modl + 5120; break;
        default: break;
        }
#ifndef NO_GEMM
        if (g.K != 0) { pg8::StaticOrder S; S.init(T, g.N, gridDim.x, blockIdx.x); pg8::gemm_phase(lds, g, S, E); }
#endif
        }
        if (ph != LAST_PH) GSYNC(ph);
    }
}

extern "C" void kernel_launch(void* const* d_in, const int* in_sizes, int n_in, void* d_out, int out_size, void* d_ws, size_t ws_size, hipStream_t stream) {
    static int grid = 0;
    if (grid == 0) {
        if (n_in != 30 || out_size != T * D || ws_size < WS_END) { fprintf(stderr, "kernel_launch: unexpected shapes (n_in %d out %d ws %zu)\n", n_in, out_size, ws_size); grid = -1; return; }
        int dev = 0, cus = 0, per_cu = 0;
        hipGetDevice(&dev); hipDeviceGetAttribute(&cus, hipDeviceAttributeMultiprocessorCount, dev);
        hipFuncSetAttribute((const void*)mega_fwd, hipFuncAttributeMaxDynamicSharedMemorySize, LDS_BYTES);
        hipOccupancyMaxActiveBlocksPerMultiprocessor(&per_cu, (const void*)mega_fwd, NT, LDS_BYTES);
        if (per_cu < 1) { fprintf(stderr, "kernel_launch: occupancy query says %d blocks/CU\n", per_cu); per_cu = 1; }
        grid = cus * 1;
        (void)hipGetLastError();
    }
    if (grid < 0) return;
    (void)hipMemsetAsync((char*)d_ws + WS_CTL, 0, 4096, stream);
    Args a{};
    for (int i = 0; i < 30; ++i) a.in[i] = (const float*)d_in[i];
    a.out = (float*)d_out; a.ws = (unsigned char*)d_ws;
    void* args[] = {&a};
    hipError_t e = hipLaunchCooperativeKernel((const void*)mega_fwd, dim3(grid), dim3(NT), args, LDS_BYTES, stream);
    if (e != hipSuccess) fprintf(stderr, "cooperative launch failed: %s (grid %d)\n", hipGetErrorString(e), grid);
}
```

```cpp
#include <hip/hip_runtime.h>
#include <hip/hip_cooperative_groups.h>
#include <cstdio>
namespace cg = cooperative_groups;

#define LAS __attribute__((address_space(3)))
#define GAS __attribute__((address_space(1)))
typedef unsigned short bf16_t;
typedef short bf16x8 __attribute__((ext_vector_type(8)));
typedef short bf16x4 __attribute__((ext_vector_type(4)));
typedef float f32x4 __attribute__((ext_vector_type(4)));
typedef float f32x2 __attribute__((ext_vector_type(2)));
typedef unsigned u32x4 __attribute__((ext_vector_type(4)));
typedef unsigned u32x2 __attribute__((ext_vector_type(2)));

constexpr int T = 65536, SEQ = 8192, D = 1024, FFD = 4096;
constexpr int LD0 = 3840, LD1 = 1536;
constexpr int C_GQ = 0, C_GK = 512, C_GV = 1024, C_GG = 1536, C_FQ = 2048, C_FK = 2560, C_FV = 3072, C_LR = 3584, C_FF = 3600;
constexpr float EPS = 1e-6f;
constexpr size_t MiB = 1u << 20;
constexpr size_t WS_CTL = 0, WS_WIN0 = 2 * MiB, WS_WOUT0 = 10 * MiB, WS_W1_0 = 12 * MiB, WS_W2_0 = 20 * MiB, WS_WIN1 = 28 * MiB, WS_WOUT1 = 31 * MiB,
                 WS_WGLU = 33 * MiB, WS_W1_1 = 34 * MiB, WS_W2_1 = 42 * MiB, WS_WSB = 50 * MiB, WS_MOD = 51 * MiB, WS_S5P = 52 * MiB, WS_CUM = 53 * MiB,
                 WS_H = 64 * MiB, WS_MIX = 192 * MiB, WS_BIG = 320 * MiB, WS_WB0 = 832 * MiB, WS_WB1 = 896 * MiB, WS_WB2 = 920 * MiB, WS_END = 984 * MiB;
constexpr size_t WS_PRM = 56 * MiB, WS_ROWSS = 57 * MiB  , WS_SHW = 61 * MiB  , WS_YS5 = WS_BIG + 256 * MiB;
constexpr int PR_WLR = 0, PR_BLR = 8192, PR_GGAIN = 8704, PR_BF = 9216, PR_QG = 9280, PR_KG = 9792, PR_S5D = 10304, PR_BGLU = 10816, PR_LNG = 11328, PR_LNB = 11840, PR_BS = 12352;
constexpr size_t S5_ABAR = 0, S5_BB = 16384, S5_CM = 16384 + 131072;
constexpr int LDS_BYTES = 147456;
constexpr int NT = 512;

struct Args { const float* in[30]; float* out; unsigned char* ws; };

typedef __bf16 bf16x2_t __attribute__((ext_vector_type(2)));
__device__ __forceinline__ unsigned pkbf(float lo, float hi) { f32x2 v = {lo, hi}; bf16x2_t b = __builtin_convertvector(v, bf16x2_t); return __builtin_bit_cast(unsigned, b); }
__device__ __forceinline__ float bflo(unsigned w) { return __uint_as_float(w << 16); }
__device__ __forceinline__ float bfhi(unsigned w) { return __uint_as_float(w & 0xffff0000u); }
__device__ __forceinline__ void unpack8(u32x4 w, float* f) { f[0] = bflo(w.x); f[1] = bfhi(w.x); f[2] = bflo(w.y); f[3] = bfhi(w.y); f[4] = bflo(w.z); f[5] = bfhi(w.z); f[6] = bflo(w.w); f[7] = bfhi(w.w); }
__device__ __forceinline__ float sigmoidf_(float x) { return 1.0f / (1.0f + __expf(-x)); }
__device__ __forceinline__ float siluf_(float x) { return x * sigmoidf_(x); }
__device__ __forceinline__ float gelu_tanh(float x) { const float u = 1.5957691216057308f * (x + 0.044715f * x * x * x); return x * sigmoidf_(u); }
__device__ __forceinline__ float logsig(float x) { return fminf(x, 0.f) - __logf(1.0f + __expf(-fabsf(x))); }
__device__ __forceinline__ int otid() { int t = threadIdx.x; asm volatile("" : "+v"(t)); return t; }
#define LDS_WAIT() asm volatile("s_waitcnt lgkmcnt(0)" ::: "memory")
#define BAR_LDS() do { asm volatile("s_waitcnt lgkmcnt(0)" ::: "memory"); __builtin_amdgcn_s_barrier(); asm volatile("" ::: "memory"); } while (0)
#define MFMA16(a, b, c) __builtin_amdgcn_mfma_f32_16x16x32_bf16((a), (b), (c), 0, 0, 0)
__device__ __forceinline__ bf16x8 as_bf16x8(u32x4 v) { return __builtin_bit_cast(bf16x8, v); }

namespace pg8 {
constexpr int BM = 256, BK = 64, HALF = 128, HTB = HALF * BK * 2, STAGE_BYTES = 8 * HTB, NXCD = 8, WGM = 8;
__device__ __forceinline__ int lds_byte(int r, int c) { const int st = (r >> 4) * 2 + (c >> 5), rr = r & 15, cc = c & 31, ob = rr * 64 + cc * 2; return st * 1024 + (ob ^ (((ob >> 9) & 1) << 5)); }
__device__ __forceinline__ void stage_rc(int b, int& R, int& C) { const int st = b / 1024, sb = b % 1024, swz = sb ^ (((sb >> 9) & 1) << 5); R = (st >> 1) * 16 + swz / 64; C = (st & 1) * 32 + (swz % 64) / 2; }
__device__ __forceinline__ int perm32(int rho) { const int n = rho >> 4, i = rho & 15; return 8 * (i >> 2) + 4 * n + (i & 3); }
struct Unit { int pm, pn; };
struct Gemm { const bf16_t* A; const bf16_t* Bt; int M, N, K; size_t bbatch; };
struct StaticOrder {
    int nM, nN, nwg, G, c;
    __device__ void init(int M, int N, int G_, int c_) { nM = M / BM; nN = N / BM; nwg = nM * nN; G = G_; c = c_; }
    __device__ bool next(int i, Unit& u) const {
        const long L = (long)i * G + c; if (L >= nwg) return false;
        int wgid = (int)L; { const int q = nwg / NXCD, r = nwg % NXCD, xcd = wgid % NXCD, off = wgid / NXCD; wgid = (xcd < r ? xcd * (q + 1) : r * (q + 1) + (xcd - r) * q) + off; }
        const int nig = WGM * nN, gid = wgid / nig, fm = gid * WGM, gsz = (nM - fm) < WGM ? (nM - fm) : WGM;
        u.pm = fm + ((wgid % nig) % gsz); u.pn = (wgid % nig) / gsz; return true;
    }
};

struct Epi {
    int mode, sub; GAS bf16_t* O; int ldc; const GAS float* base32; GAS float* out32; const GAS float* gate; const GAS bf16_t* Y; const GAS float* bias; GAS float* rowss; const GAS float* shw; int ldsh;
    __device__ __forceinline__ void operator()(const f32x4 (&acc)[2][2][4][2], const Unit& u, int wr, int wc, int fr, int fq) const {
        const int row0 = u.pm * BM + wr * 64 + fr, col0 = u.pn * BM + wc * 32 + 8 * fq, bidx = (u.pm * BM) >> 13;
        if (mode >= 6) {
            const GAS float* gp = gate + (size_t)bidx * 6144 + col0;
            f32x4 gg[2][2];
#pragma unroll
            for (int bj = 0; bj < 2; ++bj) { gg[bj][0] = *(const GAS f32x4*)(gp + bj * HALF); gg[bj][1] = *(const GAS f32x4*)(gp + bj * HALF + 4); }
            if (mode == 6) {
#pragma unroll
                for (int ai = 0; ai < 2; ++ai)
#pragma unroll
                    for (int mh = 0; mh < 2; ++mh) { f32x4 bb[2][2][2];
#pragma unroll
                        for (int ml = 0; ml < 2; ++ml) { const size_t off = (size_t)(row0 + ai * HALF + (2 * mh + ml) * 16) * D + col0;
#pragma unroll
                            for (int bj = 0; bj < 2; ++bj) { bb[ml][bj][0] = *(const GAS f32x4*)(base32 + off + bj * HALF); bb[ml][bj][1] = *(const GAS f32x4*)(base32 + off + bj * HALF + 4); } }
#pragma unroll
                        for (int ml = 0; ml < 2; ++ml) { const int m = 2 * mh + ml; const size_t row = (size_t)(row0 + ai * HALF + m * 16), off = row * D + col0; float ss = 0.f;
#pragma unroll
                            for (int bj = 0; bj < 2; ++bj) { const f32x4 x0 = bb[ml][bj][0] + gg[bj][0] * acc[ai][bj][m][0], x1 = bb[ml][bj][1] + gg[bj][1] * acc[ai][bj][m][1];
                                ss += (x0[0] * x0[0] + x0[1] * x0[1]) + (x0[2] * x0[2] + x0[3] * x0[3]) + (x1[0] * x1[0] + x1[1] * x1[1]) + (x1[2] * x1[2] + x1[3] * x1[3]);
                                u32x4 w; w.x = pkbf(x0[0], x0[1]); w.y = pkbf(x0[2], x0[3]); w.z = pkbf(x1[0], x1[1]); w.w = pkbf(x1[2], x1[3]); *(GAS u32x4*)(O + off + bj * HALF) = w; }
                            ss += __shfl_xor(ss, 16); ss += __shfl_xor(ss, 32); if (fq == 0) rowss[row * 16 + u.pn * 4 + wc] = ss; }
                        asm volatile("" ::: "memory"); }
            } else {
#pragma unroll
                for (int ai = 0; ai < 2; ++ai) { u32x4 bw[4][2];
#pragma unroll
                    for (int m = 0; m < 4; ++m) { const size_t off = (size_t)(row0 + ai * HALF + m * 16) * D + col0;
#pragma unroll
                        for (int bj = 0; bj < 2; ++bj) bw[m][bj] = *(const GAS u32x4*)(O + off + bj * HALF); }
#pragma unroll
                    for (int m = 0; m < 4; ++m) { const size_t row = (size_t)(row0 + ai * HALF + m * 16), off = row * D + col0; float ss = 0.f;
#pragma unroll
                        for (int bj = 0; bj < 2; ++bj) { const u32x4 t = bw[m][bj];
                            const f32x4 b0 = (f32x4){bflo(t.x), bfhi(t.x), bflo(t.y), bfhi(t.y)}, b1 = (f32x4){bflo(t.z), bfhi(t.z), bflo(t.w), bfhi(t.w)};
                            const f32x4 x0 = b0 + gg[bj][0] * acc[ai][bj][m][0], x1 = b1 + gg[bj][1] * acc[ai][bj][m][1];
                            if (mode == 8) { *(GAS f32x4*)(out32 + off + bj * HALF) = x0; *(GAS f32x4*)(out32 + off + bj * HALF + 4) = x1; }
                            else { ss += (x0[0] * x0[0] + x0[1] * x0[1]) + (x0[2] * x0[2] + x0[3] * x0[3]) + (x1[0] * x1[0] + x1[1] * x1[1]) + (x1[2] * x1[2] + x1[3] * x1[3]);
                                u32x4 w; w.x = pkbf(x0[0], x0[1]); w.y = pkbf(x0[2], x0[3]); w.z = pkbf(x1[0], x1[1]); w.w = pkbf(x1[2], x1[3]); *(GAS u32x4*)(O + off + bj * HALF) = w; } }
                        if (mode != 8) { ss += __shfl_xor(ss, 16); ss += __shfl_xor(ss, 32); if (fq == 0) rowss[row * 16 + u.pn * 4 + wc] = ss; } }
                    asm volatile("" ::: "memory"); }
            }
        } else if (mode == 3) {
#pragma unroll
            for (int bj = 0; bj < 2; ++bj) {
                const f32x4 b0 = *(const GAS f32x4*)(bias + col0 + bj * HALF), b1 = *(const GAS f32x4*)(bias + col0 + bj * HALF + 4);
#pragma unroll
                for (int ai = 0; ai < 2; ++ai)
#pragma unroll
                    for (int m = 0; m < 4; ++m) { const size_t row = (size_t)(row0 + ai * HALF + m * 16);
                        const u32x4 yw = *(const GAS u32x4*)(Y + row * 512 + col0 + bj * HALF); float y[8]; unpack8(yw, y);
                        const f32x4 v0 = acc[ai][bj][m][0] + b0, v1 = acc[ai][bj][m][1] + b1; float o[8];
#pragma unroll
                        for (int j = 0; j < 4; ++j) { o[j] = y[j] * sigmoidf_(v0[j]); o[4 + j] = y[4 + j] * sigmoidf_(v1[j]); }
                        u32x4 w; w.x = pkbf(o[0], o[1]); w.y = pkbf(o[2], o[3]); w.z = pkbf(o[4], o[5]); w.w = pkbf(o[6], o[7]);
                        *(GAS u32x4*)(O + row * D + col0 + bj * HALF) = w; asm volatile("" ::: "memory"); } }
        } else {
            const bool act2 = (sub == 2) && (u.pn >= 2);
            float rr[8]; f32x4 sb[2][2];
#pragma unroll
            for (int j = 0; j < 8; ++j) rr[j] = 1.0f;
#pragma unroll
            for (int bj = 0; bj < 2; ++bj) { sb[bj][0] = (f32x4){0.f, 0.f, 0.f, 0.f}; sb[bj][1] = sb[bj][0]; }
            if (mode == 5) {
                const int lane = fq * 16 + fr; float slot[2];
                f32x4 pp[2][4];
#pragma unroll
                for (int h = 0; h < 2; ++h) { const int li = lane + 64 * h, am = li >> 4; const size_t row = (size_t)(u.pm * BM + (am >> 2) * HALF + wr * 64 + (am & 3) * 16 + (li & 15));
                    const GAS f32x4* rp = (const GAS f32x4*)(rowss + row * 16);
#pragma unroll
                    for (int k = 0; k < 4; ++k) pp[h][k] = rp[k]; }
                const GAS float* sp = shw + (size_t)bidx * ldsh + col0;
#pragma unroll
                for (int bj = 0; bj < 2; ++bj) { sb[bj][0] = *(const GAS f32x4*)(sp + bj * HALF); sb[bj][1] = *(const GAS f32x4*)(sp + bj * HALF + 4); }
#pragma unroll
                for (int h = 0; h < 2; ++h) { const f32x4 s = (pp[h][0] + pp[h][1]) + (pp[h][2] + pp[h][3]); slot[h] = rsqrtf(((s[0] + s[1]) + (s[2] + s[3])) * (1.0f / D) + EPS); }
#pragma unroll
                for (int j = 0; j < 8; ++j) rr[j] = __shfl(slot[j >> 2], (j & 3) * 16 + fr);
            }
#pragma unroll
            for (int ai = 0; ai < 2; ++ai)
#pragma unroll
                for (int m = 0; m < 4; ++m) { const size_t row = (size_t)(row0 + ai * HALF + m * 16); GAS bf16_t* rowp = O + row * ldc + col0; const float r = rr[ai * 4 + m];
#pragma unroll
                    for (int bj = 0; bj < 2; ++bj) { f32x4 v0 = acc[ai][bj][m][0], v1 = acc[ai][bj][m][1];
                        if (mode == 5) { v0 = v0 * r + sb[bj][0]; v1 = v1 * r + sb[bj][1]; }
                        if (sub == 1) {
#pragma unroll
                            for (int j = 0; j < 4; ++j) { const float a0 = fmaxf(v0[j], 0.f), a1 = fmaxf(v1[j], 0.f); v0[j] = a0 * a0; v1[j] = a1 * a1; } }
                        if (act2) {
#pragma unroll
                            for (int j = 0; j < 4; ++j) { v0[j] = gelu_tanh(v0[j]); v1[j] = gelu_tanh(v1[j]); } }
                        u32x4 w; w.x = pkbf(v0[0], v0[1]); w.y = pkbf(v0[2], v0[3]); w.z = pkbf(v1[0], v1[1]); w.w = pkbf(v1[2], v1[3]);
                        *(GAS u32x4*)(rowp + bj * HALF) = w; }
                    asm volatile("" ::: "memory"); }
        }
    }
};

__device__ __forceinline__ void gemm_phase(LAS unsigned char* lds, const Gemm g, const StaticOrder& S, const Epi& E) {

    const int tid = otid(), wid = __builtin_amdgcn_readfirstlane(tid >> 6), lane = tid & 63, wr = wid >> 2, wc = wid & 3, fr = lane & 15, fq = lane >> 4;
    const int K = g.K, nt = K / BK;
    unsigned voffA[2], voffB[2];
#pragma unroll
    for (int i = 0; i < 2; ++i) { int R, C; stage_rc(tid * 16 + i * 8192, R, C); const int Rb = (R & ~31) + perm32(R & 31);
        voffA[i] = (unsigned)(R * K + C) * 2u; voffB[i] = (unsigned)(Rb * K + C) * 2u; }
    const size_t kstep = (size_t)(BK * 2);
    const size_t hstep = (size_t)HALF * K * 2;
    const size_t tstep = 2 * hstep;
    const unsigned ldsw = (unsigned)wid * 1024u;
    const int aoff = lds_byte(wr * 64 + fr, fq * 8), boff = lds_byte(wc * 32 + fr, fq * 8);
#define PG8_SA(b, h) (((b) * 2 + (h)) * HTB)
#define PG8_SB(b, h) ((4 + (b) * 2 + (h)) * HTB)
#define PG8_STAGE(bufoff, gbase, voff) do { _Pragma("unroll") for (int _i = 0; _i < 2; ++_i) \
        __builtin_amdgcn_global_load_lds((const unsigned*)((const char*)(gbase) + (voff)[_i]), (LAS unsigned*)(lds + (bufoff) + ldsw + _i * 8192), 16, 0, 0); } while (0)
#define PG8_LDA(dst, b, h) do { _Pragma("unroll") for (int m = 0; m < 4; ++m) _Pragma("unroll") for (int k = 0; k < 2; ++k) dst[m][k] = *(const LAS bf16x8*)(lds + PG8_SA(b, h) + aoff + m * 2048 + k * 1024); } while (0)
#define PG8_LDB(dst, b, h) do { _Pragma("unroll") for (int n = 0; n < 2; ++n) _Pragma("unroll") for (int k = 0; k < 2; ++k) dst[n][k] = *(const LAS bf16x8*)(lds + PG8_SB(b, h) + boff + n * 2048 + k * 1024); } while (0)
#define PG8_MMA(ai, bj, At, Bt) do { __builtin_amdgcn_s_setprio(1); _Pragma("unroll") for (int m = 0; m < 4; ++m) _Pragma("unroll") for (int n = 0; n < 2; ++n) _Pragma("unroll") for (int k = 0; k < 2; ++k) \
        acc[ai][bj][m][n] = __builtin_amdgcn_mfma_f32_16x16x32_bf16(Bt[n][k], At[m][k], acc[ai][bj][m][n], 0, 0, 0); __builtin_amdgcn_s_setprio(0); } while (0)
#define PG8_WAIT_V(n) asm volatile("s_waitcnt vmcnt(" #n ")" ::: "memory")
#define PG8_WAIT_L(n) asm volatile("s_waitcnt lgkmcnt(" #n ")" ::: "memory")
#define PG8_BAR __builtin_amdgcn_s_barrier()
#define PG8_SCHED __builtin_amdgcn_sched_barrier(0)
    Unit cur, nxt; int ui = 0;
    if (!S.next(0, cur)) return;
    f32x4 acc[2][2][4][2];
#pragma unroll
    for (int a = 0; a < 2; ++a)
#pragma unroll
        for (int b = 0; b < 2; ++b)
#pragma unroll
            for (int m = 0; m < 4; ++m)
#pragma unroll
                for (int n = 0; n < 2; ++n) acc[a][b][m][n] = (f32x4){0.f, 0.f, 0.f, 0.f};
    bf16x8 At[4][2], B0[2][2], B1[2][2];
    const char* cA = (const char*)g.A + (size_t)cur.pm * tstep; const char* cB = (const char*)g.Bt + (size_t)cur.pn * tstep + (size_t)(cur.pm >> 5) * g.bbatch;
    PG8_STAGE(PG8_SB(0, 0), cB, voffB); PG8_STAGE(PG8_SA(0, 0), cA, voffA); PG8_STAGE(PG8_SB(0, 1), cB + hstep, voffB); PG8_STAGE(PG8_SA(0, 1), cA + hstep, voffA);
    if (wr == 1) PG8_BAR;
    PG8_WAIT_V(4); PG8_BAR;
    PG8_STAGE(PG8_SB(1, 0), cB + kstep, voffB); PG8_STAGE(PG8_SA(1, 0), cA + kstep, voffA); PG8_STAGE(PG8_SB(1, 1), cB + hstep + kstep, voffB);
    PG8_WAIT_V(6); PG8_BAR;
    for (;;) {
        const bool has_next = S.next(ui + 1, nxt);
        const char* nA = has_next ? (const char*)g.A + (size_t)nxt.pm * tstep : cA; const char* nB = has_next ? (const char*)g.Bt + (size_t)nxt.pn * tstep + (size_t)(nxt.pm >> 5) * g.bbatch : cB;
        for (int t = 0; t < nt; t += 2) {
            const bool last = (t == nt - 2);
            const char* a1 = cA + (size_t)(t + 1) * kstep;
            const char* a2 = last ? nA : cA + (size_t)(t + 2) * kstep; const char* b2 = last ? nB : cB + (size_t)(t + 2) * kstep;
            const char* a3 = a2 + kstep; const char* b3 = b2 + kstep;
            PG8_LDB(B0, 0, 0); PG8_SCHED; PG8_LDA(At, 0, 0); PG8_STAGE(PG8_SA(1, 1), a1 + hstep, voffA);
            PG8_WAIT_L(8); PG8_BAR; PG8_WAIT_L(0); PG8_MMA(0, 0, At, B0); PG8_BAR; PG8_SCHED;
            PG8_LDB(B1, 0, 1); PG8_STAGE(PG8_SB(0, 0), b2, voffB);
            PG8_BAR; PG8_WAIT_L(0); PG8_MMA(0, 1, At, B1); PG8_BAR;
            PG8_LDA(At, 0, 1); PG8_STAGE(PG8_SA(0, 0), a2, voffA);
            PG8_BAR; PG8_WAIT_L(0); PG8_MMA(1, 0, At, B0); PG8_BAR; PG8_SCHED;
            PG8_STAGE(PG8_SB(0, 1), b2 + hstep, voffB);
            PG8_WAIT_V(6); PG8_BAR; PG8_MMA(1, 1, At, B1); PG8_BAR;
            PG8_LDB(B0, 1, 0); PG8_SCHED; PG8_LDA(At, 1, 0); PG8_STAGE(PG8_SA(0, 1), a2 + hstep, voffA);
            PG8_WAIT_L(8); PG8_BAR; PG8_WAIT_L(0); PG8_MMA(0, 0, At, B0); PG8_BAR; PG8_SCHED;
            PG8_LDB(B1, 1, 1); PG8_STAGE(PG8_SB(1, 0), b3, voffB);
            PG8_BAR; PG8_WAIT_L(0); PG8_MMA(0, 1, At, B1); PG8_BAR;
            PG8_LDA(At, 1, 1); PG8_STAGE(PG8_SA(1, 0), a3, voffA);
            PG8_BAR; PG8_WAIT_L(0); PG8_MMA(1, 0, At, B0); PG8_BAR; PG8_SCHED;
            PG8_STAGE(PG8_SB(1, 1), b3 + hstep, voffB);
            PG8_WAIT_V(6); PG8_BAR; PG8_MMA(1, 1, At, B1); PG8_BAR;
        }
        E(acc, cur, wr, wc, fr, fq);
        if (!has_next) break;
#pragma unroll
        for (int a = 0; a < 2; ++a)
#pragma unroll
            for (int b = 0; b < 2; ++b)
#pragma unroll
                for (int m = 0; m < 4; ++m)
#pragma unroll
                    for (int n = 0; n < 2; ++n) acc[a][b][m][n] = (f32x4){0.f, 0.f, 0.f, 0.f};
        cur = nxt; cA = nA; cB = nB; ++ui;
    }
    PG8_WAIT_V(0);
    if (wr == 0) PG8_BAR;
    PG8_BAR;
#undef PG8_SA
#undef PG8_SB
#undef PG8_STAGE
#undef PG8_LDA
#undef PG8_LDB
#undef PG8_MMA
#undef PG8_WAIT_V
#undef PG8_WAIT_L
#undef PG8_BAR
#undef PG8_SCHED
}

}

__device__ __forceinline__ void tr_item(const float* W, int ldw, int ncol0, int K, int nblk, bf16_t* WT, int row_off, LAS float* scr, int item, int lane) {
    const int kb = item / nblk, nb = item % nblk, k0 = 64 * kb, n0 = 32 * nb;
#pragma unroll 8
    for (int i = 0; i < 32; ++i) { const int kk = 2 * i + (lane >> 5); scr[kk * 33 + (lane & 31)] = W[(size_t)(k0 + kk) * ldw + ncol0 + n0 + (lane & 31)]; }
    LDS_WAIT();
    const int c = lane & 7;
#pragma unroll
    for (int j = 0; j < 4; ++j) { const int n = (lane >> 3) + 8 * j; const LAS float* s = scr + (8 * c) * 33 + n;
        u32x4 o; o.x = pkbf(s[0 * 33], s[1 * 33]); o.y = pkbf(s[2 * 33], s[3 * 33]); o.z = pkbf(s[4 * 33], s[5 * 33]); o.w = pkbf(s[6 * 33], s[7 * 33]);
        *(u32x4*)(WT + (size_t)(row_off + n0 + n) * K + k0 + 8 * c) = o; }
    LDS_WAIT();
}

__device__ __forceinline__ void p0_prologue(const Args& a, LAS unsigned char* lds) {
    const int tid = otid(), lane = tid & 63, wave = __builtin_amdgcn_readfirstlane(tid >> 6);
    unsigned char* ws = a.ws;
    if (blockIdx.x < 192) {
        LAS float* cact = (LAS float*)lds;
        LAS float* red = (LAS float*)(lds + 32768);
        const float* c = a.in[1];
        for (int i = tid; i < 8192; i += NT) cact[i] = siluf_(c[i]);
        __syncthreads();
        const int item = blockIdx.x, layer = item / 96, e = 64 * (item % 96) + lane;
        const float* wp = a.in[2] + (size_t)layer * D * 6144 + e;
        float acc[8];
#pragma unroll
        for (int b = 0; b < 8; ++b) acc[b] = 0.f;
        for (int k0 = wave * 128; k0 < wave * 128 + 128; k0 += 8) {
            float wv[8];
#pragma unroll
            for (int i = 0; i < 8; ++i) wv[i] = wp[(size_t)(k0 + i) * 6144];
#pragma unroll
            for (int i = 0; i < 8; ++i)
#pragma unroll
                for (int b = 0; b < 8; ++b) acc[b] += cact[b * 1024 + k0 + i] * wv[i];
        }
#pragma unroll
        for (int b = 0; b < 8; ++b) red[(wave * 8 + b) * 64 + lane] = acc[b];
        __syncthreads();
        { const int b = tid >> 6; float s = 0.f;
#pragma unroll
          for (int w = 0; w < 8; ++w) s += red[(w * 8 + b) * 64 + lane];
          ((float*)(ws + WS_MOD))[(size_t)(layer * 8 + b) * 6144 + e] = s + a.in[3][layer * 6144 + e]; }
        __syncthreads();
    }
    {
        LAS float* scr = (LAS float*)(lds + wave * 16384);
        const int gw = blockIdx.x * 8 + wave, NGW = gridDim.x * 8;
        constexpr int I0 = 16 * 64, I1 = 16 * 48, I2 = 16 * 32, I3 = 16 * 128, I4 = 64 * 32, I5 = 16 * 48, I6 = 16 * 32, I7 = 8 * 16, I8 = I3, I9 = I4;
        constexpr int NIT = I0 + I1 + I2 + I3 + I4 + I5 + I6 + I7 + I8 + I9;
        for (int it = gw; it < NIT; it += NGW) {
            int r = it;
            if (r < I0) { tr_item(a.in[4], 3608, 0, 1024, 64, (bf16_t*)(ws + WS_WIN0), 0, scr, r, lane); continue; } r -= I0;
            if (r < I1) { tr_item(a.in[4], 3608, 2064, 1024, 48, (bf16_t*)(ws + WS_WIN0), 2048, scr, r, lane); continue; } r -= I1;
            if (r < I2) { tr_item(a.in[5], 1024, 0, 1024, 32, (bf16_t*)(ws + WS_WOUT0), 0, scr, r, lane); continue; } r -= I2;
            if (r < I3) { tr_item(a.in[28], 4096, 0, 1024, 128, (bf16_t*)(ws + WS_W1_0), 0, scr, r, lane); continue; } r -= I3;
            if (r < I4) { tr_item(a.in[29], 1024, 0, 4096, 32, (bf16_t*)(ws + WS_W2_0), 0, scr, r, lane); continue; } r -= I4;
            if (r < I5) { tr_item(a.in[12], 1536, 0, 1024, 48, (bf16_t*)(ws + WS_WIN1), 0, scr, r, lane); continue; } r -= I5;
            if (r < I6) { tr_item(a.in[13], 1024, 0, 1024, 32, (bf16_t*)(ws + WS_WOUT1), 0, scr, r, lane); continue; } r -= I6;
            if (r < I7) { tr_item(a.in[22], 512, 0, 512, 16, (bf16_t*)(ws + WS_WGLU), 0, scr, r, lane); continue; } r -= I7;
            if (r < I8) { tr_item(a.in[28] + (size_t)D * FFD, 4096, 0, 1024, 128, (bf16_t*)(ws + WS_W1_1), 0, scr, r, lane); continue; } r -= I8;
            tr_item(a.in[29] + (size_t)D * FFD, 1024, 0, 4096, 32, (bf16_t*)(ws + WS_W2_1), 0, scr, r, lane);
        }
    }
    {
        if (blockIdx.x == 0 && tid == 0) { unsigned* ctl = (unsigned*)(ws + WS_CTL); __hip_atomic_store(ctl, 0u, __ATOMIC_RELAXED, __HIP_MEMORY_SCOPE_AGENT); __hip_atomic_store(ctl + 64, 0u, __ATOMIC_RELAXED, __HIP_MEMORY_SCOPE_AGENT); }
        const int gt = blockIdx.x * NT + tid, NGT = gridDim.x * NT;
        bf16_t* win0 = (bf16_t*)(ws + WS_WIN0);
        for (int i = gt; i < 256 * 1024; i += NGT) { const int n = i >> 10, k = i & 1023; float v = 0.f;
            if (n < 16) v = a.in[4][(size_t)k * 3608 + 2048 + n]; else if (n < 24) v = a.in[4][(size_t)k * 3608 + 3600 + (n - 16)];
            win0[(size_t)(3584 + n) * 1024 + k] = (bf16_t)(pkbf(v, 0.f) & 0xffffu); }
        bf16_t* wsb = (bf16_t*)(ws + WS_WSB);
        for (int i = gt; i < 8 * 128 * 128; i += NGT) { const int t = (i >> 7) & 127, s = i & 127; const float v = (s <= t) ? a.in[26][i] : 0.f; wsb[i] = (bf16_t)(pkbf(v, 0.f) & 0xffffu); }
        { float* prm = (float*)(ws + WS_PRM);
          for (int i = gt; i < 8192; i += NGT) prm[PR_WLR + i] = a.in[6][i];
          for (int i = gt; i < 1024; i += NGT) prm[PR_BS + i] = a.in[27][i];
          for (int i = gt; i < 512; i += NGT) { prm[PR_BLR + i] = a.in[7][i]; prm[PR_GGAIN + i] = a.in[8][i]; prm[PR_QG + i] = a.in[10][i]; prm[PR_KG + i] = a.in[11][i]; prm[PR_S5D + i] = a.in[21][i];
              prm[PR_BGLU + i] = a.in[23][i]; prm[PR_LNG + i] = a.in[24][i]; prm[PR_LNB + i] = a.in[25][i]; }
          for (int i = gt; i < 8; i += NGT) prm[PR_BF + i] = a.in[9][i]; }
        float* abar = (float*)(ws + WS_S5P + S5_ABAR); bf16_t* Bb = (bf16_t*)(ws + WS_S5P + S5_BB); bf16_t* Cm = (bf16_t*)(ws + WS_S5P + S5_CM);
        for (int i = gt; i < 32 * 64; i += NGT) { const int g = i >> 6, p = i & 63;
            const float lr = a.in[14][i], li = a.in[15][i], dt = expf(a.in[16][g]);
            const float mag = expf(lr * dt), ang = li * dt, ar = mag * cosf(ang), ai = mag * sinf(ang), den = lr * lr + li * li;
            const float cr = ((ar - 1.0f) * lr + ai * li) / den, ci = (ai * lr - (ar - 1.0f) * li) / den;
            abar[2 * i] = ar; abar[2 * i + 1] = ai;
            for (int k = 0; k < 16; ++k) { const float br = a.in[17][(size_t)i * 16 + k], bi = a.in[18][(size_t)i * 16 + k];
                Bb[((size_t)g * 128 + p) * 16 + k] = (bf16_t)(pkbf(cr * br - ci * bi, 0.f) & 0xffffu);
                Bb[((size_t)g * 128 + 64 + p) * 16 + k] = (bf16_t)(pkbf(cr * bi + ci * br, 0.f) & 0xffffu); } }
        for (int i = gt; i < 32 * 16 * 64; i += NGT) { const int gi = i >> 6, p = i & 63;
            Cm[(size_t)gi * 128 + p] = (bf16_t)(pkbf(a.in[19][i], 0.f) & 0xffffu); Cm[(size_t)gi * 128 + 64 + p] = (bf16_t)(pkbf(-a.in[20][i], 0.f) & 0xffffu); }
    }
}

__device__ __forceinline__ void norm_phase(const float* x, const float* mod, int off_sh, int off_sc, bf16_t* H) {
    const int tid_ = otid(); const int lane = tid_ & 63, gw = blockIdx.x * 8 + (tid_ >> 6), NGW = gridDim.x * 8;
    for (int m = gw; m < T; m += NGW) {
        const GAS f32x4* xr = (const GAS f32x4*)(x + (size_t)m * D) + lane;
        const GAS float* mp = (const GAS float*)mod + (size_t)(m >> 13) * 6144;
        f32x4 v[4]; float s = 0.f;
#pragma unroll
        for (int j = 0; j < 4; ++j) { v[j] = xr[64 * j]; s += (v[j].x * v[j].x + v[j].y * v[j].y) + (v[j].z * v[j].z + v[j].w * v[j].w); }
#pragma unroll
        for (int o = 1; o < 64; o <<= 1) s += __shfl_xor(s, o);
        const float r = rsqrtf(s * (1.0f / D) + EPS);
        GAS u32x2* o8 = (GAS u32x2*)(H + (size_t)m * D) + lane;
#pragma unroll
        for (int j = 0; j < 4; ++j) { const f32x4 sc = *((const GAS f32x4*)(mp + off_sc) + lane + 64 * j), sh = *((const GAS f32x4*)(mp + off_sh) + lane + 64 * j);
            const f32x4 y = v[j] * r * (sc + 1.0f) + sh; u32x2 w; w.x = pkbf(y.x, y.y); w.y = pkbf(y.z, y.w); o8[64 * j] = w; }
    }
}

__device__ __forceinline__ void prep_phase(unsigned char* ws, LAS unsigned char* lds) {
    const int tid = otid(), lane = tid & 63, wave = tid >> 6;
    const GAS float* mod = (const GAS float*)(ws + WS_MOD);
    LAS float* sc = (LAS float*)lds; LAS float* sh = (LAS float*)(lds + 32768);
    for (int site = 0; site < 3; ++site) {
        const int N = (site == 1) ? LD1 : FFD, layer = site ? 1 : 0, osc = (site == 1) ? 1024 : 4096, osh = (site == 1) ? 0 : 3072;
        const GAS bf16_t* Wt = (const GAS bf16_t*)(ws + (site == 0 ? WS_W1_0 : site == 1 ? WS_WIN1 : WS_W1_1));
        GAS bf16_t* WB = (GAS bf16_t*)(ws + (site == 0 ? WS_WB0 : site == 1 ? WS_WB1 : WS_WB2));
        GAS float* shw = (GAS float*)(ws + WS_SHW) + (size_t)site * 8 * 4096;
        __syncthreads();
        for (int i = tid; i < 8192; i += NT) { const int b = i >> 10, k = i & 1023; const GAS float* mp = mod + (size_t)(layer * 8 + b) * 6144; sc[i] = 1.0f + mp[osc + k]; sh[i] = mp[osh + k]; }
        __syncthreads();
        for (int n = blockIdx.x * 8 + wave; n < N; n += gridDim.x * 8) {
            const u32x4 w0 = *(const GAS u32x4*)(Wt + (size_t)n * D + 16 * lane), w1 = *(const GAS u32x4*)(Wt + (size_t)n * D + 16 * lane + 8);
            float wv[16]; unpack8(w0, wv); unpack8(w1, wv + 8);
#pragma unroll 1
            for (int b = 0; b < 8; ++b) { float o[16]; float dot = 0.f;
#pragma unroll
                for (int i4 = 0; i4 < 4; ++i4) { const f32x4 s4 = *(const LAS f32x4*)(sc + b * 1024 + 16 * lane + 4 * i4), h4 = *(const LAS f32x4*)(sh + b * 1024 + 16 * lane + 4 * i4);
#pragma unroll
                    for (int j = 0; j < 4; ++j) { o[4 * i4 + j] = wv[4 * i4 + j] * s4[j]; dot += wv[4 * i4 + j] * h4[j]; } }
                u32x4 p0, p1; p0.x = pkbf(o[0], o[1]); p0.y = pkbf(o[2], o[3]); p0.z = pkbf(o[4], o[5]); p0.w = pkbf(o[6], o[7]); p1.x = pkbf(o[8], o[9]); p1.y = pkbf(o[10], o[11]); p1.z = pkbf(o[12], o[13]); p1.w = pkbf(o[14], o[15]);
                GAS bf16_t* dst = WB + ((size_t)b * N + n) * D + 16 * lane; *(GAS u32x4*)dst = p0; *(GAS u32x4*)(dst + 8) = p1;
#pragma unroll
                for (int o2 = 1; o2 < 64; o2 <<= 1) dot += __shfl_xor(dot, o2);
                if (lane == 0) shw[(size_t)b * N + n] = dot; }
        }
    }
}

__device__ __forceinline__ void cum_phase(unsigned char* ws, LAS unsigned char* lds) {
    if (blockIdx.x >= 8) return;
    const int b = blockIdx.x, tid = otid(), lane = tid & 63, wave = tid >> 6;
    const bf16_t* P0 = (const bf16_t*)(ws + WS_BIG); float* cum = (float*)(ws + WS_CUM);
    LAS float* wt = (LAS float*)lds;
    float bf[8];
#pragma unroll
    for (int h = 0; h < 8; ++h) bf[h] = ((const float*)(ws + WS_PRM))[PR_BF + h];
    float run[8];
#pragma unroll
    for (int h = 0; h < 8; ++h) run[h] = 0.f;
    const size_t m0 = (size_t)b * SEQ + 16 * tid;
    for (int i = 0; i < 16; ++i) { const u32x4 w = *(const u32x4*)(P0 + (m0 + i) * LD0 + C_FF); float f[8]; unpack8(w, f);
#pragma unroll
        for (int h = 0; h < 8; ++h) run[h] += logsig(f[h] + bf[h]); }
    float incl[8];
#pragma unroll
    for (int h = 0; h < 8; ++h) { float v = run[h];
#pragma unroll
        for (int d = 1; d < 64; d <<= 1) { const float o = __shfl_up(v, d); if (lane >= d) v += o; }
        incl[h] = v; }
    if (lane == 63) {
#pragma unroll
        for (int h = 0; h < 8; ++h) wt[wave * 8 + h] = incl[h]; }
    __syncthreads();
    float off[8];
#pragma unroll
    for (int h = 0; h < 8; ++h) { float o = incl[h] - run[h]; for (int w = 0; w < wave; ++w) o += wt[w * 8 + h]; off[h] = o; }
    for (int i = 0; i < 16; ++i) { const u32x4 w = *(const u32x4*)(P0 + (m0 + i) * LD0 + C_FF); float f[8]; unpack8(w, f);
#pragma unroll
        for (int h = 0; h < 8; ++h) { off[h] += logsig(f[h] + bf[h]); cum[(size_t)(b * 8 + h) * SEQ + 16 * tid + i] = off[h]; } }
}

__device__ __forceinline__ int q_next(unsigned* ctr, LAS int* slot) {
    __syncthreads();
    if (threadIdx.x == 0) *slot = (int)atomicAdd(ctr, 1u);
    __syncthreads();
    return *slot;
}

__device__ __forceinline__ void gla_item(unsigned char* ws, LAS unsigned char* lds, int b, int h) {
    const int tid = otid(), lane = tid & 63, w = __builtin_amdgcn_readfirstlane(tid >> 6), c = lane & 15, q = lane >> 4;
    const GAS bf16_t* P0 = (const GAS bf16_t*)(ws + WS_BIG); GAS bf16_t* MIX = (GAS bf16_t*)(ws + WS_MIX); const GAS float* prm = (const GAS float*)(ws + WS_PRM);
    LAS bf16_t* Qp = (LAS bf16_t*)(lds); LAS bf16_t* Kp = (LAS bf16_t*)(lds + 9216); LAS bf16_t* Kt = (LAS bf16_t*)(lds + 18432); LAS bf16_t* Vt = (LAS bf16_t*)(lds + 27648);
    LAS bf16_t* Pm = (LAS bf16_t*)(lds + 36864); LAS bf16_t* St = (LAS bf16_t*)(lds + 46080); LAS float* dec = (LAS float*)(lds + 55296);
    LAS float* wl = (LAS float*)(lds + 55552); LAS float* blr = (LAS float*)(lds + 59648);
    for (int i = tid; i < 2304; i += NT) ((LAS unsigned*)St)[i] = 0u;
    for (int i = tid; i < 1024; i += NT) wl[i] = prm[PR_WLR + (i >> 6) * 512 + 64 * h + (i & 63)];
    if (tid < 64) blr[tid] = prm[PR_BLR + 64 * h + tid];
    float gain[16];
#pragma unroll
    for (int vi = 0; vi < 4; ++vi)
#pragma unroll
        for (int j = 0; j < 4; ++j) gain[vi * 4 + j] = prm[PR_GGAIN + h * 64 + 16 * vi + 4 * q + j];
    f32x4 sacc[4];
#pragma unroll
    for (int vi = 0; vi < 4; ++vi) sacc[vi] = (f32x4){0.f, 0.f, 0.f, 0.f};
    const size_t rowbase = (size_t)b * SEQ;
    u32x4 rq, rk, rv, rl0, rl1;
    { const GAS bf16_t* p = P0 + (rowbase + lane) * LD0; rq = *(const GAS u32x4*)(p + C_GQ + 64 * h + 8 * w); rk = *(const GAS u32x4*)(p + C_GK + 64 * h + 8 * w); rv = *(const GAS u32x4*)(p + C_GV + 64 * h + 8 * w);
      rl0 = *(const GAS u32x4*)(p + C_LR); rl1 = *(const GAS u32x4*)(p + C_LR + 8); }
    __syncthreads();
    for (int ch = 0; ch < 128; ++ch) {
        {
            float glr[16]; unpack8(rl0, glr); unpack8(rl1, glr + 8);
            f32x4 z0 = *(const LAS f32x4*)(blr + 8 * w), z1 = *(const LAS f32x4*)(blr + 8 * w + 4);
#pragma unroll
            for (int r = 0; r < 16; ++r) { const f32x4 w0 = *(const LAS f32x4*)(wl + r * 64 + 8 * w), w1 = *(const LAS f32x4*)(wl + r * 64 + 8 * w + 4); z0 += w0 * glr[r]; z1 += w1 * glr[r]; }
            float bc[8];
#pragma unroll
            for (int j = 0; j < 4; ++j) { bc[j] = logsig(z0[j]) * 0.0625f; bc[4 + j] = logsig(z1[j]) * 0.0625f; }
#pragma unroll
            for (int d = 1; d < 64; d <<= 1) {
#pragma unroll
                for (int j = 0; j < 8; ++j) { const float o = __shfl_up(bc[j], d); if (lane >= d) bc[j] += o; } }
            float qf[8], kf[8]; unpack8(rq, qf); unpack8(rk, kf);
            float qp[8], kp[8], kpp[8], bl[8];
#pragma unroll
            for (int j = 0; j < 8; ++j) { bl[j] = __shfl(bc[j], 63); qp[j] = qf[j] * 0.125f * __expf(bc[j]); kp[j] = kf[j] * __expf(-bc[j]); kpp[j] = kf[j] * __expf(bl[j] - bc[j]); }
            u32x4 wq, wk; wq.x = pkbf(qp[0], qp[1]); wq.y = pkbf(qp[2], qp[3]); wq.z = pkbf(qp[4], qp[5]); wq.w = pkbf(qp[6], qp[7]);
            wk.x = pkbf(kp[0], kp[1]); wk.y = pkbf(kp[2], kp[3]); wk.z = pkbf(kp[4], kp[5]); wk.w = pkbf(kp[6], kp[7]);
            *(LAS u32x4*)(Qp + lane * 72 + 8 * w) = wq; *(LAS u32x4*)(Kp + lane * 72 + 8 * w) = wk;
            const unsigned vv[4] = {rv.x, rv.y, rv.z, rv.w};
#pragma unroll
            for (int j = 0; j < 8; ++j) { Kt[(8 * w + j) * 72 + lane] = (bf16_t)(pkbf(kpp[j], 0.f) & 0xffffu); Vt[(8 * w + j) * 72 + lane] = (bf16_t)((j & 1) ? (vv[j >> 1] >> 16) : (vv[j >> 1] & 0xffffu)); }
            if (lane == 63) {
#pragma unroll
                for (int j = 0; j < 8; ++j) dec[8 * w + j] = __expf(bl[j]); }
        }
        if (ch + 1 < 128) { const GAS bf16_t* p = P0 + (rowbase + 64 * (ch + 1) + lane) * LD0; rq = *(const GAS u32x4*)(p + C_GQ + 64 * h + 8 * w); rk = *(const GAS u32x4*)(p + C_GK + 64 * h + 8 * w); rv = *(const GAS u32x4*)(p + C_GV + 64 * h + 8 * w);
            rl0 = *(const GAS u32x4*)(p + C_LR); rl1 = *(const GAS u32x4*)(p + C_LR + 8); }
        BAR_LDS();
        f32x4 oacc[4];
        {
            const int ti = w & 3;
            const bf16x8 qf0 = *(const LAS bf16x8*)(Qp + (16 * ti + c) * 72 + 8 * q), qf1 = *(const LAS bf16x8*)(Qp + (16 * ti + c) * 72 + 8 * q + 32);
#pragma unroll
            for (int u = 0; u < 2; ++u) { const int si = 2 * (w >> 2) + u; f32x4 acc = (f32x4){0.f, 0.f, 0.f, 0.f};
                if (si <= ti) { const bf16x8 k0 = *(const LAS bf16x8*)(Kp + (16 * si + c) * 72 + 8 * q), k1 = *(const LAS bf16x8*)(Kp + (16 * si + c) * 72 + 8 * q + 32);
                    acc = MFMA16(k0, qf0, acc); acc = MFMA16(k1, qf1, acc);
#pragma unroll
                    for (int j = 0; j < 4; ++j) if (16 * si + 4 * q + j > 16 * ti + c) acc[j] = 0.f; }
                u32x2 pw; pw.x = pkbf(acc[0], acc[1]); pw.y = pkbf(acc[2], acc[3]);
                *(LAS u32x2*)(Pm + (16 * ti + c) * 72 + 16 * si + 4 * q) = pw; }
            if (w < 4) {
#pragma unroll
                for (int vi = 0; vi < 4; ++vi) { const bf16x8 s0 = *(const LAS bf16x8*)(St + (16 * vi + c) * 72 + 8 * q), s1 = *(const LAS bf16x8*)(St + (16 * vi + c) * 72 + 8 * q + 32);
                    f32x4 acc = (f32x4){0.f, 0.f, 0.f, 0.f}; acc = MFMA16(s0, qf0, acc); acc = MFMA16(s1, qf1, acc); oacc[vi] = acc; } }
        }
        BAR_LDS();
        if (w < 4) {
            const bf16x8 p0 = *(const LAS bf16x8*)(Pm + (16 * w + c) * 72 + 8 * q), p1 = *(const LAS bf16x8*)(Pm + (16 * w + c) * 72 + 8 * q + 32);
            float ssq = 0.f;
#pragma unroll
            for (int vi = 0; vi < 4; ++vi) { const bf16x8 v0 = *(const LAS bf16x8*)(Vt + (16 * vi + c) * 72 + 8 * q), v1 = *(const LAS bf16x8*)(Vt + (16 * vi + c) * 72 + 8 * q + 32);
                oacc[vi] = MFMA16(v0, p0, oacc[vi]); oacc[vi] = MFMA16(v1, p1, oacc[vi]);
#pragma unroll
                for (int j = 0; j < 4; ++j) ssq += oacc[vi][j] * oacc[vi][j]; }
            ssq += __shfl_xor(ssq, 16); ssq += __shfl_xor(ssq, 32);
            const float r = rsqrtf(ssq * (1.0f / 64.0f) + EPS);
            const size_t m = rowbase + 64 * ch + 16 * w + c;
#pragma unroll
            for (int vi = 0; vi < 4; ++vi) { const u32x2 gw = *(const GAS u32x2*)(P0 + m * LD0 + C_GG + 64 * h + 16 * vi + 4 * q);
                const float g0 = bflo(gw.x), g1 = bfhi(gw.x), g2 = bflo(gw.y), g3 = bfhi(gw.y);
                u32x2 ow; ow.x = pkbf(oacc[vi][0] * r * gain[vi * 4 + 0] * siluf_(g0), oacc[vi][1] * r * gain[vi * 4 + 1] * siluf_(g1));
                ow.y = pkbf(oacc[vi][2] * r * gain[vi * 4 + 2] * siluf_(g2), oacc[vi][3] * r * gain[vi * 4 + 3] * siluf_(g3));
                *(GAS u32x2*)(MIX + m * D + 64 * h + 16 * vi + 4 * q) = ow; }
        } else {
            const int ki = w - 4;
            const f32x4 d4 = *(const LAS f32x4*)(dec + 16 * ki + 4 * q);
            const bf16x8 k0 = *(const LAS bf16x8*)(Kt + (16 * ki + c) * 72 + 8 * q), k1 = *(const LAS bf16x8*)(Kt + (16 * ki + c) * 72 + 8 * q + 32);
#pragma unroll
            for (int vi = 0; vi < 4; ++vi) { const bf16x8 v0 = *(const LAS bf16x8*)(Vt + (16 * vi + c) * 72 + 8 * q), v1 = *(const LAS bf16x8*)(Vt + (16 * vi + c) * 72 + 8 * q + 32);
                f32x4 s = sacc[vi] * d4; s = MFMA16(k0, v0, s); s = MFMA16(k1, v1, s); sacc[vi] = s;
                u32x2 sw; sw.x = pkbf(s[0], s[1]); sw.y = pkbf(s[2], s[3]);
                *(LAS u32x2*)(St + (16 * vi + c) * 72 + 16 * ki + 4 * q) = sw; }
        }
        BAR_LDS();
    }
}

__device__ __forceinline__ void fox_item(unsigned char* ws, LAS unsigned char* lds, int b, int h, int qi) {
    const int tid = otid(), lane = tid & 63, w = __builtin_amdgcn_readfirstlane(tid >> 6), c = lane & 15, q = lane >> 4;
    const GAS bf16_t* P0 = (const GAS bf16_t*)(ws + WS_BIG); GAS bf16_t* MIX = (GAS bf16_t*)(ws + WS_MIX);
    const GAS float* cumb = (const GAS float*)(ws + WS_CUM) + (size_t)(b * 8 + h) * SEQ;
    LAS bf16_t* Kn = (LAS bf16_t*)(lds); LAS bf16_t* Vt = (LAS bf16_t*)(lds + 9216); LAS float* cumk = (LAS float*)(lds + 18432);
    const GAS float* gq = (const GAS float*)(ws + WS_PRM) + PR_QG + h * 64; const GAS float* gk = (const GAS float*)(ws + WS_PRM) + PR_KG + h * 64;
    float mq = fabsf(gq[lane]), mk = fabsf(gk[lane]);
#pragma unroll
    for (int o = 1; o < 64; o <<= 1) { mq = fmaxf(mq, __shfl_xor(mq, o)); mk = fmaxf(mk, __shfl_xor(mk, o)); }
    const float B2 = 16.0f * mq * mk * 1.001f;
    const int t0 = 128 * qi, t = t0 + 16 * w + c; const size_t rowbase = (size_t)b * SEQ, m = rowbase + t;
    const float cum_t0 = cumb[t0], cum_t = cumb[t];
    bf16x8 qf[2];
    { const u32x4 r0 = *(const GAS u32x4*)(P0 + m * LD0 + C_FQ + 64 * h + 8 * q), r1 = *(const GAS u32x4*)(P0 + m * LD0 + C_FQ + 64 * h + 8 * q + 32);
      float f[16]; unpack8(r0, f); unpack8(r1, f + 8); float ss = 0.f;
#pragma unroll
      for (int e = 0; e < 16; ++e) ss += f[e] * f[e];
      ss += __shfl_xor(ss, 16); ss += __shfl_xor(ss, 32);
      const float r = rsqrtf(ss * (1.0f / 64.0f) + EPS) * 0.125f;
#pragma unroll
      for (int kk = 0; kk < 2; ++kk) { float g[8];
#pragma unroll
          for (int e = 0; e < 8; ++e) g[e] = f[8 * kk + e] * r * gq[8 * q + 32 * kk + e];
          u32x4 pw; pw.x = pkbf(g[0], g[1]); pw.y = pkbf(g[2], g[3]); pw.z = pkbf(g[4], g[5]); pw.w = pkbf(g[6], g[7]); qf[kk] = as_bf16x8(pw); } }
    f32x4 oacc[4];
#pragma unroll
    for (int di = 0; di < 4; ++di) oacc[di] = (f32x4){0.f, 0.f, 0.f, 0.f};
    float mrun = -1e30f, lpart = 0.f;
    const int srow = tid >> 3, dc = tid & 7;
    float gkr[8];
#pragma unroll
    for (int e = 0; e < 8; ++e) gkr[e] = gk[8 * dc + e];
    int j = 2 * qi + 1;
    u32x4 rk, rv; float rc;
    { const size_t ms = rowbase + 64 * j + srow; rk = *(const GAS u32x4*)(P0 + ms * LD0 + C_FK + 64 * h + 8 * dc); rv = *(const GAS u32x4*)(P0 + ms * LD0 + C_FV + 64 * h + 8 * dc); rc = cumb[64 * j + srow]; }
    for (;;) {
        { float f[8]; unpack8(rk, f); float ss = 0.f;
#pragma unroll
          for (int e = 0; e < 8; ++e) ss += f[e] * f[e];
          ss += __shfl_xor(ss, 1); ss += __shfl_xor(ss, 2); ss += __shfl_xor(ss, 4);
          const float r = rsqrtf(ss * (1.0f / 64.0f) + EPS);
#pragma unroll
          for (int e = 0; e < 8; ++e) f[e] = f[e] * r * gkr[e];
          u32x4 pw; pw.x = pkbf(f[0], f[1]); pw.y = pkbf(f[2], f[3]); pw.z = pkbf(f[4], f[5]); pw.w = pkbf(f[6], f[7]);
          *(LAS u32x4*)(Kn + srow * 72 + 8 * dc) = pw;
          const unsigned vv[4] = {rv.x, rv.y, rv.z, rv.w};
#pragma unroll
          for (int e = 0; e < 8; ++e) Vt[(8 * dc + e) * 72 + srow] = (bf16_t)((e & 1) ? (vv[e >> 1] >> 16) : (vv[e >> 1] & 0xffffu));
          if (dc == 0) cumk[srow] = rc; }
        const int jn = j - 1;
        bool cont = jn >= 0;
        if (cont && jn < 2 * qi) cont = (B2 + cum_t0 - cumb[64 * jn + 63]) >= -110.0f;
        if (cont) { const size_t ms = rowbase + 64 * jn + srow; rk = *(const GAS u32x4*)(P0 + ms * LD0 + C_FK + 64 * h + 8 * dc); rv = *(const GAS u32x4*)(P0 + ms * LD0 + C_FV + 64 * h + 8 * dc); rc = cumb[64 * jn + srow]; }
        BAR_LDS();
        if (!(j == 2 * qi + 1 && w < 4)) {
            float sv[4][4]; float mx = -1e30f;
#pragma unroll
            for (int si = 0; si < 4; ++si) { f32x4 acc = (f32x4){0.f, 0.f, 0.f, 0.f};
                const bf16x8 k0 = *(const LAS bf16x8*)(Kn + (16 * si + c) * 72 + 8 * q), k1 = *(const LAS bf16x8*)(Kn + (16 * si + c) * 72 + 8 * q + 32);
                acc = MFMA16(k0, qf[0], acc); acc = MFMA16(k1, qf[1], acc);
                const f32x4 ck = *(const LAS f32x4*)(cumk + 16 * si + 4 * q);
#pragma unroll
                for (int jj = 0; jj < 4; ++jj) { float lg = acc[jj] + (cum_t - ck[jj]); if (j >= 2 * qi && (64 * j + 16 * si + 4 * q + jj) > t) lg = -1e30f; sv[si][jj] = lg; mx = fmaxf(mx, lg); } }
            mx = fmaxf(mx, __shfl_xor(mx, 16)); mx = fmaxf(mx, __shfl_xor(mx, 32));
            const float mnew = fmaxf(mrun, mx), alpha = __expf(mrun - mnew); mrun = mnew;
            float ps = 0.f;
#pragma unroll
            for (int si = 0; si < 4; ++si)
#pragma unroll
                for (int jj = 0; jj < 4; ++jj) { sv[si][jj] = __expf(sv[si][jj] - mnew); ps += sv[si][jj]; }
            lpart = lpart * alpha + ps;
#pragma unroll
            for (int di = 0; di < 4; ++di) oacc[di] *= alpha;
#pragma unroll
            for (int kk = 0; kk < 2; ++kk) { u32x4 pw; pw.x = pkbf(sv[2 * kk][0], sv[2 * kk][1]); pw.y = pkbf(sv[2 * kk][2], sv[2 * kk][3]); pw.z = pkbf(sv[2 * kk + 1][0], sv[2 * kk + 1][1]); pw.w = pkbf(sv[2 * kk + 1][2], sv[2 * kk + 1][3]);
                const bf16x8 pf = as_bf16x8(pw);
#pragma unroll
                for (int di = 0; di < 4; ++di) { const u32x2 va = *(const LAS u32x2*)(Vt + (16 * di + c) * 72 + 32 * kk + 4 * q), vb = *(const LAS u32x2*)(Vt + (16 * di + c) * 72 + 32 * kk + 16 + 4 * q);
                    u32x4 vw; vw.x = va.x; vw.y = va.y; vw.z = vb.x; vw.w = vb.y; oacc[di] = MFMA16(as_bf16x8(vw), pf, oacc[di]); } }
        }
        BAR_LDS();
        if (!cont) break;
        j = jn;
    }
    float l = lpart; l += __shfl_xor(l, 16); l += __shfl_xor(l, 32);
    const float inv = 1.0f / l;
#pragma unroll
    for (int di = 0; di < 4; ++di) { u32x2 ow; ow.x = pkbf(oacc[di][0] * inv, oacc[di][1] * inv); ow.y = pkbf(oacc[di][2] * inv, oacc[di][3] * inv);
        *(GAS u32x2*)(MIX + m * D + 512 + 64 * h + 16 * di + 4 * q) = ow; }
}

__device__ __forceinline__ void s5_item(unsigned char* ws, LAS unsigned char* lds, int b, int g) {
    const int tid = otid(), lane = tid & 63, w = __builtin_amdgcn_readfirstlane(tid >> 6), c = lane & 15, q = lane >> 4;
    const GAS bf16_t* P1 = (const GAS bf16_t*)(ws + WS_BIG); GAS bf16_t* YS = (GAS bf16_t*)(ws + WS_YS5);
    const GAS float* abar = (const GAS float*)(ws + WS_S5P + S5_ABAR); const GAS bf16_t* Bb = (const GAS bf16_t*)(ws + WS_S5P + S5_BB); const GAS bf16_t* Cm = (const GAS bf16_t*)(ws + WS_S5P + S5_CM);
    LAS float* bu = (LAS float*)(lds + w * 12800); LAS bf16_t* xs = (LAS bf16_t*)(lds + w * 12800 + 8448); LAS float* E = (LAS float*)(lds + 102400);
    const float ar = abar[(g * 64 + lane) * 2], ai = abar[(g * 64 + lane) * 2 + 1];
    float pr = ar, pi = ai;
#pragma unroll
    for (int i = 0; i < 10; ++i) { const float nr = pr * pr - pi * pi, ni = 2.0f * pr * pi; pr = nr; pi = ni; }
    bf16x8 bfr[8], cfr[4];
    const bf16x8 zero8 = (bf16x8){0, 0, 0, 0, 0, 0, 0, 0};
#pragma unroll
    for (int pt = 0; pt < 8; ++pt) bfr[pt] = (q < 2) ? *(const GAS bf16x8*)(Bb + ((size_t)(g * 128 + 16 * pt + c)) * 16 + 8 * q) : zero8;
#pragma unroll
    for (int kk = 0; kk < 4; ++kk) cfr[kk] = *(const GAS bf16x8*)(Cm + (size_t)(g * 16 + c) * 128 + 32 * kk + 8 * q);
    float dsk[4];
#pragma unroll
    for (int j = 0; j < 4; ++j) dsk[j] = ((const GAS float*)(ws + WS_PRM))[PR_S5D + g * 16 + 4 * q + j];
    float xr = 0.f, xi = 0.f;
    for (int pass = 0; pass < 2; ++pass) {
        const size_t mbase = (size_t)b * SEQ + 1024 * w + c;
        bf16x8 uf_n = (q < 2) ? *(const GAS bf16x8*)(P1 + mbase * LD1 + 16 * g + 8 * q) : zero8;
        u32x2 uw_n = *(const GAS u32x2*)(P1 + mbase * LD1 + 16 * g + 4 * q);
        for (int sc = 0; sc < 64; ++sc) {
            const size_t m = mbase + 16 * sc;
            const bf16x8 uf = uf_n; const u32x2 uw = uw_n;
            if (sc + 1 < 64) { const size_t mn = m + 16;
                uf_n = (q < 2) ? *(const GAS bf16x8*)(P1 + mn * LD1 + 16 * g + 8 * q) : zero8; uw_n = *(const GAS u32x2*)(P1 + mn * LD1 + 16 * g + 4 * q); }
#pragma unroll
            for (int pt = 0; pt < 8; ++pt) { f32x4 acc = (f32x4){0.f, 0.f, 0.f, 0.f}; acc = MFMA16(bfr[pt], uf, acc); *(LAS f32x4*)(bu + c * 132 + 16 * pt + 4 * q) = acc; }
            LDS_WAIT();
#pragma unroll
            for (int tt = 0; tt < 16; ++tt) { const float br = bu[tt * 132 + lane], bi = bu[tt * 132 + 64 + lane];
                const float nr = ar * xr - ai * xi + br, ni = ar * xi + ai * xr + bi; xr = nr; xi = ni;
                if (pass) { xs[tt * 136 + lane] = (bf16_t)(pkbf(xr, 0.f) & 0xffffu); xs[tt * 136 + 64 + lane] = (bf16_t)(pkbf(xi, 0.f) & 0xffffu); } }
            if (pass) {
                LDS_WAIT();
                f32x4 acc = (f32x4){0.f, 0.f, 0.f, 0.f};
#pragma unroll
                for (int kk = 0; kk < 4; ++kk) { const bf16x8 xf = *(const LAS bf16x8*)(xs + c * 136 + 32 * kk + 8 * q); acc = MFMA16(cfr[kk], xf, acc); }
                const float y0 = gelu_tanh(acc[0] + dsk[0] * bflo(uw.x)), y1 = gelu_tanh(acc[1] + dsk[1] * bfhi(uw.x)), y2 = gelu_tanh(acc[2] + dsk[2] * bflo(uw.y)), y3 = gelu_tanh(acc[3] + dsk[3] * bfhi(uw.y));
                u32x2 ow; ow.x = pkbf(y0, y1); ow.y = pkbf(y2, y3);
                *(GAS u32x2*)(YS + m * 512 + 16 * g + 4 * q) = ow;
            }
            LDS_WAIT();
        }
        if (pass == 0) {
            E[w * 128 + lane] = xr; E[w * 128 + 64 + lane] = xi;
            __syncthreads();
            float cr = 0.f, ci = 0.f;
            for (int w2 = 0; w2 < w; ++w2) { const float er = E[w2 * 128 + lane], ei = E[w2 * 128 + 64 + lane]; const float nr = pr * cr - pi * ci + er, ni = pr * ci + pi * cr + ei; cr = nr; ci = ni; }
            xr = cr; xi = ci;
        }
    }
}

__device__ __forceinline__ void sgu_item(unsigned char* ws, LAS unsigned char* lds, int b, int n) {
    const int tid = otid(), lane = tid & 63, w = __builtin_amdgcn_readfirstlane(tid >> 6), c = lane & 15, q = lane >> 4;
    const GAS bf16_t* P1 = (const GAS bf16_t*)(ws + WS_BIG); GAS bf16_t* MIX = (GAS bf16_t*)(ws + WS_MIX); const GAS bf16_t* wsb = (const GAS bf16_t*)(ws + WS_WSB);
    LAS bf16_t* Vt = (LAS bf16_t*)lds;
    const size_t m0 = (size_t)b * SEQ + 128 * n;
    {
        const int s = tid >> 2, qq = tid & 3; const GAS bf16_t* vp = P1 + (m0 + s) * LD1 + 1024 + 128 * qq;
        u32x4 rv[16]; float sum = 0.f, ssq = 0.f;
#pragma unroll
        for (int i = 0; i < 16; ++i) { rv[i] = *(const GAS u32x4*)(vp + 8 * i); float f[8]; unpack8(rv[i], f);
#pragma unroll
            for (int e = 0; e < 8; ++e) { sum += f[e]; ssq += f[e] * f[e]; } }
        sum += __shfl_xor(sum, 1); sum += __shfl_xor(sum, 2); ssq += __shfl_xor(ssq, 1); ssq += __shfl_xor(ssq, 2);
        const float mu = sum * (1.0f / 512.0f), var = fmaxf(ssq * (1.0f / 512.0f) - mu * mu, 0.f), rstd = rsqrtf(var + EPS);
        const GAS float* lg = (const GAS float*)(ws + WS_PRM) + PR_LNG + 128 * qq; const GAS float* lb = (const GAS float*)(ws + WS_PRM) + PR_LNB + 128 * qq;
#pragma unroll
        for (int i = 0; i < 16; ++i) { float f[8]; unpack8(rv[i], f);
            const f32x4 g0 = *(const GAS f32x4*)(lg + 8 * i), g1 = *(const GAS f32x4*)(lg + 8 * i + 4), b0 = *(const GAS f32x4*)(lb + 8 * i), b1 = *(const GAS f32x4*)(lb + 8 * i + 4);
#pragma unroll
            for (int e = 0; e < 8; ++e) { const float gg = e < 4 ? g0[e & 3] : g1[e & 3], bb = e < 4 ? b0[e & 3] : b1[e & 3]; const float y = (f[e] - mu) * rstd * gg + bb;
                Vt[(128 * qq + 8 * i + e) * 136 + s] = (bf16_t)(pkbf(y, 0.f) & 0xffffu); } }
    }
    __syncthreads();
    const int nk = (w >> 1) + 1; const int trow = 16 * w + c; const size_t m = m0 + trow;
    for (int g = 0; g < 8; ++g) {
        f32x4 acc[4];
#pragma unroll
        for (int ct = 0; ct < 4; ++ct) acc[ct] = (f32x4){0.f, 0.f, 0.f, 0.f};
        for (int kk = 0; kk < nk; ++kk) { const bf16x8 wf = *(const GAS bf16x8*)(wsb + ((size_t)g * 128 + trow) * 128 + 32 * kk + 8 * q);
#pragma unroll
            for (int ct = 0; ct < 4; ++ct) { const bf16x8 vf = *(const LAS bf16x8*)(Vt + (64 * g + 16 * ct + c) * 136 + 32 * kk + 8 * q); acc[ct] = MFMA16(vf, wf, acc[ct]); } }
        const float bs = ((const GAS float*)(ws + WS_PRM))[PR_BS + g * 128 + trow];
#pragma unroll
        for (int ct = 0; ct < 4; ++ct) { const u32x2 uw = *(const GAS u32x2*)(P1 + m * LD1 + 512 + 64 * g + 16 * ct + 4 * q);
            u32x2 ow; ow.x = pkbf(bflo(uw.x) * (acc[ct][0] + bs), bfhi(uw.x) * (acc[ct][1] + bs)); ow.y = pkbf(bflo(uw.y) * (acc[ct][2] + bs), bfhi(uw.y) * (acc[ct][3] + bs));
            *(GAS u32x2*)(MIX + m * D + 512 + 64 * g + 16 * ct + 4 * q) = ow; }
    }
}

__device__ __forceinline__ void grid_bar(unsigned* bar, unsigned k) {
    asm volatile("s_waitcnt vmcnt(0) lgkmcnt(0)" ::: "memory");
    __syncthreads();
    if (threadIdx.x == 0) {
        const unsigned target = (k + 1u) * gridDim.x;
        __builtin_amdgcn_fence(__ATOMIC_RELEASE, "agent"); asm volatile("s_waitcnt vmcnt(0)" ::: "memory");
        __hip_atomic_fetch_add(bar, 1u, __ATOMIC_RELAXED, __HIP_MEMORY_SCOPE_AGENT);
        while (__hip_atomic_load(bar, __ATOMIC_RELAXED, __HIP_MEMORY_SCOPE_AGENT) < target) __builtin_amdgcn_s_sleep(1);
        __builtin_amdgcn_fence(__ATOMIC_ACQUIRE, "agent"); asm volatile("s_waitcnt vmcnt(0)" ::: "memory");
    }
    __syncthreads();
}
#define GSYNC(k) grid_bar((unsigned*)(a.ws + WS_CTL) + 128, (unsigned)(k))
__global__ void __launch_bounds__(NT, 2) mega_fwd(Args a) {
    extern __shared__ __attribute__((aligned(16))) unsigned char lds_raw[];
    LAS unsigned char* lds = (LAS unsigned char*)lds_raw;
    cg::grid_group grid = cg::this_grid();
    LAS int* slot = (LAS int*)(lds + LDS_BYTES - 64);
    grid.sync();
#ifndef NO_P0
    p0_prologue(a, lds);
#endif
    GSYNC(0);
    unsigned char* const ws0 = a.ws; const float* const x00 = a.in[0]; float* const xout0 = a.out;
    unsigned kb = 1;
    for (int ph = 1; ph <= 16; ++ph) {
        if (ph == 6 || ph == 9 || ph == 14) continue;
        unsigned char* ws = ws0; const float* x0 = x00; float* xout = xout0;
        asm volatile("" : "+s"(ws), "+s"(x0), "+s"(xout));

        const float* mod = (const float*)(ws + WS_MOD);
        bf16_t* H = (bf16_t*)(ws + WS_H); bf16_t* MIX = (bf16_t*)(ws + WS_MIX); bf16_t* BIG = (bf16_t*)(ws + WS_BIG);
        unsigned* ctl = (unsigned*)(ws + WS_CTL);
        const int layer = ph >= 9;
        const GAS float* modl = (const GAS float*)mod + (size_t)layer * 8 * 6144;
        GAS float* rowss = (GAS float*)(ws + WS_ROWSS); const GAS float* shw = (const GAS float*)(ws + WS_SHW);
        pg8::Gemm g{nullptr, nullptr, T, 0, 0, 0}; pg8::Epi E{0, 0, nullptr, 0, nullptr, nullptr, nullptr, nullptr, nullptr, nullptr, nullptr, 0};
        switch (ph) {
        case 1: norm_phase(x0, mod, 0, 1024, H); prep_phase(ws, lds); break;
        case 3: cum_phase(ws, lds); break;
        case 4:
            for (;;) { const int it = q_next(ctl, slot); if (it >= 64 + 4096) break;
                if (it < 64) gla_item(ws, lds, it >> 3, it & 7); else { const int f = it - 64; fox_item(ws, lds, f >> 9, (f >> 6) & 7, f & 63); } }
            break;
        case 11:
            for (;;) { const int it = q_next(ctl + 64, slot); if (it >= 256 + 512) break;
                if (it < 256) s5_item(ws, lds, it >> 5, it & 31); else { const int f = it - 256; sgu_item(ws, lds, f >> 6, f & 63); } }
            break;
        case 2: g.A = H; g.Bt = (const bf16_t*)(ws + WS_WIN0); g.N = LD0; g.K = D; E.mode = 0; E.O = (GAS bf16_t*)BIG; E.ldc = LD0; break;
        case 5: g.A = MIX; g.Bt = (const bf16_t*)(ws + WS_WOUT0); g.N = D; g.K = D; E.mode = 6; E.O = (GAS bf16_t*)H; E.base32 = (const GAS float*)x0; E.gate = modl + 2048; E.rowss = rowss; break;
        case 7: g.A = H; g.Bt = (const bf16_t*)(ws + WS_WB0); g.bbatch = (size_t)FFD * D * 2; g.N = FFD; g.K = D; E.mode = 5; E.sub = 1; E.O = (GAS bf16_t*)BIG; E.ldc = FFD; E.rowss = rowss; E.shw = shw; E.ldsh = FFD; break;
        case 8: g.A = BIG; g.Bt = (const bf16_t*)(ws + WS_W2_0); g.N = D; g.K = FFD; E.mode = 7; E.O = (GAS bf16_t*)H; E.gate = modl + 5120; E.rowss = rowss; break;
        case 10: g.A = H; g.Bt = (const bf16_t*)(ws + WS_WB1); g.bbatch = (size_t)LD1 * D * 2; g.N = LD1; g.K = D; E.mode = 5; E.sub = 2; E.O = (GAS bf16_t*)BIG; E.ldc = LD1; E.rowss = rowss; E.shw = shw + 8 * 4096; E.ldsh = LD1; break;
        case 12: g.A = (const bf16_t*)(ws + WS_YS5); g.Bt = (const bf16_t*)(ws + WS_WGLU); g.N = 512; g.K = 512; E.mode = 3; E.O = (GAS bf16_t*)MIX; E.Y = (const GAS bf16_t*)(ws + WS_YS5); E.bias = (const GAS float*)(ws + WS_PRM) + PR_BGLU; break;
        case 13: g.A = MIX; g.Bt = (const bf16_t*)(ws + WS_WOUT1); g.N = D; g.K = D; E.mode = 7; E.O = (GAS bf16_t*)H; E.gate = modl + 2048; E.rowss = rowss; break;
        case 15: g.A = H; g.Bt = (const bf16_t*)(ws + WS_WB2); g.bbatch = (size_t)FFD * D * 2; g.N = FFD; g.K = D; E.mode = 5; E.sub = 1; E.O = (GAS bf16_t*)BIG; E.ldc = FFD; E.rowss = rowss; E.shw = shw + 16 * 4096; E.ldsh = FFD; break;
        case 16: g.A = BIG; g.Bt = (const bf16_t*)(ws + WS_W2_1); g.N = D; g.K = FFD; E.mode = 8; E.O = (GAS bf16_t*)H; E.out32 = (GAS float*)xout; E.gate = modl + 5120; break;
        default: break;
        }
        if (g.K != 0) { pg8::StaticOrder S; S.init(T, g.N, gridDim.x, blockIdx.x); pg8::gemm_phase(lds, g, S, E); }
        if (ph != 16) { GSYNC(kb); ++kb; }
    }
}

extern "C" void kernel_launch(void* const* d_in, const int* in_sizes, int n_in, void* d_out, int out_size, void* d_ws, size_t ws_size, hipStream_t stream) {
    static int grid = 0;
    if (grid == 0) {
        if (n_in != 30 || out_size != T * D || ws_size < WS_END) { fprintf(stderr, "kernel_launch: unexpected shapes (n_in %d out %d ws %zu)\n", n_in, out_size, ws_size); grid = -1; return; }
        int dev = 0, cus = 0, per_cu = 0;
        hipGetDevice(&dev); hipDeviceGetAttribute(&cus, hipDeviceAttributeMultiprocessorCount, dev);
        hipFuncSetAttribute((const void*)mega_fwd, hipFuncAttributeMaxDynamicSharedMemorySize, LDS_BYTES);
        hipOccupancyMaxActiveBlocksPerMultiprocessor(&per_cu, (const void*)mega_fwd, NT, LDS_BYTES);
        if (per_cu < 1) { fprintf(stderr, "kernel_launch: occupancy query says %d blocks/CU\n", per_cu); per_cu = 1; }
        grid = cus * 1;
        (void)hipGetLastError();
    }
    if (grid < 0) return;
    (void)hipMemsetAsync((char*)d_ws + WS_CTL, 0, 4096, stream);
    Args a{};
    for (int i = 0; i < 30; ++i) a.in[i] = (const float*)d_in[i];
    a.out = (float*)d_out; a.ws = (unsigned char*)d_ws;
    void* args[] = {&a};
    hipError_t e = hipLaunchCooperativeKernel((const void*)mega_fwd, dim3(grid), dim3(NT), args, LDS_BYTES, stream);
    if (e != hipSuccess) fprintf(stderr, "cooperative launch failed: %s (grid %d)\n", hipGetErrorString(e), grid);
}
```

```cpp
#include <hip/hip_runtime.h>
#include <hip/hip_cooperative_groups.h>
#include <cstdio>
namespace cg = cooperative_groups;

#define LAS __attribute__((address_space(3)))
#define GAS __attribute__((address_space(1)))
typedef unsigned short bf16_t;
typedef short bf16x8 __attribute__((ext_vector_type(8)));
typedef short bf16x4 __attribute__((ext_vector_type(4)));
typedef float f32x4 __attribute__((ext_vector_type(4)));
typedef float f32x2 __attribute__((ext_vector_type(2)));
typedef unsigned u32x4 __attribute__((ext_vector_type(4)));
typedef unsigned u32x2 __attribute__((ext_vector_type(2)));

constexpr int T = 65536, SEQ = 8192, D = 1024, FFD = 4096;
constexpr int LD0 = 3840, LD1 = 1536;
constexpr int C_GQ = 0, C_GK = 512, C_GV = 1024, C_GG = 1536, C_FQ = 2048, C_FK = 2560, C_FV = 3072, C_LR = 3584, C_FF = 3600;
constexpr float EPS = 1e-6f;
constexpr size_t MiB = 1u << 20;
constexpr size_t WS_CTL = 0, WS_WIN0 = 2 * MiB, WS_WOUT0 = 10 * MiB, WS_W1_0 = 12 * MiB, WS_W2_0 = 20 * MiB, WS_WIN1 = 28 * MiB, WS_WOUT1 = 31 * MiB,
                 WS_WGLU = 33 * MiB, WS_W1_1 = 34 * MiB, WS_W2_1 = 42 * MiB, WS_WSB = 50 * MiB, WS_MOD = 51 * MiB, WS_S5P = 52 * MiB, WS_CUM = 53 * MiB,
                 WS_H = 64 * MiB, WS_MIX = 192 * MiB, WS_BIG = 320 * MiB, WS_WB0 = 832 * MiB, WS_WB1 = 896 * MiB, WS_WB2 = 920 * MiB, WS_END = 984 * MiB;
constexpr size_t WS_PRM = 56 * MiB, WS_ROWSS = 57 * MiB  , WS_SHW = 61 * MiB  , WS_YS5 = WS_BIG + 256 * MiB;
constexpr int PR_WLR = 0, PR_BLR = 8192, PR_GGAIN = 8704, PR_BF = 9216, PR_QG = 9280, PR_KG = 9792, PR_S5D = 10304, PR_BGLU = 10816, PR_LNG = 11328, PR_LNB = 11840, PR_BS = 12352;
constexpr size_t S5_ABAR = 0, S5_BB = 16384, S5_CM = 16384 + 131072;
constexpr int LDS_BYTES = 147456;
constexpr int NT = 512;

struct Args { const float* in[30]; float* out; unsigned char* ws; };

typedef __bf16 bf16x2_t __attribute__((ext_vector_type(2)));
__device__ __forceinline__ unsigned pkbf(float lo, float hi) { f32x2 v = {lo, hi}; bf16x2_t b = __builtin_convertvector(v, bf16x2_t); return __builtin_bit_cast(unsigned, b); }
__device__ __forceinline__ float bflo(unsigned w) { return __uint_as_float(w << 16); }
__device__ __forceinline__ float bfhi(unsigned w) { return __uint_as_float(w & 0xffff0000u); }
__device__ __forceinline__ void unpack8(u32x4 w, float* f) { f[0] = bflo(w.x); f[1] = bfhi(w.x); f[2] = bflo(w.y); f[3] = bfhi(w.y); f[4] = bflo(w.z); f[5] = bfhi(w.z); f[6] = bflo(w.w); f[7] = bfhi(w.w); }
__device__ __forceinline__ float sigmoidf_(float x) { return 1.0f / (1.0f + __expf(-x)); }
__device__ __forceinline__ float siluf_(float x) { return x * sigmoidf_(x); }
__device__ __forceinline__ float gelu_tanh(float x) { const float u = 1.5957691216057308f * (x + 0.044715f * x * x * x); return x * sigmoidf_(u); }
__device__ __forceinline__ float logsig(float x) { return fminf(x, 0.f) - __logf(1.0f + __expf(-fabsf(x))); }
__device__ __forceinline__ int otid() { int t = threadIdx.x; asm volatile("" : "+v"(t)); return t; }
#define LDS_WAIT() asm volatile("s_waitcnt lgkmcnt(0)" ::: "memory")
#define BAR_LDS() do { asm volatile("s_waitcnt lgkmcnt(0)" ::: "memory"); __builtin_amdgcn_s_barrier(); asm volatile("" ::: "memory"); } while (0)
#define MFMA16(a, b, c) __builtin_amdgcn_mfma_f32_16x16x32_bf16((a), (b), (c), 0, 0, 0)
__device__ __forceinline__ bf16x8 as_bf16x8(u32x4 v) { return __builtin_bit_cast(bf16x8, v); }

namespace pg8 {
constexpr int BM = 256, BK = 64, HALF = 128, HTB = HALF * BK * 2, STAGE_BYTES = 8 * HTB, NXCD = 8, WGM = 8;
__device__ __forceinline__ int lds_byte(int r, int c) { const int st = (r >> 4) * 2 + (c >> 5), rr = r & 15, cc = c & 31, ob = rr * 64 + cc * 2; return st * 1024 + (ob ^ (((ob >> 9) & 1) << 5)); }
__device__ __forceinline__ void stage_rc(int b, int& R, int& C) { const int st = b / 1024, sb = b % 1024, swz = sb ^ (((sb >> 9) & 1) << 5); R = (st >> 1) * 16 + swz / 64; C = (st & 1) * 32 + (swz % 64) / 2; }
__device__ __forceinline__ int perm32(int rho) { const int n = rho >> 4, i = rho & 15; return 8 * (i >> 2) + 4 * n + (i & 3); }
struct Unit { int pm, pn; };
struct Gemm { const bf16_t* A; const bf16_t* Bt; int M, N, K; size_t bbatch; };
struct StaticOrder {
    int nM, nN, nwg, G, c;
    __device__ void init(int M, int N, int G_, int c_) { nM = M / BM; nN = N / BM; nwg = nM * nN; G = G_; c = c_; }
    __device__ bool next(int i, Unit& u) const {
        const long L = (long)i * G + c; if (L >= nwg) return false;
        int wgid = (int)L; { const int q = nwg / NXCD, r = nwg % NXCD, xcd = wgid % NXCD, off = wgid / NXCD; wgid = (xcd < r ? xcd * (q + 1) : r * (q + 1) + (xcd - r) * q) + off; }
        const int nig = WGM * nN, gid = wgid / nig, fm = gid * WGM, gsz = (nM - fm) < WGM ? (nM - fm) : WGM;
        u.pm = fm + ((wgid % nig) % gsz); u.pn = (wgid % nig) / gsz; return true;
    }
};

struct Epi {
    int mode, sub; GAS bf16_t* O; int ldc; const GAS float* base32; GAS float* out32; const GAS float* gate; const GAS bf16_t* Y; const GAS float* bias; GAS float* rowss; const GAS float* shw; int ldsh;
    __device__ __forceinline__ void operator()(const f32x4 (&acc)[2][2][4][2], const Unit& u, int wr, int wc, int fr, int fq) const {
        const int row0 = u.pm * BM + wr * 64 + fr, col0 = u.pn * BM + wc * 32 + 8 * fq, bidx = (u.pm * BM) >> 13;
        if (mode >= 6) {
            const GAS float* gp = gate + (size_t)bidx * 6144 + col0;
            f32x4 gg[2][2];
#pragma unroll
            for (int bj = 0; bj < 2; ++bj) { gg[bj][0] = *(const GAS f32x4*)(gp + bj * HALF); gg[bj][1] = *(const GAS f32x4*)(gp + bj * HALF + 4); }
            if (mode == 6) {
#pragma unroll
                for (int ai = 0; ai < 2; ++ai)
#pragma unroll
                    for (int mh = 0; mh < 2; ++mh) { f32x4 bb[2][2][2];
#pragma unroll
                        for (int ml = 0; ml < 2; ++ml) { const size_t off = (size_t)(row0 + ai * HALF + (2 * mh + ml) * 16) * D + col0;
#pragma unroll
                            for (int bj = 0; bj < 2; ++bj) { bb[ml][bj][0] = *(const GAS f32x4*)(base32 + off + bj * HALF); bb[ml][bj][1] = *(const GAS f32x4*)(base32 + off + bj * HALF + 4); } }
#pragma unroll
                        for (int ml = 0; ml < 2; ++ml) { const int m = 2 * mh + ml; const size_t row = (size_t)(row0 + ai * HALF + m * 16), off = row * D + col0; float ss = 0.f;
#pragma unroll
                            for (int bj = 0; bj < 2; ++bj) { const f32x4 x0 = bb[ml][bj][0] + gg[bj][0] * acc[ai][bj][m][0], x1 = bb[ml][bj][1] + gg[bj][1] * acc[ai][bj][m][1];
                                ss += (x0[0] * x0[0] + x0[1] * x0[1]) + (x0[2] * x0[2] + x0[3] * x0[3]) + (x1[0] * x1[0] + x1[1] * x1[1]) + (x1[2] * x1[2] + x1[3] * x1[3]);
                                u32x4 w; w.x = pkbf(x0[0], x0[1]); w.y = pkbf(x0[2], x0[3]); w.z = pkbf(x1[0], x1[1]); w.w = pkbf(x1[2], x1[3]); *(GAS u32x4*)(O + off + bj * HALF) = w; }
                            ss += __shfl_xor(ss, 16); ss += __shfl_xor(ss, 32); if (fq == 0) rowss[row * 16 + u.pn * 4 + wc] = ss; }
                        asm volatile("" ::: "memory"); }
            } else {
#pragma unroll
                for (int ai = 0; ai < 2; ++ai) { u32x4 bw[4][2];
#pragma unroll
                    for (int m = 0; m < 4; ++m) { const size_t off = (size_t)(row0 + ai * HALF + m * 16) * D + col0;
#pragma unroll
                        for (int bj = 0; bj < 2; ++bj) bw[m][bj] = *(const GAS u32x4*)(O + off + bj * HALF); }
#pragma unroll
                    for (int m = 0; m < 4; ++m) { const size_t row = (size_t)(row0 + ai * HALF + m * 16), off = row * D + col0; float ss = 0.f;
#pragma unroll
                        for (int bj = 0; bj < 2; ++bj) { const u32x4 t = bw[m][bj];
                            const f32x4 b0 = (f32x4){bflo(t.x), bfhi(t.x), bflo(t.y), bfhi(t.y)}, b1 = (f32x4){bflo(t.z), bfhi(t.z), bflo(t.w), bfhi(t.w)};
                            const f32x4 x0 = b0 + gg[bj][0] * acc[ai][bj][m][0], x1 = b1 + gg[bj][1] * acc[ai][bj][m][1];
                            if (mode == 8) { *(GAS f32x4*)(out32 + off + bj * HALF) = x0; *(GAS f32x4*)(out32 + off + bj * HALF + 4) = x1; }
                            else { ss += (x0[0] * x0[0] + x0[1] * x0[1]) + (x0[2] * x0[2] + x0[3] * x0[3]) + (x1[0] * x1[0] + x1[1] * x1[1]) + (x1[2] * x1[2] + x1[3] * x1[3]);
                                u32x4 w; w.x = pkbf(x0[0], x0[1]); w.y = pkbf(x0[2], x0[3]); w.z = pkbf(x1[0], x1[1]); w.w = pkbf(x1[2], x1[3]); *(GAS u32x4*)(O + off + bj * HALF) = w; } }
                        if (mode != 8) { ss += __shfl_xor(ss, 16); ss += __shfl_xor(ss, 32); if (fq == 0) rowss[row * 16 + u.pn * 4 + wc] = ss; } }
                    asm volatile("" ::: "memory"); }
            }
        } else if (mode == 3) {
#pragma unroll
            for (int bj = 0; bj < 2; ++bj) {
                const f32x4 b0 = *(const GAS f32x4*)(bias + col0 + bj * HALF), b1 = *(const GAS f32x4*)(bias + col0 + bj * HALF + 4);
#pragma unroll
                for (int ai = 0; ai < 2; ++ai)
#pragma unroll
                    for (int m = 0; m < 4; ++m) { const size_t row = (size_t)(row0 + ai * HALF + m * 16);
                        const u32x4 yw = *(const GAS u32x4*)(Y + row * 512 + col0 + bj * HALF); float y[8]; unpack8(yw, y);
                        const f32x4 v0 = acc[ai][bj][m][0] + b0, v1 = acc[ai][bj][m][1] + b1; float o[8];
#pragma unroll
                        for (int j = 0; j < 4; ++j) { o[j] = y[j] * sigmoidf_(v0[j]); o[4 + j] = y[4 + j] * sigmoidf_(v1[j]); }
                        u32x4 w; w.x = pkbf(o[0], o[1]); w.y = pkbf(o[2], o[3]); w.z = pkbf(o[4], o[5]); w.w = pkbf(o[6], o[7]);
                        *(GAS u32x4*)(O + row * D + col0 + bj * HALF) = w; asm volatile("" ::: "memory"); } }
        } else {
            const bool act2 = (sub == 2) && (u.pn >= 2);
            float rr[8]; f32x4 sb[2][2];
#pragma unroll
            for (int j = 0; j < 8; ++j) rr[j] = 1.0f;
#pragma unroll
            for (int bj = 0; bj < 2; ++bj) { sb[bj][0] = (f32x4){0.f, 0.f, 0.f, 0.f}; sb[bj][1] = sb[bj][0]; }
            if (mode == 5) {
                const int lane = fq * 16 + fr; float slot[2];
                f32x4 pp[2][4];
#pragma unroll
                for (int h = 0; h < 2; ++h) { const int li = lane + 64 * h, am = li >> 4; const size_t row = (size_t)(u.pm * BM + (am >> 2) * HALF + wr * 64 + (am & 3) * 16 + (li & 15));
                    const GAS f32x4* rp = (const GAS f32x4*)(rowss + row * 16);
#pragma unroll
                    for (int k = 0; k < 4; ++k) pp[h][k] = rp[k]; }
                const GAS float* sp = shw + (size_t)bidx * ldsh + col0;
#pragma unroll
                for (int bj = 0; bj < 2; ++bj) { sb[bj][0] = *(const GAS f32x4*)(sp + bj * HALF); sb[bj][1] = *(const GAS f32x4*)(sp + bj * HALF + 4); }
#pragma unroll
                for (int h = 0; h < 2; ++h) { const f32x4 s = (pp[h][0] + pp[h][1]) + (pp[h][2] + pp[h][3]); slot[h] = rsqrtf(((s[0] + s[1]) + (s[2] + s[3])) * (1.0f / D) + EPS); }
#pragma unroll
                for (int j = 0; j < 8; ++j) rr[j] = __shfl(slot[j >> 2], (j & 3) * 16 + fr);
            }
#pragma unroll
            for (int ai = 0; ai < 2; ++ai)
#pragma unroll
                for (int m = 0; m < 4; ++m) { const size_t row = (size_t)(row0 + ai * HALF + m * 16); GAS bf16_t* rowp = O + row * ldc + col0; const float r = rr[ai * 4 + m];
#pragma unroll
                    for (int bj = 0; bj < 2; ++bj) { f32x4 v0 = acc[ai][bj][m][0], v1 = acc[ai][bj][m][1];
                        if (mode == 5) { v0 = v0 * r + sb[bj][0]; v1 = v1 * r + sb[bj][1]; }
                        if (sub == 1) {
#pragma unroll
                            for (int j = 0; j < 4; ++j) { const float a0 = fmaxf(v0[j], 0.f), a1 = fmaxf(v1[j], 0.f); v0[j] = a0 * a0; v1[j] = a1 * a1; } }
                        if (act2) {
#pragma unroll
                            for (int j = 0; j < 4; ++j) { v0[j] = gelu_tanh(v0[j]); v1[j] = gelu_tanh(v1[j]); } }
                        u32x4 w; w.x = pkbf(v0[0], v0[1]); w.y = pkbf(v0[2], v0[3]); w.z = pkbf(v1[0], v1[1]); w.w = pkbf(v1[2], v1[3]);
                        *(GAS u32x4*)(rowp + bj * HALF) = w; }
                    asm volatile("" ::: "memory"); }
        }
    }
};

__device__ __forceinline__ void gemm_phase(LAS unsigned char* lds, const Gemm g, const StaticOrder& S, const Epi& E) {

    const int tid = otid(), wid = __builtin_amdgcn_readfirstlane(tid >> 6), lane = tid & 63, wr = wid >> 2, wc = wid & 3, fr = lane & 15, fq = lane >> 4;
    const int K = g.K, nt = K / BK;
    unsigned voffA[2], voffB[2];
#pragma unroll
    for (int i = 0; i < 2; ++i) { int R, C; stage_rc(tid * 16 + i * 8192, R, C); const int Rb = (R & ~31) + perm32(R & 31);
        voffA[i] = (unsigned)(R * K + C) * 2u; voffB[i] = (unsigned)(Rb * K + C) * 2u; }
    const size_t kstep = (size_t)(BK * 2);
    const size_t hstep = (size_t)HALF * K * 2;
    const size_t tstep = 2 * hstep;
    const unsigned ldsw = (unsigned)wid * 1024u;
    const int aoff = lds_byte(wr * 64 + fr, fq * 8), boff = lds_byte(wc * 32 + fr, fq * 8);
    const unsigned ldsbase = (unsigned)(unsigned long)lds;
#define PG8_SA(b, h) (((b) * 2 + (h)) * HTB)
#define PG8_SB(b, h) ((4 + (b) * 2 + (h)) * HTB)
#define PG8_STAGE(bufoff, gbase, voff) do { _Pragma("unroll") for (int _i = 0; _i < 2; ++_i) \
        __builtin_amdgcn_global_load_lds((const unsigned*)((const char*)(gbase) + (voff)[_i]), (LAS unsigned*)(lds + (bufoff) + ldsw + _i * 8192), 16, 0, 0); } while (0)
#define PG8_LDA(dst, b, h) do { _Pragma("unroll") for (int m = 0; m < 4; ++m) _Pragma("unroll") for (int k = 0; k < 2; ++k) dst[m][k] = *(const LAS bf16x8*)(lds + PG8_SA(b, h) + aoff + m * 2048 + k * 1024); } while (0)
#define PG8_LDB(dst, b, h) do { _Pragma("unroll") for (int n = 0; n < 2; ++n) _Pragma("unroll") for (int k = 0; k < 2; ++k) dst[n][k] = *(const LAS bf16x8*)(lds + PG8_SB(b, h) + boff + n * 2048 + k * 1024); } while (0)
#define PG8_MMA(ai, bj, At, Bt) do { __builtin_amdgcn_s_setprio(1); _Pragma("unroll") for (int m = 0; m < 4; ++m) _Pragma("unroll") for (int n = 0; n < 2; ++n) _Pragma("unroll") for (int k = 0; k < 2; ++k) \
        acc[ai][bj][m][n] = __builtin_amdgcn_mfma_f32_16x16x32_bf16(Bt[n][k], At[m][k], acc[ai][bj][m][n], 0, 0, 0); __builtin_amdgcn_s_setprio(0); } while (0)
#define PG8_WAIT_V(n) asm volatile("s_waitcnt vmcnt(" #n ")" ::: "memory")
#define PG8_WAIT_L(n) asm volatile("s_waitcnt lgkmcnt(" #n ")" ::: "memory")
#define PG8_BAR __builtin_amdgcn_s_barrier()
#define PG8_SCHED __builtin_amdgcn_sched_barrier(0)
    Unit cur, nxt; int ui = 0;
    if (!S.next(0, cur)) return;
    f32x4 acc[2][2][4][2];
#pragma unroll
    for (int a = 0; a < 2; ++a)
#pragma unroll
        for (int b = 0; b < 2; ++b)
#pragma unroll
            for (int m = 0; m < 4; ++m)
#pragma unroll
                for (int n = 0; n < 2; ++n) acc[a][b][m][n] = (f32x4){0.f, 0.f, 0.f, 0.f};
    bf16x8 At[4][2], B0[2][2], B1[2][2];
    const char* cA = (const char*)g.A + (size_t)cur.pm * tstep; const char* cB = (const char*)g.Bt + (size_t)cur.pn * tstep + (size_t)(cur.pm >> 5) * g.bbatch;
    PG8_STAGE(PG8_SB(0, 0), cB, voffB); PG8_STAGE(PG8_SA(0, 0), cA, voffA); PG8_STAGE(PG8_SB(0, 1), cB + hstep, voffB); PG8_STAGE(PG8_SA(0, 1), cA + hstep, voffA);
    if (wr == 1) PG8_BAR;
    PG8_WAIT_V(4); PG8_BAR;
    PG8_STAGE(PG8_SB(1, 0), cB + kstep, voffB); PG8_STAGE(PG8_SA(1, 0), cA + kstep, voffA); PG8_STAGE(PG8_SB(1, 1), cB + hstep + kstep, voffB);
    PG8_WAIT_V(6); PG8_BAR;
    for (;;) {
        const bool has_next = S.next(ui + 1, nxt);
        const char* nA = has_next ? (const char*)g.A + (size_t)nxt.pm * tstep : cA; const char* nB = has_next ? (const char*)g.Bt + (size_t)nxt.pn * tstep + (size_t)(nxt.pm >> 5) * g.bbatch : cB;
        for (int t = 0; t < nt; t += 2) {
            const bool last = (t == nt - 2);
            const char* a1 = cA + (size_t)(t + 1) * kstep;
            const char* a2 = last ? nA : cA + (size_t)(t + 2) * kstep; const char* b2 = last ? nB : cB + (size_t)(t + 2) * kstep;
            const char* a3 = a2 + kstep; const char* b3 = b2 + kstep;
            PG8_LDB(B0, 0, 0); PG8_SCHED; PG8_LDA(At, 0, 0); PG8_STAGE(PG8_SA(1, 1), a1 + hstep, voffA);
            PG8_WAIT_L(8); PG8_BAR; PG8_WAIT_L(0); PG8_MMA(0, 0, At, B0); PG8_BAR; PG8_SCHED;
            PG8_LDB(B1, 0, 1); PG8_STAGE(PG8_SB(0, 0), b2, voffB);
            PG8_BAR; PG8_WAIT_L(0); PG8_MMA(0, 1, At, B1); PG8_BAR;
            PG8_LDA(At, 0, 1); PG8_STAGE(PG8_SA(0, 0), a2, voffA);
            PG8_BAR; PG8_WAIT_L(0); PG8_MMA(1, 0, At, B0); PG8_BAR; PG8_SCHED;
            PG8_STAGE(PG8_SB(0, 1), b2 + hstep, voffB);
            PG8_WAIT_V(6); PG8_BAR; PG8_MMA(1, 1, At, B1); PG8_BAR;
            PG8_LDB(B0, 1, 0); PG8_SCHED; PG8_LDA(At, 1, 0); PG8_STAGE(PG8_SA(0, 1), a2 + hstep, voffA);
            PG8_WAIT_L(8); PG8_BAR; PG8_WAIT_L(0); PG8_MMA(0, 0, At, B0); PG8_BAR; PG8_SCHED;
            PG8_LDB(B1, 1, 1); PG8_STAGE(PG8_SB(1, 0), b3, voffB);
            PG8_BAR; PG8_WAIT_L(0); PG8_MMA(0, 1, At, B1); PG8_BAR;
            PG8_LDA(At, 1, 1); PG8_STAGE(PG8_SA(1, 0), a3, voffA);
            PG8_BAR; PG8_WAIT_L(0); PG8_MMA(1, 0, At, B0); PG8_BAR; PG8_SCHED;
            PG8_STAGE(PG8_SB(1, 1), b3 + hstep, voffB);
            PG8_WAIT_V(6); PG8_BAR; PG8_MMA(1, 1, At, B1); PG8_BAR;
        }
        E(acc, cur, wr, wc, fr, fq);
        __builtin_amdgcn_s_waitcnt(0x0F70);
        if (!has_next) break;
#pragma unroll
        for (int a = 0; a < 2; ++a)
#pragma unroll
            for (int b = 0; b < 2; ++b)
#pragma unroll
                for (int m = 0; m < 4; ++m)
#pragma unroll
                    for (int n = 0; n < 2; ++n) acc[a][b][m][n] = (f32x4){0.f, 0.f, 0.f, 0.f};
        cur = nxt; cA = nA; cB = nB; ++ui;
    }
    PG8_WAIT_V(0);
    if (wr == 0) PG8_BAR;
    PG8_BAR;
#undef PG8_SA
#undef PG8_SB
#undef PG8_STAGE
#undef PG8_LDA
#undef PG8_LDB
#undef PG8_MMA
#undef PG8_WAIT_V
#undef PG8_WAIT_L
#undef PG8_BAR
#undef PG8_SCHED
}

}

__device__ __forceinline__ void tr_item(const float* W, int ldw, int ncol0, int K, int nblk, bf16_t* WT, int row_off, LAS float* scr, int item, int lane) {
    const int kb = item / nblk, nb = item % nblk, k0 = 64 * kb, n0 = 32 * nb;
#pragma unroll 8
    for (int i = 0; i < 32; ++i) { const int kk = 2 * i + (lane >> 5); scr[kk * 33 + (lane & 31)] = W[(size_t)(k0 + kk) * ldw + ncol0 + n0 + (lane & 31)]; }
    LDS_WAIT();
    const int c = lane & 7;
#pragma unroll
    for (int j = 0; j < 4; ++j) { const int n = (lane >> 3) + 8 * j; const LAS float* s = scr + (8 * c) * 33 + n;
        u32x4 o; o.x = pkbf(s[0 * 33], s[1 * 33]); o.y = pkbf(s[2 * 33], s[3 * 33]); o.z = pkbf(s[4 * 33], s[5 * 33]); o.w = pkbf(s[6 * 33], s[7 * 33]);
        *(u32x4*)(WT + (size_t)(row_off + n0 + n) * K + k0 + 8 * c) = o; }
    LDS_WAIT();
}

__device__ __forceinline__ void p0_prologue(const Args& a, LAS unsigned char* lds) {
    const int tid = otid(), lane = tid & 63, wave = __builtin_amdgcn_readfirstlane(tid >> 6);
    unsigned char* ws = a.ws;
    if (blockIdx.x < 192) {
        LAS float* cact = (LAS float*)lds;
        LAS float* red = (LAS float*)(lds + 32768);
        const float* c = a.in[1];
        for (int i = tid; i < 8192; i += NT) cact[i] = siluf_(c[i]);
        __syncthreads();
        const int item = blockIdx.x, layer = item / 96, e = 64 * (item % 96) + lane;
        const float* wp = a.in[2] + (size_t)layer * D * 6144 + e;
        float acc[8];
#pragma unroll
        for (int b = 0; b < 8; ++b) acc[b] = 0.f;
        for (int k0 = wave * 128; k0 < wave * 128 + 128; k0 += 8) {
            float wv[8];
#pragma unroll
            for (int i = 0; i < 8; ++i) wv[i] = wp[(size_t)(k0 + i) * 6144];
#pragma unroll
            for (int i = 0; i < 8; ++i)
#pragma unroll
                for (int b = 0; b < 8; ++b) acc[b] += cact[b * 1024 + k0 + i] * wv[i];
        }
#pragma unroll
        for (int b = 0; b < 8; ++b) red[(wave * 8 + b) * 64 + lane] = acc[b];
        __syncthreads();
        { const int b = tid >> 6; float s = 0.f;
#pragma unroll
          for (int w = 0; w < 8; ++w) s += red[(w * 8 + b) * 64 + lane];
          ((float*)(ws + WS_MOD))[(size_t)(layer * 8 + b) * 6144 + e] = s + a.in[3][layer * 6144 + e]; }
        __syncthreads();
    }
    {
        LAS float* scr = (LAS float*)(lds + wave * 16384);
        const int gw = blockIdx.x * 8 + wave, NGW = gridDim.x * 8;
        constexpr int I0 = 16 * 64, I1 = 16 * 48, I2 = 16 * 32, I3 = 16 * 128, I4 = 64 * 32, I5 = 16 * 48, I6 = 16 * 32, I7 = 8 * 16, I8 = I3, I9 = I4;
        constexpr int NIT = I0 + I1 + I2 + I3 + I4 + I5 + I6 + I7 + I8 + I9;
        for (int it = gw; it < NIT; it += NGW) {
            int r = it;
            if (r < I0) { tr_item(a.in[4], 3608, 0, 1024, 64, (bf16_t*)(ws + WS_WIN0), 0, scr, r, lane); continue; } r -= I0;
            if (r < I1) { tr_item(a.in[4], 3608, 2064, 1024, 48, (bf16_t*)(ws + WS_WIN0), 2048, scr, r, lane); continue; } r -= I1;
            if (r < I2) { tr_item(a.in[5], 1024, 0, 1024, 32, (bf16_t*)(ws + WS_WOUT0), 0, scr, r, lane); continue; } r -= I2;
            if (r < I3) { tr_item(a.in[28], 4096, 0, 1024, 128, (bf16_t*)(ws + WS_W1_0), 0, scr, r, lane); continue; } r -= I3;
            if (r < I4) { tr_item(a.in[29], 1024, 0, 4096, 32, (bf16_t*)(ws + WS_W2_0), 0, scr, r, lane); continue; } r -= I4;
            if (r < I5) { tr_item(a.in[12], 1536, 0, 1024, 48, (bf16_t*)(ws + WS_WIN1), 0, scr, r, lane); continue; } r -= I5;
            if (r < I6) { tr_item(a.in[13], 1024, 0, 1024, 32, (bf16_t*)(ws + WS_WOUT1), 0, scr, r, lane); continue; } r -= I6;
            if (r < I7) { tr_item(a.in[22], 512, 0, 512, 16, (bf16_t*)(ws + WS_WGLU), 0, scr, r, lane); continue; } r -= I7;
            if (r < I8) { tr_item(a.in[28] + (size_t)D * FFD, 4096, 0, 1024, 128, (bf16_t*)(ws + WS_W1_1), 0, scr, r, lane); continue; } r -= I8;
            tr_item(a.in[29] + (size_t)D * FFD, 1024, 0, 4096, 32, (bf16_t*)(ws + WS_W2_1), 0, scr, r, lane);
        }
    }
    {
        if (blockIdx.x == 0 && tid == 0) { unsigned* ctl = (unsigned*)(ws + WS_CTL); __hip_atomic_store(ctl, 0u, __ATOMIC_RELAXED, __HIP_MEMORY_SCOPE_AGENT); __hip_atomic_store(ctl + 64, 0u, __ATOMIC_RELAXED, __HIP_MEMORY_SCOPE_AGENT); }
        const int gt = blockIdx.x * NT + tid, NGT = gridDim.x * NT;
        bf16_t* win0 = (bf16_t*)(ws + WS_WIN0);
        for (int i = gt; i < 256 * 1024; i += NGT) { const int n = i >> 10, k = i & 1023; float v = 0.f;
            if (n < 16) v = a.in[4][(size_t)k * 3608 + 2048 + n]; else if (n < 24) v = a.in[4][(size_t)k * 3608 + 3600 + (n - 16)];
            win0[(size_t)(3584 + n) * 1024 + k] = (bf16_t)(pkbf(v, 0.f) & 0xffffu); }
        bf16_t* wsb = (bf16_t*)(ws + WS_WSB);
        for (int i = gt; i < 8 * 128 * 128; i += NGT) { const int t = (i >> 7) & 127, s = i & 127; const float v = (s <= t) ? a.in[26][i] : 0.f; wsb[i] = (bf16_t)(pkbf(v, 0.f) & 0xffffu); }
        { float* prm = (float*)(ws + WS_PRM);
          for (int i = gt; i < 8192; i += NGT) prm[PR_WLR + i] = a.in[6][i];
          for (int i = gt; i < 1024; i += NGT) prm[PR_BS + i] = a.in[27][i];
          for (int i = gt; i < 512; i += NGT) { prm[PR_BLR + i] = a.in[7][i]; prm[PR_GGAIN + i] = a.in[8][i]; prm[PR_QG + i] = a.in[10][i]; prm[PR_KG + i] = a.in[11][i]; prm[PR_S5D + i] = a.in[21][i];
              prm[PR_BGLU + i] = a.in[23][i]; prm[PR_LNG + i] = a.in[24][i]; prm[PR_LNB + i] = a.in[25][i]; }
          for (int i = gt; i < 8; i += NGT) prm[PR_BF + i] = a.in[9][i]; }
        float* abar = (float*)(ws + WS_S5P + S5_ABAR); bf16_t* Bb = (bf16_t*)(ws + WS_S5P + S5_BB); bf16_t* Cm = (bf16_t*)(ws + WS_S5P + S5_CM);
        for (int i = gt; i < 32 * 64; i += NGT) { const int g = i >> 6, p = i & 63;
            const float lr = a.in[14][i], li = a.in[15][i], dt = expf(a.in[16][g]);
            const float mag = expf(lr * dt), ang = li * dt, ar = mag * cosf(ang), ai = mag * sinf(ang), den = lr * lr + li * li;
            const float cr = ((ar - 1.0f) * lr + ai * li) / den, ci = (ai * lr - (ar - 1.0f) * li) / den;
            abar[2 * i] = ar; abar[2 * i + 1] = ai;
            for (int k = 0; k < 16; ++k) { const float br = a.in[17][(size_t)i * 16 + k], bi = a.in[18][(size_t)i * 16 + k];
                Bb[((size_t)g * 128 + p) * 16 + k] = (bf16_t)(pkbf(cr * br - ci * bi, 0.f) & 0xffffu);
                Bb[((size_t)g * 128 + 64 + p) * 16 + k] = (bf16_t)(pkbf(cr * bi + ci * br, 0.f) & 0xffffu); } }
        for (int i = gt; i < 32 * 16 * 64; i += NGT) { const int gi = i >> 6, p = i & 63;
            Cm[(size_t)gi * 128 + p] = (bf16_t)(pkbf(a.in[19][i], 0.f) & 0xffffu); Cm[(size_t)gi * 128 + 64 + p] = (bf16_t)(pkbf(-a.in[20][i], 0.f) & 0xffffu); }
    }
}

__device__ __forceinline__ void norm_phase(const float* x, const float* mod, int off_sh, int off_sc, bf16_t* H) {
    const int tid_ = otid(); const int lane = tid_ & 63, gw = blockIdx.x * 8 + (tid_ >> 6), NGW = gridDim.x * 8;
    for (int m = gw; m < T; m += NGW) {
        const GAS f32x4* xr = (const GAS f32x4*)(x + (size_t)m * D) + lane;
        const GAS float* mp = (const GAS float*)mod + (size_t)(m >> 13) * 6144;
        f32x4 v[4]; float s = 0.f;
#pragma unroll
        for (int j = 0; j < 4; ++j) { v[j] = xr[64 * j]; s += (v[j].x * v[j].x + v[j].y * v[j].y) + (v[j].z * v[j].z + v[j].w * v[j].w); }
#pragma unroll
        for (int o = 1; o < 64; o <<= 1) s += __shfl_xor(s, o);
        const float r = rsqrtf(s * (1.0f / D) + EPS);
        GAS u32x2* o8 = (GAS u32x2*)(H + (size_t)m * D) + lane;
#pragma unroll
        for (int j = 0; j < 4; ++j) { const f32x4 sc = *((const GAS f32x4*)(mp + off_sc) + lane + 64 * j), sh = *((const GAS f32x4*)(mp + off_sh) + lane + 64 * j);
            const f32x4 y = v[j] * r * (sc + 1.0f) + sh; u32x2 w; w.x = pkbf(y.x, y.y); w.y = pkbf(y.z, y.w); o8[64 * j] = w; }
    }
}

__device__ __forceinline__ void prep_item(unsigned char* ws, LAS unsigned char* lds, int item) {
    const int tid = otid(), lane = tid & 63, wave = tid >> 6;
    const GAS float* mod = (const GAS float*)(ws + WS_MOD);
    LAS float* sc = (LAS float*)lds; LAS float* sh = (LAS float*)(lds + 32768);
    const int site = item < 64 ? 0 : (item < 88 ? 1 : 2), rb = item < 64 ? item : (item < 88 ? item - 64 : item - 88);
    const int N = (site == 1) ? LD1 : FFD, layer = site ? 1 : 0, osc = (site == 1) ? 1024 : 4096, osh = (site == 1) ? 0 : 3072;
    const GAS bf16_t* Wt = (const GAS bf16_t*)(ws + (site == 0 ? WS_W1_0 : site == 1 ? WS_WIN1 : WS_W1_1));
    GAS bf16_t* WB = (GAS bf16_t*)(ws + (site == 0 ? WS_WB0 : site == 1 ? WS_WB1 : WS_WB2));
    GAS float* shw = (GAS float*)(ws + WS_SHW) + (size_t)site * 8 * 4096;
    for (int i = tid; i < 8192; i += NT) { const int b = i >> 10, k = i & 1023; const GAS float* mp = mod + (size_t)(layer * 8 + b) * 6144; sc[i] = 1.0f + mp[osc + k]; sh[i] = mp[osh + k]; }
    __syncthreads();
    for (int n = 64 * rb + wave; n < 64 * rb + 64; n += 8) {
        const u32x4 w0 = *(const GAS u32x4*)(Wt + (size_t)n * D + 16 * lane), w1 = *(const GAS u32x4*)(Wt + (size_t)n * D + 16 * lane + 8);
        float wv[16]; unpack8(w0, wv); unpack8(w1, wv + 8);
#pragma unroll 1
        for (int b = 0; b < 8; ++b) { float o[16]; float dot = 0.f;
#pragma unroll
            for (int i4 = 0; i4 < 4; ++i4) { const f32x4 s4 = *(const LAS f32x4*)(sc + b * 1024 + 16 * lane + 4 * i4), h4 = *(const LAS f32x4*)(sh + b * 1024 + 16 * lane + 4 * i4);
#pragma unroll
                for (int j = 0; j < 4; ++j) { o[4 * i4 + j] = wv[4 * i4 + j] * s4[j]; dot += wv[4 * i4 + j] * h4[j]; } }
            u32x4 p0, p1; p0.x = pkbf(o[0], o[1]); p0.y = pkbf(o[2], o[3]); p0.z = pkbf(o[4], o[5]); p0.w = pkbf(o[6], o[7]); p1.x = pkbf(o[8], o[9]); p1.y = pkbf(o[10], o[11]); p1.z = pkbf(o[12], o[13]); p1.w = pkbf(o[14], o[15]);
            GAS bf16_t* dst = WB + ((size_t)b * N + n) * D + 16 * lane; *(GAS u32x4*)dst = p0; *(GAS u32x4*)(dst + 8) = p1;
#pragma unroll
            for (int o2 = 1; o2 < 64; o2 <<= 1) dot += __shfl_xor(dot, o2);
            if (lane == 0) shw[(size_t)b * N + n] = dot; }
    }
}

__device__ __forceinline__ void cum_phase(unsigned char* ws, LAS unsigned char* lds) {
    if (blockIdx.x >= 8) {
        const int tid = otid(), lane = tid & 63, w = __builtin_amdgcn_readfirstlane(tid >> 6);
        const GAS bf16_t* P0 = (const GAS bf16_t*)(ws + WS_BIG); GAS float* BC = (GAS float*)(ws + WS_H); const GAS float* prm = (const GAS float*)(ws + WS_PRM);
        LAS float* wl = (LAS float*)lds; LAS float* blr = (LAS float*)(lds + 32768);
        for (int i = tid; i < 8192; i += NT) wl[i] = prm[PR_WLR + i];
        blr[tid] = prm[PR_BLR + tid];
        __syncthreads();
        for (int item = blockIdx.x - 8; item < T / 64; item += gridDim.x - 8) {
            const size_t m = (size_t)item * 64 + lane;
            const u32x4 rl0 = *(const GAS u32x4*)(P0 + m * LD0 + C_LR), rl1 = *(const GAS u32x4*)(P0 + m * LD0 + C_LR + 8);
            float glr[16]; unpack8(rl0, glr); unpack8(rl1, glr + 8);
#pragma unroll 1
            for (int h = 0; h < 8; ++h) {
                f32x4 z0 = *(const LAS f32x4*)(blr + 64 * h + 8 * w), z1 = *(const LAS f32x4*)(blr + 64 * h + 8 * w + 4);
#pragma unroll
                for (int r = 0; r < 16; ++r) { const f32x4 w0 = *(const LAS f32x4*)(wl + r * 512 + 64 * h + 8 * w), w1 = *(const LAS f32x4*)(wl + r * 512 + 64 * h + 8 * w + 4); z0 += w0 * glr[r]; z1 += w1 * glr[r]; }
                float bc[8];
#pragma unroll
                for (int j = 0; j < 4; ++j) { bc[j] = logsig(z0[j]) * 0.0625f; bc[4 + j] = logsig(z1[j]) * 0.0625f; }
#pragma unroll
                for (int d = 1; d < 64; d <<= 1) {
#pragma unroll
                    for (int j = 0; j < 8; ++j) { const float o = __shfl_up(bc[j], d); if (lane >= d) bc[j] += o; } }
                GAS float* dst = BC + m * 512 + 64 * h + 8 * w;
                *(GAS f32x4*)dst = (f32x4){bc[0], bc[1], bc[2], bc[3]}; *(GAS f32x4*)(dst + 4) = (f32x4){bc[4], bc[5], bc[6], bc[7]};
            }
        }
        return;
    }
    const int b = blockIdx.x, tid = otid(), lane = tid & 63, wave = tid >> 6;
    const bf16_t* P0 = (const bf16_t*)(ws + WS_BIG); float* cum = (float*)(ws + WS_CUM);
    LAS float* wt = (LAS float*)lds;
    float bf[8];
#pragma unroll
    for (int h = 0; h < 8; ++h) bf[h] = ((const float*)(ws + WS_PRM))[PR_BF + h];
    float run[8];
#pragma unroll
    for (int h = 0; h < 8; ++h) run[h] = 0.f;
    const size_t m0 = (size_t)b * SEQ + 16 * tid;
    for (int i = 0; i < 16; ++i) { const u32x4 w = *(const u32x4*)(P0 + (m0 + i) * LD0 + C_FF); float f[8]; unpack8(w, f);
#pragma unroll
        for (int h = 0; h < 8; ++h) run[h] += logsig(f[h] + bf[h]); }
    float incl[8];
#pragma unroll
    for (int h = 0; h < 8; ++h) { float v = run[h];
#pragma unroll
        for (int d = 1; d < 64; d <<= 1) { const float o = __shfl_up(v, d); if (lane >= d) v += o; }
        incl[h] = v; }
    if (lane == 63) {
#pragma unroll
        for (int h = 0; h < 8; ++h) wt[wave * 8 + h] = incl[h]; }
    __syncthreads();
    float off[8];
#pragma unroll
    for (int h = 0; h < 8; ++h) { float o = incl[h] - run[h]; for (int w = 0; w < wave; ++w) o += wt[w * 8 + h]; off[h] = o; }
    for (int i = 0; i < 16; ++i) { const u32x4 w = *(const u32x4*)(P0 + (m0 + i) * LD0 + C_FF); float f[8]; unpack8(w, f);
#pragma unroll
        for (int h = 0; h < 8; ++h) { off[h] += logsig(f[h] + bf[h]); cum[(size_t)(b * 8 + h) * SEQ + 16 * tid + i] = off[h]; } }
}

__device__ __forceinline__ int q_next(unsigned* ctr, LAS int* slot) {
    __syncthreads();
    if (threadIdx.x == 0) *slot = (int)atomicAdd(ctr, 1u);
    __syncthreads();
    return *slot;
}

__device__ __forceinline__ void gla_item(unsigned char* ws, LAS unsigned char* lds, int b, int h) {
    const int tid = otid(), lane = tid & 63, w = __builtin_amdgcn_readfirstlane(tid >> 6), c = lane & 15, q = lane >> 4;
    const GAS bf16_t* P0 = (const GAS bf16_t*)(ws + WS_BIG); GAS bf16_t* MIX = (GAS bf16_t*)(ws + WS_MIX); const GAS float* BC = (const GAS float*)(ws + WS_H); const GAS float* prm = (const GAS float*)(ws + WS_PRM);
    LAS bf16_t* Qp = (LAS bf16_t*)(lds); LAS bf16_t* Kp = (LAS bf16_t*)(lds + 9216); LAS bf16_t* Kt = (LAS bf16_t*)(lds + 18432); LAS bf16_t* Vt = (LAS bf16_t*)(lds + 27648);
    LAS bf16_t* Pm = (LAS bf16_t*)(lds + 36864); LAS bf16_t* St = (LAS bf16_t*)(lds + 46080); LAS float* dec = (LAS float*)(lds + 55296);
    LAS float* wl = (LAS float*)(lds + 55552); LAS float* blr = (LAS float*)(lds + 59648);
    for (int i = tid; i < 2304; i += NT) ((LAS unsigned*)St)[i] = 0u;
    float gain[16];
#pragma unroll
    for (int vi = 0; vi < 4; ++vi)
#pragma unroll
        for (int j = 0; j < 4; ++j) gain[vi * 4 + j] = prm[PR_GGAIN + h * 64 + 16 * vi + 4 * q + j];
    f32x4 sacc[4];
#pragma unroll
    for (int vi = 0; vi < 4; ++vi) sacc[vi] = (f32x4){0.f, 0.f, 0.f, 0.f};
    const size_t rowbase = (size_t)b * SEQ;
    u32x4 rq, rk, rv; f32x4 rb0, rb1, re0, re1; u32x2 rg[4];
#define GLA_LOAD(ch_) do { const size_t m_ = rowbase + 64 * (ch_) + lane; const GAS bf16_t* p = P0 + m_ * LD0; \
        rq = *(const GAS u32x4*)(p + C_GQ + 64 * h + 8 * w); rk = *(const GAS u32x4*)(p + C_GK + 64 * h + 8 * w); rv = *(const GAS u32x4*)(p + C_GV + 64 * h + 8 * w); \
        const GAS float* pb = BC + m_ * 512 + 64 * h + 8 * w; rb0 = *(const GAS f32x4*)pb; rb1 = *(const GAS f32x4*)(pb + 4); \
        const GAS float* pe = BC + (rowbase + 64 * (ch_) + 63) * 512 + 64 * h + 8 * w; re0 = *(const GAS f32x4*)pe; re1 = *(const GAS f32x4*)(pe + 4); \
        if (w < 4) { const GAS bf16_t* pg = P0 + (rowbase + 64 * (ch_) + 16 * w + c) * LD0 + C_GG + 64 * h + 4 * q; _Pragma("unroll") for (int vi_ = 0; vi_ < 4; ++vi_) rg[vi_] = *(const GAS u32x2*)(pg + 16 * vi_); } } while (0)
    GLA_LOAD(0);
    __syncthreads();
    for (int ch = 0; ch < 128; ++ch) {
        u32x2 gcur[4];
#pragma unroll
        for (int vi = 0; vi < 4; ++vi) gcur[vi] = rg[vi];
        {
            const float bc[8] = {rb0[0], rb0[1], rb0[2], rb0[3], rb1[0], rb1[1], rb1[2], rb1[3]};
            const float ble[8] = {re0[0], re0[1], re0[2], re0[3], re1[0], re1[1], re1[2], re1[3]};
            float qf[8], kf[8]; unpack8(rq, qf); unpack8(rk, kf);
            float qp[8], kp[8], kpp[8], bl[8];
#pragma unroll
            for (int j = 0; j < 8; ++j) { bl[j] = ble[j]; qp[j] = qf[j] * 0.125f * __expf(bc[j]); kp[j] = kf[j] * __expf(-bc[j]); kpp[j] = kf[j] * __expf(bl[j] - bc[j]); }
            u32x4 wq, wk; wq.x = pkbf(qp[0], qp[1]); wq.y = pkbf(qp[2], qp[3]); wq.z = pkbf(qp[4], qp[5]); wq.w = pkbf(qp[6], qp[7]);
            wk.x = pkbf(kp[0], kp[1]); wk.y = pkbf(kp[2], kp[3]); wk.z = pkbf(kp[4], kp[5]); wk.w = pkbf(kp[6], kp[7]);
            *(LAS u32x4*)(Qp + lane * 72 + 8 * w) = wq; *(LAS u32x4*)(Kp + lane * 72 + 8 * w) = wk;
            const unsigned vv[4] = {rv.x, rv.y, rv.z, rv.w};
#pragma unroll
            for (int j = 0; j < 8; ++j) { Kt[(8 * w + j) * 72 + lane] = (bf16_t)(pkbf(kpp[j], 0.f) & 0xffffu); Vt[(8 * w + j) * 72 + lane] = (bf16_t)((j & 1) ? (vv[j >> 1] >> 16) : (vv[j >> 1] & 0xffffu)); }
            if (lane == 63) {
#pragma unroll
                for (int j = 0; j < 8; ++j) dec[8 * w + j] = __expf(bl[j]); }
        }
        if (ch + 1 < 128) GLA_LOAD(ch + 1);
        BAR_LDS();
        f32x4 oacc[4];
        {
            const int ti = w & 3;
            const bf16x8 qf0 = *(const LAS bf16x8*)(Qp + (16 * ti + c) * 72 + 8 * q), qf1 = *(const LAS bf16x8*)(Qp + (16 * ti + c) * 72 + 8 * q + 32);
#pragma unroll
            for (int u = 0; u < 2; ++u) { const int si = 2 * (w >> 2) + u; f32x4 acc = (f32x4){0.f, 0.f, 0.f, 0.f};
                if (si <= ti) { const bf16x8 k0 = *(const LAS bf16x8*)(Kp + (16 * si + c) * 72 + 8 * q), k1 = *(const LAS bf16x8*)(Kp + (16 * si + c) * 72 + 8 * q + 32);
                    acc = MFMA16(k0, qf0, acc); acc = MFMA16(k1, qf1, acc);
#pragma unroll
                    for (int j = 0; j < 4; ++j) if (16 * si + 4 * q + j > 16 * ti + c) acc[j] = 0.f; }
                u32x2 pw; pw.x = pkbf(acc[0], acc[1]); pw.y = pkbf(acc[2], acc[3]);
                *(LAS u32x2*)(Pm + (16 * ti + c) * 72 + 16 * si + 4 * q) = pw; }
            if (w < 4) {
#pragma unroll
                for (int vi = 0; vi < 4; ++vi) { const bf16x8 s0 = *(const LAS bf16x8*)(St + (16 * vi + c) * 72 + 8 * q), s1 = *(const LAS bf16x8*)(St + (16 * vi + c) * 72 + 8 * q + 32);
                    f32x4 acc = (f32x4){0.f, 0.f, 0.f, 0.f}; acc = MFMA16(s0, qf0, acc); acc = MFMA16(s1, qf1, acc); oacc[vi] = acc; } }
        }
        BAR_LDS();
        if (w < 4) {
            const bf16x8 p0 = *(const LAS bf16x8*)(Pm + (16 * w + c) * 72 + 8 * q), p1 = *(const LAS bf16x8*)(Pm + (16 * w + c) * 72 + 8 * q + 32);
            float ssq = 0.f;
#pragma unroll
            for (int vi = 0; vi < 4; ++vi) { const bf16x8 v0 = *(const LAS bf16x8*)(Vt + (16 * vi + c) * 72 + 8 * q), v1 = *(const LAS bf16x8*)(Vt + (16 * vi + c) * 72 + 8 * q + 32);
                oacc[vi] = MFMA16(v0, p0, oacc[vi]); oacc[vi] = MFMA16(v1, p1, oacc[vi]);
#pragma unroll
                for (int j = 0; j < 4; ++j) ssq += oacc[vi][j] * oacc[vi][j]; }
            ssq += __shfl_xor(ssq, 16); ssq += __shfl_xor(ssq, 32);
            const float r = rsqrtf(ssq * (1.0f / 64.0f) + EPS);
            const size_t m = rowbase + 64 * ch + 16 * w + c;
#pragma unroll
            for (int vi = 0; vi < 4; ++vi) { const u32x2 gw = gcur[vi];
                const float g0 = bflo(gw.x), g1 = bfhi(gw.x), g2 = bflo(gw.y), g3 = bfhi(gw.y);
                u32x2 ow; ow.x = pkbf(oacc[vi][0] * r * gain[vi * 4 + 0] * siluf_(g0), oacc[vi][1] * r * gain[vi * 4 + 1] * siluf_(g1));
                ow.y = pkbf(oacc[vi][2] * r * gain[vi * 4 + 2] * siluf_(g2), oacc[vi][3] * r * gain[vi * 4 + 3] * siluf_(g3));
                *(GAS u32x2*)(MIX + m * D + 64 * h + 16 * vi + 4 * q) = ow; }
        } else {
            const int ki = w - 4;
            const f32x4 d4 = *(const LAS f32x4*)(dec + 16 * ki + 4 * q);
            const bf16x8 k0 = *(const LAS bf16x8*)(Kt + (16 * ki + c) * 72 + 8 * q), k1 = *(const LAS bf16x8*)(Kt + (16 * ki + c) * 72 + 8 * q + 32);
#pragma unroll
            for (int vi = 0; vi < 4; ++vi) { const bf16x8 v0 = *(const LAS bf16x8*)(Vt + (16 * vi + c) * 72 + 8 * q), v1 = *(const LAS bf16x8*)(Vt + (16 * vi + c) * 72 + 8 * q + 32);
                f32x4 s = sacc[vi] * d4; s = MFMA16(k0, v0, s); s = MFMA16(k1, v1, s); sacc[vi] = s;
                u32x2 sw; sw.x = pkbf(s[0], s[1]); sw.y = pkbf(s[2], s[3]);
                *(LAS u32x2*)(St + (16 * vi + c) * 72 + 16 * ki + 4 * q) = sw; }
        }
        BAR_LDS();
    }
}

#undef GLA_LOAD
__device__ __forceinline__ void fox_item(unsigned char* ws, LAS unsigned char* lds, int b, int h, int qg) {
    const int tid = otid(), lane = tid & 63, w = __builtin_amdgcn_readfirstlane(tid >> 6), c = lane & 15, q = lane >> 4;
    const GAS bf16_t* P0 = (const GAS bf16_t*)(ws + WS_BIG); GAS bf16_t* MIX = (GAS bf16_t*)(ws + WS_MIX);
    const GAS float* cumb = (const GAS float*)(ws + WS_CUM) + (size_t)(b * 8 + h) * SEQ;
    LAS bf16_t* Kn = (LAS bf16_t*)(lds); LAS bf16_t* Vt = (LAS bf16_t*)(lds + 9216); LAS float* cumk = (LAS float*)(lds + 18432);
    const GAS float* gq = (const GAS float*)(ws + WS_PRM) + PR_QG + h * 64; const GAS float* gk = (const GAS float*)(ws + WS_PRM) + PR_KG + h * 64;
    float mq = fabsf(gq[lane]), mk = fabsf(gk[lane]);
#pragma unroll
    for (int o = 1; o < 64; o <<= 1) { mq = fmaxf(mq, __shfl_xor(mq, o)); mk = fmaxf(mk, __shfl_xor(mk, o)); }
    const float B2 = 16.0f * mq * mk * 1.001f;
    const int srow = tid >> 3, dc = tid & 7;
    float gkr[8], gqr[16];
#pragma unroll
    for (int e2 = 0; e2 < 8; ++e2) { gkr[e2] = gk[8 * dc + e2]; gqr[e2] = gq[8 * q + e2]; gqr[8 + e2] = gq[8 * q + 32 + e2]; }
    const size_t rowbase = (size_t)b * SEQ;
    for (int qi = 4 * qg; qi < 4 * qg + 4; ++qi) {
        const int t0 = 128 * qi, t = t0 + 16 * w + c; const size_t m = rowbase + t;
        int j = 2 * qi + 1;
        const u32x4 r0 = *(const GAS u32x4*)(P0 + m * LD0 + C_FQ + 64 * h + 8 * q), r1 = *(const GAS u32x4*)(P0 + m * LD0 + C_FQ + 64 * h + 8 * q + 32);
        const float cum_t0 = cumb[t0], cum_t = cumb[t];
        const int jl0 = 2 * qi - 1 - lane; const float ce0 = (jl0 >= 0) ? cumb[64 * jl0 + 63] : 0.f;
        u32x4 rk, rv; float rc;
        { const size_t ms = rowbase + 64 * j + srow; rk = *(const GAS u32x4*)(P0 + ms * LD0 + C_FK + 64 * h + 8 * dc); rv = *(const GAS u32x4*)(P0 + ms * LD0 + C_FV + 64 * h + 8 * dc); rc = cumb[64 * j + srow]; }
        int nbelow = 0;
        { const bool skp = (jl0 < 0) || ((B2 + cum_t0 - ce0) < -110.0f); const unsigned long long mk0 = __ballot(skp);
          if (mk0) nbelow = __ffsll((long long)mk0) - 1;
          else { nbelow = 64;
              for (int basej = 2 * qi - 1 - 64; basej >= 0; basej -= 64) { const int jl = basej - lane; const float ce = (jl >= 0) ? cumb[64 * jl + 63] : 0.f;
                  const bool sk2 = (jl < 0) || ((B2 + cum_t0 - ce) < -110.0f); const unsigned long long mk2 = __ballot(sk2);
                  if (mk2) { nbelow += __ffsll((long long)mk2) - 1; break; } nbelow += 64; } } }
        const int jlo = 2 * qi - nbelow;
        bf16x8 qf[2];
        { float f[16]; unpack8(r0, f); unpack8(r1, f + 8); float ss = 0.f;
#pragma unroll
          for (int e2 = 0; e2 < 16; ++e2) ss += f[e2] * f[e2];
          ss += __shfl_xor(ss, 16); ss += __shfl_xor(ss, 32);
          const float r = rsqrtf(ss * (1.0f / 64.0f) + EPS) * 0.125f;
#pragma unroll
          for (int kk = 0; kk < 2; ++kk) { float g[8];
#pragma unroll
              for (int e2 = 0; e2 < 8; ++e2) g[e2] = f[8 * kk + e2] * r * gqr[8 * kk + e2];
              u32x4 pw; pw.x = pkbf(g[0], g[1]); pw.y = pkbf(g[2], g[3]); pw.z = pkbf(g[4], g[5]); pw.w = pkbf(g[6], g[7]); qf[kk] = as_bf16x8(pw); } }
        f32x4 oacc[4];
#pragma unroll
        for (int di = 0; di < 4; ++di) oacc[di] = (f32x4){0.f, 0.f, 0.f, 0.f};
        float mrun = -1e30f, lpart = 0.f;
        for (;;) {
            { float f[8]; unpack8(rk, f); float ss = 0.f;
#pragma unroll
              for (int e2 = 0; e2 < 8; ++e2) ss += f[e2] * f[e2];
              ss += __shfl_xor(ss, 1); ss += __shfl_xor(ss, 2); ss += __shfl_xor(ss, 4);
              const float r = rsqrtf(ss * (1.0f / 64.0f) + EPS);
#pragma unroll
              for (int e2 = 0; e2 < 8; ++e2) f[e2] = f[e2] * r * gkr[e2];
              u32x4 pw; pw.x = pkbf(f[0], f[1]); pw.y = pkbf(f[2], f[3]); pw.z = pkbf(f[4], f[5]); pw.w = pkbf(f[6], f[7]);
              *(LAS u32x4*)(Kn + srow * 72 + 8 * dc) = pw;
              const unsigned vv[4] = {rv.x, rv.y, rv.z, rv.w};
#pragma unroll
              for (int e2 = 0; e2 < 8; ++e2) Vt[(8 * dc + e2) * 72 + srow] = (bf16_t)((e2 & 1) ? (vv[e2 >> 1] >> 16) : (vv[e2 >> 1] & 0xffffu));
              if (dc == 0) cumk[srow] = rc; }
            const int jn = j - 1;
            const bool cont = jn >= jlo;
            if (cont) { const size_t ms = rowbase + 64 * jn + srow; rk = *(const GAS u32x4*)(P0 + ms * LD0 + C_FK + 64 * h + 8 * dc); rv = *(const GAS u32x4*)(P0 + ms * LD0 + C_FV + 64 * h + 8 * dc); rc = cumb[64 * jn + srow]; }
            BAR_LDS();
            if (!(j == 2 * qi + 1 && w < 4)) {
                float sv[4][4]; float mx = -1e30f;
#pragma unroll
                for (int si = 0; si < 4; ++si) { f32x4 acc = (f32x4){0.f, 0.f, 0.f, 0.f};
                    const bf16x8 k0 = *(const LAS bf16x8*)(Kn + (16 * si + c) * 72 + 8 * q), k1 = *(const LAS bf16x8*)(Kn + (16 * si + c) * 72 + 8 * q + 32);
                    acc = MFMA16(k0, qf[0], acc); acc = MFMA16(k1, qf[1], acc);
                    const f32x4 ck = *(const LAS f32x4*)(cumk + 16 * si + 4 * q);
#pragma unroll
                    for (int jj = 0; jj < 4; ++jj) { float lg = acc[jj] + (cum_t - ck[jj]); if (j >= 2 * qi && (64 * j + 16 * si + 4 * q + jj) > t) lg = -1e30f; sv[si][jj] = lg; mx = fmaxf(mx, lg); } }
                mx = fmaxf(mx, __shfl_xor(mx, 16)); mx = fmaxf(mx, __shfl_xor(mx, 32));
                const float mnew = fmaxf(mrun, mx), alpha = __expf(mrun - mnew); mrun = mnew;
                float ps = 0.f;
#pragma unroll
                for (int si = 0; si < 4; ++si)
#pragma unroll
                    for (int jj = 0; jj < 4; ++jj) { sv[si][jj] = __expf(sv[si][jj] - mnew); ps += sv[si][jj]; }
                lpart = lpart * alpha + ps;
#pragma unroll
                for (int di = 0; di < 4; ++di) oacc[di] *= alpha;
#pragma unroll
                for (int kk = 0; kk < 2; ++kk) { u32x4 pw; pw.x = pkbf(sv[2 * kk][0], sv[2 * kk][1]); pw.y = pkbf(sv[2 * kk][2], sv[2 * kk][3]); pw.z = pkbf(sv[2 * kk + 1][0], sv[2 * kk + 1][1]); pw.w = pkbf(sv[2 * kk + 1][2], sv[2 * kk + 1][3]);
                    const bf16x8 pf = as_bf16x8(pw);
#pragma unroll
                    for (int di = 0; di < 4; ++di) { const u32x2 va = *(const LAS u32x2*)(Vt + (16 * di + c) * 72 + 32 * kk + 4 * q), vb = *(const LAS u32x2*)(Vt + (16 * di + c) * 72 + 32 * kk + 16 + 4 * q);
                        u32x4 vw; vw.x = va.x; vw.y = va.y; vw.z = vb.x; vw.w = vb.y; oacc[di] = MFMA16(as_bf16x8(vw), pf, oacc[di]); } }
            }
            BAR_LDS();
            if (!cont) break;
            j = jn;
        }
        float l = lpart; l += __shfl_xor(l, 16); l += __shfl_xor(l, 32);
        const float inv = 1.0f / l;
#pragma unroll
        for (int di = 0; di < 4; ++di) { u32x2 ow; ow.x = pkbf(oacc[di][0] * inv, oacc[di][1] * inv); ow.y = pkbf(oacc[di][2] * inv, oacc[di][3] * inv);
            *(GAS u32x2*)(MIX + m * D + 512 + 64 * h + 16 * di + 4 * q) = ow; }
    }
}

__device__ __forceinline__ void s5_item(unsigned char* ws, LAS unsigned char* lds, int b, int g) {
    const int tid = otid(), lane = tid & 63, w = __builtin_amdgcn_readfirstlane(tid >> 6), c = lane & 15, q = lane >> 4;
    const GAS bf16_t* P1 = (const GAS bf16_t*)(ws + WS_BIG); GAS bf16_t* YS = (GAS bf16_t*)(ws + WS_YS5);
    const GAS float* abar = (const GAS float*)(ws + WS_S5P + S5_ABAR); const GAS bf16_t* Bb = (const GAS bf16_t*)(ws + WS_S5P + S5_BB); const GAS bf16_t* Cm = (const GAS bf16_t*)(ws + WS_S5P + S5_CM);
    LAS float* bu = (LAS float*)(lds + w * 12800); LAS bf16_t* xs = (LAS bf16_t*)(lds + w * 12800 + 8448); LAS float* E = (LAS float*)(lds + 102400);
    const float ar = abar[(g * 64 + lane) * 2], ai = abar[(g * 64 + lane) * 2 + 1];
    float pr = ar, pi = ai;
#pragma unroll
    for (int i = 0; i < 10; ++i) { const float nr = pr * pr - pi * pi, ni = 2.0f * pr * pi; pr = nr; pi = ni; }
    bf16x8 bfr[8], cfr[4];
    const bf16x8 zero8 = (bf16x8){0, 0, 0, 0, 0, 0, 0, 0};
#pragma unroll
    for (int pt = 0; pt < 8; ++pt) bfr[pt] = (q < 2) ? *(const GAS bf16x8*)(Bb + ((size_t)(g * 128 + 16 * pt + c)) * 16 + 8 * q) : zero8;
#pragma unroll
    for (int kk = 0; kk < 4; ++kk) cfr[kk] = *(const GAS bf16x8*)(Cm + (size_t)(g * 16 + c) * 128 + 32 * kk + 8 * q);
    float dsk[4];
#pragma unroll
    for (int j = 0; j < 4; ++j) dsk[j] = ((const GAS float*)(ws + WS_PRM))[PR_S5D + g * 16 + 4 * q + j];
    float xr = 0.f, xi = 0.f;
    for (int pass = 0; pass < 2; ++pass) {
        const size_t mbase = (size_t)b * SEQ + 1024 * w + c;
        bf16x8 uf_n = (q < 2) ? *(const GAS bf16x8*)(P1 + mbase * LD1 + 16 * g + 8 * q) : zero8;
        u32x2 uw_n = *(const GAS u32x2*)(P1 + mbase * LD1 + 16 * g + 4 * q);
        for (int sc = 0; sc < 64; ++sc) {
            const size_t m = mbase + 16 * sc;
            const bf16x8 uf = uf_n; const u32x2 uw = uw_n;
            if (sc + 1 < 64) { const size_t mn = m + 16;
                uf_n = (q < 2) ? *(const GAS bf16x8*)(P1 + mn * LD1 + 16 * g + 8 * q) : zero8; uw_n = *(const GAS u32x2*)(P1 + mn * LD1 + 16 * g + 4 * q); }
#pragma unroll
            for (int pt = 0; pt < 8; ++pt) { f32x4 acc = (f32x4){0.f, 0.f, 0.f, 0.f}; acc = MFMA16(bfr[pt], uf, acc); *(LAS f32x4*)(bu + c * 132 + 16 * pt + 4 * q) = acc; }
            LDS_WAIT();
#pragma unroll
            for (int tt = 0; tt < 16; ++tt) { const float br = bu[tt * 132 + lane], bi = bu[tt * 132 + 64 + lane];
                const float nr = ar * xr - ai * xi + br, ni = ar * xi + ai * xr + bi; xr = nr; xi = ni;
                if (pass) { xs[tt * 136 + lane] = (bf16_t)(pkbf(xr, 0.f) & 0xffffu); xs[tt * 136 + 64 + lane] = (bf16_t)(pkbf(xi, 0.f) & 0xffffu); } }
            if (pass) {
                LDS_WAIT();
                f32x4 acc = (f32x4){0.f, 0.f, 0.f, 0.f};
#pragma unroll
                for (int kk = 0; kk < 4; ++kk) { const bf16x8 xf = *(const LAS bf16x8*)(xs + c * 136 + 32 * kk + 8 * q); acc = MFMA16(cfr[kk], xf, acc); }
                const float y0 = gelu_tanh(acc[0] + dsk[0] * bflo(uw.x)), y1 = gelu_tanh(acc[1] + dsk[1] * bfhi(uw.x)), y2 = gelu_tanh(acc[2] + dsk[2] * bflo(uw.y)), y3 = gelu_tanh(acc[3] + dsk[3] * bfhi(uw.y));
                u32x2 ow; ow.x = pkbf(y0, y1); ow.y = pkbf(y2, y3);
                *(GAS u32x2*)(YS + m * 512 + 16 * g + 4 * q) = ow;
            }
            LDS_WAIT();
        }
        if (pass == 0) {
            E[w * 128 + lane] = xr; E[w * 128 + 64 + lane] = xi;
            __syncthreads();
            float cr = 0.f, ci = 0.f;
            for (int w2 = 0; w2 < w; ++w2) { const float er = E[w2 * 128 + lane], ei = E[w2 * 128 + 64 + lane]; const float nr = pr * cr - pi * ci + er, ni = pr * ci + pi * cr + ei; cr = nr; ci = ni; }
            xr = cr; xi = ci;
        }
    }
}

__device__ __forceinline__ void sgu_item(unsigned char* ws, LAS unsigned char* lds, int b, int n) {
    const int tid = otid(), lane = tid & 63, w = __builtin_amdgcn_readfirstlane(tid >> 6), c = lane & 15, q = lane >> 4;
    const GAS bf16_t* P1 = (const GAS bf16_t*)(ws + WS_BIG); GAS bf16_t* MIX = (GAS bf16_t*)(ws + WS_MIX); const GAS bf16_t* wsb = (const GAS bf16_t*)(ws + WS_WSB);
    LAS bf16_t* Vt = (LAS bf16_t*)lds;
    const size_t m0 = (size_t)b * SEQ + 128 * n;
    {
        const int s = tid >> 2, qq = tid & 3; const GAS bf16_t* vp = P1 + (m0 + s) * LD1 + 1024 + 128 * qq;
        u32x4 rv[16]; float sum = 0.f, ssq = 0.f;
#pragma unroll
        for (int i = 0; i < 16; ++i) { rv[i] = *(const GAS u32x4*)(vp + 8 * i); float f[8]; unpack8(rv[i], f);
#pragma unroll
            for (int e = 0; e < 8; ++e) { sum += f[e]; ssq += f[e] * f[e]; } }
        sum += __shfl_xor(sum, 1); sum += __shfl_xor(sum, 2); ssq += __shfl_xor(ssq, 1); ssq += __shfl_xor(ssq, 2);
        const float mu = sum * (1.0f / 512.0f), var = fmaxf(ssq * (1.0f / 512.0f) - mu * mu, 0.f), rstd = rsqrtf(var + EPS);
        const GAS float* lg = (const GAS float*)(ws + WS_PRM) + PR_LNG + 128 * qq; const GAS float* lb = (const GAS float*)(ws + WS_PRM) + PR_LNB + 128 * qq;
#pragma unroll
        for (int i = 0; i < 16; ++i) { float f[8]; unpack8(rv[i], f);
            const f32x4 g0 = *(const GAS f32x4*)(lg + 8 * i), g1 = *(const GAS f32x4*)(lg + 8 * i + 4), b0 = *(const GAS f32x4*)(lb + 8 * i), b1 = *(const GAS f32x4*)(lb + 8 * i + 4);
#pragma unroll
            for (int e = 0; e < 8; ++e) { const float gg = e < 4 ? g0[e & 3] : g1[e & 3], bb = e < 4 ? b0[e & 3] : b1[e & 3]; const float y = (f[e] - mu) * rstd * gg + bb;
                Vt[(128 * qq + 8 * i + e) * 136 + s] = (bf16_t)(pkbf(y, 0.f) & 0xffffu); } }
    }
    __syncthreads();
    const int nk = (w >> 1) + 1; const int trow = 16 * w + c; const size_t m = m0 + trow;
    for (int g = 0; g < 8; ++g) {
        f32x4 acc[4];
#pragma unroll
        for (int ct = 0; ct < 4; ++ct) acc[ct] = (f32x4){0.f, 0.f, 0.f, 0.f};
        for (int kk = 0; kk < nk; ++kk) { const bf16x8 wf = *(const GAS bf16x8*)(wsb + ((size_t)g * 128 + trow) * 128 + 32 * kk + 8 * q);
#pragma unroll
            for (int ct = 0; ct < 4; ++ct) { const bf16x8 vf = *(const LAS bf16x8*)(Vt + (64 * g + 16 * ct + c) * 136 + 32 * kk + 8 * q); acc[ct] = MFMA16(vf, wf, acc[ct]); } }
        const float bs = ((const GAS float*)(ws + WS_PRM))[PR_BS + g * 128 + trow];
#pragma unroll
        for (int ct = 0; ct < 4; ++ct) { const u32x2 uw = *(const GAS u32x2*)(P1 + m * LD1 + 512 + 64 * g + 16 * ct + 4 * q);
            u32x2 ow; ow.x = pkbf(bflo(uw.x) * (acc[ct][0] + bs), bfhi(uw.x) * (acc[ct][1] + bs)); ow.y = pkbf(bflo(uw.y) * (acc[ct][2] + bs), bfhi(uw.y) * (acc[ct][3] + bs));
            *(GAS u32x2*)(MIX + m * D + 512 + 64 * g + 16 * ct + 4 * q) = ow; }
    }
}

__device__ __forceinline__ void grid_bar(unsigned* bar, unsigned k) {
    asm volatile("s_waitcnt vmcnt(0) lgkmcnt(0)" ::: "memory");
    __syncthreads();
    if (threadIdx.x == 0) {
        const unsigned target = (k + 1u) * gridDim.x;
        __builtin_amdgcn_fence(__ATOMIC_RELEASE, "agent"); asm volatile("s_waitcnt vmcnt(0)" ::: "memory");
        __hip_atomic_fetch_add(bar, 1u, __ATOMIC_RELAXED, __HIP_MEMORY_SCOPE_AGENT);
        while (__hip_atomic_load(bar, __ATOMIC_RELAXED, __HIP_MEMORY_SCOPE_AGENT) < target) __builtin_amdgcn_s_sleep(1);
        __builtin_amdgcn_fence(__ATOMIC_ACQUIRE, "agent"); asm volatile("s_waitcnt vmcnt(0)" ::: "memory");
    }
    __syncthreads();
}
#define GSYNC(k) grid_bar((unsigned*)(a.ws + WS_CTL) + 128, (unsigned)(k))
__global__ void __launch_bounds__(NT, 2) mega_fwd(Args a) {
    extern __shared__ __attribute__((aligned(16))) unsigned char lds_raw[];
    LAS unsigned char* lds = (LAS unsigned char*)lds_raw;
    cg::grid_group grid = cg::this_grid();
    LAS int* slot = (LAS int*)(lds + LDS_BYTES - 64);
    grid.sync();
#ifndef NO_P0
    p0_prologue(a, lds);
#endif
    GSYNC(0);
    unsigned char* const ws0 = a.ws; const float* const x00 = a.in[0]; float* const xout0 = a.out;
    unsigned kb = 1;
    for (int ph = 1; ph <= 16; ++ph) {
        if (ph == 6 || ph == 9 || ph == 14) continue;
        unsigned char* ws = ws0; const float* x0 = x00; float* xout = xout0;
        asm volatile("" : "+s"(ws), "+s"(x0), "+s"(xout));

        const float* mod = (const float*)(ws + WS_MOD);
        bf16_t* H = (bf16_t*)(ws + WS_H); bf16_t* MIX = (bf16_t*)(ws + WS_MIX); bf16_t* BIG = (bf16_t*)(ws + WS_BIG);
        unsigned* ctl = (unsigned*)(ws + WS_CTL);
        const int layer = ph >= 9;
        const GAS float* modl = (const GAS float*)mod + (size_t)layer * 8 * 6144;
        GAS float* rowss = (GAS float*)(ws + WS_ROWSS); const GAS float* shw = (const GAS float*)(ws + WS_SHW);
#ifndef REPEAT_PH
#define REPEAT_PH -1
#endif
        for (int rep = 0; rep < ((ph == REPEAT_PH) ? 2 : 1); ++rep) {
        pg8::Gemm g{nullptr, nullptr, T, 0, 0, 0}; pg8::Epi E{0, 0, nullptr, 0, nullptr, nullptr, nullptr, nullptr, nullptr, nullptr, nullptr, 0};
        switch (ph) {
        case 1: norm_phase(x0, mod, 0, 1024, H); break;
        case 3: cum_phase(ws, lds); break;
        case 4:
            for (;;) { const int it = q_next(ctl + 256 * rep, slot); if (it >= 64 + 1024 + 152) break;
                if (it < 64) gla_item(ws, lds, it >> 3, it & 7); else if (it < 64 + 1024) { const int f = it - 64; fox_item(ws, lds, f >> 7, (f >> 4) & 7, f & 15); }
                else prep_item(ws, lds, it - 64 - 1024); }
            break;
        case 11:
            for (;;) { const int it = q_next(ctl + 64 + 256 * rep, slot); if (it >= 256 + 512) break;
                if (it < 256) s5_item(ws, lds, it >> 5, it & 31); else { const int f = it - 256; sgu_item(ws, lds, f >> 6, f & 63); } }
            break;
        case 2: g.A = H; g.Bt = (const bf16_t*)(ws + WS_WIN0); g.N = LD0; g.K = D; E.mode = 0; E.O = (GAS bf16_t*)BIG; E.ldc = LD0; break;
        case 5: g.A = MIX; g.Bt = (const bf16_t*)(ws + WS_WOUT0); g.N = D; g.K = D; E.mode = 6; E.O = (GAS bf16_t*)H; E.base32 = (const GAS float*)x0; E.gate = modl + 2048; E.rowss = rowss; break;
        case 7: g.A = H; g.Bt = (const bf16_t*)(ws + WS_WB0); g.bbatch = (size_t)FFD * D * 2; g.N = FFD; g.K = D; E.mode = 5; E.sub = 1; E.O = (GAS bf16_t*)BIG; E.ldc = FFD; E.rowss = rowss; E.shw = shw; E.ldsh = FFD; break;
        case 8: g.A = BIG; g.Bt = (const bf16_t*)(ws + WS_W2_0); g.N = D; g.K = FFD; E.mode = 7; E.O = (GAS bf16_t*)H; E.gate = modl + 5120; E.rowss = rowss; break;
        case 10: g.A = H; g.Bt = (const bf16_t*)(ws + WS_WB1); g.bbatch = (size_t)LD1 * D * 2; g.N = LD1; g.K = D; E.mode = 5; E.sub = 2; E.O = (GAS bf16_t*)BIG; E.ldc = LD1; E.rowss = rowss; E.shw = shw + 8 * 4096; E.ldsh = LD1; break;
        case 12: g.A = (const bf16_t*)(ws + WS_YS5); g.Bt = (const bf16_t*)(ws + WS_WGLU); g.N = 512; g.K = 512; E.mode = 3; E.O = (GAS bf16_t*)MIX; E.Y = (const GAS bf16_t*)(ws + WS_YS5); E.bias = (const GAS float*)(ws + WS_PRM) + PR_BGLU; break;
        case 13: g.A = MIX; g.Bt = (const bf16_t*)(ws + WS_WOUT1); g.N = D; g.K = D; E.mode = 7; E.O = (GAS bf16_t*)H; E.gate = modl + 2048; E.rowss = rowss; break;
        case 15: g.A = H; g.Bt = (const bf16_t*)(ws + WS_WB2); g.bbatch = (size_t)FFD * D * 2; g.N = FFD; g.K = D; E.mode = 5; E.sub = 1; E.O = (GAS bf16_t*)BIG; E.ldc = FFD; E.rowss = rowss; E.shw = shw + 16 * 4096; E.ldsh = FFD; break;
        case 16: g.A = BIG; g.Bt = (const bf16_t*)(ws + WS_W2_1); g.N = D; g.K = FFD; E.mode = 8; E.O = (GAS bf16_t*)H; E.out32 = (GAS float*)xout; E.gate = modl + 5120; break;
        default: break;
        }
        if (g.K != 0) { pg8::StaticOrder S; S.init(T, g.N, gridDim.x, blockIdx.x); pg8::gemm_phase(lds, g, S, E); }
        }
        if (ph != 16) { GSYNC(kb); ++kb; }
    }
}

extern "C" void kernel_launch(void* const* d_in, const int* in_sizes, int n_in, void* d_out, int out_size, void* d_ws, size_t ws_size, hipStream_t stream) {
    static int grid = 0;
    if (grid == 0) {
        if (n_in != 30 || out_size != T * D || ws_size < WS_END) { fprintf(stderr, "kernel_launch: unexpected shapes (n_in %d out %d ws %zu)\n", n_in, out_size, ws_size); grid = -1; return; }
        int dev = 0, cus = 0, per_cu = 0;
        hipGetDevice(&dev); hipDeviceGetAttribute(&cus, hipDeviceAttributeMultiprocessorCount, dev);
        hipFuncSetAttribute((const void*)mega_fwd, hipFuncAttributeMaxDynamicSharedMemorySize, LDS_BYTES);
        hipOccupancyMaxActiveBlocksPerMultiprocessor(&per_cu, (const void*)mega_fwd, NT, LDS_BYTES);
        if (per_cu < 1) { fprintf(stderr, "kernel_launch: occupancy query says %d blocks/CU\n", per_cu); per_cu = 1; }
        grid = cus * 1;
        (void)hipGetLastError();
    }
    if (grid < 0) return;
    (void)hipMemsetAsync((char*)d_ws + WS_CTL, 0, 4096, stream);
    Args a{};
    for (int i = 0; i < 30; ++i) a.in[i] = (const float*)d_in[i];
    a.out = (float*)d_out; a.ws = (unsigned char*)d_ws;
    void* args[] = {&a};
    hipError_t e = hipLaunchCooperativeKernel((const void*)mega_fwd, dim3(grid), dim3(NT), args, LDS_BYTES, stream);
    if (e != hipSuccess) fprintf(stderr, "cooperative launch failed: %s (grid %d)\n", hipGetErrorString(e), grid);
}
```

```cpp
#include <hip/hip_runtime.h>
#include <hip/hip_cooperative_groups.h>
#include <cstdio>
namespace cg = cooperative_groups;

#define LAS __attribute__((address_space(3)))
#define GAS __attribute__((address_space(1)))
typedef unsigned short bf16_t;
typedef short bf16x8 __attribute__((ext_vector_type(8)));
typedef short bf16x4 __attribute__((ext_vector_type(4)));
typedef float f32x4 __attribute__((ext_vector_type(4)));
typedef float f32x2 __attribute__((ext_vector_type(2)));
typedef unsigned u32x4 __attribute__((ext_vector_type(4)));
typedef unsigned u32x2 __attribute__((ext_vector_type(2)));

constexpr int T = 65536, SEQ = 8192, D = 1024, FFD = 4096;
constexpr int LD0 = 3840, LD1 = 1536;
constexpr int C_GQ = 0, C_GK = 512, C_GV = 1024, C_GG = 1536, C_FQ = 2048, C_FK = 2560, C_FV = 3072, C_LR = 3584, C_FF = 3600;
constexpr float EPS = 1e-6f;
constexpr size_t MiB = 1u << 20;
constexpr size_t WS_CTL = 0, WS_WIN0 = 2 * MiB, WS_WOUT0 = 10 * MiB, WS_W1_0 = 12 * MiB, WS_W2_0 = 20 * MiB, WS_WIN1 = 28 * MiB, WS_WOUT1 = 31 * MiB,
                 WS_WGLU = 33 * MiB, WS_W1_1 = 34 * MiB, WS_W2_1 = 42 * MiB, WS_WSB = 50 * MiB, WS_MOD = 51 * MiB, WS_S5P = 52 * MiB, WS_CUM = 53 * MiB,
                 WS_H = 64 * MiB, WS_MIX = 192 * MiB, WS_BIG = 320 * MiB, WS_WB0 = 832 * MiB, WS_WB1 = 896 * MiB, WS_WB2 = 920 * MiB, WS_END = 984 * MiB;
constexpr size_t WS_PRM = 56 * MiB, WS_ROWSS = 57 * MiB  , WS_SHW = 61 * MiB  , WS_YS5 = WS_BIG + 256 * MiB;
constexpr int PR_WLR = 0, PR_BLR = 8192, PR_GGAIN = 8704, PR_BF = 9216, PR_QG = 9280, PR_KG = 9792, PR_S5D = 10304, PR_BGLU = 10816, PR_LNG = 11328, PR_LNB = 11840, PR_BS = 12352;
constexpr size_t S5_ABAR = 0, S5_BB = 16384, S5_CM = 16384 + 131072;
constexpr int LDS_BYTES = 147456;
constexpr int NT = 512;

struct Args { const float* in[30]; float* out; unsigned char* ws; };

typedef __bf16 bf16x2_t __attribute__((ext_vector_type(2)));
__device__ __forceinline__ unsigned pkbf(float lo, float hi) { f32x2 v = {lo, hi}; bf16x2_t b = __builtin_convertvector(v, bf16x2_t); return __builtin_bit_cast(unsigned, b); }
__device__ __forceinline__ float bflo(unsigned w) { return __uint_as_float(w << 16); }
__device__ __forceinline__ float bfhi(unsigned w) { return __uint_as_float(w & 0xffff0000u); }
__device__ __forceinline__ void unpack8(u32x4 w, float* f) { f[0] = bflo(w.x); f[1] = bfhi(w.x); f[2] = bflo(w.y); f[3] = bfhi(w.y); f[4] = bflo(w.z); f[5] = bfhi(w.z); f[6] = bflo(w.w); f[7] = bfhi(w.w); }
__device__ __forceinline__ float sigmoidf_(float x) { return 1.0f / (1.0f + __expf(-x)); }
__device__ __forceinline__ float siluf_(float x) { return x * sigmoidf_(x); }
__device__ __forceinline__ float gelu_tanh(float x) { const float u = 1.5957691216057308f * (x + 0.044715f * x * x * x); return x * sigmoidf_(u); }
__device__ __forceinline__ float logsig(float x) { return fminf(x, 0.f) - __logf(1.0f + __expf(-fabsf(x))); }
__device__ __forceinline__ int otid() { int t = threadIdx.x; asm volatile("" : "+v"(t)); return t; }
#define LDS_WAIT() asm volatile("s_waitcnt lgkmcnt(0)" ::: "memory")
#define BAR_LDS() do { asm volatile("s_waitcnt lgkmcnt(0)" ::: "memory"); __builtin_amdgcn_s_barrier(); asm volatile("" ::: "memory"); } while (0)
#define MFMA16(a, b, c) __builtin_amdgcn_mfma_f32_16x16x32_bf16((a), (b), (c), 0, 0, 0)
__device__ __forceinline__ bf16x8 as_bf16x8(u32x4 v) { return __builtin_bit_cast(bf16x8, v); }

namespace pg8 {
constexpr int BM = 256, BK = 64, HALF = 128, HTB = HALF * BK * 2, STAGE_BYTES = 8 * HTB, NXCD = 8, WGM = 8;
__device__ __forceinline__ int lds_byte(int r, int c) { const int st = (r >> 4) * 2 + (c >> 5), rr = r & 15, cc = c & 31, ob = rr * 64 + cc * 2; return st * 1024 + (ob ^ (((ob >> 9) & 1) << 5)); }
__device__ __forceinline__ void stage_rc(int b, int& R, int& C) { const int st = b / 1024, sb = b % 1024, swz = sb ^ (((sb >> 9) & 1) << 5); R = (st >> 1) * 16 + swz / 64; C = (st & 1) * 32 + (swz % 64) / 2; }
__device__ __forceinline__ int perm32(int rho) { const int n = rho >> 4, i = rho & 15; return 8 * (i >> 2) + 4 * n + (i & 3); }
struct Unit { int pm, pn; };
struct Gemm { const bf16_t* A; const bf16_t* Bt; int M, N, K; size_t bbatch; };
struct StaticOrder {
    int nM, nN, nwg, G, c;
    __device__ void init(int M, int N, int G_, int c_) { nM = M / BM; nN = N / BM; nwg = nM * nN; G = G_; c = c_; }
    __device__ bool next(int i, Unit& u) const {
        const long L = (long)i * G + c; if (L >= nwg) return false;
        int wgid = (int)L; { const int q = nwg / NXCD, r = nwg % NXCD, xcd = wgid % NXCD, off = wgid / NXCD; wgid = (xcd < r ? xcd * (q + 1) : r * (q + 1) + (xcd - r) * q) + off; }
        const int nig = WGM * nN, gid = wgid / nig, fm = gid * WGM, gsz = (nM - fm) < WGM ? (nM - fm) : WGM;
        u.pm = fm + ((wgid % nig) % gsz); u.pn = (wgid % nig) / gsz; return true;
    }
};

struct Epi {
    int mode, sub; GAS bf16_t* O; int ldc; const GAS float* base32; GAS float* out32; const GAS float* gate; const GAS bf16_t* Y; const GAS float* bias; GAS float* rowss; const GAS float* shw; int ldsh;
    __device__ __forceinline__ void operator()(const f32x4 (&acc)[2][2][4][2], const Unit& u, int wr, int wc, int fr, int fq) const {
        const int row0 = u.pm * BM + wr * 64 + fr, col0 = u.pn * BM + wc * 32 + 8 * fq, bidx = (u.pm * BM) >> 13;
        if (mode >= 6) {
            const GAS float* gp = gate + (size_t)bidx * 6144 + col0;
            f32x4 gg[2][2];
#pragma unroll
            for (int bj = 0; bj < 2; ++bj) { gg[bj][0] = *(const GAS f32x4*)(gp + bj * HALF); gg[bj][1] = *(const GAS f32x4*)(gp + bj * HALF + 4); }
            if (mode == 6) {
#pragma unroll
                for (int ai = 0; ai < 2; ++ai)
#pragma unroll
                    for (int mh = 0; mh < 2; ++mh) { f32x4 bb[2][2][2];
#pragma unroll
                        for (int ml = 0; ml < 2; ++ml) { const size_t off = (size_t)(row0 + ai * HALF + (2 * mh + ml) * 16) * D + col0;
#pragma unroll
                            for (int bj = 0; bj < 2; ++bj) { bb[ml][bj][0] = *(const GAS f32x4*)(base32 + off + bj * HALF); bb[ml][bj][1] = *(const GAS f32x4*)(base32 + off + bj * HALF + 4); } }
#pragma unroll
                        for (int ml = 0; ml < 2; ++ml) { const int m = 2 * mh + ml; const size_t row = (size_t)(row0 + ai * HALF + m * 16), off = row * D + col0; float ss = 0.f;
#pragma unroll
                            for (int bj = 0; bj < 2; ++bj) { const f32x4 x0 = bb[ml][bj][0] + gg[bj][0] * acc[ai][bj][m][0], x1 = bb[ml][bj][1] + gg[bj][1] * acc[ai][bj][m][1];
                                ss += (x0[0] * x0[0] + x0[1] * x0[1]) + (x0[2] * x0[2] + x0[3] * x0[3]) + (x1[0] * x1[0] + x1[1] * x1[1]) + (x1[2] * x1[2] + x1[3] * x1[3]);
                                u32x4 w; w.x = pkbf(x0[0], x0[1]); w.y = pkbf(x0[2], x0[3]); w.z = pkbf(x1[0], x1[1]); w.w = pkbf(x1[2], x1[3]); *(GAS u32x4*)(O + off + bj * HALF) = w; }
                            ss += __shfl_xor(ss, 16); ss += __shfl_xor(ss, 32); if (fq == 0) rowss[row * 16 + u.pn * 4 + wc] = ss; }
                        asm volatile("" ::: "memory"); }
            } else {
#pragma unroll
                for (int ai = 0; ai < 2; ++ai) { u32x4 bw[4][2];
#pragma unroll
                    for (int m = 0; m < 4; ++m) { const size_t off = (size_t)(row0 + ai * HALF + m * 16) * D + col0;
#pragma unroll
                        for (int bj = 0; bj < 2; ++bj) bw[m][bj] = *(const GAS u32x4*)(O + off + bj * HALF); }
#pragma unroll
                    for (int m = 0; m < 4; ++m) { const size_t row = (size_t)(row0 + ai * HALF + m * 16), off = row * D + col0; float ss = 0.f;
#pragma unroll
                        for (int bj = 0; bj < 2; ++bj) { const u32x4 t = bw[m][bj];
                            const f32x4 b0 = (f32x4){bflo(t.x), bfhi(t.x), bflo(t.y), bfhi(t.y)}, b1 = (f32x4){bflo(t.z), bfhi(t.z), bflo(t.w), bfhi(t.w)};
                            const f32x4 x0 = b0 + gg[bj][0] * acc[ai][bj][m][0], x1 = b1 + gg[bj][1] * acc[ai][bj][m][1];
                            if (mode == 8) { *(GAS f32x4*)(out32 + off + bj * HALF) = x0; *(GAS f32x4*)(out32 + off + bj * HALF + 4) = x1; }
                            else { ss += (x0[0] * x0[0] + x0[1] * x0[1]) + (x0[2] * x0[2] + x0[3] * x0[3]) + (x1[0] * x1[0] + x1[1] * x1[1]) + (x1[2] * x1[2] + x1[3] * x1[3]);
                                u32x4 w; w.x = pkbf(x0[0], x0[1]); w.y = pkbf(x0[2], x0[3]); w.z = pkbf(x1[0], x1[1]); w.w = pkbf(x1[2], x1[3]); *(GAS u32x4*)(O + off + bj * HALF) = w; } }
                        if (mode != 8) { ss += __shfl_xor(ss, 16); ss += __shfl_xor(ss, 32); if (fq == 0) rowss[row * 16 + u.pn * 4 + wc] = ss; } }
                    asm volatile("" ::: "memory"); }
            }
        } else if (mode == 3) {
#pragma unroll
            for (int bj = 0; bj < 2; ++bj) {
                const f32x4 b0 = *(const GAS f32x4*)(bias + col0 + bj * HALF), b1 = *(const GAS f32x4*)(bias + col0 + bj * HALF + 4);
#pragma unroll
                for (int ai = 0; ai < 2; ++ai)
#pragma unroll
                    for (int m = 0; m < 4; ++m) { const size_t row = (size_t)(row0 + ai * HALF + m * 16);
                        const u32x4 yw = *(const GAS u32x4*)(Y + row * 512 + col0 + bj * HALF); float y[8]; unpack8(yw, y);
                        const f32x4 v0 = acc[ai][bj][m][0] + b0, v1 = acc[ai][bj][m][1] + b1; float o[8];
#pragma unroll
                        for (int j = 0; j < 4; ++j) { o[j] = y[j] * sigmoidf_(v0[j]); o[4 + j] = y[4 + j] * sigmoidf_(v1[j]); }
                        u32x4 w; w.x = pkbf(o[0], o[1]); w.y = pkbf(o[2], o[3]); w.z = pkbf(o[4], o[5]); w.w = pkbf(o[6], o[7]);
                        *(GAS u32x4*)(O + row * D + col0 + bj * HALF) = w; asm volatile("" ::: "memory"); } }
        } else {
            const bool act2 = (sub == 2) && (u.pn >= 2);
            float rr[8]; f32x4 sb[2][2];
#pragma unroll
            for (int j = 0; j < 8; ++j) rr[j] = 1.0f;
#pragma unroll
            for (int bj = 0; bj < 2; ++bj) { sb[bj][0] = (f32x4){0.f, 0.f, 0.f, 0.f}; sb[bj][1] = sb[bj][0]; }
            if (mode == 5) {
                const int lane = fq * 16 + fr; float slot[2];
                f32x4 pp[2][4];
#pragma unroll
                for (int h = 0; h < 2; ++h) { const int li = lane + 64 * h, am = li >> 4; const size_t row = (size_t)(u.pm * BM + (am >> 2) * HALF + wr * 64 + (am & 3) * 16 + (li & 15));
                    const GAS f32x4* rp = (const GAS f32x4*)(rowss + row * 16);
#pragma unroll
                    for (int k = 0; k < 4; ++k) pp[h][k] = rp[k]; }
                const GAS float* sp = shw + (size_t)bidx * ldsh + col0;
#pragma unroll
                for (int bj = 0; bj < 2; ++bj) { sb[bj][0] = *(const GAS f32x4*)(sp + bj * HALF); sb[bj][1] = *(const GAS f32x4*)(sp + bj * HALF + 4); }
#pragma unroll
                for (int h = 0; h < 2; ++h) { const f32x4 s = (pp[h][0] + pp[h][1]) + (pp[h][2] + pp[h][3]); slot[h] = rsqrtf(((s[0] + s[1]) + (s[2] + s[3])) * (1.0f / D) + EPS); }
#pragma unroll
                for (int j = 0; j < 8; ++j) rr[j] = __shfl(slot[j >> 2], (j & 3) * 16 + fr);
            }
#pragma unroll
            for (int ai = 0; ai < 2; ++ai)
#pragma unroll
                for (int m = 0; m < 4; ++m) { const size_t row = (size_t)(row0 + ai * HALF + m * 16); GAS bf16_t* rowp = O + row * ldc + col0; const float r = rr[ai * 4 + m];
#pragma unroll
                    for (int bj = 0; bj < 2; ++bj) { f32x4 v0 = acc[ai][bj][m][0], v1 = acc[ai][bj][m][1];
                        if (mode == 5) { v0 = v0 * r + sb[bj][0]; v1 = v1 * r + sb[bj][1]; }
                        if (sub == 1) {
#pragma unroll
                            for (int j = 0; j < 4; ++j) { const float a0 = fmaxf(v0[j], 0.f), a1 = fmaxf(v1[j], 0.f); v0[j] = a0 * a0; v1[j] = a1 * a1; } }
                        if (act2) {
#pragma unroll
                            for (int j = 0; j < 4; ++j) { v0[j] = gelu_tanh(v0[j]); v1[j] = gelu_tanh(v1[j]); } }
                        u32x4 w; w.x = pkbf(v0[0], v0[1]); w.y = pkbf(v0[2], v0[3]); w.z = pkbf(v1[0], v1[1]); w.w = pkbf(v1[2], v1[3]);
                        *(GAS u32x4*)(rowp + bj * HALF) = w; }
                    asm volatile("" ::: "memory"); }
        }
    }
};

__device__ __forceinline__ void gemm_phase(LAS unsigned char* lds, const Gemm g, const StaticOrder& S, const Epi& E) {

    const int tid = otid(), wid = __builtin_amdgcn_readfirstlane(tid >> 6), lane = tid & 63, wr = wid >> 2, wc = wid & 3, fr = lane & 15, fq = lane >> 4;
    const int K = g.K, nt = K / BK;
    unsigned voffA[2], voffB[2];
#pragma unroll
    for (int i = 0; i < 2; ++i) { int R, C; stage_rc(tid * 16 + i * 8192, R, C); const int Rb = (R & ~31) + perm32(R & 31);
        voffA[i] = (unsigned)(R * K + C) * 2u; voffB[i] = (unsigned)(Rb * K + C) * 2u; }
    const size_t kstep = (size_t)(BK * 2);
    const size_t hstep = (size_t)HALF * K * 2;
    const size_t tstep = 2 * hstep;
    const unsigned ldsw = (unsigned)wid * 1024u;
    const int aoff = lds_byte(wr * 64 + fr, fq * 8), boff = lds_byte(wc * 32 + fr, fq * 8);
    const unsigned ldsbase = (unsigned)(unsigned long)lds;
#define PG8_SA(b, h) (((b) * 2 + (h)) * HTB)
#define PG8_SB(b, h) ((4 + (b) * 2 + (h)) * HTB)
#define PG8_STAGE(bufoff, gbase, voff) do { _Pragma("unroll") for (int _i = 0; _i < 2; ++_i) \
        __builtin_amdgcn_global_load_lds((const unsigned*)((const char*)(gbase) + (voff)[_i]), (LAS unsigned*)(lds + (bufoff) + ldsw + _i * 8192), 16, 0, 0); } while (0)
#define PG8_LDA(dst, b, h) do { _Pragma("unroll") for (int m = 0; m < 4; ++m) _Pragma("unroll") for (int k = 0; k < 2; ++k) dst[m][k] = *(const LAS bf16x8*)(lds + PG8_SA(b, h) + aoff + m * 2048 + k * 1024); } while (0)
#define PG8_LDB(dst, b, h) do { _Pragma("unroll") for (int n = 0; n < 2; ++n) _Pragma("unroll") for (int k = 0; k < 2; ++k) dst[n][k] = *(const LAS bf16x8*)(lds + PG8_SB(b, h) + boff + n * 2048 + k * 1024); } while (0)
#define PG8_MMA(ai, bj, At, Bt) do { __builtin_amdgcn_s_setprio(1); _Pragma("unroll") for (int m = 0; m < 4; ++m) _Pragma("unroll") for (int n = 0; n < 2; ++n) _Pragma("unroll") for (int k = 0; k < 2; ++k) \
        acc[ai][bj][m][n] = __builtin_amdgcn_mfma_f32_16x16x32_bf16(Bt[n][k], At[m][k], acc[ai][bj][m][n], 0, 0, 0); __builtin_amdgcn_s_setprio(0); } while (0)
#define PG8_WAIT_V(n) asm volatile("s_waitcnt vmcnt(" #n ")" ::: "memory")
#define PG8_WAIT_L(n) asm volatile("s_waitcnt lgkmcnt(" #n ")" ::: "memory")
#define PG8_BAR __builtin_amdgcn_s_barrier()
#define PG8_SCHED __builtin_amdgcn_sched_barrier(0)
    Unit cur, nxt; int ui = 0;
    if (!S.next(0, cur)) return;
    f32x4 acc[2][2][4][2];
#pragma unroll
    for (int a = 0; a < 2; ++a)
#pragma unroll
        for (int b = 0; b < 2; ++b)
#pragma unroll
            for (int m = 0; m < 4; ++m)
#pragma unroll
                for (int n = 0; n < 2; ++n) acc[a][b][m][n] = (f32x4){0.f, 0.f, 0.f, 0.f};
    bf16x8 At[4][2], B0[2][2], B1[2][2];
    const char* cA = (const char*)g.A + (size_t)cur.pm * tstep; const char* cB = (const char*)g.Bt + (size_t)cur.pn * tstep + (size_t)(cur.pm >> 5) * g.bbatch;
    PG8_STAGE(PG8_SB(0, 0), cB, voffB); PG8_STAGE(PG8_SA(0, 0), cA, voffA); PG8_STAGE(PG8_SB(0, 1), cB + hstep, voffB); PG8_STAGE(PG8_SA(0, 1), cA + hstep, voffA);
    if (wr == 1) PG8_BAR;
    PG8_WAIT_V(4); PG8_BAR;
    PG8_STAGE(PG8_SB(1, 0), cB + kstep, voffB); PG8_STAGE(PG8_SA(1, 0), cA + kstep, voffA); PG8_STAGE(PG8_SB(1, 1), cB + hstep + kstep, voffB);
    PG8_WAIT_V(6); PG8_BAR;
    for (;;) {
        const bool has_next = S.next(ui + 1, nxt);
        const char* nA = has_next ? (const char*)g.A + (size_t)nxt.pm * tstep : cA; const char* nB = has_next ? (const char*)g.Bt + (size_t)nxt.pn * tstep + (size_t)(nxt.pm >> 5) * g.bbatch : cB;
        for (int t = 0; t < nt; t += 2) {
            const bool last = (t == nt - 2);
            const char* a1 = cA + (size_t)(t + 1) * kstep;
            const char* a2 = last ? nA : cA + (size_t)(t + 2) * kstep; const char* b2 = last ? nB : cB + (size_t)(t + 2) * kstep;
            const char* a3 = a2 + kstep; const char* b3 = b2 + kstep;
            PG8_LDB(B0, 0, 0); PG8_SCHED; PG8_LDA(At, 0, 0); PG8_STAGE(PG8_SA(1, 1), a1 + hstep, voffA);
            PG8_WAIT_L(8); PG8_BAR; PG8_WAIT_L(0); PG8_MMA(0, 0, At, B0); PG8_BAR; PG8_SCHED;
            PG8_LDB(B1, 0, 1); PG8_STAGE(PG8_SB(0, 0), b2, voffB);
            PG8_BAR; PG8_WAIT_L(0); PG8_MMA(0, 1, At, B1); PG8_BAR;
            PG8_LDA(At, 0, 1); PG8_STAGE(PG8_SA(0, 0), a2, voffA);
            PG8_BAR; PG8_WAIT_L(0); PG8_MMA(1, 0, At, B0); PG8_BAR; PG8_SCHED;
            PG8_STAGE(PG8_SB(0, 1), b2 + hstep, voffB);
            PG8_WAIT_V(6); PG8_BAR; PG8_MMA(1, 1, At, B1); PG8_BAR;
            PG8_LDB(B0, 1, 0); PG8_SCHED; PG8_LDA(At, 1, 0); PG8_STAGE(PG8_SA(0, 1), a2 + hstep, voffA);
            PG8_WAIT_L(8); PG8_BAR; PG8_WAIT_L(0); PG8_MMA(0, 0, At, B0); PG8_BAR; PG8_SCHED;
            PG8_LDB(B1, 1, 1); PG8_STAGE(PG8_SB(1, 0), b3, voffB);
            PG8_BAR; PG8_WAIT_L(0); PG8_MMA(0, 1, At, B1); PG8_BAR;
            PG8_LDA(At, 1, 1); PG8_STAGE(PG8_SA(1, 0), a3, voffA);
            PG8_BAR; PG8_WAIT_L(0); PG8_MMA(1, 0, At, B0); PG8_BAR; PG8_SCHED;
            PG8_STAGE(PG8_SB(1, 1), b3 + hstep, voffB);
            PG8_WAIT_V(6); PG8_BAR; PG8_MMA(1, 1, At, B1); PG8_BAR;
        }
        E(acc, cur, wr, wc, fr, fq);
        __builtin_amdgcn_s_waitcnt(0x0F70);
        if (!has_next) break;
#pragma unroll
        for (int a = 0; a < 2; ++a)
#pragma unroll
            for (int b = 0; b < 2; ++b)
#pragma unroll
                for (int m = 0; m < 4; ++m)
#pragma unroll
                    for (int n = 0; n < 2; ++n) acc[a][b][m][n] = (f32x4){0.f, 0.f, 0.f, 0.f};
        cur = nxt; cA = nA; cB = nB; ++ui;
    }
    PG8_WAIT_V(0);
    if (wr == 0) PG8_BAR;
    PG8_BAR;
#undef PG8_SA
#undef PG8_SB
#undef PG8_STAGE
#undef PG8_LDA
#undef PG8_LDB
#undef PG8_MMA
#undef PG8_WAIT_V
#undef PG8_WAIT_L
#undef PG8_BAR
#undef PG8_SCHED
}

}

__device__ __forceinline__ void tr_item(const float* W, int ldw, int ncol0, int K, int nblk, bf16_t* WT, int row_off, LAS float* scr, int item, int lane) {
    const int kb = item / nblk, nb = item % nblk, k0 = 64 * kb, n0 = 32 * nb;
    float tv[32];
#pragma unroll
    for (int i = 0; i < 32; ++i) tv[i] = W[(size_t)(k0 + 2 * i + (lane >> 5)) * ldw + ncol0 + n0 + (lane & 31)];
#pragma unroll
    for (int i = 0; i < 32; ++i) scr[(2 * i + (lane >> 5)) * 33 + (lane & 31)] = tv[i];
    LDS_WAIT();
    const int c = lane & 7;
#pragma unroll
    for (int j = 0; j < 4; ++j) { const int n = (lane >> 3) + 8 * j; const LAS float* s = scr + (8 * c) * 33 + n;
        u32x4 o; o.x = pkbf(s[0 * 33], s[1 * 33]); o.y = pkbf(s[2 * 33], s[3 * 33]); o.z = pkbf(s[4 * 33], s[5 * 33]); o.w = pkbf(s[6 * 33], s[7 * 33]);
        *(u32x4*)(WT + (size_t)(row_off + n0 + n) * K + k0 + 8 * c) = o; }
    LDS_WAIT();
}

__device__ __forceinline__ void p0_prologue(const Args& a, LAS unsigned char* lds) {
    const int tid = otid(), lane = tid & 63, wave = __builtin_amdgcn_readfirstlane(tid >> 6);
    unsigned char* ws = a.ws;
    if (blockIdx.x < 192) {
        LAS float* cact = (LAS float*)lds;
        LAS float* red = (LAS float*)(lds + 32768);
        const float* c = a.in[1];
        for (int i = tid; i < 8192; i += NT) cact[i] = siluf_(c[i]);
        __syncthreads();
        const int item = blockIdx.x, layer = item / 96, e = 64 * (item % 96) + lane;
        const float* wp = a.in[2] + (size_t)layer * D * 6144 + e;
        float acc[8];
#pragma unroll
        for (int b = 0; b < 8; ++b) acc[b] = 0.f;
        for (int k0 = wave * 128; k0 < wave * 128 + 128; k0 += 32) {
            float wv[32];
#pragma unroll
            for (int i = 0; i < 32; ++i) wv[i] = wp[(size_t)(k0 + i) * 6144];
#pragma unroll
            for (int i = 0; i < 32; ++i)
#pragma unroll
                for (int b = 0; b < 8; ++b) acc[b] += cact[b * 1024 + k0 + i] * wv[i];
        }
#pragma unroll
        for (int b = 0; b < 8; ++b) red[(wave * 8 + b) * 64 + lane] = acc[b];
        __syncthreads();
        { const int b = tid >> 6; float s = 0.f;
#pragma unroll
          for (int w = 0; w < 8; ++w) s += red[(w * 8 + b) * 64 + lane];
          ((float*)(ws + WS_MOD))[(size_t)(layer * 8 + b) * 6144 + e] = s + a.in[3][layer * 6144 + e]; }
        __syncthreads();
    }
    {
        LAS float* scr = (LAS float*)(lds + wave * 16384);
        const int gw = blockIdx.x * 8 + wave, NGW = gridDim.x * 8;
        constexpr int I0 = 16 * 64, I1 = 16 * 48, I2 = 16 * 32, I3 = 16 * 128, I4 = 64 * 32, I5 = 16 * 48, I6 = 16 * 32, I7 = 8 * 16, I8 = I3, I9 = I4;
        constexpr int NIT = I0 + I1 + I2 + I3 + I4 + I5 + I6 + I7 + I8 + I9;
        for (int it = gw; it < NIT; it += NGW) {
            int r = it;
            if (r < I0) { tr_item(a.in[4], 3608, 0, 1024, 64, (bf16_t*)(ws + WS_WIN0), 0, scr, r, lane); continue; } r -= I0;
            if (r < I1) { tr_item(a.in[4], 3608, 2064, 1024, 48, (bf16_t*)(ws + WS_WIN0), 2048, scr, r, lane); continue; } r -= I1;
            if (r < I2) { tr_item(a.in[5], 1024, 0, 1024, 32, (bf16_t*)(ws + WS_WOUT0), 0, scr, r, lane); continue; } r -= I2;
            if (r < I3) { tr_item(a.in[28], 4096, 0, 1024, 128, (bf16_t*)(ws + WS_W1_0), 0, scr, r, lane); continue; } r -= I3;
            if (r < I4) { tr_item(a.in[29], 1024, 0, 4096, 32, (bf16_t*)(ws + WS_W2_0), 0, scr, r, lane); continue; } r -= I4;
            if (r < I5) { tr_item(a.in[12], 1536, 0, 1024, 48, (bf16_t*)(ws + WS_WIN1), 0, scr, r, lane); continue; } r -= I5;
            if (r < I6) { tr_item(a.in[13], 1024, 0, 1024, 32, (bf16_t*)(ws + WS_WOUT1), 0, scr, r, lane); continue; } r -= I6;
            if (r < I7) { tr_item(a.in[22], 512, 0, 512, 16, (bf16_t*)(ws + WS_WGLU), 0, scr, r, lane); continue; } r -= I7;
            if (r < I8) { tr_item(a.in[28] + (size_t)D * FFD, 4096, 0, 1024, 128, (bf16_t*)(ws + WS_W1_1), 0, scr, r, lane); continue; } r -= I8;
            tr_item(a.in[29] + (size_t)D * FFD, 1024, 0, 4096, 32, (bf16_t*)(ws + WS_W2_1), 0, scr, r, lane);
        }
    }
    {
        if (blockIdx.x == 0 && tid == 0) { unsigned* ctl = (unsigned*)(ws + WS_CTL); __hip_atomic_store(ctl, 0u, __ATOMIC_RELAXED, __HIP_MEMORY_SCOPE_AGENT); __hip_atomic_store(ctl + 64, 0u, __ATOMIC_RELAXED, __HIP_MEMORY_SCOPE_AGENT); }
        const int gt = blockIdx.x * NT + tid, NGT = gridDim.x * NT;
        bf16_t* win0 = (bf16_t*)(ws + WS_WIN0);
        for (int i = gt; i < 256 * 1024; i += NGT) { const int n = i >> 10, k = i & 1023; float v = 0.f;
            if (n < 16) v = a.in[4][(size_t)k * 3608 + 2048 + n]; else if (n < 24) v = a.in[4][(size_t)k * 3608 + 3600 + (n - 16)];
            win0[(size_t)(3584 + n) * 1024 + k] = (bf16_t)(pkbf(v, 0.f) & 0xffffu); }
        bf16_t* wsb = (bf16_t*)(ws + WS_WSB);
        for (int i = gt; i < 8 * 128 * 128; i += NGT) { const int t = (i >> 7) & 127, s = i & 127; const float v = (s <= t) ? a.in[26][i] : 0.f; wsb[i] = (bf16_t)(pkbf(v, 0.f) & 0xffffu); }
        { float* prm = (float*)(ws + WS_PRM);
          for (int i = gt; i < 8192; i += NGT) prm[PR_WLR + i] = a.in[6][i];
          for (int i = gt; i < 1024; i += NGT) prm[PR_BS + i] = a.in[27][i];
          for (int i = gt; i < 512; i += NGT) { prm[PR_BLR + i] = a.in[7][i]; prm[PR_GGAIN + i] = a.in[8][i]; prm[PR_QG + i] = a.in[10][i]; prm[PR_KG + i] = a.in[11][i]; prm[PR_S5D + i] = a.in[21][i];
              prm[PR_BGLU + i] = a.in[23][i]; prm[PR_LNG + i] = a.in[24][i]; prm[PR_LNB + i] = a.in[25][i]; }
          for (int i = gt; i < 8; i += NGT) prm[PR_BF + i] = a.in[9][i]; }
        float* abar = (float*)(ws + WS_S5P + S5_ABAR); bf16_t* Bb = (bf16_t*)(ws + WS_S5P + S5_BB); bf16_t* Cm = (bf16_t*)(ws + WS_S5P + S5_CM);
        for (int i = gt; i < 32 * 64; i += NGT) { const int g = i >> 6, p = i & 63;
            const float lr = a.in[14][i], li = a.in[15][i], dt = expf(a.in[16][g]);
            const float mag = expf(lr * dt), ang = li * dt, ar = mag * cosf(ang), ai = mag * sinf(ang), den = lr * lr + li * li;
            const float cr = ((ar - 1.0f) * lr + ai * li) / den, ci = (ai * lr - (ar - 1.0f) * li) / den;
            abar[2 * i] = ar; abar[2 * i + 1] = ai;
            for (int k = 0; k < 16; ++k) { const float br = a.in[17][(size_t)i * 16 + k], bi = a.in[18][(size_t)i * 16 + k];
                Bb[((size_t)g * 128 + p) * 16 + k] = (bf16_t)(pkbf(cr * br - ci * bi, 0.f) & 0xffffu);
                Bb[((size_t)g * 128 + 64 + p) * 16 + k] = (bf16_t)(pkbf(cr * bi + ci * br, 0.f) & 0xffffu); } }
        for (int i = gt; i < 32 * 16 * 64; i += NGT) { const int gi = i >> 6, p = i & 63;
            Cm[(size_t)gi * 128 + p] = (bf16_t)(pkbf(a.in[19][i], 0.f) & 0xffffu); Cm[(size_t)gi * 128 + 64 + p] = (bf16_t)(pkbf(-a.in[20][i], 0.f) & 0xffffu); }
    }
}

__device__ __forceinline__ void norm_phase(const float* x, const float* mod, int off_sh, int off_sc, bf16_t* H) {
    const int tid_ = otid(); const int lane = tid_ & 63, gw = blockIdx.x * 8 + (tid_ >> 6), NGW = gridDim.x * 8;
    for (int m = gw; m < T; m += NGW) {
        const GAS f32x4* xr = (const GAS f32x4*)(x + (size_t)m * D) + lane;
        const GAS float* mp = (const GAS float*)mod + (size_t)(m >> 13) * 6144;
        f32x4 v[4]; float s = 0.f;
#pragma unroll
        for (int j = 0; j < 4; ++j) { v[j] = xr[64 * j]; s += (v[j].x * v[j].x + v[j].y * v[j].y) + (v[j].z * v[j].z + v[j].w * v[j].w); }
#pragma unroll
        for (int o = 1; o < 64; o <<= 1) s += __shfl_xor(s, o);
        const float r = rsqrtf(s * (1.0f / D) + EPS);
        GAS u32x2* o8 = (GAS u32x2*)(H + (size_t)m * D) + lane;
#pragma unroll
        for (int j = 0; j < 4; ++j) { const f32x4 sc = *((const GAS f32x4*)(mp + off_sc) + lane + 64 * j), sh = *((const GAS f32x4*)(mp + off_sh) + lane + 64 * j);
            const f32x4 y = v[j] * r * (sc + 1.0f) + sh; u32x2 w; w.x = pkbf(y.x, y.y); w.y = pkbf(y.z, y.w); o8[64 * j] = w; }
    }
}

__device__ __forceinline__ void prep_item(unsigned char* ws, LAS unsigned char* lds, int item) {
    const int tid = otid(), lane = tid & 63, wave = tid >> 6;
    const GAS float* mod = (const GAS float*)(ws + WS_MOD);
    LAS float* sc = (LAS float*)lds; LAS float* sh = (LAS float*)(lds + 32768);
    const int site = item < 64 ? 0 : (item < 88 ? 1 : 2), rb = item < 64 ? item : (item < 88 ? item - 64 : item - 88);
    const int N = (site == 1) ? LD1 : FFD, layer = site ? 1 : 0, osc = (site == 1) ? 1024 : 4096, osh = (site == 1) ? 0 : 3072;
    const GAS bf16_t* Wt = (const GAS bf16_t*)(ws + (site == 0 ? WS_W1_0 : site == 1 ? WS_WIN1 : WS_W1_1));
    GAS bf16_t* WB = (GAS bf16_t*)(ws + (site == 0 ? WS_WB0 : site == 1 ? WS_WB1 : WS_WB2));
    GAS float* shw = (GAS float*)(ws + WS_SHW) + (size_t)site * 8 * 4096;
    for (int i = tid; i < 8192; i += NT) { const int b = i >> 10, k = i & 1023; const GAS float* mp = mod + (size_t)(layer * 8 + b) * 6144; sc[i] = 1.0f + mp[osc + k]; sh[i] = mp[osh + k]; }
    __syncthreads();
    for (int n = 64 * rb + wave; n < 64 * rb + 64; n += 8) {
        const u32x4 w0 = *(const GAS u32x4*)(Wt + (size_t)n * D + 16 * lane), w1 = *(const GAS u32x4*)(Wt + (size_t)n * D + 16 * lane + 8);
        float wv[16]; unpack8(w0, wv); unpack8(w1, wv + 8);
#pragma unroll 1
        for (int b = 0; b < 8; ++b) { float o[16]; float dot = 0.f;
#pragma unroll
            for (int i4 = 0; i4 < 4; ++i4) { const f32x4 s4 = *(const LAS f32x4*)(sc + b * 1024 + 16 * lane + 4 * i4), h4 = *(const LAS f32x4*)(sh + b * 1024 + 16 * lane + 4 * i4);
#pragma unroll
                for (int j = 0; j < 4; ++j) { o[4 * i4 + j] = wv[4 * i4 + j] * s4[j]; dot += wv[4 * i4 + j] * h4[j]; } }
            u32x4 p0, p1; p0.x = pkbf(o[0], o[1]); p0.y = pkbf(o[2], o[3]); p0.z = pkbf(o[4], o[5]); p0.w = pkbf(o[6], o[7]); p1.x = pkbf(o[8], o[9]); p1.y = pkbf(o[10], o[11]); p1.z = pkbf(o[12], o[13]); p1.w = pkbf(o[14], o[15]);
            GAS bf16_t* dst = WB + ((size_t)b * N + n) * D + 16 * lane; *(GAS u32x4*)dst = p0; *(GAS u32x4*)(dst + 8) = p1;
#pragma unroll
            for (int o2 = 1; o2 < 64; o2 <<= 1) dot += __shfl_xor(dot, o2);
            if (lane == 0) shw[(size_t)b * N + n] = dot; }
    }
}

__device__ __forceinline__ void cum_phase(unsigned char* ws, LAS unsigned char* lds) {
    if (blockIdx.x >= 8) {
        const int tid = otid(), lane = tid & 63, w = __builtin_amdgcn_readfirstlane(tid >> 6);
        const GAS bf16_t* P0 = (const GAS bf16_t*)(ws + WS_BIG); GAS float* BC = (GAS float*)(ws + WS_H); const GAS float* prm = (const GAS float*)(ws + WS_PRM);
        LAS float* wl = (LAS float*)lds; LAS float* blr = (LAS float*)(lds + 32768);
        for (int i = tid; i < 8192; i += NT) wl[i] = prm[PR_WLR + i];
        blr[tid] = prm[PR_BLR + tid];
        __syncthreads();
        for (int item = blockIdx.x - 8; item < T / 64; item += gridDim.x - 8) {
            const size_t m = (size_t)item * 64 + lane;
            const u32x4 rl0 = *(const GAS u32x4*)(P0 + m * LD0 + C_LR), rl1 = *(const GAS u32x4*)(P0 + m * LD0 + C_LR + 8);
            float glr[16]; unpack8(rl0, glr); unpack8(rl1, glr + 8);
#pragma unroll 1
            for (int h = 0; h < 8; ++h) {
                f32x4 z0 = *(const LAS f32x4*)(blr + 64 * h + 8 * w), z1 = *(const LAS f32x4*)(blr + 64 * h + 8 * w + 4);
#pragma unroll
                for (int r = 0; r < 16; ++r) { const f32x4 w0 = *(const LAS f32x4*)(wl + r * 512 + 64 * h + 8 * w), w1 = *(const LAS f32x4*)(wl + r * 512 + 64 * h + 8 * w + 4); z0 += w0 * glr[r]; z1 += w1 * glr[r]; }
                float bc[8];
#pragma unroll
                for (int j = 0; j < 4; ++j) { bc[j] = logsig(z0[j]) * 0.0625f; bc[4 + j] = logsig(z1[j]) * 0.0625f; }
#pragma unroll
                for (int d = 1; d < 64; d <<= 1) {
#pragma unroll
                    for (int j = 0; j < 8; ++j) { const float o = __shfl_up(bc[j], d); if (lane >= d) bc[j] += o; } }
                GAS float* dst = BC + m * 512 + 64 * h + 8 * w;
                *(GAS f32x4*)dst = (f32x4){bc[0], bc[1], bc[2], bc[3]}; *(GAS f32x4*)(dst + 4) = (f32x4){bc[4], bc[5], bc[6], bc[7]};
            }
        }
        return;
    }
    const int b = blockIdx.x, tid = otid(), lane = tid & 63, wave = tid >> 6;
    const bf16_t* P0 = (const bf16_t*)(ws + WS_BIG); float* cum = (float*)(ws + WS_CUM);
    LAS float* wt = (LAS float*)lds;
    float bf[8];
#pragma unroll
    for (int h = 0; h < 8; ++h) bf[h] = ((const float*)(ws + WS_PRM))[PR_BF + h];
    float run[8];
#pragma unroll
    for (int h = 0; h < 8; ++h) run[h] = 0.f;
    const size_t m0 = (size_t)b * SEQ + 16 * tid;
    for (int i = 0; i < 16; ++i) { const u32x4 w = *(const u32x4*)(P0 + (m0 + i) * LD0 + C_FF); float f[8]; unpack8(w, f);
#pragma unroll
        for (int h = 0; h < 8; ++h) run[h] += logsig(f[h] + bf[h]); }
    float incl[8];
#pragma unroll
    for (int h = 0; h < 8; ++h) { float v = run[h];
#pragma unroll
        for (int d = 1; d < 64; d <<= 1) { const float o = __shfl_up(v, d); if (lane >= d) v += o; }
        incl[h] = v; }
    if (lane == 63) {
#pragma unroll
        for (int h = 0; h < 8; ++h) wt[wave * 8 + h] = incl[h]; }
    __syncthreads();
    float off[8];
#pragma unroll
    for (int h = 0; h < 8; ++h) { float o = incl[h] - run[h]; for (int w = 0; w < wave; ++w) o += wt[w * 8 + h]; off[h] = o; }
    for (int i = 0; i < 16; ++i) { const u32x4 w = *(const u32x4*)(P0 + (m0 + i) * LD0 + C_FF); float f[8]; unpack8(w, f);
#pragma unroll
        for (int h = 0; h < 8; ++h) { off[h] += logsig(f[h] + bf[h]); cum[(size_t)(b * 8 + h) * SEQ + 16 * tid + i] = off[h]; } }
}

__device__ __forceinline__ int q_next(unsigned* ctr, LAS int* slot) {
    __syncthreads();
    if (threadIdx.x == 0) *slot = (int)atomicAdd(ctr, 1u);
    __syncthreads();
    return *slot;
}

__device__ __forceinline__ void gla_item(unsigned char* ws, LAS unsigned char* lds, int b, int h) {
    const int tid = otid(), lane = tid & 63, w = __builtin_amdgcn_readfirstlane(tid >> 6), c = lane & 15, q = lane >> 4;
    const GAS bf16_t* P0 = (const GAS bf16_t*)(ws + WS_BIG); GAS bf16_t* MIX = (GAS bf16_t*)(ws + WS_MIX); const GAS float* BC = (const GAS float*)(ws + WS_H); const GAS float* prm = (const GAS float*)(ws + WS_PRM);
    LAS bf16_t* Qp = (LAS bf16_t*)(lds); LAS bf16_t* Kp = (LAS bf16_t*)(lds + 9216); LAS bf16_t* Kt = (LAS bf16_t*)(lds + 18432); LAS bf16_t* Vt = (LAS bf16_t*)(lds + 27648);
    LAS bf16_t* Pm = (LAS bf16_t*)(lds + 36864); LAS bf16_t* St = (LAS bf16_t*)(lds + 46080); LAS float* dec = (LAS float*)(lds + 55296);
    LAS float* wl = (LAS float*)(lds + 55552); LAS float* blr = (LAS float*)(lds + 59648);
    for (int i = tid; i < 2304; i += NT) ((LAS unsigned*)St)[i] = 0u;
    float gain[16];
#pragma unroll
    for (int vi = 0; vi < 4; ++vi)
#pragma unroll
        for (int j = 0; j < 4; ++j) gain[vi * 4 + j] = prm[PR_GGAIN + h * 64 + 16 * vi + 4 * q + j];
    f32x4 sacc[4];
#pragma unroll
    for (int vi = 0; vi < 4; ++vi) sacc[vi] = (f32x4){0.f, 0.f, 0.f, 0.f};
    const size_t rowbase = (size_t)b * SEQ;
    u32x4 rq, rk, rv; f32x4 rb0, rb1, re0, re1; u32x2 rg[4];
#define GLA_LOAD(ch_) do { const size_t m_ = rowbase + 64 * (ch_) + lane; const GAS bf16_t* p = P0 + m_ * LD0; \
        rq = *(const GAS u32x4*)(p + C_GQ + 64 * h + 8 * w); rk = *(const GAS u32x4*)(p + C_GK + 64 * h + 8 * w); rv = *(const GAS u32x4*)(p + C_GV + 64 * h + 8 * w); \
        const GAS float* pb = BC + m_ * 512 + 64 * h + 8 * w; rb0 = *(const GAS f32x4*)pb; rb1 = *(const GAS f32x4*)(pb + 4); \
        const GAS float* pe = BC + (rowbase + 64 * (ch_) + 63) * 512 + 64 * h + 8 * w; re0 = *(const GAS f32x4*)pe; re1 = *(const GAS f32x4*)(pe + 4); \
        if (w < 4) { const GAS bf16_t* pg = P0 + (rowbase + 64 * (ch_) + 16 * w + c) * LD0 + C_GG + 64 * h + 4 * q; _Pragma("unroll") for (int vi_ = 0; vi_ < 4; ++vi_) rg[vi_] = *(const GAS u32x2*)(pg + 16 * vi_); } } while (0)
    GLA_LOAD(0);
    __syncthreads();
    for (int ch = 0; ch < 128; ++ch) {
        u32x2 gcur[4];
#pragma unroll
        for (int vi = 0; vi < 4; ++vi) gcur[vi] = rg[vi];
        {
            const float bc[8] = {rb0[0], rb0[1], rb0[2], rb0[3], rb1[0], rb1[1], rb1[2], rb1[3]};
            const float ble[8] = {re0[0], re0[1], re0[2], re0[3], re1[0], re1[1], re1[2], re1[3]};
            float qf[8], kf[8]; unpack8(rq, qf); unpack8(rk, kf);
            float qp[8], kp[8], kpp[8], bl[8];
#pragma unroll
            for (int j = 0; j < 8; ++j) { bl[j] = ble[j]; qp[j] = qf[j] * 0.125f * __expf(bc[j]); kp[j] = kf[j] * __expf(-bc[j]); kpp[j] = kf[j] * __expf(bl[j] - bc[j]); }
            u32x4 wq, wk; wq.x = pkbf(qp[0], qp[1]); wq.y = pkbf(qp[2], qp[3]); wq.z = pkbf(qp[4], qp[5]); wq.w = pkbf(qp[6], qp[7]);
            wk.x = pkbf(kp[0], kp[1]); wk.y = pkbf(kp[2], kp[3]); wk.z = pkbf(kp[4], kp[5]); wk.w = pkbf(kp[6], kp[7]);
            *(LAS u32x4*)(Qp + lane * 72 + 8 * w) = wq; *(LAS u32x4*)(Kp + lane * 72 + 8 * w) = wk;
            const unsigned vv[4] = {rv.x, rv.y, rv.z, rv.w};
#pragma unroll
            for (int j = 0; j < 8; ++j) { Kt[(8 * w + j) * 72 + lane] = (bf16_t)(pkbf(kpp[j], 0.f) & 0xffffu); Vt[(8 * w + j) * 72 + lane] = (bf16_t)((j & 1) ? (vv[j >> 1] >> 16) : (vv[j >> 1] & 0xffffu)); }
            if (lane == 63) {
#pragma unroll
                for (int j = 0; j < 8; ++j) dec[8 * w + j] = __expf(bl[j]); }
        }
        if (ch + 1 < 128) GLA_LOAD(ch + 1);
        BAR_LDS();
        f32x4 oacc[4];
        {
            const int ti = w & 3;
            const bf16x8 qf0 = *(const LAS bf16x8*)(Qp + (16 * ti + c) * 72 + 8 * q), qf1 = *(const LAS bf16x8*)(Qp + (16 * ti + c) * 72 + 8 * q + 32);
#pragma unroll
            for (int u = 0; u < 2; ++u) { const int si = 2 * (w >> 2) + u; f32x4 acc = (f32x4){0.f, 0.f, 0.f, 0.f};
                if (si <= ti) { const bf16x8 k0 = *(const LAS bf16x8*)(Kp + (16 * si + c) * 72 + 8 * q), k1 = *(const LAS bf16x8*)(Kp + (16 * si + c) * 72 + 8 * q + 32);
                    acc = MFMA16(k0, qf0, acc); acc = MFMA16(k1, qf1, acc);
#pragma unroll
                    for (int j = 0; j < 4; ++j) if (16 * si + 4 * q + j > 16 * ti + c) acc[j] = 0.f; }
                u32x2 pw; pw.x = pkbf(acc[0], acc[1]); pw.y = pkbf(acc[2], acc[3]);
                *(LAS u32x2*)(Pm + (16 * ti + c) * 72 + 16 * si + 4 * q) = pw; }
            if (w < 4) {
#pragma unroll
                for (int vi = 0; vi < 4; ++vi) { const bf16x8 s0 = *(const LAS bf16x8*)(St + (16 * vi + c) * 72 + 8 * q), s1 = *(const LAS bf16x8*)(St + (16 * vi + c) * 72 + 8 * q + 32);
                    f32x4 acc = (f32x4){0.f, 0.f, 0.f, 0.f}; acc = MFMA16(s0, qf0, acc); acc = MFMA16(s1, qf1, acc); oacc[vi] = acc; } }
        }
        BAR_LDS();
        if (w < 4) {
            const bf16x8 p0 = *(const LAS bf16x8*)(Pm + (16 * w + c) * 72 + 8 * q), p1 = *(const LAS bf16x8*)(Pm + (16 * w + c) * 72 + 8 * q + 32);
            float ssq = 0.f;
#pragma unroll
            for (int vi = 0; vi < 4; ++vi) { const bf16x8 v0 = *(const LAS bf16x8*)(Vt + (16 * vi + c) * 72 + 8 * q), v1 = *(const LAS bf16x8*)(Vt + (16 * vi + c) * 72 + 8 * q + 32);
                oacc[vi] = MFMA16(v0, p0, oacc[vi]); oacc[vi] = MFMA16(v1, p1, oacc[vi]);
#pragma unroll
                for (int j = 0; j < 4; ++j) ssq += oacc[vi][j] * oacc[vi][j]; }
            ssq += __shfl_xor(ssq, 16); ssq += __shfl_xor(ssq, 32);
            const float r = rsqrtf(ssq * (1.0f / 64.0f) + EPS);
            const size_t m = rowbase + 64 * ch + 16 * w + c;
#pragma unroll
            for (int vi = 0; vi < 4; ++vi) { const u32x2 gw = gcur[vi];
                const float g0 = bflo(gw.x), g1 = bfhi(gw.x), g2 = bflo(gw.y), g3 = bfhi(gw.y);
                u32x2 ow; ow.x = pkbf(oacc[vi][0] * r * gain[vi * 4 + 0] * siluf_(g0), oacc[vi][1] * r * gain[vi * 4 + 1] * siluf_(g1));
                ow.y = pkbf(oacc[vi][2] * r * gain[vi * 4 + 2] * siluf_(g2), oacc[vi][3] * r * gain[vi * 4 + 3] * siluf_(g3));
                *(GAS u32x2*)(MIX + m * D + 64 * h + 16 * vi + 4 * q) = ow; }
        } else {
            const int ki = w - 4;
            const f32x4 d4 = *(const LAS f32x4*)(dec + 16 * ki + 4 * q);
            const bf16x8 k0 = *(const LAS bf16x8*)(Kt + (16 * ki + c) * 72 + 8 * q), k1 = *(const LAS bf16x8*)(Kt + (16 * ki + c) * 72 + 8 * q + 32);
#pragma unroll
            for (int vi = 0; vi < 4; ++vi) { const bf16x8 v0 = *(const LAS bf16x8*)(Vt + (16 * vi + c) * 72 + 8 * q), v1 = *(const LAS bf16x8*)(Vt + (16 * vi + c) * 72 + 8 * q + 32);
                f32x4 s = sacc[vi] * d4; s = MFMA16(k0, v0, s); s = MFMA16(k1, v1, s); sacc[vi] = s;
                u32x2 sw; sw.x = pkbf(s[0], s[1]); sw.y = pkbf(s[2], s[3]);
                *(LAS u32x2*)(St + (16 * vi + c) * 72 + 16 * ki + 4 * q) = sw; }
        }
        BAR_LDS();
    }
}

#undef GLA_LOAD
__device__ __forceinline__ void fox_item(unsigned char* ws, LAS unsigned char* lds, int b, int h, int qg) {
    const int tid = otid(), lane = tid & 63, w = __builtin_amdgcn_readfirstlane(tid >> 6), c = lane & 15, q = lane >> 4;
    const GAS bf16_t* P0 = (const GAS bf16_t*)(ws + WS_BIG); GAS bf16_t* MIX = (GAS bf16_t*)(ws + WS_MIX);
    const GAS float* cumb = (const GAS float*)(ws + WS_CUM) + (size_t)(b * 8 + h) * SEQ;
    LAS bf16_t* Kn = (LAS bf16_t*)(lds); LAS bf16_t* Vt = (LAS bf16_t*)(lds + 9216); LAS float* cumk = (LAS float*)(lds + 18432);
    const GAS float* gq = (const GAS float*)(ws + WS_PRM) + PR_QG + h * 64; const GAS float* gk = (const GAS float*)(ws + WS_PRM) + PR_KG + h * 64;
    float mq = fabsf(gq[lane]), mk = fabsf(gk[lane]);
#pragma unroll
    for (int o = 1; o < 64; o <<= 1) { mq = fmaxf(mq, __shfl_xor(mq, o)); mk = fmaxf(mk, __shfl_xor(mk, o)); }
    const float B2 = 16.0f * mq * mk * 1.001f;
    const int srow = tid >> 3, dc = tid & 7;
    float gkr[8], gqr[16];
#pragma unroll
    for (int e2 = 0; e2 < 8; ++e2) { gkr[e2] = gk[8 * dc + e2]; gqr[e2] = gq[8 * q + e2]; gqr[8 + e2] = gq[8 * q + 32 + e2]; }
    const size_t rowbase = (size_t)b * SEQ;
    for (int qi = 4 * qg; qi < 4 * qg + 4; ++qi) {
        const int t0 = 128 * qi, t = t0 + 16 * w + c; const size_t m = rowbase + t;
        int j = 2 * qi + 1;
        const u32x4 r0 = *(const GAS u32x4*)(P0 + m * LD0 + C_FQ + 64 * h + 8 * q), r1 = *(const GAS u32x4*)(P0 + m * LD0 + C_FQ + 64 * h + 8 * q + 32);
        const float cum_t0 = cumb[t0], cum_t = cumb[t];
        const int jl0 = 2 * qi - 1 - lane; const float ce0 = (jl0 >= 0) ? cumb[64 * jl0 + 63] : 0.f;
        u32x4 rk, rv; float rc;
        { const size_t ms = rowbase + 64 * j + srow; rk = *(const GAS u32x4*)(P0 + ms * LD0 + C_FK + 64 * h + 8 * dc); rv = *(const GAS u32x4*)(P0 + ms * LD0 + C_FV + 64 * h + 8 * dc); rc = cumb[64 * j + srow]; }
        int nbelow = 0;
        { const bool skp = (jl0 < 0) || ((B2 + cum_t0 - ce0) < -110.0f); const unsigned long long mk0 = __ballot(skp);
          if (mk0) nbelow = __ffsll((long long)mk0) - 1;
          else { nbelow = 64;
              for (int basej = 2 * qi - 1 - 64; basej >= 0; basej -= 64) { const int jl = basej - lane; const float ce = (jl >= 0) ? cumb[64 * jl + 63] : 0.f;
                  const bool sk2 = (jl < 0) || ((B2 + cum_t0 - ce) < -110.0f); const unsigned long long mk2 = __ballot(sk2);
                  if (mk2) { nbelow += __ffsll((long long)mk2) - 1; break; } nbelow += 64; } } }
        const int jlo = 2 * qi - nbelow;
        bf16x8 qf[2];
        { float f[16]; unpack8(r0, f); unpack8(r1, f + 8); float ss = 0.f;
#pragma unroll
          for (int e2 = 0; e2 < 16; ++e2) ss += f[e2] * f[e2];
          ss += __shfl_xor(ss, 16); ss += __shfl_xor(ss, 32);
          const float r = rsqrtf(ss * (1.0f / 64.0f) + EPS) * 0.125f;
#pragma unroll
          for (int kk = 0; kk < 2; ++kk) { float g[8];
#pragma unroll
              for (int e2 = 0; e2 < 8; ++e2) g[e2] = f[8 * kk + e2] * r * gqr[8 * kk + e2];
              u32x4 pw; pw.x = pkbf(g[0], g[1]); pw.y = pkbf(g[2], g[3]); pw.z = pkbf(g[4], g[5]); pw.w = pkbf(g[6], g[7]); qf[kk] = as_bf16x8(pw); } }
        f32x4 oacc[4];
#pragma unroll
        for (int di = 0; di < 4; ++di) oacc[di] = (f32x4){0.f, 0.f, 0.f, 0.f};
        float mrun = -1e30f, lpart = 0.f;
        for (;;) {
            { float f[8]; unpack8(rk, f); float ss = 0.f;
#pragma unroll
              for (int e2 = 0; e2 < 8; ++e2) ss += f[e2] * f[e2];
              ss += __shfl_xor(ss, 1); ss += __shfl_xor(ss, 2); ss += __shfl_xor(ss, 4);
              const float r = rsqrtf(ss * (1.0f / 64.0f) + EPS);
#pragma unroll
              for (int e2 = 0; e2 < 8; ++e2) f[e2] = f[e2] * r * gkr[e2];
              u32x4 pw; pw.x = pkbf(f[0], f[1]); pw.y = pkbf(f[2], f[3]); pw.z = pkbf(f[4], f[5]); pw.w = pkbf(f[6], f[7]);
              *(LAS u32x4*)(Kn + srow * 72 + 8 * dc) = pw;
              const unsigned vv[4] = {rv.x, rv.y, rv.z, rv.w};
#pragma unroll
              for (int e2 = 0; e2 < 8; ++e2) Vt[(8 * dc + e2) * 72 + srow] = (bf16_t)((e2 & 1) ? (vv[e2 >> 1] >> 16) : (vv[e2 >> 1] & 0xffffu));
              if (dc == 0) cumk[srow] = rc; }
            const int jn = j - 1;
            const bool cont = jn >= jlo;
            if (cont) { const size_t ms = rowbase + 64 * jn + srow; rk = *(const GAS u32x4*)(P0 + ms * LD0 + C_FK + 64 * h + 8 * dc); rv = *(const GAS u32x4*)(P0 + ms * LD0 + C_FV + 64 * h + 8 * dc); rc = cumb[64 * jn + srow]; }
            BAR_LDS();
            if (!(j == 2 * qi + 1 && w < 4)) {
                float sv[4][4]; float mx = -1e30f;
#pragma unroll
                for (int si = 0; si < 4; ++si) { f32x4 acc = (f32x4){0.f, 0.f, 0.f, 0.f};
                    const bf16x8 k0 = *(const LAS bf16x8*)(Kn + (16 * si + c) * 72 + 8 * q), k1 = *(const LAS bf16x8*)(Kn + (16 * si + c) * 72 + 8 * q + 32);
                    acc = MFMA16(k0, qf[0], acc); acc = MFMA16(k1, qf[1], acc);
                    const f32x4 ck = *(const LAS f32x4*)(cumk + 16 * si + 4 * q);
#pragma unroll
                    for (int jj = 0; jj < 4; ++jj) { float lg = acc[jj] + (cum_t - ck[jj]); if (j >= 2 * qi && (64 * j + 16 * si + 4 * q + jj) > t) lg = -1e30f; sv[si][jj] = lg; mx = fmaxf(mx, lg); } }
                mx = fmaxf(mx, __shfl_xor(mx, 16)); mx = fmaxf(mx, __shfl_xor(mx, 32));
                const float mnew = fmaxf(mrun, mx), alpha = __expf(mrun - mnew); mrun = mnew;
                float ps = 0.f;
#pragma unroll
                for (int si = 0; si < 4; ++si)
#pragma unroll
                    for (int jj = 0; jj < 4; ++jj) { sv[si][jj] = __expf(sv[si][jj] - mnew); ps += sv[si][jj]; }
                lpart = lpart * alpha + ps;
#pragma unroll
                for (int di = 0; di < 4; ++di) oacc[di] *= alpha;
#pragma unroll
                for (int kk = 0; kk < 2; ++kk) { u32x4 pw; pw.x = pkbf(sv[2 * kk][0], sv[2 * kk][1]); pw.y = pkbf(sv[2 * kk][2], sv[2 * kk][3]); pw.z = pkbf(sv[2 * kk + 1][0], sv[2 * kk + 1][1]); pw.w = pkbf(sv[2 * kk + 1][2], sv[2 * kk + 1][3]);
                    const bf16x8 pf = as_bf16x8(pw);
#pragma unroll
                    for (int di = 0; di < 4; ++di) { const u32x2 va = *(const LAS u32x2*)(Vt + (16 * di + c) * 72 + 32 * kk + 4 * q), vb = *(const LAS u32x2*)(Vt + (16 * di + c) * 72 + 32 * kk + 16 + 4 * q);
                        u32x4 vw; vw.x = va.x; vw.y = va.y; vw.z = vb.x; vw.w = vb.y; oacc[di] = MFMA16(as_bf16x8(vw), pf, oacc[di]); } }
            }
            BAR_LDS();
            if (!cont) break;
            j = jn;
        }
        float l = lpart; l += __shfl_xor(l, 16); l += __shfl_xor(l, 32);
        const float inv = 1.0f / l;
#pragma unroll
        for (int di = 0; di < 4; ++di) { u32x2 ow; ow.x = pkbf(oacc[di][0] * inv, oacc[di][1] * inv); ow.y = pkbf(oacc[di][2] * inv, oacc[di][3] * inv);
            *(GAS u32x2*)(MIX + m * D + 512 + 64 * h + 16 * di + 4 * q) = ow; }
    }
}

__device__ __forceinline__ void s5_item(unsigned char* ws, LAS unsigned char* lds, int b, int g) {
    const int tid = otid(), lane = tid & 63, w = __builtin_amdgcn_readfirstlane(tid >> 6), c = lane & 15, q = lane >> 4;
    const GAS bf16_t* P1 = (const GAS bf16_t*)(ws + WS_BIG); GAS bf16_t* YS = (GAS bf16_t*)(ws + WS_YS5);
    const GAS float* abar = (const GAS float*)(ws + WS_S5P + S5_ABAR); const GAS bf16_t* Bb = (const GAS bf16_t*)(ws + WS_S5P + S5_BB); const GAS bf16_t* Cm = (const GAS bf16_t*)(ws + WS_S5P + S5_CM);
    LAS float* bu = (LAS float*)(lds + w * 12800); LAS bf16_t* xs = (LAS bf16_t*)(lds + w * 12800 + 8448); LAS float* E = (LAS float*)(lds + 102400);
    const float ar = abar[(g * 64 + lane) * 2], ai = abar[(g * 64 + lane) * 2 + 1];
    float pr = ar, pi = ai;
#pragma unroll
    for (int i = 0; i < 10; ++i) { const float nr = pr * pr - pi * pi, ni = 2.0f * pr * pi; pr = nr; pi = ni; }
    bf16x8 bfr[8], cfr[4];
    const bf16x8 zero8 = (bf16x8){0, 0, 0, 0, 0, 0, 0, 0};
#pragma unroll
    for (int pt = 0; pt < 8; ++pt) bfr[pt] = (q < 2) ? *(const GAS bf16x8*)(Bb + ((size_t)(g * 128 + 16 * pt + c)) * 16 + 8 * q) : zero8;
#pragma unroll
    for (int kk = 0; kk < 4; ++kk) cfr[kk] = *(const GAS bf16x8*)(Cm + (size_t)(g * 16 + c) * 128 + 32 * kk + 8 * q);
    float dsk[4];
#pragma unroll
    for (int j = 0; j < 4; ++j) dsk[j] = ((const GAS float*)(ws + WS_PRM))[PR_S5D + g * 16 + 4 * q + j];
    float xr = 0.f, xi = 0.f;
    for (int pass = 0; pass < 2; ++pass) {
        const size_t mbase = (size_t)b * SEQ + 1024 * w + c;
        bf16x8 uf_n = (q < 2) ? *(const GAS bf16x8*)(P1 + mbase * LD1 + 16 * g + 8 * q) : zero8;
        u32x2 uw_n = *(const GAS u32x2*)(P1 + mbase * LD1 + 16 * g + 4 * q);
        for (int sc = 0; sc < 64; ++sc) {
            const size_t m = mbase + 16 * sc;
            const bf16x8 uf = uf_n; const u32x2 uw = uw_n;
            if (sc + 1 < 64) { const size_t mn = m + 16;
                uf_n = (q < 2) ? *(const GAS bf16x8*)(P1 + mn * LD1 + 16 * g + 8 * q) : zero8; uw_n = *(const GAS u32x2*)(P1 + mn * LD1 + 16 * g + 4 * q); }
#pragma unroll
            for (int pt = 0; pt < 8; ++pt) { f32x4 acc = (f32x4){0.f, 0.f, 0.f, 0.f}; acc = MFMA16(bfr[pt], uf, acc); *(LAS f32x4*)(bu + c * 132 + 16 * pt + 4 * q) = acc; }
            LDS_WAIT();
#pragma unroll
            for (int tt = 0; tt < 16; ++tt) { const float br = bu[tt * 132 + lane], bi = bu[tt * 132 + 64 + lane];
                const float nr = ar * xr - ai * xi + br, ni = ar * xi + ai * xr + bi; xr = nr; xi = ni;
                if (pass) { xs[tt * 136 + lane] = (bf16_t)(pkbf(xr, 0.f) & 0xffffu); xs[tt * 136 + 64 + lane] = (bf16_t)(pkbf(xi, 0.f) & 0xffffu); } }
            if (pass) {
                LDS_WAIT();
                f32x4 acc = (f32x4){0.f, 0.f, 0.f, 0.f};
#pragma unroll
                for (int kk = 0; kk < 4; ++kk) { const bf16x8 xf = *(const LAS bf16x8*)(xs + c * 136 + 32 * kk + 8 * q); acc = MFMA16(cfr[kk], xf, acc); }
                const float y0 = gelu_tanh(acc[0] + dsk[0] * bflo(uw.x)), y1 = gelu_tanh(acc[1] + dsk[1] * bfhi(uw.x)), y2 = gelu_tanh(acc[2] + dsk[2] * bflo(uw.y)), y3 = gelu_tanh(acc[3] + dsk[3] * bfhi(uw.y));
                u32x2 ow; ow.x = pkbf(y0, y1); ow.y = pkbf(y2, y3);
                *(GAS u32x2*)(YS + m * 512 + 16 * g + 4 * q) = ow;
            }
            LDS_WAIT();
        }
        if (pass == 0) {
            E[w * 128 + lane] = xr; E[w * 128 + 64 + lane] = xi;
            __syncthreads();
            float cr = 0.f, ci = 0.f;
            for (int w2 = 0; w2 < w; ++w2) { const float er = E[w2 * 128 + lane], ei = E[w2 * 128 + 64 + lane]; const float nr = pr * cr - pi * ci + er, ni = pr * ci + pi * cr + ei; cr = nr; ci = ni; }
            xr = cr; xi = ci;
        }
    }
}

__device__ __forceinline__ void sgu_item(unsigned char* ws, LAS unsigned char* lds, int b, int n) {
    const int tid = otid(), lane = tid & 63, w = __builtin_amdgcn_readfirstlane(tid >> 6), c = lane & 15, q = lane >> 4;
    const GAS bf16_t* P1 = (const GAS bf16_t*)(ws + WS_BIG); GAS bf16_t* MIX = (GAS bf16_t*)(ws + WS_MIX); const GAS bf16_t* wsb = (const GAS bf16_t*)(ws + WS_WSB);
    LAS bf16_t* Vt = (LAS bf16_t*)lds;
    const size_t m0 = (size_t)b * SEQ + 128 * n;
    {
        const int s = tid >> 2, qq = tid & 3; const GAS bf16_t* vp = P1 + (m0 + s) * LD1 + 1024 + 128 * qq;
        u32x4 rv[16]; float sum = 0.f, ssq = 0.f;
#pragma unroll
        for (int i = 0; i < 16; ++i) { rv[i] = *(const GAS u32x4*)(vp + 8 * i); float f[8]; unpack8(rv[i], f);
#pragma unroll
            for (int e = 0; e < 8; ++e) { sum += f[e]; ssq += f[e] * f[e]; } }
        sum += __shfl_xor(sum, 1); sum += __shfl_xor(sum, 2); ssq += __shfl_xor(ssq, 1); ssq += __shfl_xor(ssq, 2);
        const float mu = sum * (1.0f / 512.0f), var = fmaxf(ssq * (1.0f / 512.0f) - mu * mu, 0.f), rstd = rsqrtf(var + EPS);
        const GAS float* lg = (const GAS float*)(ws + WS_PRM) + PR_LNG + 128 * qq; const GAS float* lb = (const GAS float*)(ws + WS_PRM) + PR_LNB + 128 * qq;
#pragma unroll
        for (int i = 0; i < 16; ++i) { float f[8]; unpack8(rv[i], f);
            const f32x4 g0 = *(const GAS f32x4*)(lg + 8 * i), g1 = *(const GAS f32x4*)(lg + 8 * i + 4), b0 = *(const GAS f32x4*)(lb + 8 * i), b1 = *(const GAS f32x4*)(lb + 8 * i + 4);
#pragma unroll
            for (int e = 0; e < 8; ++e) { const float gg = e < 4 ? g0[e & 3] : g1[e & 3], bb = e < 4 ? b0[e & 3] : b1[e & 3]; const float y = (f[e] - mu) * rstd * gg + bb;
                Vt[(128 * qq + 8 * i + e) * 136 + s] = (bf16_t)(pkbf(y, 0.f) & 0xffffu); } }
    }
    __syncthreads();
    const int nk = (w >> 1) + 1; const int trow = 16 * w + c; const size_t m = m0 + trow;
    for (int g = 0; g < 8; ++g) {
        f32x4 acc[4];
#pragma unroll
        for (int ct = 0; ct < 4; ++ct) acc[ct] = (f32x4){0.f, 0.f, 0.f, 0.f};
        for (int kk = 0; kk < nk; ++kk) { const bf16x8 wf = *(const GAS bf16x8*)(wsb + ((size_t)g * 128 + trow) * 128 + 32 * kk + 8 * q);
#pragma unroll
            for (int ct = 0; ct < 4; ++ct) { const bf16x8 vf = *(const LAS bf16x8*)(Vt + (64 * g + 16 * ct + c) * 136 + 32 * kk + 8 * q); acc[ct] = MFMA16(vf, wf, acc[ct]); } }
        const float bs = ((const GAS float*)(ws + WS_PRM))[PR_BS + g * 128 + trow];
#pragma unroll
        for (int ct = 0; ct < 4; ++ct) { const u32x2 uw = *(const GAS u32x2*)(P1 + m * LD1 + 512 + 64 * g + 16 * ct + 4 * q);
            u32x2 ow; ow.x = pkbf(bflo(uw.x) * (acc[ct][0] + bs), bfhi(uw.x) * (acc[ct][1] + bs)); ow.y = pkbf(bflo(uw.y) * (acc[ct][2] + bs), bfhi(uw.y) * (acc[ct][3] + bs));
            *(GAS u32x2*)(MIX + m * D + 512 + 64 * g + 16 * ct + 4 * q) = ow; }
    }
}

#define XB_TMO      128
#define XB_XCNT(j)  (256  + 64 * (j))
#define XB_XSUB(j)  (1280 + 64 * (j))
#define XB_XGEN(j)  (2304 + 64 * (j))
#define XB_TOP      3328
#define XB_TOPGEN   3392
#define XCD_BAR_WORDS 3456
#define XB_SPIN_CAP (1u << 22)
__device__ __forceinline__ unsigned xb_ld(unsigned* p)              { return __hip_atomic_load(p, __ATOMIC_RELAXED, __HIP_MEMORY_SCOPE_AGENT); }
__device__ __forceinline__ unsigned xb_add(unsigned* p, unsigned v) { return __hip_atomic_fetch_add(p, v, __ATOMIC_RELAXED, __HIP_MEMORY_SCOPE_AGENT); }
__device__ __forceinline__ unsigned xb_xcc_id() { return (unsigned)__builtin_amdgcn_s_getreg((3 << 11) | 20) & 0xFu; }
#define XB_SPIN(cond, bar) do { unsigned _sp = 0; while (cond) { __builtin_amdgcn_s_sleep(1); \
    if ((++_sp & 255u) == 0u) { if (xb_ld(&(bar)[XB_TMO])) break; if (_sp > XB_SPIN_CAP) { atomicAdd(&(bar)[XB_TMO], 1u); break; } } } } while (0)
struct XcdBarrier { unsigned* bar; unsigned x; volatile LAS unsigned* st; };
__device__ __forceinline__ XcdBarrier xcd_barrier_post(unsigned* bar, volatile LAS unsigned* st) {
    XcdBarrier b; b.bar = bar; b.x = xb_xcc_id(); b.st = st;
    if (threadIdx.x == 0) (void)xb_add(&bar[XB_XCNT(b.x)], 1u);
    return b;
}
__device__ __forceinline__ void xcd_barrier_complete(unsigned* bar, unsigned x, unsigned& nloc, unsigned& nx) {
    const unsigned G = gridDim.x * gridDim.y * gridDim.z;
    unsigned sum, cnt, mine, sp = 0u;
    for (;;) {
        sum = 0u; cnt = 0u; mine = 0u;
#pragma unroll
        for (unsigned j = 0; j < 16; ++j) { const unsigned c = xb_ld(&bar[XB_XCNT(j)]); sum += c; cnt += (c > 0u) ? 1u : 0u; mine = (j == x) ? c : mine; }
        if (sum == G) break;
        __builtin_amdgcn_s_sleep(1);
        if ((++sp & 255u) == 0u) { if (xb_ld(&bar[XB_TMO])) break; if (sp > XB_SPIN_CAP) { atomicAdd(&bar[XB_TMO], 1u); break; } }
    }
    nloc = mine > 0u ? mine : 1u; nx = cnt > 0u ? cnt : 1u;
}
__device__ __forceinline__ void xcd_barrier(const XcdBarrier& b) {
    asm volatile("s_waitcnt vmcnt(0) lgkmcnt(0)" ::: "memory");
    __syncthreads();
    if (threadIdx.x == 0) {
        unsigned* bar = b.bar;
        __builtin_amdgcn_s_waitcnt(0);
        unsigned nloc = b.st[0], nx = b.st[1];
        if (nloc == 0u) { xcd_barrier_complete(bar, b.x, nloc, nx); b.st[0] = nloc; b.st[1] = nx; }
        const unsigned old = xb_add(&bar[XB_XSUB(b.x)], 1u);
        const unsigned gen = old / nloc;
        if (old + 1u == (gen + 1u) * nloc) {
            __builtin_amdgcn_fence(__ATOMIC_RELEASE, "agent");
            asm volatile("s_waitcnt vmcnt(0)" ::: "memory");
            const unsigned og = xb_add(&bar[XB_TOP], 1u);
            const unsigned tg = og / nx;
            if (og + 1u == (tg + 1u) * nx) xb_add(&bar[XB_TOPGEN], 1u);
            else XB_SPIN(xb_ld(&bar[XB_TOPGEN]) == tg, bar);
            __builtin_amdgcn_fence(__ATOMIC_ACQUIRE, "agent");
            xb_add(&bar[XB_XGEN(b.x)], 1u);
            asm volatile("s_waitcnt vmcnt(0)" ::: "memory");
        } else {
            XB_SPIN(xb_ld(&bar[XB_XGEN(b.x)]) == gen, bar);
            __builtin_amdgcn_fence(__ATOMIC_ACQUIRE, "agent");
            asm volatile("s_waitcnt vmcnt(0)" ::: "memory");
        }
    }
    __syncthreads();
}
#define GSYNC(k) xcd_barrier(xbar)
__global__ void __launch_bounds__(NT, 2) mega_fwd(Args a) {
    extern __shared__ __attribute__((aligned(16))) unsigned char lds_raw[];
    LAS unsigned char* lds = (LAS unsigned char*)lds_raw;
    cg::grid_group grid = cg::this_grid();
    LAS int* slot = (LAS int*)(lds + LDS_BYTES - 64);
    volatile LAS unsigned* xst = (volatile LAS unsigned*)(lds + LDS_BYTES - 32);
    if (threadIdx.x < 2) xst[threadIdx.x] = 0u;
    __syncthreads();
    XcdBarrier xbar = xcd_barrier_post((unsigned*)(a.ws + WS_CTL) + 1024, xst);
    grid.sync();
#ifndef NO_P0
    p0_prologue(a, lds);
#endif
    GSYNC(0);
    unsigned char* const ws0 = a.ws; const float* const x00 = a.in[0]; float* const xout0 = a.out;
    unsigned kb = 1;
    for (int ph = 1; ph <= 16; ++ph) {
        if (ph == 6 || ph == 9 || ph == 14) continue;
        unsigned char* ws = ws0; const float* x0 = x00; float* xout = xout0;
        asm volatile("" : "+s"(ws), "+s"(x0), "+s"(xout));

        const float* mod = (const float*)(ws + WS_MOD);
        bf16_t* H = (bf16_t*)(ws + WS_H); bf16_t* MIX = (bf16_t*)(ws + WS_MIX); bf16_t* BIG = (bf16_t*)(ws + WS_BIG);
        unsigned* ctl = (unsigned*)(ws + WS_CTL);
        const int layer = ph >= 9;
        const GAS float* modl = (const GAS float*)mod + (size_t)layer * 8 * 6144;
        GAS float* rowss = (GAS float*)(ws + WS_ROWSS); const GAS float* shw = (const GAS float*)(ws + WS_SHW);
#ifndef REPEAT_PH
#define REPEAT_PH -1
#endif
        for (int rep = 0; rep < ((ph == REPEAT_PH) ? 2 : 1); ++rep) {
        pg8::Gemm g{nullptr, nullptr, T, 0, 0, 0}; pg8::Epi E{0, 0, nullptr, 0, nullptr, nullptr, nullptr, nullptr, nullptr, nullptr, nullptr, 0};
        switch (ph) {
        case 1: norm_phase(x0, mod, 0, 1024, H); break;
        case 3: cum_phase(ws, lds); break;
        case 4:
            for (;;) { const int it = q_next(ctl + 256 * rep, slot); if (it >= 64 + 1024 + 152) break;
                if (it < 64) gla_item(ws, lds, it >> 3, it & 7); else if (it < 64 + 1024) { const int f = it - 64; fox_item(ws, lds, f >> 7, (f >> 4) & 7, f & 15); }
                else prep_item(ws, lds, it - 64 - 1024); }
            break;
        case 11:
            for (;;) { const int it = q_next(ctl + 64 + 256 * rep, slot); if (it >= 256 + 512) break;
                if (it < 256) s5_item(ws, lds, it >> 5, it & 31); else { const int f = it - 256; sgu_item(ws, lds, f >> 6, f & 63); } }
            break;
        case 2: g.A = H; g.Bt = (const bf16_t*)(ws + WS_WIN0); g.N = LD0; g.K = D; E.mode = 0; E.O = (GAS bf16_t*)BIG; E.ldc = LD0; break;
        case 5: g.A = MIX; g.Bt = (const bf16_t*)(ws + WS_WOUT0); g.N = D; g.K = D; E.mode = 6; E.O = (GAS bf16_t*)H; E.base32 = (const GAS float*)x0; E.gate = modl + 2048; E.rowss = rowss; break;
        case 7: g.A = H; g.Bt = (const bf16_t*)(ws + WS_WB0); g.bbatch = (size_t)FFD * D * 2; g.N = FFD; g.K = D; E.mode = 5; E.sub = 1; E.O = (GAS bf16_t*)BIG; E.ldc = FFD; E.rowss = rowss; E.shw = shw; E.ldsh = FFD; break;
        case 8: g.A = BIG; g.Bt = (const bf16_t*)(ws + WS_W2_0); g.N = D; g.K = FFD; E.mode = 7; E.O = (GAS bf16_t*)H; E.gate = modl + 5120; E.rowss = rowss; break;
        case 10: g.A = H; g.Bt = (const bf16_t*)(ws + WS_WB1); g.bbatch = (size_t)LD1 * D * 2; g.N = LD1; g.K = D; E.mode = 5; E.sub = 2; E.O = (GAS bf16_t*)BIG; E.ldc = LD1; E.rowss = rowss; E.shw = shw + 8 * 4096; E.ldsh = LD1; break;
        case 12: g.A = (const bf16_t*)(ws + WS_YS5); g.Bt = (const bf16_t*)(ws + WS_WGLU); g.N = 512; g.K = 512; E.mode = 3; E.O = (GAS bf16_t*)MIX; E.Y = (const GAS bf16_t*)(ws + WS_YS5); E.bias = (const GAS float*)(ws + WS_PRM) + PR_BGLU; break;
        case 13: g.A = MIX; g.Bt = (const bf16_t*)(ws + WS_WOUT1); g.N = D; g.K = D; E.mode = 7; E.O = (GAS bf16_t*)H; E.gate = modl + 2048; E.rowss = rowss; break;
        case 15: g.A = H; g.Bt = (const bf16_t*)(ws + WS_WB2); g.bbatch = (size_t)FFD * D * 2; g.N = FFD; g.K = D; E.mode = 5; E.sub = 1; E.O = (GAS bf16_t*)BIG; E.ldc = FFD; E.rowss = rowss; E.shw = shw + 16 * 4096; E.ldsh = FFD; break;
        case 16: g.A = BIG; g.Bt = (const bf16_t*)(ws + WS_W2_1); g.N = D; g.K = FFD; E.mode = 8; E.O = (GAS bf16_t*)H; E.out32 = (GAS float*)xout; E.gate = modl + 5120; break;
        default: break;
        }
        if (g.K != 0) { pg8::StaticOrder S; S.init(T, g.N, gridDim.x, blockIdx.x); pg8::gemm_phase(lds, g, S, E); }
        }
        if (ph != 16) { GSYNC(kb); ++kb; }
    }
}

extern "C" void kernel_launch(void* const* d_in, const int* in_sizes, int n_in, void* d_out, int out_size, void* d_ws, size_t ws_size, hipStream_t stream) {
    static int grid = 0;
    if (grid == 0) {
        if (n_in != 30 || out_size != T * D || ws_size < WS_END) { fprintf(stderr, "kernel_launch: unexpected shapes (n_in %d out %d ws %zu)\n", n_in, out_size, ws_size); grid = -1; return; }
        int dev = 0, cus = 0, per_cu = 0;
        hipGetDevice(&dev); hipDeviceGetAttribute(&cus, hipDeviceAttributeMultiprocessorCount, dev);
        hipFuncSetAttribute((const void*)mega_fwd, hipFuncAttributeMaxDynamicSharedMemorySize, LDS_BYTES);
        hipOccupancyMaxActiveBlocksPerMultiprocessor(&per_cu, (const void*)mega_fwd, NT, LDS_BYTES);
        if (per_cu < 1) { fprintf(stderr, "kernel_launch: occupancy query says %d blocks/CU\n", per_cu); per_cu = 1; }
        grid = cus * 1;
        (void)hipGetLastError();
    }
    if (grid < 0) return;
    (void)hipMemsetAsync((char*)d_ws + WS_CTL, 0, 32768, stream);
    Args a{};
    for (int i = 0; i < 30; ++i) a.in[i] = (const float*)d_in[i];
    a.out = (float*)d_out; a.ws = (unsigned char*)d_ws;
    void* args[] = {&a};
    hipError_t e = hipLaunchCooperativeKernel((const void*)mega_fwd, dim3(grid), dim3(NT), args, LDS_BYTES, stream);
    if (e != hipSuccess) fprintf(stderr, "cooperative launch failed: %s (grid %d)\n", hipGetErrorString(e), grid);
}
```

```cpp
#include <hip/hip_runtime.h>
#include <hip/hip_cooperative_groups.h>
#include <cstdio>
namespace cg = cooperative_groups;

#define LAS __attribute__((address_space(3)))
#define GAS __attribute__((address_space(1)))
typedef unsigned short bf16_t;
typedef short bf16x8 __attribute__((ext_vector_type(8)));
typedef short bf16x4 __attribute__((ext_vector_type(4)));
typedef float f32x4 __attribute__((ext_vector_type(4)));
typedef float f32x2 __attribute__((ext_vector_type(2)));
typedef unsigned u32x4 __attribute__((ext_vector_type(4)));
typedef unsigned u32x2 __attribute__((ext_vector_type(2)));

constexpr int T = 65536, SEQ = 8192, D = 1024, FFD = 4096;
constexpr int LD0 = 3840, LD1 = 1536;
constexpr int C_GQ = 0, C_GK = 512, C_GV = 1024, C_GG = 1536, C_FQ = 2048, C_FK = 2560, C_FV = 3072, C_LR = 3584, C_FF = 3600;
constexpr float EPS = 1e-6f;
constexpr size_t MiB = 1u << 20;
constexpr size_t WS_CTL = 0, WS_WIN0 = 2 * MiB, WS_WOUT0 = 10 * MiB, WS_W1_0 = 12 * MiB, WS_W2_0 = 20 * MiB, WS_WIN1 = 28 * MiB, WS_WOUT1 = 31 * MiB,
                 WS_WGLU = 33 * MiB, WS_W1_1 = 34 * MiB, WS_W2_1 = 42 * MiB, WS_WSB = 50 * MiB, WS_MOD = 51 * MiB, WS_S5P = 52 * MiB, WS_CUM = 53 * MiB,
                 WS_H = 64 * MiB, WS_MIX = 192 * MiB, WS_BIG = 320 * MiB, WS_WB0 = 832 * MiB, WS_WB1 = 896 * MiB, WS_WB2 = 920 * MiB, WS_GLAE = 984 * MiB  , WS_GLAD = 990 * MiB  , WS_END = 992 * MiB;
constexpr size_t WS_PRM = 56 * MiB, WS_ROWSS = 57 * MiB  , WS_SHW = 61 * MiB  , WS_YS5 = WS_BIG + 256 * MiB;
constexpr int PR_WLR = 0, PR_BLR = 8192, PR_GGAIN = 8704, PR_BF = 9216, PR_QG = 9280, PR_KG = 9792, PR_S5D = 10304, PR_BGLU = 10816, PR_LNG = 11328, PR_LNB = 11840, PR_BS = 12352;
constexpr size_t S5_ABAR = 0, S5_BB = 16384, S5_CM = 16384 + 131072;
constexpr int LDS_BYTES = 147456;
constexpr int NT = 512;

struct Args { const float* in[30]; float* out; unsigned char* ws; };

typedef __bf16 bf16x2_t __attribute__((ext_vector_type(2)));
__device__ __forceinline__ unsigned pkbf(float lo, float hi) { f32x2 v = {lo, hi}; bf16x2_t b = __builtin_convertvector(v, bf16x2_t); return __builtin_bit_cast(unsigned, b); }
__device__ __forceinline__ float bflo(unsigned w) { return __uint_as_float(w << 16); }
__device__ __forceinline__ float bfhi(unsigned w) { return __uint_as_float(w & 0xffff0000u); }
__device__ __forceinline__ void unpack8(u32x4 w, float* f) { f[0] = bflo(w.x); f[1] = bfhi(w.x); f[2] = bflo(w.y); f[3] = bfhi(w.y); f[4] = bflo(w.z); f[5] = bfhi(w.z); f[6] = bflo(w.w); f[7] = bfhi(w.w); }
__device__ __forceinline__ float sigmoidf_(float x) { return 1.0f / (1.0f + __expf(-x)); }
__device__ __forceinline__ float siluf_(float x) { return x * sigmoidf_(x); }
__device__ __forceinline__ float gelu_tanh(float x) { const float u = 1.5957691216057308f * (x + 0.044715f * x * x * x); return x * sigmoidf_(u); }
__device__ __forceinline__ float logsig(float x) { return fminf(x, 0.f) - __logf(1.0f + __expf(-fabsf(x))); }
__device__ __forceinline__ int otid() { int t = threadIdx.x; asm volatile("" : "+v"(t)); return t; }
#define LDS_WAIT() asm volatile("s_waitcnt lgkmcnt(0)" ::: "memory")
#define BAR_LDS() do { asm volatile("s_waitcnt lgkmcnt(0)" ::: "memory"); __builtin_amdgcn_s_barrier(); asm volatile("" ::: "memory"); } while (0)
#define MFMA16(a, b, c) __builtin_amdgcn_mfma_f32_16x16x32_bf16((a), (b), (c), 0, 0, 0)
__device__ __forceinline__ bf16x8 as_bf16x8(u32x4 v) { return __builtin_bit_cast(bf16x8, v); }

namespace pg8 {
constexpr int BM = 256, BK = 64, HALF = 128, HTB = HALF * BK * 2, STAGE_BYTES = 8 * HTB, NXCD = 8, WGM = 8;
__device__ __forceinline__ int lds_byte(int r, int c) { const int st = (r >> 4) * 2 + (c >> 5), rr = r & 15, cc = c & 31, ob = rr * 64 + cc * 2; return st * 1024 + (ob ^ (((ob >> 9) & 1) << 5)); }
__device__ __forceinline__ void stage_rc(int b, int& R, int& C) { const int st = b / 1024, sb = b % 1024, swz = sb ^ (((sb >> 9) & 1) << 5); R = (st >> 1) * 16 + swz / 64; C = (st & 1) * 32 + (swz % 64) / 2; }
__device__ __forceinline__ int perm32(int rho) { const int n = rho >> 4, i = rho & 15; return 8 * (i >> 2) + 4 * n + (i & 3); }
struct Unit { int pm, pn; };
struct Gemm { const bf16_t* A; const bf16_t* Bt; int M, N, K; size_t bbatch; };
struct StaticOrder {
    int nM, nN, nwg, G, c;
    __device__ void init(int M, int N, int G_, int c_) { nM = M / BM; nN = N / BM; nwg = nM * nN; G = G_; c = c_; }
    __device__ bool next(int i, Unit& u) const {
        const long L = (long)i * G + c; if (L >= nwg) return false;
        int wgid = (int)L; { const int q = nwg / NXCD, r = nwg % NXCD, xcd = wgid % NXCD, off = wgid / NXCD; wgid = (xcd < r ? xcd * (q + 1) : r * (q + 1) + (xcd - r) * q) + off; }
        const int nig = WGM * nN, gid = wgid / nig, fm = gid * WGM, gsz = (nM - fm) < WGM ? (nM - fm) : WGM;
        u.pm = fm + ((wgid % nig) % gsz); u.pn = (wgid % nig) / gsz; return true;
    }
};

struct Epi {
    int mode, sub; GAS bf16_t* O; int ldc; const GAS float* base32; GAS float* out32; const GAS float* gate; const GAS bf16_t* Y; const GAS float* bias; GAS float* rowss; const GAS float* shw; int ldsh;
    __device__ __forceinline__ void operator()(const f32x4 (&acc)[2][2][4][2], const Unit& u, int wr, int wc, int fr, int fq) const {
        const int row0 = u.pm * BM + wr * 64 + fr, col0 = u.pn * BM + wc * 32 + 8 * fq, bidx = (u.pm * BM) >> 13;
        if (mode >= 6) {
            const GAS float* gp = gate + (size_t)bidx * 6144 + col0;
            f32x4 gg[2][2];
#pragma unroll
            for (int bj = 0; bj < 2; ++bj) { gg[bj][0] = *(const GAS f32x4*)(gp + bj * HALF); gg[bj][1] = *(const GAS f32x4*)(gp + bj * HALF + 4); }
            if (mode == 6) {
#pragma unroll
                for (int ai = 0; ai < 2; ++ai)
#pragma unroll
                    for (int mh = 0; mh < 2; ++mh) { f32x4 bb[2][2][2];
#pragma unroll
                        for (int ml = 0; ml < 2; ++ml) { const size_t off = (size_t)(row0 + ai * HALF + (2 * mh + ml) * 16) * D + col0;
#pragma unroll
                            for (int bj = 0; bj < 2; ++bj) { bb[ml][bj][0] = *(const GAS f32x4*)(base32 + off + bj * HALF); bb[ml][bj][1] = *(const GAS f32x4*)(base32 + off + bj * HALF + 4); } }
#pragma unroll
                        for (int ml = 0; ml < 2; ++ml) { const int m = 2 * mh + ml; const size_t row = (size_t)(row0 + ai * HALF + m * 16), off = row * D + col0; float ss = 0.f;
#pragma unroll
                            for (int bj = 0; bj < 2; ++bj) { const f32x4 x0 = bb[ml][bj][0] + gg[bj][0] * acc[ai][bj][m][0], x1 = bb[ml][bj][1] + gg[bj][1] * acc[ai][bj][m][1];
                                ss += (x0[0] * x0[0] + x0[1] * x0[1]) + (x0[2] * x0[2] + x0[3] * x0[3]) + (x1[0] * x1[0] + x1[1] * x1[1]) + (x1[2] * x1[2] + x1[3] * x1[3]);
                                u32x4 w; w.x = pkbf(x0[0], x0[1]); w.y = pkbf(x0[2], x0[3]); w.z = pkbf(x1[0], x1[1]); w.w = pkbf(x1[2], x1[3]); *(GAS u32x4*)(O + off + bj * HALF) = w; }
                            ss += __shfl_xor(ss, 16); ss += __shfl_xor(ss, 32); if (fq == 0) rowss[row * 16 + u.pn * 4 + wc] = ss; }
                        asm volatile("" ::: "memory"); }
            } else {
#pragma unroll
                for (int ai = 0; ai < 2; ++ai) { u32x4 bw[4][2];
#pragma unroll
                    for (int m = 0; m < 4; ++m) { const size_t off = (size_t)(row0 + ai * HALF + m * 16) * D + col0;
#pragma unroll
                        for (int bj = 0; bj < 2; ++bj) bw[m][bj] = *(const GAS u32x4*)(O + off + bj * HALF); }
#pragma unroll
                    for (int m = 0; m < 4; ++m) { const size_t row = (size_t)(row0 + ai * HALF + m * 16), off = row * D + col0; float ss = 0.f;
#pragma unroll
                        for (int bj = 0; bj < 2; ++bj) { const u32x4 t = bw[m][bj];
                            const f32x4 b0 = (f32x4){bflo(t.x), bfhi(t.x), bflo(t.y), bfhi(t.y)}, b1 = (f32x4){bflo(t.z), bfhi(t.z), bflo(t.w), bfhi(t.w)};
                            const f32x4 x0 = b0 + gg[bj][0] * acc[ai][bj][m][0], x1 = b1 + gg[bj][1] * acc[ai][bj][m][1];
                            if (mode == 8) { *(GAS f32x4*)(out32 + off + bj * HALF) = x0; *(GAS f32x4*)(out32 + off + bj * HALF + 4) = x1; }
                            else { ss += (x0[0] * x0[0] + x0[1] * x0[1]) + (x0[2] * x0[2] + x0[3] * x0[3]) + (x1[0] * x1[0] + x1[1] * x1[1]) + (x1[2] * x1[2] + x1[3] * x1[3]);
                                u32x4 w; w.x = pkbf(x0[0], x0[1]); w.y = pkbf(x0[2], x0[3]); w.z = pkbf(x1[0], x1[1]); w.w = pkbf(x1[2], x1[3]); *(GAS u32x4*)(O + off + bj * HALF) = w; } }
                        if (mode != 8) { ss += __shfl_xor(ss, 16); ss += __shfl_xor(ss, 32); if (fq == 0) rowss[row * 16 + u.pn * 4 + wc] = ss; } }
                    asm volatile("" ::: "memory"); }
            }
        } else if (mode == 3) {
#pragma unroll
            for (int bj = 0; bj < 2; ++bj) {
                const f32x4 b0 = *(const GAS f32x4*)(bias + col0 + bj * HALF), b1 = *(const GAS f32x4*)(bias + col0 + bj * HALF + 4);
#pragma unroll
                for (int ai = 0; ai < 2; ++ai)
#pragma unroll
                    for (int m = 0; m < 4; ++m) { const size_t row = (size_t)(row0 + ai * HALF + m * 16);
                        const u32x4 yw = *(const GAS u32x4*)(Y + row * 512 + col0 + bj * HALF); float y[8]; unpack8(yw, y);
                        const f32x4 v0 = acc[ai][bj][m][0] + b0, v1 = acc[ai][bj][m][1] + b1; float o[8];
#pragma unroll
                        for (int j = 0; j < 4; ++j) { o[j] = y[j] * sigmoidf_(v0[j]); o[4 + j] = y[4 + j] * sigmoidf_(v1[j]); }
                        u32x4 w; w.x = pkbf(o[0], o[1]); w.y = pkbf(o[2], o[3]); w.z = pkbf(o[4], o[5]); w.w = pkbf(o[6], o[7]);
                        *(GAS u32x4*)(O + row * D + col0 + bj * HALF) = w; asm volatile("" ::: "memory"); } }
        } else {
            const bool act2 = (sub == 2) && (u.pn >= 2);
            float rr[8]; f32x4 sb[2][2];
#pragma unroll
            for (int j = 0; j < 8; ++j) rr[j] = 1.0f;
#pragma unroll
            for (int bj = 0; bj < 2; ++bj) { sb[bj][0] = (f32x4){0.f, 0.f, 0.f, 0.f}; sb[bj][1] = sb[bj][0]; }
            if (mode == 5) {
                const int lane = fq * 16 + fr; float slot[2];
                f32x4 pp[2][4];
#pragma unroll
                for (int h = 0; h < 2; ++h) { const int li = lane + 64 * h, am = li >> 4; const size_t row = (size_t)(u.pm * BM + (am >> 2) * HALF + wr * 64 + (am & 3) * 16 + (li & 15));
                    const GAS f32x4* rp = (const GAS f32x4*)(rowss + row * 16);
#pragma unroll
                    for (int k = 0; k < 4; ++k) pp[h][k] = rp[k]; }
                const GAS float* sp = shw + (size_t)bidx * ldsh + col0;
#pragma unroll
                for (int bj = 0; bj < 2; ++bj) { sb[bj][0] = *(const GAS f32x4*)(sp + bj * HALF); sb[bj][1] = *(const GAS f32x4*)(sp + bj * HALF + 4); }
#pragma unroll
                for (int h = 0; h < 2; ++h) { const f32x4 s = (pp[h][0] + pp[h][1]) + (pp[h][2] + pp[h][3]); slot[h] = rsqrtf(((s[0] + s[1]) + (s[2] + s[3])) * (1.0f / D) + EPS); }
#pragma unroll
                for (int j = 0; j < 8; ++j) rr[j] = __shfl(slot[j >> 2], (j & 3) * 16 + fr);
            }
#pragma unroll
            for (int ai = 0; ai < 2; ++ai)
#pragma unroll
                for (int m = 0; m < 4; ++m) { const size_t row = (size_t)(row0 + ai * HALF + m * 16); GAS bf16_t* rowp = O + row * ldc + col0; const float r = rr[ai * 4 + m];
#pragma unroll
                    for (int bj = 0; bj < 2; ++bj) { f32x4 v0 = acc[ai][bj][m][0], v1 = acc[ai][bj][m][1];
                        if (mode == 5) { v0 = v0 * r + sb[bj][0]; v1 = v1 * r + sb[bj][1]; }
                        if (sub == 1) {
#pragma unroll
                            for (int j = 0; j < 4; ++j) { const float a0 = fmaxf(v0[j], 0.f), a1 = fmaxf(v1[j], 0.f); v0[j] = a0 * a0; v1[j] = a1 * a1; } }
                        if (act2) {
#pragma unroll
                            for (int j = 0; j < 4; ++j) { v0[j] = gelu_tanh(v0[j]); v1[j] = gelu_tanh(v1[j]); } }
                        u32x4 w; w.x = pkbf(v0[0], v0[1]); w.y = pkbf(v0[2], v0[3]); w.z = pkbf(v1[0], v1[1]); w.w = pkbf(v1[2], v1[3]);
                        *(GAS u32x4*)(rowp + bj * HALF) = w; }
                    asm volatile("" ::: "memory"); }
        }
    }
};

__device__ __forceinline__ void gemm_phase(LAS unsigned char* lds, const Gemm g, const StaticOrder& S, const Epi& E) {

    const int tid = otid(), wid = __builtin_amdgcn_readfirstlane(tid >> 6), lane = tid & 63, wr = wid >> 2, wc = wid & 3, fr = lane & 15, fq = lane >> 4;
    const int K = g.K, nt = K / BK;
    unsigned voffA[2], voffB[2];
#pragma unroll
    for (int i = 0; i < 2; ++i) { int R, C; stage_rc(tid * 16 + i * 8192, R, C); const int Rb = (R & ~31) + perm32(R & 31);
        voffA[i] = (unsigned)(R * K + C) * 2u; voffB[i] = (unsigned)(Rb * K + C) * 2u; }
    const size_t kstep = (size_t)(BK * 2);
    const size_t hstep = (size_t)HALF * K * 2;
    const size_t tstep = 2 * hstep;
    const unsigned ldsw = (unsigned)wid * 1024u;
    const int aoff = lds_byte(wr * 64 + fr, fq * 8), boff = lds_byte(wc * 32 + fr, fq * 8);
    const unsigned ldsbase = (unsigned)(unsigned long)lds;
#define PG8_SA(b, h) (((b) * 2 + (h)) * HTB)
#define PG8_SB(b, h) ((4 + (b) * 2 + (h)) * HTB)
#define PG8_STAGE(bufoff, gbase, voff) do { _Pragma("unroll") for (int _i = 0; _i < 2; ++_i) \
        __builtin_amdgcn_global_load_lds((const unsigned*)((const char*)(gbase) + (voff)[_i]), (LAS unsigned*)(lds + (bufoff) + ldsw + _i * 8192), 16, 0, 0); } while (0)
#define PG8_LDA(dst, b, h) do { _Pragma("unroll") for (int m = 0; m < 4; ++m) _Pragma("unroll") for (int k = 0; k < 2; ++k) dst[m][k] = *(const LAS bf16x8*)(lds + PG8_SA(b, h) + aoff + m * 2048 + k * 1024); } while (0)
#define PG8_LDB(dst, b, h) do { _Pragma("unroll") for (int n = 0; n < 2; ++n) _Pragma("unroll") for (int k = 0; k < 2; ++k) dst[n][k] = *(const LAS bf16x8*)(lds + PG8_SB(b, h) + boff + n * 2048 + k * 1024); } while (0)
#define PG8_MMA(ai, bj, At, Bt) do { __builtin_amdgcn_s_setprio(1); _Pragma("unroll") for (int m = 0; m < 4; ++m) _Pragma("unroll") for (int n = 0; n < 2; ++n) _Pragma("unroll") for (int k = 0; k < 2; ++k) \
        acc[ai][bj][m][n] = __builtin_amdgcn_mfma_f32_16x16x32_bf16(Bt[n][k], At[m][k], acc[ai][bj][m][n], 0, 0, 0); __builtin_amdgcn_s_setprio(0); } while (0)
#define PG8_WAIT_V(n) asm volatile("s_waitcnt vmcnt(" #n ")" ::: "memory")
#define PG8_WAIT_L(n) asm volatile("s_waitcnt lgkmcnt(" #n ")" ::: "memory")
#define PG8_BAR __builtin_amdgcn_s_barrier()
#define PG8_SCHED __builtin_amdgcn_sched_barrier(0)
    Unit cur, nxt; int ui = 0;
    if (!S.next(0, cur)) return;
    f32x4 acc[2][2][4][2];
#pragma unroll
    for (int a = 0; a < 2; ++a)
#pragma unroll
        for (int b = 0; b < 2; ++b)
#pragma unroll
            for (int m = 0; m < 4; ++m)
#pragma unroll
                for (int n = 0; n < 2; ++n) acc[a][b][m][n] = (f32x4){0.f, 0.f, 0.f, 0.f};
    bf16x8 At[4][2], B0[2][2], B1[2][2];
    const char* cA = (const char*)g.A + (size_t)cur.pm * tstep; const char* cB = (const char*)g.Bt + (size_t)cur.pn * tstep + (size_t)(cur.pm >> 5) * g.bbatch;
    PG8_STAGE(PG8_SB(0, 0), cB, voffB); PG8_STAGE(PG8_SA(0, 0), cA, voffA); PG8_STAGE(PG8_SB(0, 1), cB + hstep, voffB); PG8_STAGE(PG8_SA(0, 1), cA + hstep, voffA);
    if (wr == 1) PG8_BAR;
    PG8_WAIT_V(4); PG8_BAR;
    PG8_STAGE(PG8_SB(1, 0), cB + kstep, voffB); PG8_STAGE(PG8_SA(1, 0), cA + kstep, voffA); PG8_STAGE(PG8_SB(1, 1), cB + hstep + kstep, voffB);
    PG8_WAIT_V(6); PG8_BAR;
    for (;;) {
        const bool has_next = S.next(ui + 1, nxt);
        const char* nA = has_next ? (const char*)g.A + (size_t)nxt.pm * tstep : cA; const char* nB = has_next ? (const char*)g.Bt + (size_t)nxt.pn * tstep + (size_t)(nxt.pm >> 5) * g.bbatch : cB;
        for (int t = 0; t < nt; t += 2) {
            const bool last = (t == nt - 2);
            const char* a1 = cA + (size_t)(t + 1) * kstep;
            const char* a2 = last ? nA : cA + (size_t)(t + 2) * kstep; const char* b2 = last ? nB : cB + (size_t)(t + 2) * kstep;
            const char* a3 = a2 + kstep; const char* b3 = b2 + kstep;
            PG8_LDB(B0, 0, 0); PG8_SCHED; PG8_LDA(At, 0, 0); PG8_STAGE(PG8_SA(1, 1), a1 + hstep, voffA);
            PG8_WAIT_L(8); PG8_BAR; PG8_WAIT_L(0); PG8_MMA(0, 0, At, B0); PG8_BAR; PG8_SCHED;
            PG8_LDB(B1, 0, 1); PG8_STAGE(PG8_SB(0, 0), b2, voffB);
            PG8_BAR; PG8_WAIT_L(0); PG8_MMA(0, 1, At, B1); PG8_BAR;
            PG8_LDA(At, 0, 1); PG8_STAGE(PG8_SA(0, 0), a2, voffA);
            PG8_BAR; PG8_WAIT_L(0); PG8_MMA(1, 0, At, B0); PG8_BAR; PG8_SCHED;
            PG8_STAGE(PG8_SB(0, 1), b2 + hstep, voffB);
            PG8_WAIT_V(6); PG8_BAR; PG8_MMA(1, 1, At, B1); PG8_BAR;
            PG8_LDB(B0, 1, 0); PG8_SCHED; PG8_LDA(At, 1, 0); PG8_STAGE(PG8_SA(0, 1), a2 + hstep, voffA);
            PG8_WAIT_L(8); PG8_BAR; PG8_WAIT_L(0); PG8_MMA(0, 0, At, B0); PG8_BAR; PG8_SCHED;
            PG8_LDB(B1, 1, 1); PG8_STAGE(PG8_SB(1, 0), b3, voffB);
            PG8_BAR; PG8_WAIT_L(0); PG8_MMA(0, 1, At, B1); PG8_BAR;
            PG8_LDA(At, 1, 1); PG8_STAGE(PG8_SA(1, 0), a3, voffA);
            PG8_BAR; PG8_WAIT_L(0); PG8_MMA(1, 0, At, B0); PG8_BAR; PG8_SCHED;
            PG8_STAGE(PG8_SB(1, 1), b3 + hstep, voffB);
            PG8_WAIT_V(6); PG8_BAR; PG8_MMA(1, 1, At, B1); PG8_BAR;
        }
        E(acc, cur, wr, wc, fr, fq);
        __builtin_amdgcn_s_waitcnt(0x0F70);
        if (!has_next) break;
#pragma unroll
        for (int a = 0; a < 2; ++a)
#pragma unroll
            for (int b = 0; b < 2; ++b)
#pragma unroll
                for (int m = 0; m < 4; ++m)
#pragma unroll
                    for (int n = 0; n < 2; ++n) acc[a][b][m][n] = (f32x4){0.f, 0.f, 0.f, 0.f};
        cur = nxt; cA = nA; cB = nB; ++ui;
    }
    PG8_WAIT_V(0);
    if (wr == 0) PG8_BAR;
    PG8_BAR;
#undef PG8_SA
#undef PG8_SB
#undef PG8_STAGE
#undef PG8_LDA
#undef PG8_LDB
#undef PG8_MMA
#undef PG8_WAIT_V
#undef PG8_WAIT_L
#undef PG8_BAR
#undef PG8_SCHED
}

}

__device__ __forceinline__ void tr_item(const float* W, int ldw, int ncol0, int K, int nblk, bf16_t* WT, int row_off, LAS float* scr, int item, int lane) {
    const int kb = item / nblk, nb = item % nblk, k0 = 64 * kb, n0 = 32 * nb;
    float tv[32];
#pragma unroll
    for (int i = 0; i < 32; ++i) tv[i] = W[(size_t)(k0 + 2 * i + (lane >> 5)) * ldw + ncol0 + n0 + (lane & 31)];
#pragma unroll
    for (int i = 0; i < 32; ++i) scr[(2 * i + (lane >> 5)) * 33 + (lane & 31)] = tv[i];
    LDS_WAIT();
    const int c = lane & 7;
#pragma unroll
    for (int j = 0; j < 4; ++j) { const int n = (lane >> 3) + 8 * j; const LAS float* s = scr + (8 * c) * 33 + n;
        u32x4 o; o.x = pkbf(s[0 * 33], s[1 * 33]); o.y = pkbf(s[2 * 33], s[3 * 33]); o.z = pkbf(s[4 * 33], s[5 * 33]); o.w = pkbf(s[6 * 33], s[7 * 33]);
        *(u32x4*)(WT + (size_t)(row_off + n0 + n) * K + k0 + 8 * c) = o; }
    LDS_WAIT();
}

__device__ __forceinline__ void p0_prologue(const Args& a, LAS unsigned char* lds) {
    const int tid = otid(), lane = tid & 63, wave = __builtin_amdgcn_readfirstlane(tid >> 6);
    unsigned char* ws = a.ws;
    if (blockIdx.x < 192) {
        LAS float* cact = (LAS float*)lds;
        LAS float* red = (LAS float*)(lds + 32768);
        const float* c = a.in[1];
        for (int i = tid; i < 8192; i += NT) cact[i] = siluf_(c[i]);
        __syncthreads();
        const int item = blockIdx.x, layer = item / 96, e = 64 * (item % 96) + lane;
        const float* wp = a.in[2] + (size_t)layer * D * 6144 + e;
        float acc[8];
#pragma unroll
        for (int b = 0; b < 8; ++b) acc[b] = 0.f;
        for (int k0 = wave * 128; k0 < wave * 128 + 128; k0 += 32) {
            float wv[32];
#pragma unroll
            for (int i = 0; i < 32; ++i) wv[i] = wp[(size_t)(k0 + i) * 6144];
#pragma unroll
            for (int i = 0; i < 32; ++i)
#pragma unroll
                for (int b = 0; b < 8; ++b) acc[b] += cact[b * 1024 + k0 + i] * wv[i];
        }
#pragma unroll
        for (int b = 0; b < 8; ++b) red[(wave * 8 + b) * 64 + lane] = acc[b];
        __syncthreads();
        { const int b = tid >> 6; float s = 0.f;
#pragma unroll
          for (int w = 0; w < 8; ++w) s += red[(w * 8 + b) * 64 + lane];
          ((float*)(ws + WS_MOD))[(size_t)(layer * 8 + b) * 6144 + e] = s + a.in[3][layer * 6144 + e]; }
        __syncthreads();
    }
    {
        LAS float* scr = (LAS float*)(lds + wave * 16384);
        const int gw = blockIdx.x * 8 + wave, NGW = gridDim.x * 8;
        constexpr int I0 = 16 * 64, I1 = 16 * 48, I2 = 16 * 32, I3 = 16 * 128, I4 = 64 * 32, I5 = 16 * 48, I6 = 16 * 32, I7 = 8 * 16, I8 = I3, I9 = I4;
        constexpr int NIT = I0 + I1 + I2 + I3 + I4 + I5 + I6 + I7 + I8 + I9;
        for (int it = gw; it < NIT; it += NGW) {
            int r = it;
            if (r < I0) { tr_item(a.in[4], 3608, 0, 1024, 64, (bf16_t*)(ws + WS_WIN0), 0, scr, r, lane); continue; } r -= I0;
            if (r < I1) { tr_item(a.in[4], 3608, 2064, 1024, 48, (bf16_t*)(ws + WS_WIN0), 2048, scr, r, lane); continue; } r -= I1;
            if (r < I2) { tr_item(a.in[5], 1024, 0, 1024, 32, (bf16_t*)(ws + WS_WOUT0), 0, scr, r, lane); continue; } r -= I2;
            if (r < I3) { tr_item(a.in[28], 4096, 0, 1024, 128, (bf16_t*)(ws + WS_W1_0), 0, scr, r, lane); continue; } r -= I3;
            if (r < I4) { tr_item(a.in[29], 1024, 0, 4096, 32, (bf16_t*)(ws + WS_W2_0), 0, scr, r, lane); continue; } r -= I4;
            if (r < I5) { tr_item(a.in[12], 1536, 0, 1024, 48, (bf16_t*)(ws + WS_WIN1), 0, scr, r, lane); continue; } r -= I5;
            if (r < I6) { tr_item(a.in[13], 1024, 0, 1024, 32, (bf16_t*)(ws + WS_WOUT1), 0, scr, r, lane); continue; } r -= I6;
            if (r < I7) { tr_item(a.in[22], 512, 0, 512, 16, (bf16_t*)(ws + WS_WGLU), 0, scr, r, lane); continue; } r -= I7;
            if (r < I8) { tr_item(a.in[28] + (size_t)D * FFD, 4096, 0, 1024, 128, (bf16_t*)(ws + WS_W1_1), 0, scr, r, lane); continue; } r -= I8;
            tr_item(a.in[29] + (size_t)D * FFD, 1024, 0, 4096, 32, (bf16_t*)(ws + WS_W2_1), 0, scr, r, lane);
        }
    }
    {
        if (blockIdx.x == 0 && tid == 0) { unsigned* ctl = (unsigned*)(ws + WS_CTL); __hip_atomic_store(ctl, 0u, __ATOMIC_RELAXED, __HIP_MEMORY_SCOPE_AGENT); __hip_atomic_store(ctl + 64, 0u, __ATOMIC_RELAXED, __HIP_MEMORY_SCOPE_AGENT); }
        const int gt = blockIdx.x * NT + tid, NGT = gridDim.x * NT;
        bf16_t* win0 = (bf16_t*)(ws + WS_WIN0);
        for (int i = gt; i < 256 * 1024; i += NGT) { const int n = i >> 10, k = i & 1023; float v = 0.f;
            if (n < 16) v = a.in[4][(size_t)k * 3608 + 2048 + n]; else if (n < 24) v = a.in[4][(size_t)k * 3608 + 3600 + (n - 16)];
            win0[(size_t)(3584 + n) * 1024 + k] = (bf16_t)(pkbf(v, 0.f) & 0xffffu); }
        bf16_t* wsb = (bf16_t*)(ws + WS_WSB);
        for (int i = gt; i < 8 * 128 * 128; i += NGT) { const int t = (i >> 7) & 127, s = i & 127; const float v = (s <= t) ? a.in[26][i] : 0.f; wsb[i] = (bf16_t)(pkbf(v, 0.f) & 0xffffu); }
        { float* prm = (float*)(ws + WS_PRM);
          for (int i = gt; i < 8192; i += NGT) prm[PR_WLR + i] = a.in[6][i];
          for (int i = gt; i < 1024; i += NGT) prm[PR_BS + i] = a.in[27][i];
          for (int i = gt; i < 512; i += NGT) { prm[PR_BLR + i] = a.in[7][i]; prm[PR_GGAIN + i] = a.in[8][i]; prm[PR_QG + i] = a.in[10][i]; prm[PR_KG + i] = a.in[11][i]; prm[PR_S5D + i] = a.in[21][i];
              prm[PR_BGLU + i] = a.in[23][i]; prm[PR_LNG + i] = a.in[24][i]; prm[PR_LNB + i] = a.in[25][i]; }
          for (int i = gt; i < 8; i += NGT) prm[PR_BF + i] = a.in[9][i]; }
        float* abar = (float*)(ws + WS_S5P + S5_ABAR); bf16_t* Bb = (bf16_t*)(ws + WS_S5P + S5_BB); bf16_t* Cm = (bf16_t*)(ws + WS_S5P + S5_CM);
        for (int i = gt; i < 32 * 64; i += NGT) { const int g = i >> 6, p = i & 63;
            const float lr = a.in[14][i], li = a.in[15][i], dt = expf(a.in[16][g]);
            const float mag = expf(lr * dt), ang = li * dt, ar = mag * cosf(ang), ai = mag * sinf(ang), den = lr * lr + li * li;
            const float cr = ((ar - 1.0f) * lr + ai * li) / den, ci = (ai * lr - (ar - 1.0f) * li) / den;
            abar[2 * i] = ar; abar[2 * i + 1] = ai;
            for (int k = 0; k < 16; ++k) { const float br = a.in[17][(size_t)i * 16 + k], bi = a.in[18][(size_t)i * 16 + k];
                Bb[((size_t)g * 128 + 2 * p) * 16 + k] = (bf16_t)(pkbf(cr * br - ci * bi, 0.f) & 0xffffu);
                Bb[((size_t)g * 128 + 2 * p + 1) * 16 + k] = (bf16_t)(pkbf(cr * bi + ci * br, 0.f) & 0xffffu); } }
        for (int i = gt; i < 32 * 16 * 64; i += NGT) { const int gi = i >> 6, p = i & 63;
            Cm[(size_t)gi * 128 + 2 * p] = (bf16_t)(pkbf(a.in[19][i], 0.f) & 0xffffu); Cm[(size_t)gi * 128 + 2 * p + 1] = (bf16_t)(pkbf(-a.in[20][i], 0.f) & 0xffffu); }
    }
}

__device__ __forceinline__ void norm_phase(const float* x, const float* mod, int off_sh, int off_sc, bf16_t* H) {
    const int tid_ = otid(); const int lane = tid_ & 63, gw = blockIdx.x * 8 + (tid_ >> 6), NGW = gridDim.x * 8;
    for (int m = gw; m < T; m += NGW) {
        const GAS f32x4* xr = (const GAS f32x4*)(x + (size_t)m * D) + lane;
        const GAS float* mp = (const GAS float*)mod + (size_t)(m >> 13) * 6144;
        f32x4 v[4]; float s = 0.f;
#pragma unroll
        for (int j = 0; j < 4; ++j) { v[j] = xr[64 * j]; s += (v[j].x * v[j].x + v[j].y * v[j].y) + (v[j].z * v[j].z + v[j].w * v[j].w); }
#pragma unroll
        for (int o = 1; o < 64; o <<= 1) s += __shfl_xor(s, o);
        const float r = rsqrtf(s * (1.0f / D) + EPS);
        GAS u32x2* o8 = (GAS u32x2*)(H + (size_t)m * D) + lane;
#pragma unroll
        for (int j = 0; j < 4; ++j) { const f32x4 sc = *((const GAS f32x4*)(mp + off_sc) + lane + 64 * j), sh = *((const GAS f32x4*)(mp + off_sh) + lane + 64 * j);
            const f32x4 y = v[j] * r * (sc + 1.0f) + sh; u32x2 w; w.x = pkbf(y.x, y.y); w.y = pkbf(y.z, y.w); o8[64 * j] = w; }
    }
}

__device__ __forceinline__ void prep_item(unsigned char* ws, LAS unsigned char* lds, int item) {
    const int tid = otid(), lane = tid & 63, wave = tid >> 6;
    const GAS float* mod = (const GAS float*)(ws + WS_MOD);
    LAS float* sc = (LAS float*)lds; LAS float* sh = (LAS float*)(lds + 32768);
    const int site = item < 64 ? 0 : (item < 88 ? 1 : 2), rb = item < 64 ? item : (item < 88 ? item - 64 : item - 88);
    const int N = (site == 1) ? LD1 : FFD, layer = site ? 1 : 0, osc = (site == 1) ? 1024 : 4096, osh = (site == 1) ? 0 : 3072;
    const GAS bf16_t* Wt = (const GAS bf16_t*)(ws + (site == 0 ? WS_W1_0 : site == 1 ? WS_WIN1 : WS_W1_1));
    GAS bf16_t* WB = (GAS bf16_t*)(ws + (site == 0 ? WS_WB0 : site == 1 ? WS_WB1 : WS_WB2));
    GAS float* shw = (GAS float*)(ws + WS_SHW) + (size_t)site * 8 * 4096;
    for (int i = tid; i < 8192; i += NT) { const int b = i >> 10, k = i & 1023; const GAS float* mp = mod + (size_t)(layer * 8 + b) * 6144; sc[i] = 1.0f + mp[osc + k]; sh[i] = mp[osh + k]; }
    __syncthreads();
    for (int n = 64 * rb + wave; n < 64 * rb + 64; n += 8) {
        const u32x4 w0 = *(const GAS u32x4*)(Wt + (size_t)n * D + 16 * lane), w1 = *(const GAS u32x4*)(Wt + (size_t)n * D + 16 * lane + 8);
        float wv[16]; unpack8(w0, wv); unpack8(w1, wv + 8);
#pragma unroll 1
        for (int b = 0; b < 8; ++b) { float o[16]; float dot = 0.f;
#pragma unroll
            for (int i4 = 0; i4 < 4; ++i4) { const f32x4 s4 = *(const LAS f32x4*)(sc + b * 1024 + 16 * lane + 4 * i4), h4 = *(const LAS f32x4*)(sh + b * 1024 + 16 * lane + 4 * i4);
#pragma unroll
                for (int j = 0; j < 4; ++j) { o[4 * i4 + j] = wv[4 * i4 + j] * s4[j]; dot += wv[4 * i4 + j] * h4[j]; } }
            u32x4 p0, p1; p0.x = pkbf(o[0], o[1]); p0.y = pkbf(o[2], o[3]); p0.z = pkbf(o[4], o[5]); p0.w = pkbf(o[6], o[7]); p1.x = pkbf(o[8], o[9]); p1.y = pkbf(o[10], o[11]); p1.z = pkbf(o[12], o[13]); p1.w = pkbf(o[14], o[15]);
            GAS bf16_t* dst = WB + ((size_t)b * N + n) * D + 16 * lane; *(GAS u32x4*)dst = p0; *(GAS u32x4*)(dst + 8) = p1;
#pragma unroll
            for (int o2 = 1; o2 < 64; o2 <<= 1) dot += __shfl_xor(dot, o2);
            if (lane == 0) shw[(size_t)b * N + n] = dot; }
    }
}

__device__ __forceinline__ void cum_phase(unsigned char* ws, LAS unsigned char* lds) {
    if (blockIdx.x >= 8) {
        const int tid = otid(), lane = tid & 63, w = __builtin_amdgcn_readfirstlane(tid >> 6);
        const GAS bf16_t* P0 = (const GAS bf16_t*)(ws + WS_BIG); GAS float* BC = (GAS float*)(ws + WS_H); const GAS float* prm = (const GAS float*)(ws + WS_PRM);
        LAS float* wl = (LAS float*)lds; LAS float* blr = (LAS float*)(lds + 32768);
        for (int i = tid; i < 8192; i += NT) wl[i] = prm[PR_WLR + i];
        blr[tid] = prm[PR_BLR + tid];
        __syncthreads();
        for (int item = blockIdx.x - 8; item < T / 64; item += gridDim.x - 8) {
            const size_t m = (size_t)item * 64 + lane;
            const u32x4 rl0 = *(const GAS u32x4*)(P0 + m * LD0 + C_LR), rl1 = *(const GAS u32x4*)(P0 + m * LD0 + C_LR + 8);
            float glr[16]; unpack8(rl0, glr); unpack8(rl1, glr + 8);
#pragma unroll 1
            for (int h = 0; h < 8; ++h) {
                f32x4 z0 = *(const LAS f32x4*)(blr + 64 * h + 8 * w), z1 = *(const LAS f32x4*)(blr + 64 * h + 8 * w + 4);
#pragma unroll
                for (int r = 0; r < 16; ++r) { const f32x4 w0 = *(const LAS f32x4*)(wl + r * 512 + 64 * h + 8 * w), w1 = *(const LAS f32x4*)(wl + r * 512 + 64 * h + 8 * w + 4); z0 += w0 * glr[r]; z1 += w1 * glr[r]; }
                float bc[8];
#pragma unroll
                for (int j = 0; j < 4; ++j) { bc[j] = logsig(z0[j]) * 0.0625f; bc[4 + j] = logsig(z1[j]) * 0.0625f; }
#pragma unroll
                for (int d = 1; d < 64; d <<= 1) {
#pragma unroll
                    for (int j = 0; j < 8; ++j) { const float o = __shfl_up(bc[j], d); if (lane >= d) bc[j] += o; } }
                GAS float* dst = BC + m * 512 + 64 * h + 8 * w;
                *(GAS f32x4*)dst = (f32x4){bc[0], bc[1], bc[2], bc[3]}; *(GAS f32x4*)(dst + 4) = (f32x4){bc[4], bc[5], bc[6], bc[7]};
            }
        }
        return;
    }
    const int b = blockIdx.x, tid = otid(), lane = tid & 63, wave = tid >> 6;
    const bf16_t* P0 = (const bf16_t*)(ws + WS_BIG); float* cum = (float*)(ws + WS_CUM);
    LAS float* wt = (LAS float*)lds;
    float bf[8];
#pragma unroll
    for (int h = 0; h < 8; ++h) bf[h] = ((const float*)(ws + WS_PRM))[PR_BF + h];
    float run[8];
#pragma unroll
    for (int h = 0; h < 8; ++h) run[h] = 0.f;
    const size_t m0 = (size_t)b * SEQ + 16 * tid;
    for (int i = 0; i < 16; ++i) { const u32x4 w = *(const u32x4*)(P0 + (m0 + i) * LD0 + C_FF); float f[8]; unpack8(w, f);
#pragma unroll
        for (int h = 0; h < 8; ++h) run[h] += logsig(f[h] + bf[h]); }
    float incl[8];
#pragma unroll
    for (int h = 0; h < 8; ++h) { float v = run[h];
#pragma unroll
        for (int d = 1; d < 64; d <<= 1) { const float o = __shfl_up(v, d); if (lane >= d) v += o; }
        incl[h] = v; }
    if (lane == 63) {
#pragma unroll
        for (int h = 0; h < 8; ++h) wt[wave * 8 + h] = incl[h]; }
    __syncthreads();
    float off[8];
#pragma unroll
    for (int h = 0; h < 8; ++h) { float o = incl[h] - run[h]; for (int w = 0; w < wave; ++w) o += wt[w * 8 + h]; off[h] = o; }
    for (int i = 0; i < 16; ++i) { const u32x4 w = *(const u32x4*)(P0 + (m0 + i) * LD0 + C_FF); float f[8]; unpack8(w, f);
#pragma unroll
        for (int h = 0; h < 8; ++h) { off[h] += logsig(f[h] + bf[h]); cum[(size_t)(b * 8 + h) * SEQ + 16 * tid + i] = off[h]; } }
}

__device__ __forceinline__ int q_next(unsigned* ctr, LAS int* slot) {
    __syncthreads();
    if (threadIdx.x == 0) *slot = (int)atomicAdd(ctr, 1u);
    __syncthreads();
    return *slot;
}

__device__ __forceinline__ void gla_item(unsigned char* ws, LAS unsigned char* lds, int b, int h, int seg) {
    const int tid = otid(), lane = tid & 63, w = __builtin_amdgcn_readfirstlane(tid >> 6), c = lane & 15, q = lane >> 4;
    const GAS bf16_t* P0 = (const GAS bf16_t*)(ws + WS_BIG); GAS bf16_t* MIX = (GAS bf16_t*)(ws + WS_MIX); const GAS float* BC = (const GAS float*)(ws + WS_H); const GAS float* prm = (const GAS float*)(ws + WS_PRM);
    LAS bf16_t* Qp = (LAS bf16_t*)(lds); LAS bf16_t* Kp = (LAS bf16_t*)(lds + 9216); LAS bf16_t* Kt = (LAS bf16_t*)(lds + 18432); LAS bf16_t* Vt = (LAS bf16_t*)(lds + 27648);
    LAS bf16_t* Pm = (LAS bf16_t*)(lds + 36864); LAS bf16_t* St = (LAS bf16_t*)(lds + 46080); LAS float* dec = (LAS float*)(lds + 55296);
    LAS float* wl = (LAS float*)(lds + 55552); LAS float* blr = (LAS float*)(lds + 59648);
    for (int i = tid; i < 2304; i += NT) ((LAS unsigned*)St)[i] = 0u;
    float gain[16];
#pragma unroll
    for (int vi = 0; vi < 4; ++vi)
#pragma unroll
        for (int j = 0; j < 4; ++j) gain[vi * 4 + j] = prm[PR_GGAIN + h * 64 + 16 * vi + 4 * q + j];
    f32x4 sacc[4];
#pragma unroll
    for (int vi = 0; vi < 4; ++vi) sacc[vi] = (f32x4){0.f, 0.f, 0.f, 0.f};
    const size_t rowbase = (size_t)b * SEQ;
    u32x4 rq, rk, rv; f32x4 rb0, rb1, re0, re1; u32x2 rg[4];
#define GLA_LOAD(ch_) do { const size_t m_ = rowbase + 64 * (ch_) + lane; const GAS bf16_t* p = P0 + m_ * LD0; \
        rq = *(const GAS u32x4*)(p + C_GQ + 64 * h + 8 * w); rk = *(const GAS u32x4*)(p + C_GK + 64 * h + 8 * w); rv = *(const GAS u32x4*)(p + C_GV + 64 * h + 8 * w); \
        const GAS float* pb = BC + m_ * 512 + 64 * h + 8 * w; rb0 = *(const GAS f32x4*)pb; rb1 = *(const GAS f32x4*)(pb + 4); \
        const GAS float* pe = BC + (rowbase + 64 * (ch_) + 63) * 512 + 64 * h + 8 * w; re0 = *(const GAS f32x4*)pe; re1 = *(const GAS f32x4*)(pe + 4); \
        if (w < 4) { const GAS bf16_t* pg = P0 + (rowbase + 64 * (ch_) + 16 * w + c) * LD0 + C_GG + 64 * h + 4 * q; _Pragma("unroll") for (int vi_ = 0; vi_ < 4; ++vi_) rg[vi_] = *(const GAS u32x2*)(pg + 16 * vi_); } } while (0)
    const int c0 = 32 * seg, item = (b * 8 + h) * 4 + seg;
    GAS float* EG = (GAS float*)(ws + WS_GLAE); GAS float* DG = (GAS float*)(ws + WS_GLAD); unsigned* flags = (unsigned*)(ws + WS_CTL) + 8192;
    __syncthreads();
    if (seg < 3) {
        float sumbl[8];
#pragma unroll
        for (int j = 0; j < 8; ++j) sumbl[j] = 0.f;
        GLA_LOAD(c0);
        for (int ch = c0; ch < c0 + 32; ++ch) {
            {
                const float bc[8] = {rb0[0], rb0[1], rb0[2], rb0[3], rb1[0], rb1[1], rb1[2], rb1[3]};
                const float bl[8] = {re0[0], re0[1], re0[2], re0[3], re1[0], re1[1], re1[2], re1[3]};
                float kf[8]; unpack8(rk, kf);
                const unsigned vv[4] = {rv.x, rv.y, rv.z, rv.w};
#pragma unroll
                for (int j = 0; j < 8; ++j) { sumbl[j] += bl[j]; Kt[(8 * w + j) * 72 + lane] = (bf16_t)(pkbf(kf[j] * __expf(bl[j] - bc[j]), 0.f) & 0xffffu); Vt[(8 * w + j) * 72 + lane] = (bf16_t)((j & 1) ? (vv[j >> 1] >> 16) : (vv[j >> 1] & 0xffffu)); }
                if (lane == 63) {
#pragma unroll
                    for (int j = 0; j < 8; ++j) dec[8 * w + j] = __expf(bl[j]); }
            }
            if (ch + 1 < c0 + 32) GLA_LOAD(ch + 1);
            BAR_LDS();
            if (w >= 4) {
                const int ki = w - 4;
                const f32x4 d4 = *(const LAS f32x4*)(dec + 16 * ki + 4 * q);
                const bf16x8 k0 = *(const LAS bf16x8*)(Kt + (16 * ki + c) * 72 + 8 * q), k1 = *(const LAS bf16x8*)(Kt + (16 * ki + c) * 72 + 8 * q + 32);
#pragma unroll
                for (int vi = 0; vi < 4; ++vi) { const bf16x8 v0 = *(const LAS bf16x8*)(Vt + (16 * vi + c) * 72 + 8 * q), v1 = *(const LAS bf16x8*)(Vt + (16 * vi + c) * 72 + 8 * q + 32);
                    f32x4 s2 = sacc[vi] * d4; s2 = MFMA16(k0, v0, s2); s2 = MFMA16(k1, v1, s2); sacc[vi] = s2; }
            }
            BAR_LDS();
        }
        if (w >= 4) { const int ki = w - 4; GAS float* ep = EG + (size_t)item * 4096;
#pragma unroll
            for (int vi = 0; vi < 4; ++vi)
#pragma unroll
                for (int j = 0; j < 4; ++j) ep[(16 * ki + 4 * q + j) * 64 + 16 * vi + c] = sacc[vi][j]; }
        if (lane == 0) {
#pragma unroll
            for (int j = 0; j < 8; ++j) DG[(size_t)item * 64 + 8 * w + j] = sumbl[j]; }
        asm volatile("s_waitcnt vmcnt(0)" ::: "memory");
        __syncthreads();
        if (tid == 0) { __builtin_amdgcn_fence(__ATOMIC_RELEASE, "agent"); asm volatile("s_waitcnt vmcnt(0)" ::: "memory"); __hip_atomic_store(flags + item, 1u, __ATOMIC_RELAXED, __HIP_MEMORY_SCOPE_AGENT); }
    }
    GLA_LOAD(c0);
#pragma unroll
    for (int vi = 0; vi < 4; ++vi) sacc[vi] = (f32x4){0.f, 0.f, 0.f, 0.f};
    if (seg > 0) {
        if (tid == 0) {
            for (int s2 = 0; s2 < seg; ++s2) { unsigned sp = 0; while (__hip_atomic_load(flags + item - seg + s2, __ATOMIC_RELAXED, __HIP_MEMORY_SCOPE_AGENT) == 0u) { __builtin_amdgcn_s_sleep(2); if (++sp > (1u << 22)) break; } }
            __builtin_amdgcn_fence(__ATOMIC_ACQUIRE, "agent"); asm volatile("s_waitcnt vmcnt(0)" ::: "memory");
        }
        __syncthreads();
        if (w >= 4) { const int ki = w - 4;
            for (int s2 = 0; s2 < seg; ++s2) { const GAS float* ep = EG + (size_t)(item - seg + s2) * 4096; const GAS float* dp = DG + (size_t)(item - seg + s2) * 64 + 16 * ki + 4 * q;
                float dv[4];
#pragma unroll
                for (int j = 0; j < 4; ++j) dv[j] = __expf(__hip_atomic_load(dp + j, __ATOMIC_RELAXED, __HIP_MEMORY_SCOPE_AGENT));
#pragma unroll
                for (int vi = 0; vi < 4; ++vi)
#pragma unroll
                    for (int j = 0; j < 4; ++j) sacc[vi][j] = dv[j] * sacc[vi][j] + __hip_atomic_load(ep + (16 * ki + 4 * q + j) * 64 + 16 * vi + c, __ATOMIC_RELAXED, __HIP_MEMORY_SCOPE_AGENT); }
#pragma unroll
            for (int vi = 0; vi < 4; ++vi) { u32x2 sw; sw.x = pkbf(sacc[vi][0], sacc[vi][1]); sw.y = pkbf(sacc[vi][2], sacc[vi][3]); *(LAS u32x2*)(St + (16 * vi + c) * 72 + 16 * ki + 4 * q) = sw; }
        }
    }
    __syncthreads();
    for (int ch = c0; ch < c0 + 32; ++ch) {
        u32x2 gcur[4];
#pragma unroll
        for (int vi = 0; vi < 4; ++vi) gcur[vi] = rg[vi];
        {
            const float bc[8] = {rb0[0], rb0[1], rb0[2], rb0[3], rb1[0], rb1[1], rb1[2], rb1[3]};
            const float ble[8] = {re0[0], re0[1], re0[2], re0[3], re1[0], re1[1], re1[2], re1[3]};
            float qf[8], kf[8]; unpack8(rq, qf); unpack8(rk, kf);
            float qp[8], kp[8], kpp[8], bl[8];
#pragma unroll
            for (int j = 0; j < 8; ++j) { bl[j] = ble[j]; qp[j] = qf[j] * 0.125f * __expf(bc[j]); kp[j] = kf[j] * __expf(-bc[j]); kpp[j] = kf[j] * __expf(bl[j] - bc[j]); }
            u32x4 wq, wk; wq.x = pkbf(qp[0], qp[1]); wq.y = pkbf(qp[2], qp[3]); wq.z = pkbf(qp[4], qp[5]); wq.w = pkbf(qp[6], qp[7]);
            wk.x = pkbf(kp[0], kp[1]); wk.y = pkbf(kp[2], kp[3]); wk.z = pkbf(kp[4], kp[5]); wk.w = pkbf(kp[6], kp[7]);
            *(LAS u32x4*)(Qp + lane * 72 + 8 * w) = wq; *(LAS u32x4*)(Kp + lane * 72 + 8 * w) = wk;
            const unsigned vv[4] = {rv.x, rv.y, rv.z, rv.w};
#pragma unroll
            for (int j = 0; j < 8; ++j) { Kt[(8 * w + j) * 72 + lane] = (bf16_t)(pkbf(kpp[j], 0.f) & 0xffffu); Vt[(8 * w + j) * 72 + lane] = (bf16_t)((j & 1) ? (vv[j >> 1] >> 16) : (vv[j >> 1] & 0xffffu)); }
            if (lane == 63) {
#pragma unroll
                for (int j = 0; j < 8; ++j) dec[8 * w + j] = __expf(bl[j]); }
        }
        if (ch + 1 < c0 + 32) GLA_LOAD(ch + 1);
        BAR_LDS();
        f32x4 oacc[4];
        {
            const int ti = w & 3;
            const bf16x8 qf0 = *(const LAS bf16x8*)(Qp + (16 * ti + c) * 72 + 8 * q), qf1 = *(const LAS bf16x8*)(Qp + (16 * ti + c) * 72 + 8 * q + 32);
#pragma unroll
            for (int u = 0; u < 2; ++u) { const int si = 2 * (w >> 2) + u; f32x4 acc = (f32x4){0.f, 0.f, 0.f, 0.f};
                if (si <= ti) { const bf16x8 k0 = *(const LAS bf16x8*)(Kp + (16 * si + c) * 72 + 8 * q), k1 = *(const LAS bf16x8*)(Kp + (16 * si + c) * 72 + 8 * q + 32);
                    acc = MFMA16(k0, qf0, acc); acc = MFMA16(k1, qf1, acc);
#pragma unroll
                    for (int j = 0; j < 4; ++j) if (16 * si + 4 * q + j > 16 * ti + c) acc[j] = 0.f; }
                u32x2 pw; pw.x = pkbf(acc[0], acc[1]); pw.y = pkbf(acc[2], acc[3]);
                *(LAS u32x2*)(Pm + (16 * ti + c) * 72 + 16 * si + 4 * q) = pw; }
            if (w < 4) {
#pragma unroll
                for (int vi = 0; vi < 4; ++vi) { const bf16x8 s0 = *(const LAS bf16x8*)(St + (16 * vi + c) * 72 + 8 * q), s1 = *(const LAS bf16x8*)(St + (16 * vi + c) * 72 + 8 * q + 32);
                    f32x4 acc = (f32x4){0.f, 0.f, 0.f, 0.f}; acc = MFMA16(s0, qf0, acc); acc = MFMA16(s1, qf1, acc); oacc[vi] = acc; } }
        }
        BAR_LDS();
        if (w < 4) {
            const bf16x8 p0 = *(const LAS bf16x8*)(Pm + (16 * w + c) * 72 + 8 * q), p1 = *(const LAS bf16x8*)(Pm + (16 * w + c) * 72 + 8 * q + 32);
            float ssq = 0.f;
#pragma unroll
            for (int vi = 0; vi < 4; ++vi) { const bf16x8 v0 = *(const LAS bf16x8*)(Vt + (16 * vi + c) * 72 + 8 * q), v1 = *(const LAS bf16x8*)(Vt + (16 * vi + c) * 72 + 8 * q + 32);
                oacc[vi] = MFMA16(v0, p0, oacc[vi]); oacc[vi] = MFMA16(v1, p1, oacc[vi]);
#pragma unroll
                for (int j = 0; j < 4; ++j) ssq += oacc[vi][j] * oacc[vi][j]; }
            ssq += __shfl_xor(ssq, 16); ssq += __shfl_xor(ssq, 32);
            const float r = rsqrtf(ssq * (1.0f / 64.0f) + EPS);
            const size_t m = rowbase + 64 * ch + 16 * w + c;
#pragma unroll
            for (int vi = 0; vi < 4; ++vi) { const u32x2 gw = gcur[vi];
                const float g0 = bflo(gw.x), g1 = bfhi(gw.x), g2 = bflo(gw.y), g3 = bfhi(gw.y);
                u32x2 ow; ow.x = pkbf(oacc[vi][0] * r * gain[vi * 4 + 0] * siluf_(g0), oacc[vi][1] * r * gain[vi * 4 + 1] * siluf_(g1));
                ow.y = pkbf(oacc[vi][2] * r * gain[vi * 4 + 2] * siluf_(g2), oacc[vi][3] * r * gain[vi * 4 + 3] * siluf_(g3));
                *(GAS u32x2*)(MIX + m * D + 64 * h + 16 * vi + 4 * q) = ow; }
        } else {
            const int ki = w - 4;
            const f32x4 d4 = *(const LAS f32x4*)(dec + 16 * ki + 4 * q);
            const bf16x8 k0 = *(const LAS bf16x8*)(Kt + (16 * ki + c) * 72 + 8 * q), k1 = *(const LAS bf16x8*)(Kt + (16 * ki + c) * 72 + 8 * q + 32);
#pragma unroll
            for (int vi = 0; vi < 4; ++vi) { const bf16x8 v0 = *(const LAS bf16x8*)(Vt + (16 * vi + c) * 72 + 8 * q), v1 = *(const LAS bf16x8*)(Vt + (16 * vi + c) * 72 + 8 * q + 32);
                f32x4 s = sacc[vi] * d4; s = MFMA16(k0, v0, s); s = MFMA16(k1, v1, s); sacc[vi] = s;
                u32x2 sw; sw.x = pkbf(s[0], s[1]); sw.y = pkbf(s[2], s[3]);
                *(LAS u32x2*)(St + (16 * vi + c) * 72 + 16 * ki + 4 * q) = sw; }
        }
        BAR_LDS();
    }
}

#undef GLA_LOAD
__device__ __forceinline__ void fox_item(unsigned char* ws, LAS unsigned char* lds, int b, int h, int qg) {
    const int tid = otid(), lane = tid & 63, w = __builtin_amdgcn_readfirstlane(tid >> 6), c = lane & 15, q = lane >> 4;
    const GAS bf16_t* P0 = (const GAS bf16_t*)(ws + WS_BIG); GAS bf16_t* MIX = (GAS bf16_t*)(ws + WS_MIX);
    const GAS float* cumb = (const GAS float*)(ws + WS_CUM) + (size_t)(b * 8 + h) * SEQ;
    LAS bf16_t* Kn = (LAS bf16_t*)(lds); LAS bf16_t* Vt = (LAS bf16_t*)(lds + 9216); LAS float* cumk = (LAS float*)(lds + 18432);
    const GAS float* gq = (const GAS float*)(ws + WS_PRM) + PR_QG + h * 64; const GAS float* gk = (const GAS float*)(ws + WS_PRM) + PR_KG + h * 64;
    float mq = fabsf(gq[lane]), mk = fabsf(gk[lane]);
#pragma unroll
    for (int o = 1; o < 64; o <<= 1) { mq = fmaxf(mq, __shfl_xor(mq, o)); mk = fmaxf(mk, __shfl_xor(mk, o)); }
    const float B2 = 16.0f * mq * mk * 1.001f;
    const int srow = tid >> 3, dc = tid & 7;
    float gkr[8], gqr[16];
#pragma unroll
    for (int e2 = 0; e2 < 8; ++e2) { gkr[e2] = gk[8 * dc + e2]; gqr[e2] = gq[8 * q + e2]; gqr[8 + e2] = gq[8 * q + 32 + e2]; }
    const size_t rowbase = (size_t)b * SEQ;
    for (int qi = 4 * qg; qi < 4 * qg + 4; ++qi) {
        const int t0 = 128 * qi, t = t0 + 16 * w + c; const size_t m = rowbase + t;
        int j = 2 * qi + 1;
        const u32x4 r0 = *(const GAS u32x4*)(P0 + m * LD0 + C_FQ + 64 * h + 8 * q), r1 = *(const GAS u32x4*)(P0 + m * LD0 + C_FQ + 64 * h + 8 * q + 32);
        const float cum_t0 = cumb[t0], cum_t = cumb[t];
        const int jl0 = 2 * qi - 1 - lane; const float ce0 = (jl0 >= 0) ? cumb[64 * jl0 + 63] : 0.f;
        u32x4 rk, rv; float rc;
        { const size_t ms = rowbase + 64 * j + srow; rk = *(const GAS u32x4*)(P0 + ms * LD0 + C_FK + 64 * h + 8 * dc); rv = *(const GAS u32x4*)(P0 + ms * LD0 + C_FV + 64 * h + 8 * dc); rc = cumb[64 * j + srow]; }
        int nbelow = 0;
        { const bool skp = (jl0 < 0) || ((B2 + cum_t0 - ce0) < -110.0f); const unsigned long long mk0 = __ballot(skp);
          if (mk0) nbelow = __ffsll((long long)mk0) - 1;
          else { nbelow = 64;
              for (int basej = 2 * qi - 1 - 64; basej >= 0; basej -= 64) { const int jl = basej - lane; const float ce = (jl >= 0) ? cumb[64 * jl + 63] : 0.f;
                  const bool sk2 = (jl < 0) || ((B2 + cum_t0 - ce) < -110.0f); const unsigned long long mk2 = __ballot(sk2);
                  if (mk2) { nbelow += __ffsll((long long)mk2) - 1; break; } nbelow += 64; } } }
        const int jlo = 2 * qi - nbelow;
        bf16x8 qf[2];
        { float f[16]; unpack8(r0, f); unpack8(r1, f + 8); float ss = 0.f;
#pragma unroll
          for (int e2 = 0; e2 < 16; ++e2) ss += f[e2] * f[e2];
          ss += __shfl_xor(ss, 16); ss += __shfl_xor(ss, 32);
          const float r = rsqrtf(ss * (1.0f / 64.0f) + EPS) * 0.125f;
#pragma unroll
          for (int kk = 0; kk < 2; ++kk) { float g[8];
#pragma unroll
              for (int e2 = 0; e2 < 8; ++e2) g[e2] = f[8 * kk + e2] * r * gqr[8 * kk + e2];
              u32x4 pw; pw.x = pkbf(g[0], g[1]); pw.y = pkbf(g[2], g[3]); pw.z = pkbf(g[4], g[5]); pw.w = pkbf(g[6], g[7]); qf[kk] = as_bf16x8(pw); } }
        f32x4 oacc[4];
#pragma unroll
        for (int di = 0; di < 4; ++di) oacc[di] = (f32x4){0.f, 0.f, 0.f, 0.f};
        float mrun = -1e30f, lpart = 0.f;
        for (;;) {
            { float f[8]; unpack8(rk, f); float ss = 0.f;
#pragma unroll
              for (int e2 = 0; e2 < 8; ++e2) ss += f[e2] * f[e2];
              ss += __shfl_xor(ss, 1); ss += __shfl_xor(ss, 2); ss += __shfl_xor(ss, 4);
              const float r = rsqrtf(ss * (1.0f / 64.0f) + EPS);
#pragma unroll
              for (int e2 = 0; e2 < 8; ++e2) f[e2] = f[e2] * r * gkr[e2];
              u32x4 pw; pw.x = pkbf(f[0], f[1]); pw.y = pkbf(f[2], f[3]); pw.z = pkbf(f[4], f[5]); pw.w = pkbf(f[6], f[7]);
              *(LAS u32x4*)(Kn + srow * 72 + 8 * dc) = pw;
              const unsigned vv[4] = {rv.x, rv.y, rv.z, rv.w};
#pragma unroll
              for (int e2 = 0; e2 < 8; ++e2) Vt[(8 * dc + e2) * 72 + srow] = (bf16_t)((e2 & 1) ? (vv[e2 >> 1] >> 16) : (vv[e2 >> 1] & 0xffffu));
              if (dc == 0) cumk[srow] = rc; }
            const int jn = j - 1;
            const bool cont = jn >= jlo;
            if (cont) { const size_t ms = rowbase + 64 * jn + srow; rk = *(const GAS u32x4*)(P0 + ms * LD0 + C_FK + 64 * h + 8 * dc); rv = *(const GAS u32x4*)(P0 + ms * LD0 + C_FV + 64 * h + 8 * dc); rc = cumb[64 * jn + srow]; }
            BAR_LDS();
            if (!(j == 2 * qi + 1 && w < 4)) {
                float sv[4][4]; float mx = -1e30f;
#pragma unroll
                for (int si = 0; si < 4; ++si) { f32x4 acc = (f32x4){0.f, 0.f, 0.f, 0.f};
                    const bf16x8 k0 = *(const LAS bf16x8*)(Kn + (16 * si + c) * 72 + 8 * q), k1 = *(const LAS bf16x8*)(Kn + (16 * si + c) * 72 + 8 * q + 32);
                    acc = MFMA16(k0, qf[0], acc); acc = MFMA16(k1, qf[1], acc);
                    const f32x4 ck = *(const LAS f32x4*)(cumk + 16 * si + 4 * q);
#pragma unroll
                    for (int jj = 0; jj < 4; ++jj) { float lg = acc[jj] + (cum_t - ck[jj]); if (j >= 2 * qi && (64 * j + 16 * si + 4 * q + jj) > t) lg = -1e30f; sv[si][jj] = lg; mx = fmaxf(mx, lg); } }
                mx = fmaxf(mx, __shfl_xor(mx, 16)); mx = fmaxf(mx, __shfl_xor(mx, 32));
                const float mnew = fmaxf(mrun, mx), alpha = __expf(mrun - mnew); mrun = mnew;
                float ps = 0.f;
#pragma unroll
                for (int si = 0; si < 4; ++si)
#pragma unroll
                    for (int jj = 0; jj < 4; ++jj) { sv[si][jj] = __expf(sv[si][jj] - mnew); ps += sv[si][jj]; }
                lpart = lpart * alpha + ps;
#pragma unroll
                for (int di = 0; di < 4; ++di) oacc[di] *= alpha;
#pragma unroll
                for (int kk = 0; kk < 2; ++kk) { u32x4 pw; pw.x = pkbf(sv[2 * kk][0], sv[2 * kk][1]); pw.y = pkbf(sv[2 * kk][2], sv[2 * kk][3]); pw.z = pkbf(sv[2 * kk + 1][0], sv[2 * kk + 1][1]); pw.w = pkbf(sv[2 * kk + 1][2], sv[2 * kk + 1][3]);
                    const bf16x8 pf = as_bf16x8(pw);
#pragma unroll
                    for (int di = 0; di < 4; ++di) { const u32x2 va = *(const LAS u32x2*)(Vt + (16 * di + c) * 72 + 32 * kk + 4 * q), vb = *(const LAS u32x2*)(Vt + (16 * di + c) * 72 + 32 * kk + 16 + 4 * q);
                        u32x4 vw; vw.x = va.x; vw.y = va.y; vw.z = vb.x; vw.w = vb.y; oacc[di] = MFMA16(as_bf16x8(vw), pf, oacc[di]); } }
            }
            BAR_LDS();
            if (!cont) break;
            j = jn;
        }
        float l = lpart; l += __shfl_xor(l, 16); l += __shfl_xor(l, 32);
        const float inv = 1.0f / l;
#pragma unroll
        for (int di = 0; di < 4; ++di) { u32x2 ow; ow.x = pkbf(oacc[di][0] * inv, oacc[di][1] * inv); ow.y = pkbf(oacc[di][2] * inv, oacc[di][3] * inv);
            *(GAS u32x2*)(MIX + m * D + 512 + 64 * h + 16 * di + 4 * q) = ow; }
    }
}

__device__ __forceinline__ void s5_item(unsigned char* ws, LAS unsigned char* lds, int b, int g) {
    const int tid = otid(), lane = tid & 63, w = __builtin_amdgcn_readfirstlane(tid >> 6), c = lane & 15, q = lane >> 4;
    const GAS bf16_t* P1 = (const GAS bf16_t*)(ws + WS_BIG); GAS bf16_t* YS = (GAS bf16_t*)(ws + WS_YS5);
    const GAS float* abar = (const GAS float*)(ws + WS_S5P + S5_ABAR); const GAS bf16_t* Bb = (const GAS bf16_t*)(ws + WS_S5P + S5_BB); const GAS bf16_t* Cm = (const GAS bf16_t*)(ws + WS_S5P + S5_CM);
    LAS float* bu = (LAS float*)(lds + w * 12800); LAS bf16_t* xs = (LAS bf16_t*)(lds + w * 12800 + 8448); LAS float* E = (LAS float*)(lds + 102400);
    const float ar = abar[(g * 64 + lane) * 2], ai = abar[(g * 64 + lane) * 2 + 1];
    float pr = ar, pi = ai;
#pragma unroll
    for (int i = 0; i < 10; ++i) { const float nr = pr * pr - pi * pi, ni = 2.0f * pr * pi; pr = nr; pi = ni; }
    bf16x8 bfr[8], cfr[4];
    const bf16x8 zero8 = (bf16x8){0, 0, 0, 0, 0, 0, 0, 0};
#pragma unroll
    for (int pt = 0; pt < 8; ++pt) bfr[pt] = (q < 2) ? *(const GAS bf16x8*)(Bb + ((size_t)(g * 128 + 16 * pt + c)) * 16 + 8 * q) : zero8;
#pragma unroll
    for (int kk = 0; kk < 4; ++kk) cfr[kk] = *(const GAS bf16x8*)(Cm + (size_t)(g * 16 + c) * 128 + 32 * kk + 8 * q);
    float dsk[4];
#pragma unroll
    for (int j = 0; j < 4; ++j) dsk[j] = ((const GAS float*)(ws + WS_PRM))[PR_S5D + g * 16 + 4 * q + j];
    f32x2 x2 = {0.f, 0.f}; const f32x2 a1 = {ar, ar}, a2 = {-ai, ai};
    LAS bf16_t* xs1 = (LAS bf16_t*)(lds + 106496 + w * 4352);
    for (int pass = 0; pass < 2; ++pass) {
        const size_t mbase = (size_t)b * SEQ + 1024 * w + c;
        bf16x8 uf_a = (q < 2) ? *(const GAS bf16x8*)(P1 + mbase * LD1 + 16 * g + 8 * q) : zero8;
        bf16x8 uf_b = (q < 2) ? *(const GAS bf16x8*)(P1 + (mbase + 16) * LD1 + 16 * g + 8 * q) : zero8;
        u32x2 uw_cur = *(const GAS u32x2*)(P1 + mbase * LD1 + 16 * g + 4 * q), uw_nxt = *(const GAS u32x2*)(P1 + (mbase + 16) * LD1 + 16 * g + 4 * q), uw_prev = uw_cur;
        f32x4 abu[8];
#pragma unroll
        for (int pt = 0; pt < 8; ++pt) abu[pt] = MFMA16(bfr[pt], uf_a, ((f32x4){0.f, 0.f, 0.f, 0.f}));
        for (int sc = 0; sc < 64; ++sc) {
            const size_t m = mbase + 16 * sc;
            LAS bf16_t* xw = (sc & 1) ? xs1 : xs; LAS bf16_t* xr = (sc & 1) ? xs : xs1;
#pragma unroll
            for (int pt = 0; pt < 8; ++pt) *(LAS f32x4*)(bu + c * 132 + 16 * pt + 4 * q) = abu[pt];
            const bf16x8 uf_use = uf_b;
            if (sc + 2 < 64) { uf_b = (q < 2) ? *(const GAS bf16x8*)(P1 + (m + 32) * LD1 + 16 * g + 8 * q) : zero8; }
            u32x2 uw_n2 = uw_nxt; if (sc + 2 < 64) uw_n2 = *(const GAS u32x2*)(P1 + (m + 32) * LD1 + 16 * g + 4 * q);
#pragma unroll
            for (int pt = 0; pt < 8; ++pt) abu[pt] = MFMA16(bfr[pt], uf_use, ((f32x4){0.f, 0.f, 0.f, 0.f}));
            bf16x8 xf[4];
            if (pass && sc > 0) {
#pragma unroll
                for (int kk = 0; kk < 4; ++kk) xf[kk] = *(const LAS bf16x8*)(xr + c * 136 + 32 * kk + 8 * q); }
            LDS_WAIT();
#pragma unroll
            for (int tt = 0; tt < 16; ++tt) { const f32x2 bb = *(const LAS f32x2*)(bu + tt * 132 + 2 * lane);
                const f32x2 t2 = a1 * x2 + bb; const f32x2 xsw = {x2.y, x2.x}; x2 = a2 * xsw + t2;
                if (pass) *(LAS unsigned*)(xw + tt * 136 + 2 * lane) = pkbf(x2.x, x2.y); }
            if (pass && sc > 0) {
                f32x4 acc = (f32x4){0.f, 0.f, 0.f, 0.f};
#pragma unroll
                for (int kk = 0; kk < 4; ++kk) acc = MFMA16(cfr[kk], xf[kk], acc);
                const float y0 = gelu_tanh(acc[0] + dsk[0] * bflo(uw_prev.x)), y1 = gelu_tanh(acc[1] + dsk[1] * bfhi(uw_prev.x)), y2 = gelu_tanh(acc[2] + dsk[2] * bflo(uw_prev.y)), y3 = gelu_tanh(acc[3] + dsk[3] * bfhi(uw_prev.y));
                u32x2 ow; ow.x = pkbf(y0, y1); ow.y = pkbf(y2, y3);
                *(GAS u32x2*)(YS + (m - 16) * 512 + 16 * g + 4 * q) = ow;
            }
            uw_prev = uw_cur; uw_cur = uw_nxt; uw_nxt = uw_n2;
        }
        if (pass) {
            LDS_WAIT();
            f32x4 acc = (f32x4){0.f, 0.f, 0.f, 0.f};
#pragma unroll
            for (int kk = 0; kk < 4; ++kk) { const bf16x8 xf = *(const LAS bf16x8*)(xs1 + c * 136 + 32 * kk + 8 * q); acc = MFMA16(cfr[kk], xf, acc); }
            const float y0 = gelu_tanh(acc[0] + dsk[0] * bflo(uw_prev.x)), y1 = gelu_tanh(acc[1] + dsk[1] * bfhi(uw_prev.x)), y2 = gelu_tanh(acc[2] + dsk[2] * bflo(uw_prev.y)), y3 = gelu_tanh(acc[3] + dsk[3] * bfhi(uw_prev.y));
            u32x2 ow; ow.x = pkbf(y0, y1); ow.y = pkbf(y2, y3);
            *(GAS u32x2*)(YS + (mbase + 16 * 63) * 512 + 16 * g + 4 * q) = ow;
            LDS_WAIT();
        }
        if (pass == 0) {
            E[w * 128 + lane] = x2.x; E[w * 128 + 64 + lane] = x2.y;
            __syncthreads();
            float cr = 0.f, ci = 0.f;
            for (int w2 = 0; w2 < w; ++w2) { const float er = E[w2 * 128 + lane], ei = E[w2 * 128 + 64 + lane]; const float nr = pr * cr - pi * ci + er, ni = pr * ci + pi * cr + ei; cr = nr; ci = ni; }
            x2.x = cr; x2.y = ci;
        }
    }
}

__device__ __forceinline__ void sgu_item(unsigned char* ws, LAS unsigned char* lds, int b, int n) {
    const int tid = otid(), lane = tid & 63, w = __builtin_amdgcn_readfirstlane(tid >> 6), c = lane & 15, q = lane >> 4;
    const GAS bf16_t* P1 = (const GAS bf16_t*)(ws + WS_BIG); GAS bf16_t* MIX = (GAS bf16_t*)(ws + WS_MIX); const GAS bf16_t* wsb = (const GAS bf16_t*)(ws + WS_WSB);
    LAS bf16_t* Vt = (LAS bf16_t*)lds;
    const size_t m0 = (size_t)b * SEQ + 128 * n;
    {
        const int s = tid >> 2, qq = tid & 3; const GAS bf16_t* vp = P1 + (m0 + s) * LD1 + 1024 + 128 * qq;
        u32x4 rv[16]; float sum = 0.f, ssq = 0.f;
#pragma unroll
        for (int i = 0; i < 16; ++i) { rv[i] = *(const GAS u32x4*)(vp + 8 * i); float f[8]; unpack8(rv[i], f);
#pragma unroll
            for (int e = 0; e < 8; ++e) { sum += f[e]; ssq += f[e] * f[e]; } }
        sum += __shfl_xor(sum, 1); sum += __shfl_xor(sum, 2); ssq += __shfl_xor(ssq, 1); ssq += __shfl_xor(ssq, 2);
        const float mu = sum * (1.0f / 512.0f), var = fmaxf(ssq * (1.0f / 512.0f) - mu * mu, 0.f), rstd = rsqrtf(var + EPS);
        const GAS float* lg = (const GAS float*)(ws + WS_PRM) + PR_LNG + 128 * qq; const GAS float* lb = (const GAS float*)(ws + WS_PRM) + PR_LNB + 128 * qq;
#pragma unroll
        for (int i = 0; i < 16; ++i) { float f[8]; unpack8(rv[i], f);
            const f32x4 g0 = *(const GAS f32x4*)(lg + 8 * i), g1 = *(const GAS f32x4*)(lg + 8 * i + 4), b0 = *(const GAS f32x4*)(lb + 8 * i), b1 = *(const GAS f32x4*)(lb + 8 * i + 4);
#pragma unroll
            for (int e = 0; e < 8; ++e) { const float gg = e < 4 ? g0[e & 3] : g1[e & 3], bb = e < 4 ? b0[e & 3] : b1[e & 3]; const float y = (f[e] - mu) * rstd * gg + bb;
                Vt[(128 * qq + 8 * i + e) * 136 + s] = (bf16_t)(pkbf(y, 0.f) & 0xffffu); } }
    }
    __syncthreads();
    const int nk = (w >> 1) + 1; const int trow = 16 * w + c; const size_t m = m0 + trow;
    for (int g = 0; g < 8; ++g) {
        f32x4 acc[4];
#pragma unroll
        for (int ct = 0; ct < 4; ++ct) acc[ct] = (f32x4){0.f, 0.f, 0.f, 0.f};
        for (int kk = 0; kk < nk; ++kk) { const bf16x8 wf = *(const GAS bf16x8*)(wsb + ((size_t)g * 128 + trow) * 128 + 32 * kk + 8 * q);
#pragma unroll
            for (int ct = 0; ct < 4; ++ct) { const bf16x8 vf = *(const LAS bf16x8*)(Vt + (64 * g + 16 * ct + c) * 136 + 32 * kk + 8 * q); acc[ct] = MFMA16(vf, wf, acc[ct]); } }
        const float bs = ((const GAS float*)(ws + WS_PRM))[PR_BS + g * 128 + trow];
#pragma unroll
        for (int ct = 0; ct < 4; ++ct) { const u32x2 uw = *(const GAS u32x2*)(P1 + m * LD1 + 512 + 64 * g + 16 * ct + 4 * q);
            u32x2 ow; ow.x = pkbf(bflo(uw.x) * (acc[ct][0] + bs), bfhi(uw.x) * (acc[ct][1] + bs)); ow.y = pkbf(bflo(uw.y) * (acc[ct][2] + bs), bfhi(uw.y) * (acc[ct][3] + bs));
            *(GAS u32x2*)(MIX + m * D + 512 + 64 * g + 16 * ct + 4 * q) = ow; }
    }
}

#define XB_TMO      128
#define XB_XCNT(j)  (256  + 64 * (j))
#define XB_XSUB(j)  (1280 + 64 * (j))
#define XB_XGEN(j)  (2304 + 64 * (j))
#define XB_TOP      3328
#define XB_TOPGEN   3392
#define XCD_BAR_WORDS 3456
#define XB_SPIN_CAP (1u << 22)
__device__ __forceinline__ unsigned xb_ld(unsigned* p)              { return __hip_atomic_load(p, __ATOMIC_RELAXED, __HIP_MEMORY_SCOPE_AGENT); }
__device__ __forceinline__ unsigned xb_add(unsigned* p, unsigned v) { return __hip_atomic_fetch_add(p, v, __ATOMIC_RELAXED, __HIP_MEMORY_SCOPE_AGENT); }
__device__ __forceinline__ unsigned xb_xcc_id() { return (unsigned)__builtin_amdgcn_s_getreg((3 << 11) | 20) & 0xFu; }
#define XB_SPIN(cond, bar) do { unsigned _sp = 0; while (cond) { __builtin_amdgcn_s_sleep(1); \
    if ((++_sp & 255u) == 0u) { if (xb_ld(&(bar)[XB_TMO])) break; if (_sp > XB_SPIN_CAP) { atomicAdd(&(bar)[XB_TMO], 1u); break; } } } } while (0)
struct XcdBarrier { unsigned* bar; unsigned x; volatile LAS unsigned* st; };
__device__ __forceinline__ XcdBarrier xcd_barrier_post(unsigned* bar, volatile LAS unsigned* st) {
    XcdBarrier b; b.bar = bar; b.x = xb_xcc_id(); b.st = st;
    if (threadIdx.x == 0) (void)xb_add(&bar[XB_XCNT(b.x)], 1u);
    return b;
}
__device__ __forceinline__ void xcd_barrier_complete(unsigned* bar, unsigned x, unsigned& nloc, unsigned& nx) {
    const unsigned G = gridDim.x * gridDim.y * gridDim.z;
    unsigned sum, cnt, mine, sp = 0u;
    for (;;) {
        sum = 0u; cnt = 0u; mine = 0u;
#pragma unroll
        for (unsigned j = 0; j < 16; ++j) { const unsigned c = xb_ld(&bar[XB_XCNT(j)]); sum += c; cnt += (c > 0u) ? 1u : 0u; mine = (j == x) ? c : mine; }
        if (sum == G) break;
        __builtin_amdgcn_s_sleep(1);
        if ((++sp & 255u) == 0u) { if (xb_ld(&bar[XB_TMO])) break; if (sp > XB_SPIN_CAP) { atomicAdd(&bar[XB_TMO], 1u); break; } }
    }
    nloc = mine > 0u ? mine : 1u; nx = cnt > 0u ? cnt : 1u;
}
__device__ __forceinline__ void xcd_barrier(const XcdBarrier& b) {
    asm volatile("s_waitcnt vmcnt(0) lgkmcnt(0)" ::: "memory");
    __syncthreads();
    if (threadIdx.x == 0) {
        unsigned* bar = b.bar;
        __builtin_amdgcn_s_waitcnt(0);
        unsigned nloc = b.st[0], nx = b.st[1];
        if (nloc == 0u) { xcd_barrier_complete(bar, b.x, nloc, nx); b.st[0] = nloc; b.st[1] = nx; }
        const unsigned old = xb_add(&bar[XB_XSUB(b.x)], 1u);
        const unsigned gen = old / nloc;
        if (old + 1u == (gen + 1u) * nloc) {
            __builtin_amdgcn_fence(__ATOMIC_RELEASE, "agent");
            asm volatile("s_waitcnt vmcnt(0)" ::: "memory");
            const unsigned og = xb_add(&bar[XB_TOP], 1u);
            const unsigned tg = og / nx;
            if (og + 1u == (tg + 1u) * nx) xb_add(&bar[XB_TOPGEN], 1u);
            else XB_SPIN(xb_ld(&bar[XB_TOPGEN]) == tg, bar);
            __builtin_amdgcn_fence(__ATOMIC_ACQUIRE, "agent");
            xb_add(&bar[XB_XGEN(b.x)], 1u);
            asm volatile("s_waitcnt vmcnt(0)" ::: "memory");
        } else {
            XB_SPIN(xb_ld(&bar[XB_XGEN(b.x)]) == gen, bar);
            __builtin_amdgcn_fence(__ATOMIC_ACQUIRE, "agent");
            asm volatile("s_waitcnt vmcnt(0)" ::: "memory");
        }
    }
    __syncthreads();
}
#define GSYNC(k) xcd_barrier(xbar)
__global__ void __launch_bounds__(NT, 2) mega_fwd(Args a) {
    extern __shared__ __attribute__((aligned(16))) unsigned char lds_raw[];
    LAS unsigned char* lds = (LAS unsigned char*)lds_raw;
    cg::grid_group grid = cg::this_grid();
    LAS int* slot = (LAS int*)(lds + LDS_BYTES - 64);
    volatile LAS unsigned* xst = (volatile LAS unsigned*)(lds + LDS_BYTES - 32);
    if (threadIdx.x < 2) xst[threadIdx.x] = 0u;
    __syncthreads();
    XcdBarrier xbar = xcd_barrier_post((unsigned*)(a.ws + WS_CTL) + 1024, xst);
    grid.sync();
#ifndef NO_P0
    p0_prologue(a, lds);
#endif
    GSYNC(0);
    unsigned char* const ws0 = a.ws; const float* const x00 = a.in[0]; float* const xout0 = a.out;
    unsigned kb = 1;
    for (int ph = 1; ph <= 16; ++ph) {
        if (ph == 6 || ph == 9 || ph == 14) continue;
        unsigned char* ws = ws0; const float* x0 = x00; float* xout = xout0;
        asm volatile("" : "+s"(ws), "+s"(x0), "+s"(xout));

        const float* mod = (const float*)(ws + WS_MOD);
        bf16_t* H = (bf16_t*)(ws + WS_H); bf16_t* MIX = (bf16_t*)(ws + WS_MIX); bf16_t* BIG = (bf16_t*)(ws + WS_BIG);
        unsigned* ctl = (unsigned*)(ws + WS_CTL);
        const int layer = ph >= 9;
        const GAS float* modl = (const GAS float*)mod + (size_t)layer * 8 * 6144;
        GAS float* rowss = (GAS float*)(ws + WS_ROWSS); const GAS float* shw = (const GAS float*)(ws + WS_SHW);
#ifndef REPEAT_PH
#define REPEAT_PH -1
#endif
        for (int rep = 0; rep < ((ph == REPEAT_PH) ? 2 : 1); ++rep) {
        pg8::Gemm g{nullptr, nullptr, T, 0, 0, 0}; pg8::Epi E{0, 0, nullptr, 0, nullptr, nullptr, nullptr, nullptr, nullptr, nullptr, nullptr, 0};
        switch (ph) {
        case 1: norm_phase(x0, mod, 0, 1024, H); break;
        case 3: cum_phase(ws, lds); break;
        case 4:
            for (;;) { const int it = q_next(ctl + 256 * rep, slot); if (it >= 256 + 1024 + 152) break;
                if (it < 256) gla_item(ws, lds, (it & 63) >> 3, it & 7, it >> 6); else if (it < 256 + 1024) { const int f = it - 256; fox_item(ws, lds, f >> 7, (f >> 4) & 7, f & 15); }
                else prep_item(ws, lds, it - 256 - 1024); }
            break;
        case 11:
            for (;;) { const int it = q_next(ctl + 64 + 256 * rep, slot); if (it >= 256 + 512) break;
                if (it < 256) s5_item(ws, lds, it >> 5, it & 31); else { const int f = it - 256; sgu_item(ws, lds, f >> 6, f & 63); } }
            break;
        case 2: g.A = H; g.Bt = (const bf16_t*)(ws + WS_WIN0); g.N = LD0; g.K = D; E.mode = 0; E.O = (GAS bf16_t*)BIG; E.ldc = LD0; break;
        case 5: g.A = MIX; g.Bt = (const bf16_t*)(ws + WS_WOUT0); g.N = D; g.K = D; E.mode = 6; E.O = (GAS bf16_t*)H; E.base32 = (const GAS float*)x0; E.gate = modl + 2048; E.rowss = rowss; break;
        case 7: g.A = H; g.Bt = (const bf16_t*)(ws + WS_WB0); g.bbatch = (size_t)FFD * D * 2; g.N = FFD; g.K = D; E.mode = 5; E.sub = 1; E.O = (GAS bf16_t*)BIG; E.ldc = FFD; E.rowss = rowss; E.shw = shw; E.ldsh = FFD; break;
        case 8: g.A = BIG; g.Bt = (const bf16_t*)(ws + WS_W2_0); g.N = D; g.K = FFD; E.mode = 7; E.O = (GAS bf16_t*)H; E.gate = modl + 5120; E.rowss = rowss; break;
        case 10: g.A = H; g.Bt = (const bf16_t*)(ws + WS_WB1); g.bbatch = (size_t)LD1 * D * 2; g.N = LD1; g.K = D; E.mode = 5; E.sub = 2; E.O = (GAS bf16_t*)BIG; E.ldc = LD1; E.rowss = rowss; E.shw = shw + 8 * 4096; E.ldsh = LD1; break;
        case 12: g.A = (const bf16_t*)(ws + WS_YS5); g.Bt = (const bf16_t*)(ws + WS_WGLU); g.N = 512; g.K = 512; E.mode = 3; E.O = (GAS bf16_t*)MIX; E.Y = (const GAS bf16_t*)(ws + WS_YS5); E.bias = (const GAS float*)(ws + WS_PRM) + PR_BGLU; break;
        case 13: g.A = MIX; g.Bt = (const bf16_t*)(ws + WS_WOUT1); g.N = D; g.K = D; E.mode = 7; E.O = (GAS bf16_t*)H; E.gate = modl + 2048; E.rowss = rowss; break;
        case 15: g.A = H; g.Bt = (const bf16_t*)(ws + WS_WB2); g.bbatch = (size_t)FFD * D * 2; g.N = FFD; g.K = D; E.mode = 5; E.sub = 1; E.O = (GAS bf16_t*)BIG; E.ldc = FFD; E.rowss = rowss; E.shw = shw + 16 * 4096; E.ldsh = FFD; break;
        case 16: g.A = BIG; g.Bt = (const bf16_t*)(ws + WS_W2_1); g.N = D; g.K = FFD; E.mode = 8; E.O = (GAS bf16_t*)H; E.out32 = (GAS float*)xout; E.gate = modl + 5120; break;
        default: break;
        }
        if (g.K != 0) { pg8::StaticOrder S; S.init(T, g.N, gridDim.x, blockIdx.x); pg8::gemm_phase(lds, g, S, E); }
        }
        if (ph != 16) { GSYNC(kb); ++kb; }
    }
}

extern "C" void kernel_launch(void* const* d_in, const int* in_sizes, int n_in, void* d_out, int out_size, void* d_ws, size_t ws_size, hipStream_t stream) {
    static int grid = 0;
    if (grid == 0) {
        if (n_in != 30 || out_size != T * D || ws_size < WS_END) { fprintf(stderr, "kernel_launch: unexpected shapes (n_in %d out %d ws %zu)\n", n_in, out_size, ws_size); grid = -1; return; }
        int dev = 0, cus = 0, per_cu = 0;
        hipGetDevice(&dev); hipDeviceGetAttribute(&cus, hipDeviceAttributeMultiprocessorCount, dev);
        hipFuncSetAttribute((const void*)mega_fwd, hipFuncAttributeMaxDynamicSharedMemorySize, LDS_BYTES);
        hipOccupancyMaxActiveBlocksPerMultiprocessor(&per_cu, (const void*)mega_fwd, NT, LDS_BYTES);
        if (per_cu < 1) { fprintf(stderr, "kernel_launch: occupancy query says %d blocks/CU\n", per_cu); per_cu = 1; }
        grid = cus * 1;
        (void)hipGetLastError();
    }
    if (grid < 0) return;
    (void)hipMemsetAsync((char*)d_ws + WS_CTL, 0, 65536, stream);
    Args a{};
    for (int i = 0; i < 30; ++i) a.in[i] = (const float*)d_in[i];
    a.out = (float*)d_out; a.ws = (unsigned char*)d_ws;
    void* args[] = {&a};
    hipError_t e = hipLaunchCooperativeKernel((const void*)mega_fwd, dim3(grid), dim3(NT), args, LDS_BYTES, stream);
    if (e != hipSuccess) fprintf(stderr, "cooperative launch failed: %s (grid %d)\n", hipGetErrorString(e), grid);
}
```

```cpp
#include <hip/hip_runtime.h>
#include <hip/hip_cooperative_groups.h>
#include <cstdio>
namespace cg = cooperative_groups;

#define LAS __attribute__((address_space(3)))
#define GAS __attribute__((address_space(1)))
typedef unsigned short bf16_t;
typedef short bf16x8 __attribute__((ext_vector_type(8)));
typedef short bf16x4 __attribute__((ext_vector_type(4)));
typedef float f32x4 __attribute__((ext_vector_type(4)));
typedef float f32x2 __attribute__((ext_vector_type(2)));
typedef unsigned u32x4 __attribute__((ext_vector_type(4)));
typedef unsigned u32x2 __attribute__((ext_vector_type(2)));
typedef _Float16 f16x8 __attribute__((ext_vector_type(8)));

constexpr int T = 65536, SEQ = 8192, D = 1024, FFD = 4096;
constexpr int LD0 = 3840, LD1 = 1536;
constexpr int C_GQ = 0, C_GK = 512, C_GV = 1024, C_GG = 1536, C_FQ = 2048, C_FK = 2560, C_FV = 3072, C_LR = 3584, C_FF = 3600;
constexpr float EPS = 1e-6f;
constexpr size_t MiB = 1u << 20;
constexpr size_t WS_CTL = 0, WS_WIN0 = 2 * MiB, WS_WOUT0 = 10 * MiB, WS_W1_0 = 12 * MiB, WS_W2_0 = 20 * MiB, WS_WIN1 = 28 * MiB, WS_WOUT1 = 31 * MiB,
                 WS_WGLU = 33 * MiB, WS_W1_1 = 34 * MiB, WS_W2_1 = 42 * MiB, WS_WSB = 50 * MiB, WS_MOD = 51 * MiB, WS_S5P = 52 * MiB, WS_CUM = 53 * MiB,
                 WS_H = 64 * MiB, WS_MIX = 192 * MiB, WS_BIG = 320 * MiB, WS_WB0 = 832 * MiB, WS_WB1 = 896 * MiB, WS_WB2 = 920 * MiB, WS_GLAE = 984 * MiB  , WS_GLAD = 990 * MiB  , WS_END = 992 * MiB;
constexpr size_t WS_PRM = 56 * MiB, WS_ROWSS = 57 * MiB  , WS_SHW = 61 * MiB  , WS_YS5 = WS_BIG + 256 * MiB;
constexpr int PR_WLR = 0, PR_BLR = 8192, PR_GGAIN = 8704, PR_BF = 9216, PR_QG = 9280, PR_KG = 9792, PR_S5D = 10304, PR_BGLU = 10816, PR_LNG = 11328, PR_LNB = 11840, PR_BS = 12352;
constexpr size_t S5_ABAR = 0, S5_BB = 16384, S5_CM = 16384 + 131072;
constexpr int LDS_BYTES = 147456;
constexpr int NT = 512;

struct Args { const float* in[30]; float* out; unsigned char* ws; };

typedef __bf16 bf16x2_t __attribute__((ext_vector_type(2)));
__device__ __forceinline__ unsigned pkbf(float lo, float hi) { f32x2 v = {lo, hi}; bf16x2_t b = __builtin_convertvector(v, bf16x2_t); return __builtin_bit_cast(unsigned, b); }
__device__ __forceinline__ float bflo(unsigned w) { return __uint_as_float(w << 16); }
__device__ __forceinline__ float bfhi(unsigned w) { return __uint_as_float(w & 0xffff0000u); }
__device__ __forceinline__ void unpack8(u32x4 w, float* f) { f[0] = bflo(w.x); f[1] = bfhi(w.x); f[2] = bflo(w.y); f[3] = bfhi(w.y); f[4] = bflo(w.z); f[5] = bfhi(w.z); f[6] = bflo(w.w); f[7] = bfhi(w.w); }
__device__ __forceinline__ float sigmoidf_(float x) { return 1.0f / (1.0f + __expf(-x)); }
__device__ __forceinline__ float siluf_(float x) { return x * sigmoidf_(x); }
__device__ __forceinline__ float gelu_tanh(float x) { const float u = 1.5957691216057308f * (x + 0.044715f * x * x * x); return x * sigmoidf_(u); }
__device__ __forceinline__ float logsig(float x) { return fminf(x, 0.f) - __logf(1.0f + __expf(-fabsf(x))); }
__device__ __forceinline__ int otid() { int t = threadIdx.x; asm volatile("" : "+v"(t)); return t; }
#define LDS_WAIT() asm volatile("s_waitcnt lgkmcnt(0)" ::: "memory")
#define BAR_LDS() do { asm volatile("s_waitcnt lgkmcnt(0)" ::: "memory"); __builtin_amdgcn_s_barrier(); asm volatile("" ::: "memory"); } while (0)
#define MFMA16(a, b, c) __builtin_amdgcn_mfma_f32_16x16x32_bf16((a), (b), (c), 0, 0, 0)
__device__ __forceinline__ bf16x8 as_bf16x8(u32x4 v) { return __builtin_bit_cast(bf16x8, v); }

namespace pg8 {
constexpr int BM = 256, BK = 64, HALF = 128, HTB = HALF * BK * 2, STAGE_BYTES = 8 * HTB, NXCD = 8, WGM = 8;
__device__ __forceinline__ int lds_byte(int r, int c) { const int st = (r >> 4) * 2 + (c >> 5), rr = r & 15, cc = c & 31, ob = rr * 64 + cc * 2; return st * 1024 + (ob ^ (((ob >> 9) & 1) << 5)); }
__device__ __forceinline__ void stage_rc(int b, int& R, int& C) { const int st = b / 1024, sb = b % 1024, swz = sb ^ (((sb >> 9) & 1) << 5); R = (st >> 1) * 16 + swz / 64; C = (st & 1) * 32 + (swz % 64) / 2; }
__device__ __forceinline__ int perm32(int rho) { const int n = rho >> 4, i = rho & 15; return 8 * (i >> 2) + 4 * n + (i & 3); }
struct Unit { int pm, pn; };
struct Gemm { const bf16_t* A; const bf16_t* Bt; int M, N, K; size_t bbatch; };
struct StaticOrder {
    int nM, nN, nwg, G, c;
    __device__ void init(int M, int N, int G_, int c_) { nM = M / BM; nN = N / BM; nwg = nM * nN; G = G_; c = c_; }
    __device__ bool next(int i, Unit& u) const {
        const long L = (long)i * G + c; if (L >= nwg) return false;
        int wgid = (int)L; { const int q = nwg / NXCD, r = nwg % NXCD, xcd = wgid % NXCD, off = wgid / NXCD; wgid = (xcd < r ? xcd * (q + 1) : r * (q + 1) + (xcd - r) * q) + off; }
        const int nig = WGM * nN, gid = wgid / nig, fm = gid * WGM, gsz = (nM - fm) < WGM ? (nM - fm) : WGM;
        u.pm = fm + ((wgid % nig) % gsz); u.pn = (wgid % nig) / gsz; return true;
    }
};

struct Epi {
    int mode, sub; GAS bf16_t* O; int ldc; const GAS float* base32; GAS float* out32; const GAS float* gate; const GAS bf16_t* Y; const GAS float* bias; GAS float* rowss; const GAS float* shw; int ldsh;
    template <int MODE> __device__ __forceinline__ void run(const f32x4 (&acc)[2][2][4][2], const Unit& u, int wr, int wc, int fr, int fq) const {
        constexpr int mode = MODE;
        const int row0 = u.pm * BM + wr * 64 + fr, col0 = u.pn * BM + wc * 32 + 8 * fq, bidx = (u.pm * BM) >> 13;
        if (mode >= 6) {
            const GAS float* gp = gate + (size_t)bidx * 6144 + col0;
            f32x4 gg[2][2];
#pragma unroll
            for (int bj = 0; bj < 2; ++bj) { gg[bj][0] = *(const GAS f32x4*)(gp + bj * HALF); gg[bj][1] = *(const GAS f32x4*)(gp + bj * HALF + 4); }
            if (mode == 6) {
#pragma unroll
                for (int ai = 0; ai < 2; ++ai)
#pragma unroll
                    for (int mh = 0; mh < 2; ++mh) { f32x4 bb[2][2][2];
#pragma unroll
                        for (int ml = 0; ml < 2; ++ml) { const size_t off = (size_t)(row0 + ai * HALF + (2 * mh + ml) * 16) * D + col0;
#pragma unroll
                            for (int bj = 0; bj < 2; ++bj) { bb[ml][bj][0] = __builtin_nontemporal_load((const GAS f32x4*)(base32 + off + bj * HALF)); bb[ml][bj][1] = __builtin_nontemporal_load((const GAS f32x4*)(base32 + off + bj * HALF + 4)); } }
#pragma unroll
                        for (int ml = 0; ml < 2; ++ml) { const int m = 2 * mh + ml; const size_t row = (size_t)(row0 + ai * HALF + m * 16), off = row * D + col0; float ss = 0.f;
#pragma unroll
                            for (int bj = 0; bj < 2; ++bj) { const f32x4 x0 = bb[ml][bj][0] + gg[bj][0] * acc[ai][bj][m][0], x1 = bb[ml][bj][1] + gg[bj][1] * acc[ai][bj][m][1];
                                ss += (x0[0] * x0[0] + x0[1] * x0[1]) + (x0[2] * x0[2] + x0[3] * x0[3]) + (x1[0] * x1[0] + x1[1] * x1[1]) + (x1[2] * x1[2] + x1[3] * x1[3]);
                                u32x4 w; w.x = pkbf(x0[0], x0[1]); w.y = pkbf(x0[2], x0[3]); w.z = pkbf(x1[0], x1[1]); w.w = pkbf(x1[2], x1[3]); *(GAS u32x4*)(O + off + bj * HALF) = w; }
                            ss += __shfl_xor(ss, 16); ss += __shfl_xor(ss, 32); if (fq == 0) rowss[row * 16 + u.pn * 4 + wc] = ss; }
                        asm volatile("" ::: "memory"); }
            } else {
#pragma unroll
                for (int ai = 0; ai < 2; ++ai) { u32x4 bw[4][2];
#pragma unroll
                    for (int m = 0; m < 4; ++m) { const size_t off = (size_t)(row0 + ai * HALF + m * 16) * D + col0;
#pragma unroll
                        for (int bj = 0; bj < 2; ++bj) bw[m][bj] = *(const GAS u32x4*)(O + off + bj * HALF); }
#pragma unroll
                    for (int m = 0; m < 4; ++m) { const size_t row = (size_t)(row0 + ai * HALF + m * 16), off = row * D + col0; float ss = 0.f;
#pragma unroll
                        for (int bj = 0; bj < 2; ++bj) { const u32x4 t = bw[m][bj];
                            const f32x4 b0 = (f32x4){bflo(t.x), bfhi(t.x), bflo(t.y), bfhi(t.y)}, b1 = (f32x4){bflo(t.z), bfhi(t.z), bflo(t.w), bfhi(t.w)};
                            const f32x4 x0 = b0 + gg[bj][0] * acc[ai][bj][m][0], x1 = b1 + gg[bj][1] * acc[ai][bj][m][1];
                            if (mode == 8) { __builtin_nontemporal_store(x0, (GAS f32x4*)(out32 + off + bj * HALF)); __builtin_nontemporal_store(x1, (GAS f32x4*)(out32 + off + bj * HALF + 4)); }
                            else { ss += (x0[0] * x0[0] + x0[1] * x0[1]) + (x0[2] * x0[2] + x0[3] * x0[3]) + (x1[0] * x1[0] + x1[1] * x1[1]) + (x1[2] * x1[2] + x1[3] * x1[3]);
                                u32x4 w; w.x = pkbf(x0[0], x0[1]); w.y = pkbf(x0[2], x0[3]); w.z = pkbf(x1[0], x1[1]); w.w = pkbf(x1[2], x1[3]); *(GAS u32x4*)(O + off + bj * HALF) = w; } }
                        if (mode != 8) { ss += __shfl_xor(ss, 16); ss += __shfl_xor(ss, 32); if (fq == 0) rowss[row * 16 + u.pn * 4 + wc] = ss; } }
                    asm volatile("" ::: "memory"); }
            }
        } else if (mode == 3) {
#pragma unroll
            for (int bj = 0; bj < 2; ++bj) {
                const f32x4 b0 = *(const GAS f32x4*)(bias + col0 + bj * HALF), b1 = *(const GAS f32x4*)(bias + col0 + bj * HALF + 4);
#pragma unroll
                for (int ai = 0; ai < 2; ++ai)
#pragma unroll
                    for (int m = 0; m < 4; ++m) { const size_t row = (size_t)(row0 + ai * HALF + m * 16);
                        const u32x4 yw = *(const GAS u32x4*)(Y + row * 512 + col0 + bj * HALF); float y[8]; unpack8(yw, y);
                        const f32x4 v0 = acc[ai][bj][m][0] + b0, v1 = acc[ai][bj][m][1] + b1; float o[8];
#pragma unroll
                        for (int j = 0; j < 4; ++j) { o[j] = y[j] * sigmoidf_(v0[j]); o[4 + j] = y[4 + j] * sigmoidf_(v1[j]); }
                        u32x4 w; w.x = pkbf(o[0], o[1]); w.y = pkbf(o[2], o[3]); w.z = pkbf(o[4], o[5]); w.w = pkbf(o[6], o[7]);
                        *(GAS u32x4*)(O + row * D + col0 + bj * HALF) = w; asm volatile("" ::: "memory"); } }
        } else {
            const bool act2 = (sub == 2) && (u.pn >= 2);
            float rr[8]; f32x4 sb[2][2];
#pragma unroll
            for (int j = 0; j < 8; ++j) rr[j] = 1.0f;
#pragma unroll
            for (int bj = 0; bj < 2; ++bj) { sb[bj][0] = (f32x4){0.f, 0.f, 0.f, 0.f}; sb[bj][1] = sb[bj][0]; }
            if (mode == 5) {
                const int lane = fq * 16 + fr; float slot[2];
                f32x4 pp[2][4];
#pragma unroll
                for (int h = 0; h < 2; ++h) { const int li = lane + 64 * h, am = li >> 4; const size_t row = (size_t)(u.pm * BM + (am >> 2) * HALF + wr * 64 + (am & 3) * 16 + (li & 15));
                    const GAS f32x4* rp = (const GAS f32x4*)(rowss + row * 16);
#pragma unroll
                    for (int k = 0; k < 4; ++k) pp[h][k] = rp[k]; }
                const GAS float* sp = shw + (size_t)bidx * ldsh + col0;
#pragma unroll
                for (int bj = 0; bj < 2; ++bj) { sb[bj][0] = *(const GAS f32x4*)(sp + bj * HALF); sb[bj][1] = *(const GAS f32x4*)(sp + bj * HALF + 4); }
#pragma unroll
                for (int h = 0; h < 2; ++h) { const f32x4 s = (pp[h][0] + pp[h][1]) + (pp[h][2] + pp[h][3]); slot[h] = rsqrtf(((s[0] + s[1]) + (s[2] + s[3])) * (1.0f / D) + EPS); }
#pragma unroll
                for (int j = 0; j < 8; ++j) rr[j] = __shfl(slot[j >> 2], (j & 3) * 16 + fr);
            }
#pragma unroll
            for (int ai = 0; ai < 2; ++ai)
#pragma unroll
                for (int m = 0; m < 4; ++m) { const size_t row = (size_t)(row0 + ai * HALF + m * 16); GAS bf16_t* rowp = O + row * ldc + col0; const float r = rr[ai * 4 + m];
#pragma unroll
                    for (int bj = 0; bj < 2; ++bj) { f32x4 v0 = acc[ai][bj][m][0], v1 = acc[ai][bj][m][1];
                        if (mode == 5) { v0 = v0 * r + sb[bj][0]; v1 = v1 * r + sb[bj][1]; }
                        if (sub == 1) {
#pragma unroll
                            for (int j = 0; j < 4; ++j) { const float a0 = fmaxf(v0[j], 0.f), a1 = fmaxf(v1[j], 0.f); v0[j] = a0 * a0; v1[j] = a1 * a1; } }
                        if (act2) {
#pragma unroll
                            for (int j = 0; j < 4; ++j) { v0[j] = gelu_tanh(v0[j]); v1[j] = gelu_tanh(v1[j]); } }
                        u32x4 w; w.x = pkbf(v0[0], v0[1]); w.y = pkbf(v0[2], v0[3]); w.z = pkbf(v1[0], v1[1]); w.w = pkbf(v1[2], v1[3]);
                        __builtin_nontemporal_store(w, (GAS u32x4*)(rowp + bj * HALF)); }
                    asm volatile("" ::: "memory"); }
        }
    }
};

template <int MODE>
__device__ __forceinline__ void gemm_phase(LAS unsigned char* lds, const Gemm g, const StaticOrder& S, const Epi& E) {

    const int tid = otid(), wid = __builtin_amdgcn_readfirstlane(tid >> 6), lane = tid & 63, wr = wid >> 2, wc = wid & 3, fr = lane & 15, fq = lane >> 4;
    const int K = g.K, nt = K / BK;
    unsigned voffA[2], voffB[2];
#pragma unroll
    for (int i = 0; i < 2; ++i) { int R, C; stage_rc(tid * 16 + i * 8192, R, C); const int Rb = (R & ~31) + perm32(R & 31);
        voffA[i] = (unsigned)(R * K + C) * 2u; voffB[i] = (unsigned)(Rb * K + C) * 2u; }
    const size_t kstep = (size_t)(BK * 2);
    const size_t hstep = (size_t)HALF * K * 2;
    const size_t tstep = 2 * hstep;
    const unsigned ldsw = (unsigned)wid * 1024u;
    const int aoff = lds_byte(wr * 64 + fr, fq * 8), boff = lds_byte(wc * 32 + fr, fq * 8);
    const unsigned ldsbase = (unsigned)(unsigned long)lds;
#define PG8_SA(b, h) (((b) * 2 + (h)) * HTB)
#define PG8_SB(b, h) ((4 + (b) * 2 + (h)) * HTB)
#define PG8_STAGE(bufoff, gbase, voff) do { _Pragma("unroll") for (int _i = 0; _i < 2; ++_i) \
        __builtin_amdgcn_global_load_lds((const unsigned*)((const char*)(gbase) + (voff)[_i]), (LAS unsigned*)(lds + (bufoff) + ldsw + _i * 8192), 16, 0, 0); } while (0)
#define PG8_LDA(dst, b, h) do { _Pragma("unroll") for (int m = 0; m < 4; ++m) _Pragma("unroll") for (int k = 0; k < 2; ++k) dst[m][k] = *(const LAS bf16x8*)(lds + PG8_SA(b, h) + aoff + m * 2048 + k * 1024); } while (0)
#define PG8_LDB(dst, b, h) do { _Pragma("unroll") for (int n = 0; n < 2; ++n) _Pragma("unroll") for (int k = 0; k < 2; ++k) dst[n][k] = *(const LAS bf16x8*)(lds + PG8_SB(b, h) + boff + n * 2048 + k * 1024); } while (0)
#define PG8_MMA(ai, bj, At, Bt) do { __builtin_amdgcn_s_setprio(1); _Pragma("unroll") for (int m = 0; m < 4; ++m) _Pragma("unroll") for (int n = 0; n < 2; ++n) _Pragma("unroll") for (int k = 0; k < 2; ++k) \
        acc[ai][bj][m][n] = __builtin_amdgcn_mfma_f32_16x16x32_bf16(Bt[n][k], At[m][k], acc[ai][bj][m][n], 0, 0, 0); __builtin_amdgcn_s_setprio(0); } while (0)
#define PG8_WAIT_V(n) asm volatile("s_waitcnt vmcnt(" #n ")" ::: "memory")
#define PG8_WAIT_L(n) asm volatile("s_waitcnt lgkmcnt(" #n ")" ::: "memory")
#define PG8_BAR __builtin_amdgcn_s_barrier()
#define PG8_SCHED __builtin_amdgcn_sched_barrier(0)
    Unit cur, nxt; int ui = 0;
    if (!S.next(0, cur)) return;
#ifdef STAGGER_US
    if ((blockIdx.x >> 3) & 1) {
        const unsigned long long t0 = __builtin_amdgcn_s_memrealtime();
        while (__builtin_amdgcn_s_memrealtime() - t0 < (unsigned long long)(STAGGER_US * 100)) __builtin_amdgcn_s_sleep(8);
    }
#endif
    f32x4 acc[2][2][4][2];
#pragma unroll
    for (int a = 0; a < 2; ++a)
#pragma unroll
        for (int b = 0; b < 2; ++b)
#pragma unroll
            for (int m = 0; m < 4; ++m)
#pragma unroll
                for (int n = 0; n < 2; ++n) acc[a][b][m][n] = (f32x4){0.f, 0.f, 0.f, 0.f};
    bf16x8 At[4][2], B0[2][2], B1[2][2];
    const char* cA = (const char*)g.A + (size_t)cur.pm * tstep; const char* cB = (const char*)g.Bt + (size_t)cur.pn * tstep + (size_t)(cur.pm >> 5) * g.bbatch;
    PG8_STAGE(PG8_SB(0, 0), cB, voffB); PG8_STAGE(PG8_SA(0, 0), cA, voffA); PG8_STAGE(PG8_SB(0, 1), cB + hstep, voffB); PG8_STAGE(PG8_SA(0, 1), cA + hstep, voffA);
    if (wr == 1) PG8_BAR;
    PG8_WAIT_V(4); PG8_BAR;
    PG8_STAGE(PG8_SB(1, 0), cB + kstep, voffB); PG8_STAGE(PG8_SA(1, 0), cA + kstep, voffA); PG8_STAGE(PG8_SB(1, 1), cB + hstep + kstep, voffB);
    PG8_WAIT_V(6); PG8_BAR;
    for (;;) {
        const bool has_next = S.next(ui + 1, nxt);
        const char* nA = has_next ? (const char*)g.A + (size_t)nxt.pm * tstep : cA; const char* nB = has_next ? (const char*)g.Bt + (size_t)nxt.pn * tstep + (size_t)(nxt.pm >> 5) * g.bbatch : cB;
        for (int t = 0; t < nt; t += 2) {
            const bool last = (t == nt - 2);
            const char* a1 = cA + (size_t)(t + 1) * kstep;
            const char* a2 = last ? nA : cA + (size_t)(t + 2) * kstep; const char* b2 = last ? nB : cB + (size_t)(t + 2) * kstep;
            const char* a3 = a2 + kstep; const char* b3 = b2 + kstep;
            PG8_LDB(B0, 0, 0); PG8_SCHED; PG8_LDA(At, 0, 0); PG8_STAGE(PG8_SA(1, 1), a1 + hstep, voffA);
            PG8_WAIT_L(8); PG8_BAR; PG8_WAIT_L(0); PG8_MMA(0, 0, At, B0); PG8_BAR; PG8_SCHED;
            PG8_LDB(B1, 0, 1); PG8_STAGE(PG8_SB(0, 0), b2, voffB);
            PG8_BAR; PG8_WAIT_L(0); PG8_MMA(0, 1, At, B1); PG8_BAR;
            PG8_LDA(At, 0, 1); PG8_STAGE(PG8_SA(0, 0), a2, voffA);
            PG8_BAR; PG8_WAIT_L(0); PG8_MMA(1, 0, At, B0); PG8_BAR; PG8_SCHED;
            PG8_STAGE(PG8_SB(0, 1), b2 + hstep, voffB);
            PG8_WAIT_V(6); PG8_BAR; PG8_MMA(1, 1, At, B1); PG8_BAR;
            PG8_LDB(B0, 1, 0); PG8_SCHED; PG8_LDA(At, 1, 0); PG8_STAGE(PG8_SA(0, 1), a2 + hstep, voffA);
            PG8_WAIT_L(8); PG8_BAR; PG8_WAIT_L(0); PG8_MMA(0, 0, At, B0); PG8_BAR; PG8_SCHED;
            PG8_LDB(B1, 1, 1); PG8_STAGE(PG8_SB(1, 0), b3, voffB);
            PG8_BAR; PG8_WAIT_L(0); PG8_MMA(0, 1, At, B1); PG8_BAR;
            PG8_LDA(At, 1, 1); PG8_STAGE(PG8_SA(1, 0), a3, voffA);
            PG8_BAR; PG8_WAIT_L(0); PG8_MMA(1, 0, At, B0); PG8_BAR; PG8_SCHED;
            PG8_STAGE(PG8_SB(1, 1), b3 + hstep, voffB);
            PG8_WAIT_V(6); PG8_BAR; PG8_MMA(1, 1, At, B1); PG8_BAR;
        }
        E.template run<MODE>(acc, cur, wr, wc, fr, fq);
        if (!has_next) break;
#pragma unroll
        for (int a = 0; a < 2; ++a)
#pragma unroll
            for (int b = 0; b < 2; ++b)
#pragma unroll
                for (int m = 0; m < 4; ++m)
#pragma unroll
                    for (int n = 0; n < 2; ++n) acc[a][b][m][n] = (f32x4){0.f, 0.f, 0.f, 0.f};
        cur = nxt; cA = nA; cB = nB; ++ui;
    }
    PG8_WAIT_V(0);
    if (wr == 0) PG8_BAR;
    PG8_BAR;
#undef PG8_SA
#undef PG8_SB
#undef PG8_STAGE
#undef PG8_LDA
#undef PG8_LDB
#undef PG8_MMA
#undef PG8_WAIT_V
#undef PG8_WAIT_L
#undef PG8_BAR
#undef PG8_SCHED
}

}

__device__ __forceinline__ void tr_item(const float* W, int ldw, int ncol0, int K, int nblk, bf16_t* WT, int row_off, LAS float* scr, int item, int lane) {
    const int kb = item / nblk, nb = item % nblk, k0 = 64 * kb, n0 = 32 * nb;
    float tv[32];
#pragma unroll
    for (int i = 0; i < 32; ++i) tv[i] = W[(size_t)(k0 + 2 * i + (lane >> 5)) * ldw + ncol0 + n0 + (lane & 31)];
#pragma unroll
    for (int i = 0; i < 32; ++i) scr[(2 * i + (lane >> 5)) * 33 + (lane & 31)] = tv[i];
    LDS_WAIT();
    const int c = lane & 7;
#pragma unroll
    for (int j = 0; j < 4; ++j) { const int n = (lane >> 3) + 8 * j; const LAS float* s = scr + (8 * c) * 33 + n;
        u32x4 o; o.x = pkbf(s[0 * 33], s[1 * 33]); o.y = pkbf(s[2 * 33], s[3 * 33]); o.z = pkbf(s[4 * 33], s[5 * 33]); o.w = pkbf(s[6 * 33], s[7 * 33]);
        *(u32x4*)(WT + (size_t)(row_off + n0 + n) * K + k0 + 8 * c) = o; }
    LDS_WAIT();
}

__device__ __forceinline__ void p0_prologue(const Args& a, LAS unsigned char* lds) {
    const int tid = otid(), lane = tid & 63, wave = __builtin_amdgcn_readfirstlane(tid >> 6);
    unsigned char* ws = a.ws;
    if (blockIdx.x < 192) {
        LAS float* cact = (LAS float*)lds;
        LAS float* red = (LAS float*)(lds + 32768);
        const float* c = a.in[1];
        for (int i = tid; i < 8192; i += NT) cact[i] = siluf_(c[i]);
        __syncthreads();
        const int item = blockIdx.x, layer = item / 96, e = 64 * (item % 96) + lane;
        const float* wp = a.in[2] + (size_t)layer * D * 6144 + e;
        float acc[8];
#pragma unroll
        for (int b = 0; b < 8; ++b) acc[b] = 0.f;
        for (int k0 = wave * 128; k0 < wave * 128 + 128; k0 += 32) {
            float wv[32];
#pragma unroll
            for (int i = 0; i < 32; ++i) wv[i] = wp[(size_t)(k0 + i) * 6144];
#pragma unroll
            for (int i = 0; i < 32; ++i)
#pragma unroll
                for (int b = 0; b < 8; ++b) acc[b] += cact[b * 1024 + k0 + i] * wv[i];
        }
#pragma unroll
        for (int b = 0; b < 8; ++b) red[(wave * 8 + b) * 64 + lane] = acc[b];
        __syncthreads();
        { const int b = tid >> 6; float s = 0.f;
#pragma unroll
          for (int w = 0; w < 8; ++w) s += red[(w * 8 + b) * 64 + lane];
          ((float*)(ws + WS_MOD))[(size_t)(layer * 8 + b) * 6144 + e] = s + a.in[3][layer * 6144 + e]; }
        __syncthreads();
    }
    {
        LAS float* scr = (LAS float*)(lds + wave * 16384);
        const int gw = blockIdx.x * 8 + wave, NGW = gridDim.x * 8;
        constexpr int I0 = 16 * 64, I1 = 16 * 48, I2 = 16 * 32, I3 = 16 * 128, I4 = 64 * 32, I5 = 16 * 48, I6 = 16 * 32, I7 = 8 * 16, I8 = I3, I9 = I4;
        constexpr int NIT = I0 + I1 + I2 + I3 + I4 + I5 + I6 + I7 + I8 + I9;
        for (int it = gw; it < NIT; it += NGW) {
            int r = it;
            if (r < I0) { tr_item(a.in[4], 3608, 0, 1024, 64, (bf16_t*)(ws + WS_WIN0), 0, scr, r, lane); continue; } r -= I0;
            if (r < I1) { tr_item(a.in[4], 3608, 2064, 1024, 48, (bf16_t*)(ws + WS_WIN0), 2048, scr, r, lane); continue; } r -= I1;
            if (r < I2) { tr_item(a.in[5], 1024, 0, 1024, 32, (bf16_t*)(ws + WS_WOUT0), 0, scr, r, lane); continue; } r -= I2;
            if (r < I3) { tr_item(a.in[28], 4096, 0, 1024, 128, (bf16_t*)(ws + WS_W1_0), 0, scr, r, lane); continue; } r -= I3;
            if (r < I4) { tr_item(a.in[29], 1024, 0, 4096, 32, (bf16_t*)(ws + WS_W2_0), 0, scr, r, lane); continue; } r -= I4;
            if (r < I5) { tr_item(a.in[12], 1536, 0, 1024, 48, (bf16_t*)(ws + WS_WIN1), 0, scr, r, lane); continue; } r -= I5;
            if (r < I6) { tr_item(a.in[13], 1024, 0, 1024, 32, (bf16_t*)(ws + WS_WOUT1), 0, scr, r, lane); continue; } r -= I6;
            if (r < I7) { tr_item(a.in[22], 512, 0, 512, 16, (bf16_t*)(ws + WS_WGLU), 0, scr, r, lane); continue; } r -= I7;
            if (r < I8) { tr_item(a.in[28] + (size_t)D * FFD, 4096, 0, 1024, 128, (bf16_t*)(ws + WS_W1_1), 0, scr, r, lane); continue; } r -= I8;
            tr_item(a.in[29] + (size_t)D * FFD, 1024, 0, 4096, 32, (bf16_t*)(ws + WS_W2_1), 0, scr, r, lane);
        }
    }
    {
        if (blockIdx.x == 0 && tid == 0) { unsigned* ctl = (unsigned*)(ws + WS_CTL); __hip_atomic_store(ctl, 0u, __ATOMIC_RELAXED, __HIP_MEMORY_SCOPE_AGENT); __hip_atomic_store(ctl + 64, 0u, __ATOMIC_RELAXED, __HIP_MEMORY_SCOPE_AGENT); }
        const int gt = blockIdx.x * NT + tid, NGT = gridDim.x * NT;
        bf16_t* win0 = (bf16_t*)(ws + WS_WIN0);
        for (int i = gt; i < 256 * 1024; i += NGT) { const int n = i >> 10, k = i & 1023; float v = 0.f;
            if (n < 16) v = a.in[4][(size_t)k * 3608 + 2048 + n]; else if (n < 24) v = a.in[4][(size_t)k * 3608 + 3600 + (n - 16)];
            win0[(size_t)(3584 + n) * 1024 + k] = (bf16_t)(pkbf(v, 0.f) & 0xffffu); }
        bf16_t* wsb = (bf16_t*)(ws + WS_WSB);
        for (int i = gt; i < 8 * 128 * 128; i += NGT) { const int t = (i >> 7) & 127, s = i & 127; const float v = (s <= t) ? a.in[26][i] : 0.f; wsb[i] = (bf16_t)(pkbf(v, 0.f) & 0xffffu); }
        { float* prm = (float*)(ws + WS_PRM);
          for (int i = gt; i < 8192; i += NGT) prm[PR_WLR + i] = a.in[6][i];
          for (int i = gt; i < 1024; i += NGT) prm[PR_BS + i] = a.in[27][i];
          for (int i = gt; i < 512; i += NGT) { prm[PR_BLR + i] = a.in[7][i]; prm[PR_GGAIN + i] = a.in[8][i]; prm[PR_QG + i] = a.in[10][i]; prm[PR_KG + i] = a.in[11][i]; prm[PR_S5D + i] = a.in[21][i];
              prm[PR_BGLU + i] = a.in[23][i]; prm[PR_LNG + i] = a.in[24][i]; prm[PR_LNB + i] = a.in[25][i]; }
          for (int i = gt; i < 8; i += NGT) prm[PR_BF + i] = a.in[9][i]; }
        float* abar = (float*)(ws + WS_S5P + S5_ABAR); bf16_t* Bb = (bf16_t*)(ws + WS_S5P + S5_BB); bf16_t* Cm = (bf16_t*)(ws + WS_S5P + S5_CM);
        for (int i = gt; i < 32 * 64; i += NGT) { const int g = i >> 6, p = i & 63;
            const float lr = a.in[14][i], li = a.in[15][i], dt = expf(a.in[16][g]);
            const float mag = expf(lr * dt), ang = li * dt, ar = mag * cosf(ang), ai = mag * sinf(ang), den = lr * lr + li * li;
            const float cr = ((ar - 1.0f) * lr + ai * li) / den, ci = (ai * lr - (ar - 1.0f) * li) / den;
            abar[2 * i] = ar; abar[2 * i + 1] = ai;
            for (int k = 0; k < 16; ++k) { const float br = a.in[17][(size_t)i * 16 + k], bi = a.in[18][(size_t)i * 16 + k];
                Bb[((size_t)g * 128 + 2 * p) * 16 + k] = (bf16_t)(pkbf(cr * br - ci * bi, 0.f) & 0xffffu);
                Bb[((size_t)g * 128 + 2 * p + 1) * 16 + k] = (bf16_t)(pkbf(cr * bi + ci * br, 0.f) & 0xffffu); } }
        for (int i = gt; i < 32 * 16 * 64; i += NGT) { const int gi = i >> 6, p = i & 63;
            Cm[(size_t)gi * 128 + 2 * p] = (bf16_t)(pkbf(a.in[19][i], 0.f) & 0xffffu); Cm[(size_t)gi * 128 + 2 * p + 1] = (bf16_t)(pkbf(-a.in[20][i], 0.f) & 0xffffu); }
    }
}

__device__ __forceinline__ void norm_phase(const float* x, const float* mod, int off_sh, int off_sc, bf16_t* H) {
    const int tid_ = otid(); const int lane = tid_ & 63, gw = blockIdx.x * 8 + (tid_ >> 6), NGW = gridDim.x * 8;
    for (int m = gw; m < T; m += NGW) {
        const GAS f32x4* xr = (const GAS f32x4*)(x + (size_t)m * D) + lane;
        const GAS float* mp = (const GAS float*)mod + (size_t)(m >> 13) * 6144;
        f32x4 v[4]; float s = 0.f;
#pragma unroll
        for (int j = 0; j < 4; ++j) { v[j] = __builtin_nontemporal_load(xr + 64 * j); s += (v[j].x * v[j].x + v[j].y * v[j].y) + (v[j].z * v[j].z + v[j].w * v[j].w); }
#pragma unroll
        for (int o = 1; o < 64; o <<= 1) s += __shfl_xor(s, o);
        const float r = rsqrtf(s * (1.0f / D) + EPS);
        GAS u32x2* o8 = (GAS u32x2*)(H + (size_t)m * D) + lane;
#pragma unroll
        for (int j = 0; j < 4; ++j) { const f32x4 sc = *((const GAS f32x4*)(mp + off_sc) + lane + 64 * j), sh = *((const GAS f32x4*)(mp + off_sh) + lane + 64 * j);
            const f32x4 y = v[j] * r * (sc + 1.0f) + sh; u32x2 w; w.x = pkbf(y.x, y.y); w.y = pkbf(y.z, y.w); o8[64 * j] = w; }
    }
}

__device__ __forceinline__ void prep_item(unsigned char* ws, LAS unsigned char* lds, int item) {
    const int tid = otid(), lane = tid & 63, wave = tid >> 6;
    const GAS float* mod = (const GAS float*)(ws + WS_MOD);
    LAS float* sc = (LAS float*)lds; LAS float* sh = (LAS float*)(lds + 32768);
    const int site = item < 64 ? 0 : (item < 88 ? 1 : 2), rb = item < 64 ? item : (item < 88 ? item - 64 : item - 88);
    const int N = (site == 1) ? LD1 : FFD, layer = site ? 1 : 0, osc = (site == 1) ? 1024 : 4096, osh = (site == 1) ? 0 : 3072;
    const GAS bf16_t* Wt = (const GAS bf16_t*)(ws + (site == 0 ? WS_W1_0 : site == 1 ? WS_WIN1 : WS_W1_1));
    GAS bf16_t* WB = (GAS bf16_t*)(ws + (site == 0 ? WS_WB0 : site == 1 ? WS_WB1 : WS_WB2));
    GAS float* shw = (GAS float*)(ws + WS_SHW) + (size_t)site * 8 * 4096;
    for (int i = tid; i < 8192; i += NT) { const int b = i >> 10, k = i & 1023; const GAS float* mp = mod + (size_t)(layer * 8 + b) * 6144; sc[i] = 1.0f + mp[osc + k]; sh[i] = mp[osh + k]; }
    __syncthreads();
    for (int n = 64 * rb + wave; n < 64 * rb + 64; n += 8) {
        const u32x4 w0 = *(const GAS u32x4*)(Wt + (size_t)n * D + 16 * lane), w1 = *(const GAS u32x4*)(Wt + (size_t)n * D + 16 * lane + 8);
        float wv[16]; unpack8(w0, wv); unpack8(w1, wv + 8);
#pragma unroll 1
        for (int b = 0; b < 8; ++b) { float o[16]; float dot = 0.f;
#pragma unroll
            for (int i4 = 0; i4 < 4; ++i4) { const f32x4 s4 = *(const LAS f32x4*)(sc + b * 1024 + 16 * lane + 4 * i4), h4 = *(const LAS f32x4*)(sh + b * 1024 + 16 * lane + 4 * i4);
#pragma unroll
                for (int j = 0; j < 4; ++j) { o[4 * i4 + j] = wv[4 * i4 + j] * s4[j]; dot += wv[4 * i4 + j] * h4[j]; } }
            u32x4 p0, p1; p0.x = pkbf(o[0], o[1]); p0.y = pkbf(o[2], o[3]); p0.z = pkbf(o[4], o[5]); p0.w = pkbf(o[6], o[7]); p1.x = pkbf(o[8], o[9]); p1.y = pkbf(o[10], o[11]); p1.z = pkbf(o[12], o[13]); p1.w = pkbf(o[14], o[15]);
            GAS bf16_t* dst = WB + ((size_t)b * N + n) * D + 16 * lane; *(GAS u32x4*)dst = p0; *(GAS u32x4*)(dst + 8) = p1;
#pragma unroll
            for (int o2 = 1; o2 < 64; o2 <<= 1) dot += __shfl_xor(dot, o2);
            if (lane == 0) shw[(size_t)b * N + n] = dot; }
    }
}

__device__ __forceinline__ void cum_phase(unsigned char* ws, LAS unsigned char* lds) {
    if (blockIdx.x >= 8) {
        const int tid = otid(), lane = tid & 63, w = __builtin_amdgcn_readfirstlane(tid >> 6);
        const GAS bf16_t* P0 = (const GAS bf16_t*)(ws + WS_BIG); GAS _Float16* BC = (GAS _Float16*)(ws + WS_H); const GAS float* prm = (const GAS float*)(ws + WS_PRM);
        LAS float* wl = (LAS float*)lds; LAS float* blr = (LAS float*)(lds + 32768);
        for (int i = tid; i < 8192; i += NT) wl[i] = prm[PR_WLR + i];
        blr[tid] = prm[PR_BLR + tid];
        __syncthreads();
        for (int item = blockIdx.x - 8; item < T / 64; item += gridDim.x - 8) {
            const size_t m = (size_t)item * 64 + lane;
            const u32x4 rl0 = *(const GAS u32x4*)(P0 + m * LD0 + C_LR), rl1 = *(const GAS u32x4*)(P0 + m * LD0 + C_LR + 8);
            float glr[16]; unpack8(rl0, glr); unpack8(rl1, glr + 8);
#pragma unroll 1
            for (int h = 0; h < 8; ++h) {
                f32x4 z0 = *(const LAS f32x4*)(blr + 64 * h + 8 * w), z1 = *(const LAS f32x4*)(blr + 64 * h + 8 * w + 4);
#pragma unroll
                for (int r = 0; r < 16; ++r) { const f32x4 w0 = *(const LAS f32x4*)(wl + r * 512 + 64 * h + 8 * w), w1 = *(const LAS f32x4*)(wl + r * 512 + 64 * h + 8 * w + 4); z0 += w0 * glr[r]; z1 += w1 * glr[r]; }
                float bc[8];
#pragma unroll
                for (int j = 0; j < 4; ++j) { bc[j] = logsig(z0[j]) * 0.0625f; bc[4 + j] = logsig(z1[j]) * 0.0625f; }
#pragma unroll
                for (int d = 1; d < 64; d <<= 1) {
#pragma unroll
                    for (int j = 0; j < 8; ++j) { const float o = __shfl_up(bc[j], d); if (lane >= d) bc[j] += o; } }
                f16x8 hb;
#pragma unroll
                for (int j = 0; j < 8; ++j) hb[j] = (_Float16)bc[j];
                *(GAS f16x8*)(BC + m * 512 + 64 * h + 8 * w) = hb;
            }
        }
        return;
    }
    const int b = blockIdx.x, tid = otid(), lane = tid & 63, wave = tid >> 6;
    const bf16_t* P0 = (const bf16_t*)(ws + WS_BIG); float* cum = (float*)(ws + WS_CUM);
    LAS float* wt = (LAS float*)lds;
    float bf[8];
#pragma unroll
    for (int h = 0; h < 8; ++h) bf[h] = ((const float*)(ws + WS_PRM))[PR_BF + h];
    float run[8];
#pragma unroll
    for (int h = 0; h < 8; ++h) run[h] = 0.f;
    const size_t m0 = (size_t)b * SEQ + 16 * tid;
    for (int i = 0; i < 16; ++i) { const u32x4 w = *(const u32x4*)(P0 + (m0 + i) * LD0 + C_FF); float f[8]; unpack8(w, f);
#pragma unroll
        for (int h = 0; h < 8; ++h) run[h] += logsig(f[h] + bf[h]); }
    float incl[8];
#pragma unroll
    for (int h = 0; h < 8; ++h) { float v = run[h];
#pragma unroll
        for (int d = 1; d < 64; d <<= 1) { const float o = __shfl_up(v, d); if (lane >= d) v += o; }
        incl[h] = v; }
    if (lane == 63) {
#pragma unroll
        for (int h = 0; h < 8; ++h) wt[wave * 8 + h] = incl[h]; }
    __syncthreads();
    float off[8];
#pragma unroll
    for (int h = 0; h < 8; ++h) { float o = incl[h] - run[h]; for (int w = 0; w < wave; ++w) o += wt[w * 8 + h]; off[h] = o; }
    for (int i = 0; i < 16; ++i) { const u32x4 w = *(const u32x4*)(P0 + (m0 + i) * LD0 + C_FF); float f[8]; unpack8(w, f);
#pragma unroll
        for (int h = 0; h < 8; ++h) { off[h] += logsig(f[h] + bf[h]); cum[(size_t)(b * 8 + h) * SEQ + 16 * tid + i] = off[h]; } }
}

__device__ __forceinline__ int q_next(unsigned* ctr, LAS int* slot) {
    __syncthreads();
    if (threadIdx.x == 0) *slot = (int)atomicAdd(ctr, 1u);
    __syncthreads();
    return *slot;
}

#ifndef GLA_NSEG
static_assert(true, "");
#define GLA_NSEG 2
#endif
#define GLA_CPS (128 / GLA_NSEG)
__device__ __forceinline__ void gla_item(unsigned char* ws, LAS unsigned char* lds, int b, int h, int seg) {
    const int tid = otid(), lane = tid & 63, w = __builtin_amdgcn_readfirstlane(tid >> 6), c = lane & 15, q = lane >> 4;
    const GAS bf16_t* P0 = (const GAS bf16_t*)(ws + WS_BIG); GAS bf16_t* MIX = (GAS bf16_t*)(ws + WS_MIX); const GAS _Float16* BC = (const GAS _Float16*)(ws + WS_H); const GAS float* prm = (const GAS float*)(ws + WS_PRM);
    LAS bf16_t* Qp = (LAS bf16_t*)(lds); LAS bf16_t* Kp = (LAS bf16_t*)(lds + 9216); LAS bf16_t* Kt = (LAS bf16_t*)(lds + 18432); LAS bf16_t* Vt = (LAS bf16_t*)(lds + 27648);
    LAS bf16_t* Pm = (LAS bf16_t*)(lds + 36864); LAS bf16_t* St = (LAS bf16_t*)(lds + 46080); LAS float* dec = (LAS float*)(lds + 55296);
    LAS float* wl = (LAS float*)(lds + 55552); LAS float* blr = (LAS float*)(lds + 59648);
    for (int i = tid; i < 2304; i += NT) ((LAS unsigned*)St)[i] = 0u;
    float gain[16];
#pragma unroll
    for (int vi = 0; vi < 4; ++vi)
#pragma unroll
        for (int j = 0; j < 4; ++j) gain[vi * 4 + j] = prm[PR_GGAIN + h * 64 + 16 * vi + 4 * q + j];
    f32x4 sacc[4];
#pragma unroll
    for (int vi = 0; vi < 4; ++vi) sacc[vi] = (f32x4){0.f, 0.f, 0.f, 0.f};
    const size_t rowbase = (size_t)b * SEQ;
    u32x4 rq, rk, rv; f16x8 rbh, reh; u32x2 rg[4];
#define GLA_LOAD(ch_) do { const size_t m_ = rowbase + 64 * (ch_) + lane; const GAS bf16_t* p = P0 + m_ * LD0; \
        rq = *(const GAS u32x4*)(p + C_GQ + 64 * h + 8 * w); rk = *(const GAS u32x4*)(p + C_GK + 64 * h + 8 * w); rv = *(const GAS u32x4*)(p + C_GV + 64 * h + 8 * w); \
        rbh = *(const GAS f16x8*)(BC + m_ * 512 + 64 * h + 8 * w); reh = *(const GAS f16x8*)(BC + (rowbase + 64 * (ch_) + 63) * 512 + 64 * h + 8 * w); \
        if (w < 4) { const GAS bf16_t* pg = P0 + (rowbase + 64 * (ch_) + 16 * w + c) * LD0 + C_GG + 64 * h + 4 * q; _Pragma("unroll") for (int vi_ = 0; vi_ < 4; ++vi_) rg[vi_] = *(const GAS u32x2*)(pg + 16 * vi_); } } while (0)
    const int c0 = GLA_CPS * seg, item = (b * 8 + h) * 4 + seg;
    GAS float* EG = (GAS float*)(ws + WS_GLAE); GAS float* DG = (GAS float*)(ws + WS_GLAD); unsigned* flags = (unsigned*)(ws + WS_CTL) + 8192;
    __syncthreads();
    if (seg < GLA_NSEG - 1) {
        float sumbl[8];
#pragma unroll
        for (int j = 0; j < 8; ++j) sumbl[j] = 0.f;
        GLA_LOAD(c0);
        for (int ch = c0; ch < c0 + GLA_CPS; ++ch) {
            {
                const float bc[8] = {(float)rbh[0], (float)rbh[1], (float)rbh[2], (float)rbh[3], (float)rbh[4], (float)rbh[5], (float)rbh[6], (float)rbh[7]};
                const float bl[8] = {(float)reh[0], (float)reh[1], (float)reh[2], (float)reh[3], (float)reh[4], (float)reh[5], (float)reh[6], (float)reh[7]};
                float kf[8]; unpack8(rk, kf);
                const unsigned vv[4] = {rv.x, rv.y, rv.z, rv.w};
#pragma unroll
                for (int j = 0; j < 8; ++j) { sumbl[j] += bl[j]; Kt[(8 * w + j) * 72 + lane] = (bf16_t)(pkbf(kf[j] * __expf(bl[j] - bc[j]), 0.f) & 0xffffu); Vt[(8 * w + j) * 72 + lane] = (bf16_t)((j & 1) ? (vv[j >> 1] >> 16) : (vv[j >> 1] & 0xffffu)); }
                if (lane == 63) {
#pragma unroll
                    for (int j = 0; j < 8; ++j) dec[8 * w + j] = __expf(bl[j]); }
            }
            if (ch + 1 < c0 + GLA_CPS) GLA_LOAD(ch + 1);
            BAR_LDS();
            if (w >= 4) {
                const int ki = w - 4;
                const f32x4 d4 = *(const LAS f32x4*)(dec + 16 * ki + 4 * q);
                const bf16x8 k0 = *(const LAS bf16x8*)(Kt + (16 * ki + c) * 72 + 8 * q), k1 = *(const LAS bf16x8*)(Kt + (16 * ki + c) * 72 + 8 * q + 32);
#pragma unroll
                for (int vi = 0; vi < 4; ++vi) { const bf16x8 v0 = *(const LAS bf16x8*)(Vt + (16 * vi + c) * 72 + 8 * q), v1 = *(const LAS bf16x8*)(Vt + (16 * vi + c) * 72 + 8 * q + 32);
                    f32x4 s2 = sacc[vi] * d4; s2 = MFMA16(k0, v0, s2); s2 = MFMA16(k1, v1, s2); sacc[vi] = s2; }
            }
            BAR_LDS();
        }
        if (w >= 4) { const int ki = w - 4; GAS float* ep = EG + (size_t)item * 4096;
#pragma unroll
            for (int vi = 0; vi < 4; ++vi)
#pragma unroll
                for (int j = 0; j < 4; ++j) ep[(16 * ki + 4 * q + j) * 64 + 16 * vi + c] = sacc[vi][j]; }
        if (lane == 0) {
#pragma unroll
            for (int j = 0; j < 8; ++j) DG[(size_t)item * 64 + 8 * w + j] = sumbl[j]; }
        asm volatile("s_waitcnt vmcnt(0)" ::: "memory");
        __syncthreads();
        if (tid == 0) { __builtin_amdgcn_fence(__ATOMIC_RELEASE, "agent"); asm volatile("s_waitcnt vmcnt(0)" ::: "memory"); __hip_atomic_store(flags + item, 1u, __ATOMIC_RELAXED, __HIP_MEMORY_SCOPE_AGENT); }
    }
    GLA_LOAD(c0);
#pragma unroll
    for (int vi = 0; vi < 4; ++vi) sacc[vi] = (f32x4){0.f, 0.f, 0.f, 0.f};
    if (seg > 0) {
        if (tid == 0) {
            for (int s2 = 0; s2 < seg; ++s2) { unsigned sp = 0; while (__hip_atomic_load(flags + item - seg + s2, __ATOMIC_RELAXED, __HIP_MEMORY_SCOPE_AGENT) == 0u) { __builtin_amdgcn_s_sleep(2); if (++sp > (1u << 22)) break; } }
            __builtin_amdgcn_fence(__ATOMIC_ACQUIRE, "agent"); asm volatile("s_waitcnt vmcnt(0)" ::: "memory");
        }
        __syncthreads();
        if (w >= 4) { const int ki = w - 4;
            for (int s2 = 0; s2 < seg; ++s2) { const GAS float* ep = EG + (size_t)(item - seg + s2) * 4096; const GAS float* dp = DG + (size_t)(item - seg + s2) * 64 + 16 * ki + 4 * q;
                float dv[4];
#pragma unroll
                for (int j = 0; j < 4; ++j) dv[j] = __expf(__hip_atomic_load(dp + j, __ATOMIC_RELAXED, __HIP_MEMORY_SCOPE_AGENT));
#pragma unroll
                for (int vi = 0; vi < 4; ++vi)
#pragma unroll
                    for (int j = 0; j < 4; ++j) sacc[vi][j] = dv[j] * sacc[vi][j] + __hip_atomic_load(ep + (16 * ki + 4 * q + j) * 64 + 16 * vi + c, __ATOMIC_RELAXED, __HIP_MEMORY_SCOPE_AGENT); }
#pragma unroll
            for (int vi = 0; vi < 4; ++vi) { u32x2 sw; sw.x = pkbf(sacc[vi][0], sacc[vi][1]); sw.y = pkbf(sacc[vi][2], sacc[vi][3]); *(LAS u32x2*)(St + (16 * vi + c) * 72 + 16 * ki + 4 * q) = sw; }
        }
    }
    __syncthreads();
    for (int ch = c0; ch < c0 + GLA_CPS; ++ch) {
        u32x2 gcur[4];
#pragma unroll
        for (int vi = 0; vi < 4; ++vi) gcur[vi] = rg[vi];
        {
            const float bc[8] = {(float)rbh[0], (float)rbh[1], (float)rbh[2], (float)rbh[3], (float)rbh[4], (float)rbh[5], (float)rbh[6], (float)rbh[7]};
            const float ble[8] = {(float)reh[0], (float)reh[1], (float)reh[2], (float)reh[3], (float)reh[4], (float)reh[5], (float)reh[6], (float)reh[7]};
            float qf[8], kf[8]; unpack8(rq, qf); unpack8(rk, kf);
            float qp[8], kp[8], kpp[8], bl[8];
#pragma unroll
            for (int j = 0; j < 8; ++j) { bl[j] = ble[j]; qp[j] = qf[j] * 0.125f * __expf(bc[j]); kp[j] = kf[j] * __expf(-bc[j]); kpp[j] = kf[j] * __expf(bl[j] - bc[j]); }
            u32x4 wq, wk; wq.x = pkbf(qp[0], qp[1]); wq.y = pkbf(qp[2], qp[3]); wq.z = pkbf(qp[4], qp[5]); wq.w = pkbf(qp[6], qp[7]);
            wk.x = pkbf(kp[0], kp[1]); wk.y = pkbf(kp[2], kp[3]); wk.z = pkbf(kp[4], kp[5]); wk.w = pkbf(kp[6], kp[7]);
            *(LAS u32x4*)(Qp + lane * 72 + 8 * w) = wq; *(LAS u32x4*)(Kp + lane * 72 + 8 * w) = wk;
            const unsigned vv[4] = {rv.x, rv.y, rv.z, rv.w};
#pragma unroll
            for (int j = 0; j < 8; ++j) { Kt[(8 * w + j) * 72 + lane] = (bf16_t)(pkbf(kpp[j], 0.f) & 0xffffu); Vt[(8 * w + j) * 72 + lane] = (bf16_t)((j & 1) ? (vv[j >> 1] >> 16) : (vv[j >> 1] & 0xffffu)); }
            if (lane == 63) {
#pragma unroll
                for (int j = 0; j < 8; ++j) dec[8 * w + j] = __expf(bl[j]); }
        }
        if (ch + 1 < c0 + GLA_CPS) GLA_LOAD(ch + 1);
        BAR_LDS();
        f32x4 oacc[4];
        {
            const int ti = w & 3;
            const bf16x8 qf0 = *(const LAS bf16x8*)(Qp + (16 * ti + c) * 72 + 8 * q), qf1 = *(const LAS bf16x8*)(Qp + (16 * ti + c) * 72 + 8 * q + 32);
#pragma unroll
            for (int u = 0; u < 2; ++u) { const int si = 2 * (w >> 2) + u; f32x4 acc = (f32x4){0.f, 0.f, 0.f, 0.f};
                if (si <= ti) { const bf16x8 k0 = *(const LAS bf16x8*)(Kp + (16 * si + c) * 72 + 8 * q), k1 = *(const LAS bf16x8*)(Kp + (16 * si + c) * 72 + 8 * q + 32);
                    acc = MFMA16(k0, qf0, acc); acc = MFMA16(k1, qf1, acc);
#pragma unroll
                    for (int j = 0; j < 4; ++j) if (16 * si + 4 * q + j > 16 * ti + c) acc[j] = 0.f; }
                u32x2 pw; pw.x = pkbf(acc[0], acc[1]); pw.y = pkbf(acc[2], acc[3]);
                *(LAS u32x2*)(Pm + (16 * ti + c) * 72 + 16 * si + 4 * q) = pw; }
            if (w < 4) {
#pragma unroll
                for (int vi = 0; vi < 4; ++vi) { const bf16x8 s0 = *(const LAS bf16x8*)(St + (16 * vi + c) * 72 + 8 * q), s1 = *(const LAS bf16x8*)(St + (16 * vi + c) * 72 + 8 * q + 32);
                    f32x4 acc = (f32x4){0.f, 0.f, 0.f, 0.f}; acc = MFMA16(s0, qf0, acc); acc = MFMA16(s1, qf1, acc); oacc[vi] = acc; } }
        }
        BAR_LDS();
        if (w < 4) {
            const bf16x8 p0 = *(const LAS bf16x8*)(Pm + (16 * w + c) * 72 + 8 * q), p1 = *(const LAS bf16x8*)(Pm + (16 * w + c) * 72 + 8 * q + 32);
            float ssq = 0.f;
#pragma unroll
            for (int vi = 0; vi < 4; ++vi) { const bf16x8 v0 = *(const LAS bf16x8*)(Vt + (16 * vi + c) * 72 + 8 * q), v1 = *(const LAS bf16x8*)(Vt + (16 * vi + c) * 72 + 8 * q + 32);
                oacc[vi] = MFMA16(v0, p0, oacc[vi]); oacc[vi] = MFMA16(v1, p1, oacc[vi]);
#pragma unroll
                for (int j = 0; j < 4; ++j) ssq += oacc[vi][j] * oacc[vi][j]; }
            ssq += __shfl_xor(ssq, 16); ssq += __shfl_xor(ssq, 32);
            const float r = rsqrtf(ssq * (1.0f / 64.0f) + EPS);
            const size_t m = rowbase + 64 * ch + 16 * w + c;
#pragma unroll
            for (int vi = 0; vi < 4; ++vi) { const u32x2 gw = gcur[vi];
                const float g0 = bflo(gw.x), g1 = bfhi(gw.x), g2 = bflo(gw.y), g3 = bfhi(gw.y);
                u32x2 ow; ow.x = pkbf(oacc[vi][0] * r * gain[vi * 4 + 0] * siluf_(g0), oacc[vi][1] * r * gain[vi * 4 + 1] * siluf_(g1));
                ow.y = pkbf(oacc[vi][2] * r * gain[vi * 4 + 2] * siluf_(g2), oacc[vi][3] * r * gain[vi * 4 + 3] * siluf_(g3));
                *(GAS u32x2*)(MIX + m * D + 64 * h + 16 * vi + 4 * q) = ow; }
        } else {
            const int ki = w - 4;
            const f32x4 d4 = *(const LAS f32x4*)(dec + 16 * ki + 4 * q);
            const bf16x8 k0 = *(const LAS bf16x8*)(Kt + (16 * ki + c) * 72 + 8 * q), k1 = *(const LAS bf16x8*)(Kt + (16 * ki + c) * 72 + 8 * q + 32);
#pragma unroll
            for (int vi = 0; vi < 4; ++vi) { const bf16x8 v0 = *(const LAS bf16x8*)(Vt + (16 * vi + c) * 72 + 8 * q), v1 = *(const LAS bf16x8*)(Vt + (16 * vi + c) * 72 + 8 * q + 32);
                f32x4 s = sacc[vi] * d4; s = MFMA16(k0, v0, s); s = MFMA16(k1, v1, s); sacc[vi] = s;
                u32x2 sw; sw.x = pkbf(s[0], s[1]); sw.y = pkbf(s[2], s[3]);
                *(LAS u32x2*)(St + (16 * vi + c) * 72 + 16 * ki + 4 * q) = sw; }
        }
        BAR_LDS();
    }
}

#undef GLA_LOAD
__device__ __forceinline__ void fox_item(unsigned char* ws, LAS unsigned char* lds, int b, int h, int qg) {
    const int tid = otid(), lane = tid & 63, w = __builtin_amdgcn_readfirstlane(tid >> 6), c = lane & 15, q = lane >> 4;
    const GAS bf16_t* P0 = (const GAS bf16_t*)(ws + WS_BIG); GAS bf16_t* MIX = (GAS bf16_t*)(ws + WS_MIX);
    const GAS float* cumb = (const GAS float*)(ws + WS_CUM) + (size_t)(b * 8 + h) * SEQ;
    LAS bf16_t* Kn = (LAS bf16_t*)(lds); LAS bf16_t* Vt = (LAS bf16_t*)(lds + 9216); LAS float* cumk = (LAS float*)(lds + 18432);
    const GAS float* gq = (const GAS float*)(ws + WS_PRM) + PR_QG + h * 64; const GAS float* gk = (const GAS float*)(ws + WS_PRM) + PR_KG + h * 64;
    float mq = fabsf(gq[lane]), mk = fabsf(gk[lane]);
#pragma unroll
    for (int o = 1; o < 64; o <<= 1) { mq = fmaxf(mq, __shfl_xor(mq, o)); mk = fmaxf(mk, __shfl_xor(mk, o)); }
    const float B2 = 16.0f * mq * mk * 1.001f;
    const int srow = tid >> 3, dc = tid & 7;
    float gkr[8], gqr[16];
#pragma unroll
    for (int e2 = 0; e2 < 8; ++e2) { gkr[e2] = gk[8 * dc + e2]; gqr[e2] = gq[8 * q + e2]; gqr[8 + e2] = gq[8 * q + 32 + e2]; }
    const size_t rowbase = (size_t)b * SEQ;
    for (int qi = 2 * qg; qi < 2 * qg + 2; ++qi) {
        const int t0 = 128 * qi, t = t0 + 16 * w + c; const size_t m = rowbase + t;
        int j = 2 * qi + 1;
        const u32x4 r0 = *(const GAS u32x4*)(P0 + m * LD0 + C_FQ + 64 * h + 8 * q), r1 = *(const GAS u32x4*)(P0 + m * LD0 + C_FQ + 64 * h + 8 * q + 32);
        const float cum_t0 = cumb[t0], cum_t = cumb[t];
        const int jl0 = 2 * qi - 1 - lane; const float ce0 = (jl0 >= 0) ? cumb[64 * jl0 + 63] : 0.f;
        u32x4 rk, rv; float rc;
        { const size_t ms = rowbase + 64 * j + srow; rk = *(const GAS u32x4*)(P0 + ms * LD0 + C_FK + 64 * h + 8 * dc); rv = *(const GAS u32x4*)(P0 + ms * LD0 + C_FV + 64 * h + 8 * dc); rc = cumb[64 * j + srow]; }
        int nbelow = 0;
        { const bool skp = (jl0 < 0) || ((B2 + cum_t0 - ce0) < -110.0f); const unsigned long long mk0 = __ballot(skp);
          if (mk0) nbelow = __ffsll((long long)mk0) - 1;
          else { nbelow = 64;
              for (int basej = 2 * qi - 1 - 64; basej >= 0; basej -= 64) { const int jl = basej - lane; const float ce = (jl >= 0) ? cumb[64 * jl + 63] : 0.f;
                  const bool sk2 = (jl < 0) || ((B2 + cum_t0 - ce) < -110.0f); const unsigned long long mk2 = __ballot(sk2);
                  if (mk2) { nbelow += __ffsll((long long)mk2) - 1; break; } nbelow += 64; } } }
        const int jlo = 2 * qi - nbelow;
        bf16x8 qf[2];
        { float f[16]; unpack8(r0, f); unpack8(r1, f + 8); float ss = 0.f;
#pragma unroll
          for (int e2 = 0; e2 < 16; ++e2) ss += f[e2] * f[e2];
          ss += __shfl_xor(ss, 16); ss += __shfl_xor(ss, 32);
          const float r = rsqrtf(ss * (1.0f / 64.0f) + EPS) * 0.125f;
#pragma unroll
          for (int kk = 0; kk < 2; ++kk) { float g[8];
#pragma unroll
              for (int e2 = 0; e2 < 8; ++e2) g[e2] = f[8 * kk + e2] * r * gqr[8 * kk + e2];
              u32x4 pw; pw.x = pkbf(g[0], g[1]); pw.y = pkbf(g[2], g[3]); pw.z = pkbf(g[4], g[5]); pw.w = pkbf(g[6], g[7]); qf[kk] = as_bf16x8(pw); } }
        f32x4 oacc[4];
#pragma unroll
        for (int di = 0; di < 4; ++di) oacc[di] = (f32x4){0.f, 0.f, 0.f, 0.f};
        float mrun = -1e30f, lpart = 0.f;
        for (;;) {
            { float f[8]; unpack8(rk, f); float ss = 0.f;
#pragma unroll
              for (int e2 = 0; e2 < 8; ++e2) ss += f[e2] * f[e2];
              ss += __shfl_xor(ss, 1); ss += __shfl_xor(ss, 2); ss += __shfl_xor(ss, 4);
              const float r = rsqrtf(ss * (1.0f / 64.0f) + EPS);
#pragma unroll
              for (int e2 = 0; e2 < 8; ++e2) f[e2] = f[e2] * r * gkr[e2];
              u32x4 pw; pw.x = pkbf(f[0], f[1]); pw.y = pkbf(f[2], f[3]); pw.z = pkbf(f[4], f[5]); pw.w = pkbf(f[6], f[7]);
              *(LAS u32x4*)(Kn + srow * 72 + 8 * dc) = pw;
              const unsigned vv[4] = {rv.x, rv.y, rv.z, rv.w};
#pragma unroll
              for (int e2 = 0; e2 < 8; ++e2) Vt[(8 * dc + e2) * 72 + srow] = (bf16_t)((e2 & 1) ? (vv[e2 >> 1] >> 16) : (vv[e2 >> 1] & 0xffffu));
              if (dc == 0) cumk[srow] = rc; }
            const int jn = j - 1;
            const bool cont = jn >= jlo;
            if (cont) { const size_t ms = rowbase + 64 * jn + srow; rk = *(const GAS u32x4*)(P0 + ms * LD0 + C_FK + 64 * h + 8 * dc); rv = *(const GAS u32x4*)(P0 + ms * LD0 + C_FV + 64 * h + 8 * dc); rc = cumb[64 * jn + srow]; }
            BAR_LDS();
            if (!(j == 2 * qi + 1 && w < 4)) {
                float sv[4][4]; float mx = -1e30f;
#pragma unroll
                for (int si = 0; si < 4; ++si) { f32x4 acc = (f32x4){0.f, 0.f, 0.f, 0.f};
                    const bf16x8 k0 = *(const LAS bf16x8*)(Kn + (16 * si + c) * 72 + 8 * q), k1 = *(const LAS bf16x8*)(Kn + (16 * si + c) * 72 + 8 * q + 32);
                    acc = MFMA16(k0, qf[0], acc); acc = MFMA16(k1, qf[1], acc);
                    const f32x4 ck = *(const LAS f32x4*)(cumk + 16 * si + 4 * q);
#pragma unroll
                    for (int jj = 0; jj < 4; ++jj) { float lg = acc[jj] + (cum_t - ck[jj]); if (j >= 2 * qi && (64 * j + 16 * si + 4 * q + jj) > t) lg = -1e30f; sv[si][jj] = lg; mx = fmaxf(mx, lg); } }
                mx = fmaxf(mx, __shfl_xor(mx, 16)); mx = fmaxf(mx, __shfl_xor(mx, 32));
                const float mnew = fmaxf(mrun, mx), alpha = __expf(mrun - mnew); mrun = mnew;
                float ps = 0.f;
#pragma unroll
                for (int si = 0; si < 4; ++si)
#pragma unroll
                    for (int jj = 0; jj < 4; ++jj) { sv[si][jj] = __expf(sv[si][jj] - mnew); ps += sv[si][jj]; }
                lpart = lpart * alpha + ps;
#pragma unroll
                for (int di = 0; di < 4; ++di) oacc[di] *= alpha;
#pragma unroll
                for (int kk = 0; kk < 2; ++kk) { u32x4 pw; pw.x = pkbf(sv[2 * kk][0], sv[2 * kk][1]); pw.y = pkbf(sv[2 * kk][2], sv[2 * kk][3]); pw.z = pkbf(sv[2 * kk + 1][0], sv[2 * kk + 1][1]); pw.w = pkbf(sv[2 * kk + 1][2], sv[2 * kk + 1][3]);
                    const bf16x8 pf = as_bf16x8(pw);
#pragma unroll
                    for (int di = 0; di < 4; ++di) { const u32x2 va = *(const LAS u32x2*)(Vt + (16 * di + c) * 72 + 32 * kk + 4 * q), vb = *(const LAS u32x2*)(Vt + (16 * di + c) * 72 + 32 * kk + 16 + 4 * q);
                        u32x4 vw; vw.x = va.x; vw.y = va.y; vw.z = vb.x; vw.w = vb.y; oacc[di] = MFMA16(as_bf16x8(vw), pf, oacc[di]); } }
            }
            BAR_LDS();
            if (!cont) break;
            j = jn;
        }
        float l = lpart; l += __shfl_xor(l, 16); l += __shfl_xor(l, 32);
        const float inv = 1.0f / l;
#pragma unroll
        for (int di = 0; di < 4; ++di) { u32x2 ow; ow.x = pkbf(oacc[di][0] * inv, oacc[di][1] * inv); ow.y = pkbf(oacc[di][2] * inv, oacc[di][3] * inv);
            *(GAS u32x2*)(MIX + m * D + 512 + 64 * h + 16 * di + 4 * q) = ow; }
    }
}

__device__ __forceinline__ void s5_item(unsigned char* ws, LAS unsigned char* lds, int b, int g) {
    const int tid = otid(), lane = tid & 63, w = __builtin_amdgcn_readfirstlane(tid >> 6), c = lane & 15, q = lane >> 4;
    const GAS bf16_t* P1 = (const GAS bf16_t*)(ws + WS_BIG); GAS bf16_t* YS = (GAS bf16_t*)(ws + WS_YS5);
    const GAS float* abar = (const GAS float*)(ws + WS_S5P + S5_ABAR); const GAS bf16_t* Bb = (const GAS bf16_t*)(ws + WS_S5P + S5_BB); const GAS bf16_t* Cm = (const GAS bf16_t*)(ws + WS_S5P + S5_CM);
    LAS float* bu = (LAS float*)(lds + w * 12800); LAS bf16_t* xs = (LAS bf16_t*)(lds + w * 12800 + 8448); LAS float* E = (LAS float*)(lds + 102400);
    const float ar = abar[(g * 64 + lane) * 2], ai = abar[(g * 64 + lane) * 2 + 1];
    float pr = ar, pi = ai;
#pragma unroll
    for (int i = 0; i < 10; ++i) { const float nr = pr * pr - pi * pi, ni = 2.0f * pr * pi; pr = nr; pi = ni; }
    bf16x8 bfr[8], cfr[4];
    const bf16x8 zero8 = (bf16x8){0, 0, 0, 0, 0, 0, 0, 0};
#pragma unroll
    for (int pt = 0; pt < 8; ++pt) bfr[pt] = (q < 2) ? *(const GAS bf16x8*)(Bb + ((size_t)(g * 128 + 16 * pt + c)) * 16 + 8 * q) : zero8;
#pragma unroll
    for (int kk = 0; kk < 4; ++kk) cfr[kk] = *(const GAS bf16x8*)(Cm + (size_t)(g * 16 + c) * 128 + 32 * kk + 8 * q);
    float dsk[4];
#pragma unroll
    for (int j = 0; j < 4; ++j) dsk[j] = ((const GAS float*)(ws + WS_PRM))[PR_S5D + g * 16 + 4 * q + j];
    f32x2 x2 = {0.f, 0.f}; const f32x2 a1 = {ar, ar}, a2 = {-ai, ai};
    LAS bf16_t* xs1 = (LAS bf16_t*)(lds + 106496 + w * 4352);
    for (int pass = 0; pass < 2; ++pass) {
        const size_t mbase = (size_t)b * SEQ + 1024 * w + c;
        bf16x8 uf_a = (q < 2) ? *(const GAS bf16x8*)(P1 + mbase * LD1 + 16 * g + 8 * q) : zero8;
        bf16x8 uf_b = (q < 2) ? *(const GAS bf16x8*)(P1 + (mbase + 16) * LD1 + 16 * g + 8 * q) : zero8;
        u32x2 uw_cur = *(const GAS u32x2*)(P1 + mbase * LD1 + 16 * g + 4 * q), uw_nxt = *(const GAS u32x2*)(P1 + (mbase + 16) * LD1 + 16 * g + 4 * q), uw_prev = uw_cur;
        f32x4 abu[8];
#pragma unroll
        for (int pt = 0; pt < 8; ++pt) abu[pt] = MFMA16(bfr[pt], uf_a, ((f32x4){0.f, 0.f, 0.f, 0.f}));
        for (int sc = 0; sc < 64; ++sc) {
            const size_t m = mbase + 16 * sc;
            LAS bf16_t* xw = (sc & 1) ? xs1 : xs; LAS bf16_t* xr = (sc & 1) ? xs : xs1;
#pragma unroll
            for (int pt = 0; pt < 8; ++pt) *(LAS f32x4*)(bu + c * 132 + 16 * pt + 4 * q) = abu[pt];
            const bf16x8 uf_use = uf_b;
            if (sc + 2 < 64) { uf_b = (q < 2) ? *(const GAS bf16x8*)(P1 + (m + 32) * LD1 + 16 * g + 8 * q) : zero8; }
            u32x2 uw_n2 = uw_nxt; if (sc + 2 < 64) uw_n2 = *(const GAS u32x2*)(P1 + (m + 32) * LD1 + 16 * g + 4 * q);
#pragma unroll
            for (int pt = 0; pt < 8; ++pt) abu[pt] = MFMA16(bfr[pt], uf_use, ((f32x4){0.f, 0.f, 0.f, 0.f}));
            bf16x8 xf[4];
            if (pass && sc > 0) {
#pragma unroll
                for (int kk = 0; kk < 4; ++kk) xf[kk] = *(const LAS bf16x8*)(xr + c * 136 + 32 * kk + 8 * q); }
            LDS_WAIT();
#pragma unroll
            for (int tt = 0; tt < 16; ++tt) { const f32x2 bb = *(const LAS f32x2*)(bu + tt * 132 + 2 * lane);
                const f32x2 t2 = a1 * x2 + bb; const f32x2 xsw = {x2.y, x2.x}; x2 = a2 * xsw + t2;
                if (pass) *(LAS unsigned*)(xw + tt * 136 + 2 * lane) = pkbf(x2.x, x2.y); }
            if (pass && sc > 0) {
                f32x4 acc = (f32x4){0.f, 0.f, 0.f, 0.f};
#pragma unroll
                for (int kk = 0; kk < 4; ++kk) acc = MFMA16(cfr[kk], xf[kk], acc);
                const float y0 = gelu_tanh(acc[0] + dsk[0] * bflo(uw_prev.x)), y1 = gelu_tanh(acc[1] + dsk[1] * bfhi(uw_prev.x)), y2 = gelu_tanh(acc[2] + dsk[2] * bflo(uw_prev.y)), y3 = gelu_tanh(acc[3] + dsk[3] * bfhi(uw_prev.y));
                u32x2 ow; ow.x = pkbf(y0, y1); ow.y = pkbf(y2, y3);
                *(GAS u32x2*)(YS + (m - 16) * 512 + 16 * g + 4 * q) = ow;
            }
            uw_prev = uw_cur; uw_cur = uw_nxt; uw_nxt = uw_n2;
        }
        if (pass) {
            LDS_WAIT();
            f32x4 acc = (f32x4){0.f, 0.f, 0.f, 0.f};
#pragma unroll
            for (int kk = 0; kk < 4; ++kk) { const bf16x8 xf = *(const LAS bf16x8*)(xs1 + c * 136 + 32 * kk + 8 * q); acc = MFMA16(cfr[kk], xf, acc); }
            const float y0 = gelu_tanh(acc[0] + dsk[0] * bflo(uw_prev.x)), y1 = gelu_tanh(acc[1] + dsk[1] * bfhi(uw_prev.x)), y2 = gelu_tanh(acc[2] + dsk[2] * bflo(uw_prev.y)), y3 = gelu_tanh(acc[3] + dsk[3] * bfhi(uw_prev.y));
            u32x2 ow; ow.x = pkbf(y0, y1); ow.y = pkbf(y2, y3);
            *(GAS u32x2*)(YS + (mbase + 16 * 63) * 512 + 16 * g + 4 * q) = ow;
            LDS_WAIT();
        }
        if (pass == 0) {
            E[w * 128 + lane] = x2.x; E[w * 128 + 64 + lane] = x2.y;
            __syncthreads();
            float cr = 0.f, ci = 0.f;
            for (int w2 = 0; w2 < w; ++w2) { const float er = E[w2 * 128 + lane], ei = E[w2 * 128 + 64 + lane]; const float nr = pr * cr - pi * ci + er, ni = pr * ci + pi * cr + ei; cr = nr; ci = ni; }
            x2.x = cr; x2.y = ci;
        }
    }
}

__device__ __forceinline__ void sgu_item(unsigned char* ws, LAS unsigned char* lds, int b, int n) {
    const int tid = otid(), lane = tid & 63, w = __builtin_amdgcn_readfirstlane(tid >> 6), c = lane & 15, q = lane >> 4;
    const GAS bf16_t* P1 = (const GAS bf16_t*)(ws + WS_BIG); GAS bf16_t* MIX = (GAS bf16_t*)(ws + WS_MIX); const GAS bf16_t* wsb = (const GAS bf16_t*)(ws + WS_WSB);
    LAS bf16_t* Vt = (LAS bf16_t*)lds;
    const size_t m0 = (size_t)b * SEQ + 128 * n;
    {
        const int s = tid >> 2, qq = tid & 3; const GAS bf16_t* vp = P1 + (m0 + s) * LD1 + 1024 + 128 * qq;
        u32x4 rv[16]; float sum = 0.f, ssq = 0.f;
#pragma unroll
        for (int i = 0; i < 16; ++i) { rv[i] = *(const GAS u32x4*)(vp + 8 * i); float f[8]; unpack8(rv[i], f);
#pragma unroll
            for (int e = 0; e < 8; ++e) { sum += f[e]; ssq += f[e] * f[e]; } }
        sum += __shfl_xor(sum, 1); sum += __shfl_xor(sum, 2); ssq += __shfl_xor(ssq, 1); ssq += __shfl_xor(ssq, 2);
        const float mu = sum * (1.0f / 512.0f), var = fmaxf(ssq * (1.0f / 512.0f) - mu * mu, 0.f), rstd = rsqrtf(var + EPS);
        const GAS float* lg = (const GAS float*)(ws + WS_PRM) + PR_LNG + 128 * qq; const GAS float* lb = (const GAS float*)(ws + WS_PRM) + PR_LNB + 128 * qq;
#pragma unroll
        for (int i = 0; i < 16; ++i) { float f[8]; unpack8(rv[i], f);
            const f32x4 g0 = *(const GAS f32x4*)(lg + 8 * i), g1 = *(const GAS f32x4*)(lg + 8 * i + 4), b0 = *(const GAS f32x4*)(lb + 8 * i), b1 = *(const GAS f32x4*)(lb + 8 * i + 4);
#pragma unroll
            for (int e = 0; e < 8; ++e) { const float gg = e < 4 ? g0[e & 3] : g1[e & 3], bb = e < 4 ? b0[e & 3] : b1[e & 3]; const float y = (f[e] - mu) * rstd * gg + bb;
                Vt[(128 * qq + 8 * i + e) * 136 + s] = (bf16_t)(pkbf(y, 0.f) & 0xffffu); } }
    }
    __syncthreads();
    const int nk = (w >> 1) + 1; const int trow = 16 * w + c; const size_t m = m0 + trow;
    bf16x8 wfn[4]; u32x2 uwn[4]; float bsn;
#define SGU_LOAD(g_) do { _Pragma("unroll") for (int kk_ = 0; kk_ < 4; ++kk_) if (kk_ < nk) wfn[kk_] = *(const GAS bf16x8*)(wsb + ((size_t)(g_) * 128 + trow) * 128 + 32 * kk_ + 8 * q); \
        _Pragma("unroll") for (int ct_ = 0; ct_ < 4; ++ct_) uwn[ct_] = *(const GAS u32x2*)(P1 + m * LD1 + 512 + 64 * (g_) + 16 * ct_ + 4 * q); \
        bsn = ((const GAS float*)(ws + WS_PRM))[PR_BS + (g_) * 128 + trow]; } while (0)
    SGU_LOAD(0);
    for (int g = 0; g < 8; ++g) {
        bf16x8 wf[4]; u32x2 uw[4];
#pragma unroll
        for (int kk = 0; kk < 4; ++kk) wf[kk] = wfn[kk];
#pragma unroll
        for (int ct = 0; ct < 4; ++ct) uw[ct] = uwn[ct];
        const float bs = bsn;
        if (g + 1 < 8) SGU_LOAD(g + 1);
        f32x4 acc[4];
#pragma unroll
        for (int ct = 0; ct < 4; ++ct) acc[ct] = (f32x4){0.f, 0.f, 0.f, 0.f};
#pragma unroll
        for (int kk = 0; kk < 4; ++kk) if (kk < nk) {
#pragma unroll
            for (int ct = 0; ct < 4; ++ct) { const bf16x8 vf = *(const LAS bf16x8*)(Vt + (64 * g + 16 * ct + c) * 136 + 32 * kk + 8 * q); acc[ct] = MFMA16(vf, wf[kk], acc[ct]); } }
#pragma unroll
        for (int ct = 0; ct < 4; ++ct) {
            u32x2 ow; ow.x = pkbf(bflo(uw[ct].x) * (acc[ct][0] + bs), bfhi(uw[ct].x) * (acc[ct][1] + bs)); ow.y = pkbf(bflo(uw[ct].y) * (acc[ct][2] + bs), bfhi(uw[ct].y) * (acc[ct][3] + bs));
            *(GAS u32x2*)(MIX + m * D + 512 + 64 * g + 16 * ct + 4 * q) = ow; }
    }
#undef SGU_LOAD
}

#define XB_TMO      128
#define XB_XCNT(j)  (256  + 64 * (j))
#define XB_XSUB(j)  (1280 + 64 * (j))
#define XB_XGEN(j)  (2304 + 64 * (j))
#define XB_TOP      3328
#define XB_TOPGEN   3392
#define XCD_BAR_WORDS 3456
#define XB_SPIN_CAP (1u << 22)
__device__ __forceinline__ unsigned xb_ld(unsigned* p)              { return __hip_atomic_load(p, __ATOMIC_RELAXED, __HIP_MEMORY_SCOPE_AGENT); }
__device__ __forceinline__ unsigned xb_add(unsigned* p, unsigned v) { return __hip_atomic_fetch_add(p, v, __ATOMIC_RELAXED, __HIP_MEMORY_SCOPE_AGENT); }
__device__ __forceinline__ unsigned xb_xcc_id() { return (unsigned)__builtin_amdgcn_s_getreg((3 << 11) | 20) & 0xFu; }
#define XB_SPIN(cond, bar) do { unsigned _sp = 0; while (cond) { __builtin_amdgcn_s_sleep(1); \
    if ((++_sp & 255u) == 0u) { if (xb_ld(&(bar)[XB_TMO])) break; if (_sp > XB_SPIN_CAP) { atomicAdd(&(bar)[XB_TMO], 1u); break; } } } } while (0)
struct XcdBarrier { unsigned* bar; unsigned x; volatile LAS unsigned* st; };
__device__ __forceinline__ XcdBarrier xcd_barrier_post(unsigned* bar, volatile LAS unsigned* st) {
    XcdBarrier b; b.bar = bar; b.x = xb_xcc_id(); b.st = st;
    if (threadIdx.x == 0) st[2] = xb_add(&bar[XB_XCNT(b.x)], 1u);
    return b;
}
__device__ __forceinline__ void xcd_barrier_complete(unsigned* bar, unsigned x, unsigned& nloc, unsigned& nx) {
    const unsigned G = gridDim.x * gridDim.y * gridDim.z;
    unsigned sum, cnt, mine, sp = 0u;
    for (;;) {
        sum = 0u; cnt = 0u; mine = 0u;
#pragma unroll
        for (unsigned j = 0; j < 16; ++j) { const unsigned c = xb_ld(&bar[XB_XCNT(j)]); sum += c; cnt += (c > 0u) ? 1u : 0u; mine = (j == x) ? c : mine; }
        if (sum == G) break;
        __builtin_amdgcn_s_sleep(1);
        if ((++sp & 255u) == 0u) { if (xb_ld(&bar[XB_TMO])) break; if (sp > XB_SPIN_CAP) { atomicAdd(&bar[XB_TMO], 1u); break; } }
    }
    nloc = mine > 0u ? mine : 1u; nx = cnt > 0u ? cnt : 1u;
}
__device__ __forceinline__ void xcd_barrier(const XcdBarrier& b) {
    asm volatile("s_waitcnt vmcnt(0) lgkmcnt(0)" ::: "memory");
    __syncthreads();
    if (threadIdx.x == 0) {
        unsigned* bar = b.bar;
        __builtin_amdgcn_s_waitcnt(0);
        unsigned nloc = b.st[0], nx = b.st[1];
        if (nloc == 0u) { xcd_barrier_complete(bar, b.x, nloc, nx); b.st[0] = nloc; b.st[1] = nx; }
        const unsigned old = xb_add(&bar[XB_XSUB(b.x)], 1u);
        const unsigned gen = old / nloc;
        if (old + 1u == (gen + 1u) * nloc) {
            __builtin_amdgcn_fence(__ATOMIC_RELEASE, "agent");
            asm volatile("s_waitcnt vmcnt(0)" ::: "memory");
            const unsigned og = xb_add(&bar[XB_TOP], 1u);
            const unsigned tg = og / nx;
            if (og + 1u == (tg + 1u) * nx) xb_add(&bar[XB_TOPGEN], 1u);
            else XB_SPIN(xb_ld(&bar[XB_TOPGEN]) == tg, bar);
            __builtin_amdgcn_fence(__ATOMIC_ACQUIRE, "agent");
            xb_add(&bar[XB_XGEN(b.x)], 1u);
            asm volatile("s_waitcnt vmcnt(0)" ::: "memory");
        } else {
            XB_SPIN(xb_ld(&bar[XB_XGEN(b.x)]) == gen, bar);
            __builtin_amdgcn_fence(__ATOMIC_ACQUIRE, "agent");
            asm volatile("s_waitcnt vmcnt(0)" ::: "memory");
        }
    }
    __syncthreads();
}
#define GSYNC(k) xcd_barrier(xbar)
__global__ void __launch_bounds__(NT, 2) mega_fwd(Args a) {
    extern __shared__ __attribute__((aligned(16))) unsigned char lds_raw[];
    LAS unsigned char* lds = (LAS unsigned char*)lds_raw;
    cg::grid_group grid = cg::this_grid();
    LAS int* slot = (LAS int*)(lds + LDS_BYTES - 64);
    volatile LAS unsigned* xst = (volatile LAS unsigned*)(lds + LDS_BYTES - 32);
    if (threadIdx.x < 4) xst[threadIdx.x] = 0u;
    __syncthreads();
    XcdBarrier xbar = xcd_barrier_post((unsigned*)(a.ws + WS_CTL) + 1024, xst);
    grid.sync();
#ifndef NO_P0
    p0_prologue(a, lds);
#endif
    GSYNC(0);
    int vcu = blockIdx.x;
    { unsigned* bw = (unsigned*)(a.ws + WS_CTL) + 1024; bool ok = (gridDim.x % 8u) == 0u;
      for (int j = 0; j < 16; ++j) { const unsigned cj = xb_ld(&bw[XB_XCNT(j)]); if (cj != (j < 8 ? gridDim.x / 8u : 0u)) ok = false; }
      if (ok) vcu = (int)(xbar.x + 8u * xst[2]); }
    unsigned char* const ws0 = a.ws; const float* const x00 = a.in[0]; float* const xout0 = a.out;
    unsigned kb = 1;
    for (int ph = 1; ph <= 16; ++ph) {
        if (ph == 6 || ph == 9 || ph == 14) continue;
        unsigned char* ws = ws0; const float* x0 = x00; float* xout = xout0;
        asm volatile("" : "+s"(ws), "+s"(x0), "+s"(xout));

        const float* mod = (const float*)(ws + WS_MOD);
        bf16_t* H = (bf16_t*)(ws + WS_H); bf16_t* MIX = (bf16_t*)(ws + WS_MIX); bf16_t* BIG = (bf16_t*)(ws + WS_BIG);
        unsigned* ctl = (unsigned*)(ws + WS_CTL);
        const int layer = ph >= 9;
        const GAS float* modl = (const GAS float*)mod + (size_t)layer * 8 * 6144;
        GAS float* rowss = (GAS float*)(ws + WS_ROWSS); const GAS float* shw = (const GAS float*)(ws + WS_SHW);
#ifndef REPEAT_PH
#define REPEAT_PH -1
#endif
        for (int rep = 0; rep < ((ph == REPEAT_PH) ? 2 : 1); ++rep) {
        pg8::Gemm g{nullptr, nullptr, T, 0, 0, 0}; pg8::Epi E{0, 0, nullptr, 0, nullptr, nullptr, nullptr, nullptr, nullptr, nullptr, nullptr, 0};
        switch (ph) {
        case 1: norm_phase(x0, mod, 0, 1024, H); break;
        case 3: cum_phase(ws, lds); break;
        case 4:
            for (;;) { const int it = q_next(ctl + 256 * rep, slot); if (it >= 64 * GLA_NSEG + 2048 + 152) break;
                constexpr int FOX_EARLY = 512;
                int kind, idx;
                if (it < 64) { kind = 0; idx = it; } else if (it < 64 + FOX_EARLY) { kind = 1; idx = it - 64; } else if (it < 128 + FOX_EARLY) { kind = 0; idx = it - FOX_EARLY; }
                else if (it < 128 + 2048) { kind = 1; idx = it - 128; } else { kind = 2; idx = it - 128 - 2048; }
                if (kind == 0) gla_item(ws, lds, (idx & 63) >> 3, idx & 7, idx >> 6); else if (kind == 1) fox_item(ws, lds, idx >> 8, (idx >> 5) & 7, idx & 31);
                else prep_item(ws, lds, idx); }
            break;
        case 11:
            for (;;) { const int it = q_next(ctl + 64 + 256 * rep, slot); if (it >= 256 + 512) break;
                if (it < 256) s5_item(ws, lds, it >> 5, it & 31); else { const int f = it - 256; sgu_item(ws, lds, f >> 6, f & 63); } }
            break;
        case 2: g.A = H; g.Bt = (const bf16_t*)(ws + WS_WIN0); g.N = LD0; g.K = D; E.mode = 0; E.O = (GAS bf16_t*)BIG; E.ldc = LD0; break;
        case 5: g.A = MIX; g.Bt = (const bf16_t*)(ws + WS_WOUT0); g.N = D; g.K = D; E.mode = 6; E.O = (GAS bf16_t*)H; E.base32 = (const GAS float*)x0; E.gate = modl + 2048; E.rowss = rowss; break;
        case 7: g.A = H; g.Bt = (const bf16_t*)(ws + WS_WB0); g.bbatch = (size_t)FFD * D * 2; g.N = FFD; g.K = D; E.mode = 5; E.sub = 1; E.O = (GAS bf16_t*)BIG; E.ldc = FFD; E.rowss = rowss; E.shw = shw; E.ldsh = FFD; break;
        case 8: g.A = BIG; g.Bt = (const bf16_t*)(ws + WS_W2_0); g.N = D; g.K = FFD; E.mode = 7; E.O = (GAS bf16_t*)H; E.gate = modl + 5120; E.rowss = rowss; break;
        case 10: g.A = H; g.Bt = (const bf16_t*)(ws + WS_WB1); g.bbatch = (size_t)LD1 * D * 2; g.N = LD1; g.K = D; E.mode = 5; E.sub = 2; E.O = (GAS bf16_t*)BIG; E.ldc = LD1; E.rowss = rowss; E.shw = shw + 8 * 4096; E.ldsh = LD1; break;
        case 12: g.A = (const bf16_t*)(ws + WS_YS5); g.Bt = (const bf16_t*)(ws + WS_WGLU); g.N = 512; g.K = 512; E.mode = 3; E.O = (GAS bf16_t*)MIX; E.Y = (const GAS bf16_t*)(ws + WS_YS5); E.bias = (const GAS float*)(ws + WS_PRM) + PR_BGLU; break;
        case 13: g.A = MIX; g.Bt = (const bf16_t*)(ws + WS_WOUT1); g.N = D; g.K = D; E.mode = 7; E.O = (GAS bf16_t*)H; E.gate = modl + 2048; E.rowss = rowss; break;
        case 15: g.A = H; g.Bt = (const bf16_t*)(ws + WS_WB2); g.bbatch = (size_t)FFD * D * 2; g.N = FFD; g.K = D; E.mode = 5; E.sub = 1; E.O = (GAS bf16_t*)BIG; E.ldc = FFD; E.rowss = rowss; E.shw = shw + 16 * 4096; E.ldsh = FFD; break;
        case 16: g.A = BIG; g.Bt = (const bf16_t*)(ws + WS_W2_1); g.N = D; g.K = FFD; E.mode = 8; E.O = (GAS bf16_t*)H; E.out32 = (GAS float*)xout; E.gate = modl + 5120; break;
        default: break;
        }
        if (g.K != 0) { pg8::StaticOrder S; S.init(T, g.N, gridDim.x, vcu);
            switch (E.mode) {
            case 0: pg8::gemm_phase<0>(lds, g, S, E); break; case 3: pg8::gemm_phase<3>(lds, g, S, E); break; case 5: pg8::gemm_phase<5>(lds, g, S, E); break;
            case 6: pg8::gemm_phase<6>(lds, g, S, E); break; case 7: pg8::gemm_phase<7>(lds, g, S, E); break; default: pg8::gemm_phase<8>(lds, g, S, E); break; } }
        }
        if (ph != 16) { GSYNC(kb); ++kb; }
    }
}

extern "C" void kernel_launch(void* const* d_in, const int* in_sizes, int n_in, void* d_out, int out_size, void* d_ws, size_t ws_size, hipStream_t stream) {
    static int grid = 0;
    if (grid == 0) {
        if (n_in != 30 || out_size != T * D || ws_size < WS_END) { fprintf(stderr, "kernel_launch: unexpected shapes (n_in %d out %d ws %zu)\n", n_in, out_size, ws_size); grid = -1; return; }
        int dev = 0, cus = 0, per_cu = 0;
        hipGetDevice(&dev); hipDeviceGetAttribute(&cus, hipDeviceAttributeMultiprocessorCount, dev);
        hipFuncSetAttribute((const void*)mega_fwd, hipFuncAttributeMaxDynamicSharedMemorySize, LDS_BYTES);
        hipOccupancyMaxActiveBlocksPerMultiprocessor(&per_cu, (const void*)mega_fwd, NT, LDS_BYTES);
        if (per_cu < 1) { fprintf(stderr, "kernel_launch: occupancy query says %d blocks/CU\n", per_cu); per_cu = 1; }
        grid = cus * 1;
        (void)hipGetLastError();
    }
    if (grid < 0) return;
    (void)hipMemsetAsync((char*)d_ws + WS_CTL, 0, 65536, stream);
    Args a{};
    for (int i = 0; i < 30; ++i) a.in[i] = (const float*)d_in[i];
    a.out = (float*)d_out; a.ws = (unsigned char*)d_ws;
    void* args[] = {&a};
    hipError_t e = hipLaunchCooperativeKernel((const void*)mega_fwd, dim3(grid), dim3(NT), args, LDS_BYTES, stream);
    if (e != hipSuccess) fprintf(stderr, "cooperative launch failed: %s (grid %d)\n", hipGetErrorString(e), grid);
}
```

```cpp
#include <hip/hip_runtime.h>
#include <hip/hip_cooperative_groups.h>
#include <cstdio>
namespace cg = cooperative_groups;

#define LAS __attribute__((address_space(3)))
#define GAS __attribute__((address_space(1)))
typedef unsigned short bf16_t;
typedef short bf16x8 __attribute__((ext_vector_type(8)));
typedef short bf16x4 __attribute__((ext_vector_type(4)));
typedef float f32x4 __attribute__((ext_vector_type(4)));
typedef float f32x2 __attribute__((ext_vector_type(2)));
typedef unsigned u32x4 __attribute__((ext_vector_type(4)));
typedef unsigned u32x2 __attribute__((ext_vector_type(2)));
typedef _Float16 f16x8 __attribute__((ext_vector_type(8)));

constexpr int T = 65536, SEQ = 8192, D = 1024, FFD = 4096;
constexpr int LD0 = 3840, LD1 = 1536;
constexpr int C_GQ = 0, C_GK = 512, C_GV = 1024, C_GG = 1536, C_FQ = 2048, C_FK = 2560, C_FV = 3072, C_LR = 3584, C_FF = 3600;
constexpr float EPS = 1e-6f;
constexpr size_t MiB = 1u << 20;
constexpr size_t WS_CTL = 0, WS_WIN0 = 2 * MiB, WS_WOUT0 = 10 * MiB, WS_W1_0 = 12 * MiB, WS_W2_0 = 20 * MiB, WS_WIN1 = 28 * MiB, WS_WOUT1 = 31 * MiB,
                 WS_WGLU = 33 * MiB, WS_W1_1 = 34 * MiB, WS_W2_1 = 42 * MiB, WS_WSB = 50 * MiB, WS_MOD = 51 * MiB, WS_S5P = 52 * MiB, WS_CUM = 53 * MiB,
                 WS_H = 64 * MiB, WS_MIX = 192 * MiB, WS_BIG = 320 * MiB, WS_WB0 = 832 * MiB, WS_WB1 = 896 * MiB, WS_WB2 = 920 * MiB, WS_GLAE = 984 * MiB  , WS_GLAD = 990 * MiB  , WS_END = 992 * MiB;
constexpr size_t WS_PRM = 56 * MiB, WS_ROWSS = 57 * MiB  , WS_SHW = 61 * MiB  , WS_YS5 = WS_BIG + 256 * MiB;
constexpr int PR_WLR = 0, PR_BLR = 8192, PR_GGAIN = 8704, PR_BF = 9216, PR_QG = 9280, PR_KG = 9792, PR_S5D = 10304, PR_BGLU = 10816, PR_LNG = 11328, PR_LNB = 11840, PR_BS = 12352;
constexpr size_t S5_ABAR = 0, S5_BB = 16384, S5_CM = 16384 + 131072;
constexpr int LDS_BYTES = 147456;
constexpr int NT = 512;

struct Args { const float* in[30]; float* out; unsigned char* ws; };

typedef __bf16 bf16x2_t __attribute__((ext_vector_type(2)));
__device__ __forceinline__ unsigned pkbf(float lo, float hi) { f32x2 v = {lo, hi}; bf16x2_t b = __builtin_convertvector(v, bf16x2_t); return __builtin_bit_cast(unsigned, b); }
__device__ __forceinline__ float bflo(unsigned w) { return __uint_as_float(w << 16); }
__device__ __forceinline__ float bfhi(unsigned w) { return __uint_as_float(w & 0xffff0000u); }
__device__ __forceinline__ void unpack8(u32x4 w, float* f) { f[0] = bflo(w.x); f[1] = bfhi(w.x); f[2] = bflo(w.y); f[3] = bfhi(w.y); f[4] = bflo(w.z); f[5] = bfhi(w.z); f[6] = bflo(w.w); f[7] = bfhi(w.w); }
__device__ __forceinline__ float sigmoidf_(float x) { return 1.0f / (1.0f + __expf(-x)); }
__device__ __forceinline__ float siluf_(float x) { return x * sigmoidf_(x); }
__device__ __forceinline__ float gelu_tanh(float x) { const float u = 1.5957691216057308f * (x + 0.044715f * x * x * x); return x * sigmoidf_(u); }
__device__ __forceinline__ float logsig(float x) { return fminf(x, 0.f) - __logf(1.0f + __expf(-fabsf(x))); }
__device__ __forceinline__ int otid() { int t = threadIdx.x; asm volatile("" : "+v"(t)); return t; }
#define LDS_WAIT() asm volatile("s_waitcnt lgkmcnt(0)" ::: "memory")
#define BAR_LDS() do { asm volatile("s_waitcnt lgkmcnt(0)" ::: "memory"); __builtin_amdgcn_s_barrier(); asm volatile("" ::: "memory"); } while (0)
#define MFMA16(a, b, c) __builtin_amdgcn_mfma_f32_16x16x32_bf16((a), (b), (c), 0, 0, 0)
__device__ __forceinline__ bf16x8 as_bf16x8(u32x4 v) { return __builtin_bit_cast(bf16x8, v); }

namespace pg8 {
constexpr int BM = 256, BK = 64, HALF = 128, HTB = HALF * BK * 2, STAGE_BYTES = 8 * HTB, NXCD = 8, WGM = 8;
__device__ __forceinline__ int lds_byte(int r, int c) { const int st = (r >> 4) * 2 + (c >> 5), rr = r & 15, cc = c & 31, ob = rr * 64 + cc * 2; return st * 1024 + (ob ^ (((ob >> 9) & 1) << 5)); }
__device__ __forceinline__ void stage_rc(int b, int& R, int& C) { const int st = b / 1024, sb = b % 1024, swz = sb ^ (((sb >> 9) & 1) << 5); R = (st >> 1) * 16 + swz / 64; C = (st & 1) * 32 + (swz % 64) / 2; }
__device__ __forceinline__ int perm32(int rho) { const int n = rho >> 4, i = rho & 15; return 8 * (i >> 2) + 4 * n + (i & 3); }
struct Unit { int pm, pn; };
struct Gemm { const bf16_t* A; const bf16_t* Bt; int M, N, K; size_t bbatch; };
struct StaticOrder {
    int nM, nN, nwg, G, c;
    __device__ void init(int M, int N, int G_, int c_) { nM = M / BM; nN = N / BM; nwg = nM * nN; G = G_; c = c_; }
    __device__ bool next(int i, Unit& u) const {
        const long L = (long)i * G + c; if (L >= nwg) return false;
        int wgid = (int)L; { const int q = nwg / NXCD, r = nwg % NXCD, xcd = wgid % NXCD, off = wgid / NXCD; wgid = (xcd < r ? xcd * (q + 1) : r * (q + 1) + (xcd - r) * q) + off; }
        const int nig = WGM * nN, gid = wgid / nig, fm = gid * WGM, gsz = (nM - fm) < WGM ? (nM - fm) : WGM;
        u.pm = fm + ((wgid % nig) % gsz); u.pn = (wgid % nig) / gsz; return true;
    }
};

struct Epi {
    int mode, sub; GAS bf16_t* O; int ldc; const GAS float* base32; GAS float* out32; const GAS float* gate; const GAS bf16_t* Y; const GAS float* bias; GAS float* rowss; const GAS float* shw; int ldsh;
    template <int MODE> __device__ __forceinline__ void run(const f32x4 (&acc)[2][2][4][2], const Unit& u, int wr, int wc, int fr, int fq) const {
        constexpr int mode = MODE;
        const int row0 = u.pm * BM + wr * 64 + fr, col0 = u.pn * BM + wc * 32 + 8 * fq, bidx = (u.pm * BM) >> 13;
        if (mode >= 6) {
            const GAS float* gp = gate + (size_t)bidx * 6144 + col0;
            f32x4 gg[2][2];
#pragma unroll
            for (int bj = 0; bj < 2; ++bj) { gg[bj][0] = *(const GAS f32x4*)(gp + bj * HALF); gg[bj][1] = *(const GAS f32x4*)(gp + bj * HALF + 4); }
            if (mode == 6) {
#pragma unroll
                for (int ai = 0; ai < 2; ++ai)
#pragma unroll
                    for (int mh = 0; mh < 2; ++mh) { f32x4 bb[2][2][2];
#pragma unroll
                        for (int ml = 0; ml < 2; ++ml) { const size_t off = (size_t)(row0 + ai * HALF + (2 * mh + ml) * 16) * D + col0;
#pragma unroll
                            for (int bj = 0; bj < 2; ++bj) { bb[ml][bj][0] = __builtin_nontemporal_load((const GAS f32x4*)(base32 + off + bj * HALF)); bb[ml][bj][1] = __builtin_nontemporal_load((const GAS f32x4*)(base32 + off + bj * HALF + 4)); } }
#pragma unroll
                        for (int ml = 0; ml < 2; ++ml) { const int m = 2 * mh + ml; const size_t row = (size_t)(row0 + ai * HALF + m * 16), off = row * D + col0; float ss = 0.f;
#pragma unroll
                            for (int bj = 0; bj < 2; ++bj) { const f32x4 x0 = bb[ml][bj][0] + gg[bj][0] * acc[ai][bj][m][0], x1 = bb[ml][bj][1] + gg[bj][1] * acc[ai][bj][m][1];
                                ss += (x0[0] * x0[0] + x0[1] * x0[1]) + (x0[2] * x0[2] + x0[3] * x0[3]) + (x1[0] * x1[0] + x1[1] * x1[1]) + (x1[2] * x1[2] + x1[3] * x1[3]);
                                u32x4 w; w.x = pkbf(x0[0], x0[1]); w.y = pkbf(x0[2], x0[3]); w.z = pkbf(x1[0], x1[1]); w.w = pkbf(x1[2], x1[3]); *(GAS u32x4*)(O + off + bj * HALF) = w; }
                            ss += __shfl_xor(ss, 16); ss += __shfl_xor(ss, 32); if (fq == 0) rowss[row * 16 + u.pn * 4 + wc] = ss; }
                        asm volatile("" ::: "memory"); }
            } else {
#pragma unroll
                for (int ai = 0; ai < 2; ++ai) { u32x4 bw[4][2];
#pragma unroll
                    for (int m = 0; m < 4; ++m) { const size_t off = (size_t)(row0 + ai * HALF + m * 16) * D + col0;
#pragma unroll
                        for (int bj = 0; bj < 2; ++bj) bw[m][bj] = *(const GAS u32x4*)(O + off + bj * HALF); }
#pragma unroll
                    for (int m = 0; m < 4; ++m) { const size_t row = (size_t)(row0 + ai * HALF + m * 16), off = row * D + col0; float ss = 0.f;
#pragma unroll
                        for (int bj = 0; bj < 2; ++bj) { const u32x4 t = bw[m][bj];
                            const f32x4 b0 = (f32x4){bflo(t.x), bfhi(t.x), bflo(t.y), bfhi(t.y)}, b1 = (f32x4){bflo(t.z), bfhi(t.z), bflo(t.w), bfhi(t.w)};
                            const f32x4 x0 = b0 + gg[bj][0] * acc[ai][bj][m][0], x1 = b1 + gg[bj][1] * acc[ai][bj][m][1];
                            if (mode == 8) { __builtin_nontemporal_store(x0, (GAS f32x4*)(out32 + off + bj * HALF)); __builtin_nontemporal_store(x1, (GAS f32x4*)(out32 + off + bj * HALF + 4)); }
                            else { ss += (x0[0] * x0[0] + x0[1] * x0[1]) + (x0[2] * x0[2] + x0[3] * x0[3]) + (x1[0] * x1[0] + x1[1] * x1[1]) + (x1[2] * x1[2] + x1[3] * x1[3]);
                                u32x4 w; w.x = pkbf(x0[0], x0[1]); w.y = pkbf(x0[2], x0[3]); w.z = pkbf(x1[0], x1[1]); w.w = pkbf(x1[2], x1[3]); *(GAS u32x4*)(O + off + bj * HALF) = w; } }
                        if (mode != 8) { ss += __shfl_xor(ss, 16); ss += __shfl_xor(ss, 32); if (fq == 0) rowss[row * 16 + u.pn * 4 + wc] = ss; } }
                    asm volatile("" ::: "memory"); }
            }
        } else if (mode == 3) {
#pragma unroll
            for (int bj = 0; bj < 2; ++bj) {
                const f32x4 b0 = *(const GAS f32x4*)(bias + col0 + bj * HALF), b1 = *(const GAS f32x4*)(bias + col0 + bj * HALF + 4);
#pragma unroll
                for (int ai = 0; ai < 2; ++ai)
#pragma unroll
                    for (int m = 0; m < 4; ++m) { const size_t row = (size_t)(row0 + ai * HALF + m * 16);
                        const u32x4 yw = *(const GAS u32x4*)(Y + row * 512 + col0 + bj * HALF); float y[8]; unpack8(yw, y);
                        const f32x4 v0 = acc[ai][bj][m][0] + b0, v1 = acc[ai][bj][m][1] + b1; float o[8];
#pragma unroll
                        for (int j = 0; j < 4; ++j) { o[j] = y[j] * sigmoidf_(v0[j]); o[4 + j] = y[4 + j] * sigmoidf_(v1[j]); }
                        u32x4 w; w.x = pkbf(o[0], o[1]); w.y = pkbf(o[2], o[3]); w.z = pkbf(o[4], o[5]); w.w = pkbf(o[6], o[7]);
                        *(GAS u32x4*)(O + row * D + col0 + bj * HALF) = w; asm volatile("" ::: "memory"); } }
        } else {
            const bool act2 = (sub == 2) && (u.pn >= 2);
            float rr[8]; f32x4 sb[2][2];
#pragma unroll
            for (int j = 0; j < 8; ++j) rr[j] = 1.0f;
#pragma unroll
            for (int bj = 0; bj < 2; ++bj) { sb[bj][0] = (f32x4){0.f, 0.f, 0.f, 0.f}; sb[bj][1] = sb[bj][0]; }
            if (mode == 5) {
                const int lane = fq * 16 + fr; float slot[2];
                f32x4 pp[2][4];
#pragma unroll
                for (int h = 0; h < 2; ++h) { const int li = lane + 64 * h, am = li >> 4; const size_t row = (size_t)(u.pm * BM + (am >> 2) * HALF + wr * 64 + (am & 3) * 16 + (li & 15));
                    const GAS f32x4* rp = (const GAS f32x4*)(rowss + row * 16);
#pragma unroll
                    for (int k = 0; k < 4; ++k) pp[h][k] = rp[k]; }
                const GAS float* sp = shw + (size_t)bidx * ldsh + col0;
#pragma unroll
                for (int bj = 0; bj < 2; ++bj) { sb[bj][0] = *(const GAS f32x4*)(sp + bj * HALF); sb[bj][1] = *(const GAS f32x4*)(sp + bj * HALF + 4); }
#pragma unroll
                for (int h = 0; h < 2; ++h) { const f32x4 s = (pp[h][0] + pp[h][1]) + (pp[h][2] + pp[h][3]); slot[h] = rsqrtf(((s[0] + s[1]) + (s[2] + s[3])) * (1.0f / D) + EPS); }
#pragma unroll
                for (int j = 0; j < 8; ++j) rr[j] = __shfl(slot[j >> 2], (j & 3) * 16 + fr);
            }
#pragma unroll
            for (int ai = 0; ai < 2; ++ai)
#pragma unroll
                for (int m = 0; m < 4; ++m) { const size_t row = (size_t)(row0 + ai * HALF + m * 16); GAS bf16_t* rowp = O + row * ldc + col0; const float r = rr[ai * 4 + m];
#pragma unroll
                    for (int bj = 0; bj < 2; ++bj) { f32x4 v0 = acc[ai][bj][m][0], v1 = acc[ai][bj][m][1];
                        if (mode == 5) { v0 = v0 * r + sb[bj][0]; v1 = v1 * r + sb[bj][1]; }
                        if (sub == 1) {
#pragma unroll
                            for (int j = 0; j < 4; ++j) { const float a0 = fmaxf(v0[j], 0.f), a1 = fmaxf(v1[j], 0.f); v0[j] = a0 * a0; v1[j] = a1 * a1; } }
                        if (act2) {
#pragma unroll
                            for (int j = 0; j < 4; ++j) { v0[j] = gelu_tanh(v0[j]); v1[j] = gelu_tanh(v1[j]); } }
                        u32x4 w; w.x = pkbf(v0[0], v0[1]); w.y = pkbf(v0[2], v0[3]); w.z = pkbf(v1[0], v1[1]); w.w = pkbf(v1[2], v1[3]);
                        __builtin_nontemporal_store(w, (GAS u32x4*)(rowp + bj * HALF)); }
                    asm volatile("" ::: "memory"); }
        }
    }
};

template <int MODE>
__device__ __forceinline__ void gemm_phase(LAS unsigned char* lds, const Gemm g, const StaticOrder& S, const Epi& E) {

    const int tid = otid(), wid = __builtin_amdgcn_readfirstlane(tid >> 6), lane = tid & 63, wr = wid >> 2, wc = wid & 3, fr = lane & 15, fq = lane >> 4;
    const int K = g.K, nt = K / BK;
    unsigned voffA[2], voffB[2];
#pragma unroll
    for (int i = 0; i < 2; ++i) { int R, C; stage_rc(tid * 16 + i * 8192, R, C); const int Rb = (R & ~31) + perm32(R & 31);
        voffA[i] = (unsigned)(R * K + C) * 2u; voffB[i] = (unsigned)(Rb * K + C) * 2u; }
    const size_t kstep = (size_t)(BK * 2);
    const size_t hstep = (size_t)HALF * K * 2;
    const size_t tstep = 2 * hstep;
    const unsigned ldsw = (unsigned)wid * 1024u;
    const int aoff = lds_byte(wr * 64 + fr, fq * 8), boff = lds_byte(wc * 32 + fr, fq * 8);
    const unsigned ldsbase = (unsigned)(unsigned long)lds;
#define PG8_SA(b, h) (((b) * 2 + (h)) * HTB)
#define PG8_SB(b, h) ((4 + (b) * 2 + (h)) * HTB)
#define PG8_STAGE(bufoff, gbase, voff) do { _Pragma("unroll") for (int _i = 0; _i < 2; ++_i) \
        __builtin_amdgcn_global_load_lds((const unsigned*)((const char*)(gbase) + (voff)[_i]), (LAS unsigned*)(lds + (bufoff) + ldsw + _i * 8192), 16, 0, 0); } while (0)
#define PG8_LDA(dst, b, h) do { _Pragma("unroll") for (int m = 0; m < 4; ++m) _Pragma("unroll") for (int k = 0; k < 2; ++k) dst[m][k] = *(const LAS bf16x8*)(lds + PG8_SA(b, h) + aoff + m * 2048 + k * 1024); } while (0)
#define PG8_LDB(dst, b, h) do { _Pragma("unroll") for (int n = 0; n < 2; ++n) _Pragma("unroll") for (int k = 0; k < 2; ++k) dst[n][k] = *(const LAS bf16x8*)(lds + PG8_SB(b, h) + boff + n * 2048 + k * 1024); } while (0)
#define PG8_MMA(ai, bj, At, Bt) do { __builtin_amdgcn_s_setprio(1); _Pragma("unroll") for (int m = 0; m < 4; ++m) _Pragma("unroll") for (int n = 0; n < 2; ++n) _Pragma("unroll") for (int k = 0; k < 2; ++k) \
        acc[ai][bj][m][n] = __builtin_amdgcn_mfma_f32_16x16x32_bf16(Bt[n][k], At[m][k], acc[ai][bj][m][n], 0, 0, 0); __builtin_amdgcn_s_setprio(0); } while (0)
#define PG8_WAIT_V(n) asm volatile("s_waitcnt vmcnt(" #n ")" ::: "memory")
#define PG8_WAIT_L(n) asm volatile("s_waitcnt lgkmcnt(" #n ")" ::: "memory")
#define PG8_BAR __builtin_amdgcn_s_barrier()
#define PG8_SCHED __builtin_amdgcn_sched_barrier(0)
    Unit cur, nxt; int ui = 0;
    if (!S.next(0, cur)) return;
#ifdef STAGGER_US
    if ((blockIdx.x >> 3) & 1) {
        const unsigned long long t0 = __builtin_amdgcn_s_memrealtime();
        while (__builtin_amdgcn_s_memrealtime() - t0 < (unsigned long long)(STAGGER_US * 100)) __builtin_amdgcn_s_sleep(8);
    }
#endif
    f32x4 acc[2][2][4][2];
#pragma unroll
    for (int a = 0; a < 2; ++a)
#pragma unroll
        for (int b = 0; b < 2; ++b)
#pragma unroll
            for (int m = 0; m < 4; ++m)
#pragma unroll
                for (int n = 0; n < 2; ++n) acc[a][b][m][n] = (f32x4){0.f, 0.f, 0.f, 0.f};
    bf16x8 At[4][2], B0[2][2], B1[2][2];
    const char* cA = (const char*)g.A + (size_t)cur.pm * tstep; const char* cB = (const char*)g.Bt + (size_t)cur.pn * tstep + (size_t)(cur.pm >> 5) * g.bbatch;
    PG8_STAGE(PG8_SB(0, 0), cB, voffB); PG8_STAGE(PG8_SA(0, 0), cA, voffA); PG8_STAGE(PG8_SB(0, 1), cB + hstep, voffB); PG8_STAGE(PG8_SA(0, 1), cA + hstep, voffA);
    if (wr == 1) PG8_BAR;
    PG8_WAIT_V(4); PG8_BAR;
    PG8_STAGE(PG8_SB(1, 0), cB + kstep, voffB); PG8_STAGE(PG8_SA(1, 0), cA + kstep, voffA); PG8_STAGE(PG8_SB(1, 1), cB + hstep + kstep, voffB);
    PG8_WAIT_V(6); PG8_BAR;
    for (;;) {
        const bool has_next = S.next(ui + 1, nxt);
        const char* nA = has_next ? (const char*)g.A + (size_t)nxt.pm * tstep : cA; const char* nB = has_next ? (const char*)g.Bt + (size_t)nxt.pn * tstep + (size_t)(nxt.pm >> 5) * g.bbatch : cB;
        for (int t = 0; t < nt; t += 2) {
            const bool last = (t == nt - 2);
            const char* a1 = cA + (size_t)(t + 1) * kstep;
            const char* a2 = last ? nA : cA + (size_t)(t + 2) * kstep; const char* b2 = last ? nB : cB + (size_t)(t + 2) * kstep;
            const char* a3 = a2 + kstep; const char* b3 = b2 + kstep;
            PG8_LDB(B0, 0, 0); PG8_SCHED; PG8_LDA(At, 0, 0); PG8_STAGE(PG8_SA(1, 1), a1 + hstep, voffA);
            PG8_WAIT_L(8); PG8_BAR; PG8_WAIT_L(0); PG8_MMA(0, 0, At, B0); PG8_BAR; PG8_SCHED;
            PG8_LDB(B1, 0, 1); PG8_STAGE(PG8_SB(0, 0), b2, voffB);
            PG8_BAR; PG8_WAIT_L(0); PG8_MMA(0, 1, At, B1); PG8_BAR;
            PG8_LDA(At, 0, 1); PG8_STAGE(PG8_SA(0, 0), a2, voffA);
            PG8_BAR; PG8_WAIT_L(0); PG8_MMA(1, 0, At, B0); PG8_BAR; PG8_SCHED;
            PG8_STAGE(PG8_SB(0, 1), b2 + hstep, voffB);
            PG8_WAIT_V(6); PG8_BAR; PG8_MMA(1, 1, At, B1); PG8_BAR;
            PG8_LDB(B0, 1, 0); PG8_SCHED; PG8_LDA(At, 1, 0); PG8_STAGE(PG8_SA(0, 1), a2 + hstep, voffA);
            PG8_WAIT_L(8); PG8_BAR; PG8_WAIT_L(0); PG8_MMA(0, 0, At, B0); PG8_BAR; PG8_SCHED;
            PG8_LDB(B1, 1, 1); PG8_STAGE(PG8_SB(1, 0), b3, voffB);
            PG8_BAR; PG8_WAIT_L(0); PG8_MMA(0, 1, At, B1); PG8_BAR;
            PG8_LDA(At, 1, 1); PG8_STAGE(PG8_SA(1, 0), a3, voffA);
            PG8_BAR; PG8_WAIT_L(0); PG8_MMA(1, 0, At, B0); PG8_BAR; PG8_SCHED;
            PG8_STAGE(PG8_SB(1, 1), b3 + hstep, voffB);
            PG8_WAIT_V(6); PG8_BAR; PG8_MMA(1, 1, At, B1); PG8_BAR;
        }
        E.template run<MODE>(acc, cur, wr, wc, fr, fq);
        if (!has_next) break;
#pragma unroll
        for (int a = 0; a < 2; ++a)
#pragma unroll
            for (int b = 0; b < 2; ++b)
#pragma unroll
                for (int m = 0; m < 4; ++m)
#pragma unroll
                    for (int n = 0; n < 2; ++n) acc[a][b][m][n] = (f32x4){0.f, 0.f, 0.f, 0.f};
        cur = nxt; cA = nA; cB = nB; ++ui;
    }
    PG8_WAIT_V(0);
    if (wr == 0) PG8_BAR;
    PG8_BAR;
#undef PG8_SA
#undef PG8_SB
#undef PG8_STAGE
#undef PG8_LDA
#undef PG8_LDB
#undef PG8_MMA
#undef PG8_WAIT_V
#undef PG8_WAIT_L
#undef PG8_BAR
#undef PG8_SCHED
}

}

__device__ __forceinline__ void tr_item(const float* W, int ldw, int ncol0, int K, int nblk, bf16_t* WT, int row_off, LAS float* scr, int item, int lane) {
    const int kb = item / nblk, nb = item % nblk, k0 = 64 * kb, n0 = 32 * nb;
    float tv[32];
#pragma unroll
    for (int i = 0; i < 32; ++i) tv[i] = W[(size_t)(k0 + 2 * i + (lane >> 5)) * ldw + ncol0 + n0 + (lane & 31)];
#pragma unroll
    for (int i = 0; i < 32; ++i) scr[(2 * i + (lane >> 5)) * 33 + (lane & 31)] = tv[i];
    LDS_WAIT();
    const int c = lane & 7;
#pragma unroll
    for (int j = 0; j < 4; ++j) { const int n = (lane >> 3) + 8 * j; const LAS float* s = scr + (8 * c) * 33 + n;
        u32x4 o; o.x = pkbf(s[0 * 33], s[1 * 33]); o.y = pkbf(s[2 * 33], s[3 * 33]); o.z = pkbf(s[4 * 33], s[5 * 33]); o.w = pkbf(s[6 * 33], s[7 * 33]);
        *(u32x4*)(WT + (size_t)(row_off + n0 + n) * K + k0 + 8 * c) = o; }
    LDS_WAIT();
}

__device__ __forceinline__ void p0_prologue(const Args& a, LAS unsigned char* lds) {
    const int tid = otid(), lane = tid & 63, wave = __builtin_amdgcn_readfirstlane(tid >> 6);
    unsigned char* ws = a.ws;
    if (blockIdx.x < 192) {
        LAS float* cact = (LAS float*)lds;
        LAS float* red = (LAS float*)(lds + 32768);
        const float* c = a.in[1];
        for (int i = tid; i < 8192; i += NT) cact[i] = siluf_(c[i]);
        __syncthreads();
        const int item = blockIdx.x, layer = item / 96, e = 64 * (item % 96) + lane;
        const float* wp = a.in[2] + (size_t)layer * D * 6144 + e;
        float acc[8];
#pragma unroll
        for (int b = 0; b < 8; ++b) acc[b] = 0.f;
        for (int k0 = wave * 128; k0 < wave * 128 + 128; k0 += 32) {
            float wv[32];
#pragma unroll
            for (int i = 0; i < 32; ++i) wv[i] = wp[(size_t)(k0 + i) * 6144];
#pragma unroll
            for (int i = 0; i < 32; ++i)
#pragma unroll
                for (int b = 0; b < 8; ++b) acc[b] += cact[b * 1024 + k0 + i] * wv[i];
        }
#pragma unroll
        for (int b = 0; b < 8; ++b) red[(wave * 8 + b) * 64 + lane] = acc[b];
        __syncthreads();
        { const int b = tid >> 6; float s = 0.f;
#pragma unroll
          for (int w = 0; w < 8; ++w) s += red[(w * 8 + b) * 64 + lane];
          ((float*)(ws + WS_MOD))[(size_t)(layer * 8 + b) * 6144 + e] = s + a.in[3][layer * 6144 + e]; }
        __syncthreads();
    }
    {
        LAS float* scr = (LAS float*)(lds + wave * 16384);
        const int gw = blockIdx.x * 8 + wave, NGW = gridDim.x * 8;
        constexpr int I0 = 16 * 64, I1 = 16 * 48, I2 = 16 * 32, I3 = 16 * 128, I4 = 64 * 32, I5 = 16 * 48, I6 = 16 * 32, I7 = 8 * 16, I8 = I3, I9 = I4;
        constexpr int NIT = I0 + I1 + I2 + I3 + I4 + I5 + I6 + I7 + I8 + I9;
        for (int it = gw; it < NIT; it += NGW) {
            int r = it;
            if (r < I0) { tr_item(a.in[4], 3608, 0, 1024, 64, (bf16_t*)(ws + WS_WIN0), 0, scr, r, lane); continue; } r -= I0;
            if (r < I1) { tr_item(a.in[4], 3608, 2064, 1024, 48, (bf16_t*)(ws + WS_WIN0), 2048, scr, r, lane); continue; } r -= I1;
            if (r < I2) { tr_item(a.in[5], 1024, 0, 1024, 32, (bf16_t*)(ws + WS_WOUT0), 0, scr, r, lane); continue; } r -= I2;
            if (r < I3) { tr_item(a.in[28], 4096, 0, 1024, 128, (bf16_t*)(ws + WS_W1_0), 0, scr, r, lane); continue; } r -= I3;
            if (r < I4) { tr_item(a.in[29], 1024, 0, 4096, 32, (bf16_t*)(ws + WS_W2_0), 0, scr, r, lane); continue; } r -= I4;
            if (r < I5) { tr_item(a.in[12], 1536, 0, 1024, 48, (bf16_t*)(ws + WS_WIN1), 0, scr, r, lane); continue; } r -= I5;
            if (r < I6) { tr_item(a.in[13], 1024, 0, 1024, 32, (bf16_t*)(ws + WS_WOUT1), 0, scr, r, lane); continue; } r -= I6;
            if (r < I7) { tr_item(a.in[22], 512, 0, 512, 16, (bf16_t*)(ws + WS_WGLU), 0, scr, r, lane); continue; } r -= I7;
            if (r < I8) { tr_item(a.in[28] + (size_t)D * FFD, 4096, 0, 1024, 128, (bf16_t*)(ws + WS_W1_1), 0, scr, r, lane); continue; } r -= I8;
            tr_item(a.in[29] + (size_t)D * FFD, 1024, 0, 4096, 32, (bf16_t*)(ws + WS_W2_1), 0, scr, r, lane);
        }
    }
    {
        if (blockIdx.x == 0 && tid == 0) { unsigned* ctl = (unsigned*)(ws + WS_CTL); __hip_atomic_store(ctl, 0u, __ATOMIC_RELAXED, __HIP_MEMORY_SCOPE_AGENT); __hip_atomic_store(ctl + 64, 0u, __ATOMIC_RELAXED, __HIP_MEMORY_SCOPE_AGENT); }
        const int gt = blockIdx.x * NT + tid, NGT = gridDim.x * NT;
        bf16_t* win0 = (bf16_t*)(ws + WS_WIN0);
        for (int i = gt; i < 256 * 1024; i += NGT) { const int n = i >> 10, k = i & 1023; float v = 0.f;
            if (n < 16) v = a.in[4][(size_t)k * 3608 + 2048 + n]; else if (n < 24) v = a.in[4][(size_t)k * 3608 + 3600 + (n - 16)];
            win0[(size_t)(3584 + n) * 1024 + k] = (bf16_t)(pkbf(v, 0.f) & 0xffffu); }
        bf16_t* wsb = (bf16_t*)(ws + WS_WSB);
        for (int i = gt; i < 8 * 128 * 128; i += NGT) { const int t = (i >> 7) & 127, s = i & 127; const float v = (s <= t) ? a.in[26][i] : 0.f; wsb[i] = (bf16_t)(pkbf(v, 0.f) & 0xffffu); }
        { float* prm = (float*)(ws + WS_PRM);
          for (int i = gt; i < 8192; i += NGT) prm[PR_WLR + i] = a.in[6][i];
          for (int i = gt; i < 1024; i += NGT) prm[PR_BS + i] = a.in[27][i];
          for (int i = gt; i < 512; i += NGT) { prm[PR_BLR + i] = a.in[7][i]; prm[PR_GGAIN + i] = a.in[8][i]; prm[PR_QG + i] = a.in[10][i]; prm[PR_KG + i] = a.in[11][i]; prm[PR_S5D + i] = a.in[21][i];
              prm[PR_BGLU + i] = a.in[23][i]; prm[PR_LNG + i] = a.in[24][i]; prm[PR_LNB + i] = a.in[25][i]; }
          for (int i = gt; i < 8; i += NGT) prm[PR_BF + i] = a.in[9][i]; }
        float* abar = (float*)(ws + WS_S5P + S5_ABAR); bf16_t* Bb = (bf16_t*)(ws + WS_S5P + S5_BB); bf16_t* Cm = (bf16_t*)(ws + WS_S5P + S5_CM);
        for (int i = gt; i < 32 * 64; i += NGT) { const int g = i >> 6, p = i & 63;
            const float lr = a.in[14][i], li = a.in[15][i], dt = expf(a.in[16][g]);
            const float mag = expf(lr * dt), ang = li * dt, ar = mag * cosf(ang), ai = mag * sinf(ang), den = lr * lr + li * li;
            const float cr = ((ar - 1.0f) * lr + ai * li) / den, ci = (ai * lr - (ar - 1.0f) * li) / den;
            abar[2 * i] = ar; abar[2 * i + 1] = ai;
            for (int k = 0; k < 16; ++k) { const float br = a.in[17][(size_t)i * 16 + k], bi = a.in[18][(size_t)i * 16 + k];
                Bb[((size_t)g * 128 + 2 * p) * 16 + k] = (bf16_t)(pkbf(cr * br - ci * bi, 0.f) & 0xffffu);
                Bb[((size_t)g * 128 + 2 * p + 1) * 16 + k] = (bf16_t)(pkbf(cr * bi + ci * br, 0.f) & 0xffffu); } }
        for (int i = gt; i < 32 * 16 * 64; i += NGT) { const int gi = i >> 6, p = i & 63;
            Cm[(size_t)gi * 128 + 2 * p] = (bf16_t)(pkbf(a.in[19][i], 0.f) & 0xffffu); Cm[(size_t)gi * 128 + 2 * p + 1] = (bf16_t)(pkbf(-a.in[20][i], 0.f) & 0xffffu); }
    }
}

__device__ __forceinline__ void norm_phase(const float* x, const float* mod, int off_sh, int off_sc, bf16_t* H) {
    const int tid_ = otid(); const int lane = tid_ & 63, gw = blockIdx.x * 8 + (tid_ >> 6), NGW = gridDim.x * 8;
    for (int m = gw; m < T; m += 2 * NGW) {
        const int m2 = (m + NGW < T) ? m + NGW : m;
        const GAS f32x4* xr = (const GAS f32x4*)(x + (size_t)m * D) + lane; const GAS f32x4* xr2 = (const GAS f32x4*)(x + (size_t)m2 * D) + lane;
        f32x4 v[4], u[4]; float s = 0.f, s2 = 0.f;
#pragma unroll
        for (int j = 0; j < 4; ++j) v[j] = __builtin_nontemporal_load(xr + 64 * j);
#pragma unroll
        for (int j = 0; j < 4; ++j) u[j] = __builtin_nontemporal_load(xr2 + 64 * j);
#pragma unroll
        for (int j = 0; j < 4; ++j) { s += (v[j].x * v[j].x + v[j].y * v[j].y) + (v[j].z * v[j].z + v[j].w * v[j].w); s2 += (u[j].x * u[j].x + u[j].y * u[j].y) + (u[j].z * u[j].z + u[j].w * u[j].w); }
#pragma unroll
        for (int o = 1; o < 64; o <<= 1) { s += __shfl_xor(s, o); s2 += __shfl_xor(s2, o); }
        const float r = rsqrtf(s * (1.0f / D) + EPS), r2 = rsqrtf(s2 * (1.0f / D) + EPS);
        const GAS float* mp = (const GAS float*)mod + (size_t)(m >> 13) * 6144; const GAS float* mp2 = (const GAS float*)mod + (size_t)(m2 >> 13) * 6144;
        GAS u32x2* o8 = (GAS u32x2*)(H + (size_t)m * D) + lane; GAS u32x2* o82 = (GAS u32x2*)(H + (size_t)m2 * D) + lane;
#pragma unroll
        for (int j = 0; j < 4; ++j) { const f32x4 sc = *((const GAS f32x4*)(mp + off_sc) + lane + 64 * j), sh = *((const GAS f32x4*)(mp + off_sh) + lane + 64 * j);
            const f32x4 y = v[j] * r * (sc + 1.0f) + sh; u32x2 w; w.x = pkbf(y.x, y.y); w.y = pkbf(y.z, y.w); o8[64 * j] = w;
            const f32x4 sc2 = *((const GAS f32x4*)(mp2 + off_sc) + lane + 64 * j), sh2 = *((const GAS f32x4*)(mp2 + off_sh) + lane + 64 * j);
            const f32x4 y2 = u[j] * r2 * (sc2 + 1.0f) + sh2; u32x2 w2; w2.x = pkbf(y2.x, y2.y); w2.y = pkbf(y2.z, y2.w); o82[64 * j] = w2; }
    }
}

__device__ __forceinline__ void prep_item(unsigned char* ws, LAS unsigned char* lds, int item) {
    const int tid = otid(), lane = tid & 63, wave = tid >> 6;
    const GAS float* mod = (const GAS float*)(ws + WS_MOD);
    LAS float* sc = (LAS float*)lds; LAS float* sh = (LAS float*)(lds + 32768);
    const int site = item < 64 ? 0 : (item < 88 ? 1 : 2), rb = item < 64 ? item : (item < 88 ? item - 64 : item - 88);
    const int N = (site == 1) ? LD1 : FFD, layer = site ? 1 : 0, osc = (site == 1) ? 1024 : 4096, osh = (site == 1) ? 0 : 3072;
    const GAS bf16_t* Wt = (const GAS bf16_t*)(ws + (site == 0 ? WS_W1_0 : site == 1 ? WS_WIN1 : WS_W1_1));
    GAS bf16_t* WB = (GAS bf16_t*)(ws + (site == 0 ? WS_WB0 : site == 1 ? WS_WB1 : WS_WB2));
    GAS float* shw = (GAS float*)(ws + WS_SHW) + (size_t)site * 8 * 4096;
    for (int i = tid; i < 8192; i += NT) { const int b = i >> 10, k = i & 1023; const GAS float* mp = mod + (size_t)(layer * 8 + b) * 6144; sc[i] = 1.0f + mp[osc + k]; sh[i] = mp[osh + k]; }
    __syncthreads();
    for (int n = 64 * rb + wave; n < 64 * rb + 64; n += 8) {
        const u32x4 w0 = *(const GAS u32x4*)(Wt + (size_t)n * D + 16 * lane), w1 = *(const GAS u32x4*)(Wt + (size_t)n * D + 16 * lane + 8);
        float wv[16]; unpack8(w0, wv); unpack8(w1, wv + 8);
#pragma unroll 1
        for (int b = 0; b < 8; ++b) { float o[16]; float dot = 0.f;
#pragma unroll
            for (int i4 = 0; i4 < 4; ++i4) { const f32x4 s4 = *(const LAS f32x4*)(sc + b * 1024 + 16 * lane + 4 * i4), h4 = *(const LAS f32x4*)(sh + b * 1024 + 16 * lane + 4 * i4);
#pragma unroll
                for (int j = 0; j < 4; ++j) { o[4 * i4 + j] = wv[4 * i4 + j] * s4[j]; dot += wv[4 * i4 + j] * h4[j]; } }
            u32x4 p0, p1; p0.x = pkbf(o[0], o[1]); p0.y = pkbf(o[2], o[3]); p0.z = pkbf(o[4], o[5]); p0.w = pkbf(o[6], o[7]); p1.x = pkbf(o[8], o[9]); p1.y = pkbf(o[10], o[11]); p1.z = pkbf(o[12], o[13]); p1.w = pkbf(o[14], o[15]);
            GAS bf16_t* dst = WB + ((size_t)b * N + n) * D + 16 * lane; *(GAS u32x4*)dst = p0; *(GAS u32x4*)(dst + 8) = p1;
#pragma unroll
            for (int o2 = 1; o2 < 64; o2 <<= 1) dot += __shfl_xor(dot, o2);
            if (lane == 0) shw[(size_t)b * N + n] = dot; }
    }
}

__device__ __forceinline__ void cum_phase(unsigned char* ws, LAS unsigned char* lds) {
    if (blockIdx.x >= 8) {
        const int tid = otid(), lane = tid & 63, w = __builtin_amdgcn_readfirstlane(tid >> 6);
        const GAS bf16_t* P0 = (const GAS bf16_t*)(ws + WS_BIG); GAS _Float16* BC = (GAS _Float16*)(ws + WS_H); const GAS float* prm = (const GAS float*)(ws + WS_PRM);
        LAS float* wl = (LAS float*)lds; LAS float* blr = (LAS float*)(lds + 32768);
        for (int i = tid; i < 8192; i += NT) wl[i] = prm[PR_WLR + i];
        blr[tid] = prm[PR_BLR + tid];
        __syncthreads();
        for (int item = blockIdx.x - 8; item < T / 64; item += gridDim.x - 8) {
            const size_t m = (size_t)item * 64 + lane;
            const u32x4 rl0 = *(const GAS u32x4*)(P0 + m * LD0 + C_LR), rl1 = *(const GAS u32x4*)(P0 + m * LD0 + C_LR + 8);
            float glr[16]; unpack8(rl0, glr); unpack8(rl1, glr + 8);
#pragma unroll 1
            for (int h = 0; h < 8; ++h) {
                f32x4 z0 = *(const LAS f32x4*)(blr + 64 * h + 8 * w), z1 = *(const LAS f32x4*)(blr + 64 * h + 8 * w + 4);
#pragma unroll
                for (int r = 0; r < 16; ++r) { const f32x4 w0 = *(const LAS f32x4*)(wl + r * 512 + 64 * h + 8 * w), w1 = *(const LAS f32x4*)(wl + r * 512 + 64 * h + 8 * w + 4); z0 += w0 * glr[r]; z1 += w1 * glr[r]; }
                float bc[8];
#pragma unroll
                for (int j = 0; j < 4; ++j) { bc[j] = logsig(z0[j]) * 0.0625f; bc[4 + j] = logsig(z1[j]) * 0.0625f; }
#pragma unroll
                for (int d = 1; d < 64; d <<= 1) {
#pragma unroll
                    for (int j = 0; j < 8; ++j) { const float o = __shfl_up(bc[j], d); if (lane >= d) bc[j] += o; } }
                f16x8 hb;
#pragma unroll
                for (int j = 0; j < 8; ++j) hb[j] = (_Float16)bc[j];
                *(GAS f16x8*)(BC + m * 512 + 64 * h + 8 * w) = hb;
            }
        }
        return;
    }
    const int b = blockIdx.x, tid = otid(), lane = tid & 63, wave = tid >> 6;
    const bf16_t* P0 = (const bf16_t*)(ws + WS_BIG); float* cum = (float*)(ws + WS_CUM);
    LAS float* wt = (LAS float*)lds;
    float bf[8];
#pragma unroll
    for (int h = 0; h < 8; ++h) bf[h] = ((const float*)(ws + WS_PRM))[PR_BF + h];
    float run[8];
#pragma unroll
    for (int h = 0; h < 8; ++h) run[h] = 0.f;
    const size_t m0 = (size_t)b * SEQ + 16 * tid;
    for (int i = 0; i < 16; ++i) { const u32x4 w = *(const u32x4*)(P0 + (m0 + i) * LD0 + C_FF); float f[8]; unpack8(w, f);
#pragma unroll
        for (int h = 0; h < 8; ++h) run[h] += logsig(f[h] + bf[h]); }
    float incl[8];
#pragma unroll
    for (int h = 0; h < 8; ++h) { float v = run[h];
#pragma unroll
        for (int d = 1; d < 64; d <<= 1) { const float o = __shfl_up(v, d); if (lane >= d) v += o; }
        incl[h] = v; }
    if (lane == 63) {
#pragma unroll
        for (int h = 0; h < 8; ++h) wt[wave * 8 + h] = incl[h]; }
    __syncthreads();
    float off[8];
#pragma unroll
    for (int h = 0; h < 8; ++h) { float o = incl[h] - run[h]; for (int w = 0; w < wave; ++w) o += wt[w * 8 + h]; off[h] = o; }
    for (int i = 0; i < 16; ++i) { const u32x4 w = *(const u32x4*)(P0 + (m0 + i) * LD0 + C_FF); float f[8]; unpack8(w, f);
#pragma unroll
        for (int h = 0; h < 8; ++h) { off[h] += logsig(f[h] + bf[h]); cum[(size_t)(b * 8 + h) * SEQ + 16 * tid + i] = off[h]; } }
}

__device__ __forceinline__ int q_next(unsigned* ctr, LAS int* slot) {
    __syncthreads();
    if (threadIdx.x == 0) *slot = (int)atomicAdd(ctr, 1u);
    __syncthreads();
    return *slot;
}

#ifndef GLA_NSEG
#define GLA_NSEG 2
#endif
#define GLA_CPS (128 / GLA_NSEG)
__device__ __forceinline__ void gla_item(unsigned char* ws, LAS unsigned char* lds, int b, int h, int seg) {
    const int tid = otid(), lane = tid & 63, w = __builtin_amdgcn_readfirstlane(tid >> 6), c = lane & 15, q = lane >> 4;
    const GAS bf16_t* P0 = (const GAS bf16_t*)(ws + WS_BIG); GAS bf16_t* MIX = (GAS bf16_t*)(ws + WS_MIX); const GAS _Float16* BC = (const GAS _Float16*)(ws + WS_H); const GAS float* prm = (const GAS float*)(ws + WS_PRM);
    LAS bf16_t* Qp = (LAS bf16_t*)(lds); LAS bf16_t* Kp = (LAS bf16_t*)(lds + 9216); LAS bf16_t* Kt = (LAS bf16_t*)(lds + 18432); LAS bf16_t* Vt = (LAS bf16_t*)(lds + 27648);
    LAS bf16_t* Pm = (LAS bf16_t*)(lds + 36864); LAS bf16_t* St = (LAS bf16_t*)(lds + 46080); LAS float* dec = (LAS float*)(lds + 55296);
    LAS float* wl = (LAS float*)(lds + 55552); LAS float* blr = (LAS float*)(lds + 59648);
    for (int i = tid; i < 2304; i += NT) ((LAS unsigned*)St)[i] = 0u;
    float gain[16];
#pragma unroll
    for (int vi = 0; vi < 4; ++vi)
#pragma unroll
        for (int j = 0; j < 4; ++j) gain[vi * 4 + j] = prm[PR_GGAIN + h * 64 + 16 * vi + 4 * q + j];
    f32x4 sacc[4];
#pragma unroll
    for (int vi = 0; vi < 4; ++vi) sacc[vi] = (f32x4){0.f, 0.f, 0.f, 0.f};
    const size_t rowbase = (size_t)b * SEQ;
    u32x4 rq, rk, rv; f16x8 rbh, reh; u32x2 rg[4];
#define GLA_LOAD(ch_) do { const size_t m_ = rowbase + 64 * (ch_) + lane; const GAS bf16_t* p = P0 + m_ * LD0; \
        rq = *(const GAS u32x4*)(p + C_GQ + 64 * h + 8 * w); rk = *(const GAS u32x4*)(p + C_GK + 64 * h + 8 * w); rv = *(const GAS u32x4*)(p + C_GV + 64 * h + 8 * w); \
        rbh = *(const GAS f16x8*)(BC + m_ * 512 + 64 * h + 8 * w); reh = *(const GAS f16x8*)(BC + (rowbase + 64 * (ch_) + 63) * 512 + 64 * h + 8 * w); \
        if (w < 4) { const GAS bf16_t* pg = P0 + (rowbase + 64 * (ch_) + 16 * w + c) * LD0 + C_GG + 64 * h + 4 * q; _Pragma("unroll") for (int vi_ = 0; vi_ < 4; ++vi_) rg[vi_] = *(const GAS u32x2*)(pg + 16 * vi_); } } while (0)
    const int c0 = GLA_CPS * seg, item = (b * 8 + h) * 4 + seg;
    GAS float* EG = (GAS float*)(ws + WS_GLAE); GAS float* DG = (GAS float*)(ws + WS_GLAD); unsigned* flags = (unsigned*)(ws + WS_CTL) + 8192;
    __syncthreads();
    if (seg < GLA_NSEG - 1) {
        float sumbl[8];
#pragma unroll
        for (int j = 0; j < 8; ++j) sumbl[j] = 0.f;
        GLA_LOAD(c0);
        for (int ch = c0; ch < c0 + GLA_CPS; ++ch) {
            {
                const float bc[8] = {(float)rbh[0], (float)rbh[1], (float)rbh[2], (float)rbh[3], (float)rbh[4], (float)rbh[5], (float)rbh[6], (float)rbh[7]};
                const float bl[8] = {(float)reh[0], (float)reh[1], (float)reh[2], (float)reh[3], (float)reh[4], (float)reh[5], (float)reh[6], (float)reh[7]};
                float kf[8]; unpack8(rk, kf);
                const unsigned vv[4] = {rv.x, rv.y, rv.z, rv.w};
#pragma unroll
                for (int j = 0; j < 8; ++j) { sumbl[j] += bl[j]; Kt[(8 * w + j) * 72 + lane] = (bf16_t)(pkbf(kf[j] * __expf(bl[j] - bc[j]), 0.f) & 0xffffu); Vt[(8 * w + j) * 72 + lane] = (bf16_t)((j & 1) ? (vv[j >> 1] >> 16) : (vv[j >> 1] & 0xffffu)); }
                if (lane == 63) {
#pragma unroll
                    for (int j = 0; j < 8; ++j) dec[8 * w + j] = __expf(bl[j]); }
            }
            if (ch + 1 < c0 + GLA_CPS) GLA_LOAD(ch + 1);
            BAR_LDS();
            if (w >= 4) {
                const int ki = w - 4;
                const f32x4 d4 = *(const LAS f32x4*)(dec + 16 * ki + 4 * q);
                const bf16x8 k0 = *(const LAS bf16x8*)(Kt + (16 * ki + c) * 72 + 8 * q), k1 = *(const LAS bf16x8*)(Kt + (16 * ki + c) * 72 + 8 * q + 32);
#pragma unroll
                for (int vi = 0; vi < 4; ++vi) { const bf16x8 v0 = *(const LAS bf16x8*)(Vt + (16 * vi + c) * 72 + 8 * q), v1 = *(const LAS bf16x8*)(Vt + (16 * vi + c) * 72 + 8 * q + 32);
                    f32x4 s2 = sacc[vi] * d4; s2 = MFMA16(k0, v0, s2); s2 = MFMA16(k1, v1, s2); sacc[vi] = s2; }
            }
            BAR_LDS();
        }
        if (w >= 4) { const int ki = w - 4; GAS float* ep = EG + (size_t)item * 4096;
#pragma unroll
            for (int vi = 0; vi < 4; ++vi)
#pragma unroll
                for (int j = 0; j < 4; ++j) ep[(16 * ki + 4 * q + j) * 64 + 16 * vi + c] = sacc[vi][j]; }
        if (lane == 0) {
#pragma unroll
            for (int j = 0; j < 8; ++j) DG[(size_t)item * 64 + 8 * w + j] = sumbl[j]; }
        asm volatile("s_waitcnt vmcnt(0)" ::: "memory");
        __syncthreads();
        if (tid == 0) { __builtin_amdgcn_fence(__ATOMIC_RELEASE, "agent"); asm volatile("s_waitcnt vmcnt(0)" ::: "memory"); __hip_atomic_store(flags + item, 1u, __ATOMIC_RELAXED, __HIP_MEMORY_SCOPE_AGENT); }
    }
    GLA_LOAD(c0);
#pragma unroll
    for (int vi = 0; vi < 4; ++vi) sacc[vi] = (f32x4){0.f, 0.f, 0.f, 0.f};
    if (seg > 0) {
        if (tid == 0) {
            for (int s2 = 0; s2 < seg; ++s2) { unsigned sp = 0; while (__hip_atomic_load(flags + item - seg + s2, __ATOMIC_RELAXED, __HIP_MEMORY_SCOPE_AGENT) == 0u) { __builtin_amdgcn_s_sleep(2); if (++sp > (1u << 22)) break; } }
            __builtin_amdgcn_fence(__ATOMIC_ACQUIRE, "agent"); asm volatile("s_waitcnt vmcnt(0)" ::: "memory");
        }
        __syncthreads();
        if (w >= 4) { const int ki = w - 4;
            for (int s2 = 0; s2 < seg; ++s2) { const GAS float* ep = EG + (size_t)(item - seg + s2) * 4096; const GAS float* dp = DG + (size_t)(item - seg + s2) * 64 + 16 * ki + 4 * q;
                float dv[4];
#pragma unroll
                for (int j = 0; j < 4; ++j) dv[j] = __expf(__hip_atomic_load(dp + j, __ATOMIC_RELAXED, __HIP_MEMORY_SCOPE_AGENT));
#pragma unroll
                for (int vi = 0; vi < 4; ++vi)
#pragma unroll
                    for (int j = 0; j < 4; ++j) sacc[vi][j] = dv[j] * sacc[vi][j] + __hip_atomic_load(ep + (16 * ki + 4 * q + j) * 64 + 16 * vi + c, __ATOMIC_RELAXED, __HIP_MEMORY_SCOPE_AGENT); }
#pragma unroll
            for (int vi = 0; vi < 4; ++vi) { u32x2 sw; sw.x = pkbf(sacc[vi][0], sacc[vi][1]); sw.y = pkbf(sacc[vi][2], sacc[vi][3]); *(LAS u32x2*)(St + (16 * vi + c) * 72 + 16 * ki + 4 * q) = sw; }
        }
    }
    __syncthreads();
    for (int ch = c0; ch < c0 + GLA_CPS; ++ch) {
        u32x2 gcur[4];
#pragma unroll
        for (int vi = 0; vi < 4; ++vi) gcur[vi] = rg[vi];
        {
            const float bc[8] = {(float)rbh[0], (float)rbh[1], (float)rbh[2], (float)rbh[3], (float)rbh[4], (float)rbh[5], (float)rbh[6], (float)rbh[7]};
            const float ble[8] = {(float)reh[0], (float)reh[1], (float)reh[2], (float)reh[3], (float)reh[4], (float)reh[5], (float)reh[6], (float)reh[7]};
            float qf[8], kf[8]; unpack8(rq, qf); unpack8(rk, kf);
            float qp[8], kp[8], kpp[8], bl[8];
#pragma unroll
            for (int j = 0; j < 8; ++j) { bl[j] = ble[j]; qp[j] = qf[j] * 0.125f * __expf(bc[j]); kp[j] = kf[j] * __expf(-bc[j]); kpp[j] = kf[j] * __expf(bl[j] - bc[j]); }
            u32x4 wq, wk; wq.x = pkbf(qp[0], qp[1]); wq.y = pkbf(qp[2], qp[3]); wq.z = pkbf(qp[4], qp[5]); wq.w = pkbf(qp[6], qp[7]);
            wk.x = pkbf(kp[0], kp[1]); wk.y = pkbf(kp[2], kp[3]); wk.z = pkbf(kp[4], kp[5]); wk.w = pkbf(kp[6], kp[7]);
            *(LAS u32x4*)(Qp + lane * 72 + 8 * w) = wq; *(LAS u32x4*)(Kp + lane * 72 + 8 * w) = wk;
            const unsigned vv[4] = {rv.x, rv.y, rv.z, rv.w};
#pragma unroll
            for (int j = 0; j < 8; ++j) { Kt[(8 * w + j) * 72 + lane] = (bf16_t)(pkbf(kpp[j], 0.f) & 0xffffu); Vt[(8 * w + j) * 72 + lane] = (bf16_t)((j & 1) ? (vv[j >> 1] >> 16) : (vv[j >> 1] & 0xffffu)); }
            if (lane == 63) {
#pragma unroll
                for (int j = 0; j < 8; ++j) dec[8 * w + j] = __expf(bl[j]); }
        }
        if (ch + 1 < c0 + GLA_CPS) GLA_LOAD(ch + 1);
        BAR_LDS();
        f32x4 oacc[4];
        {
            const int ti = w & 3;
            const bf16x8 qf0 = *(const LAS bf16x8*)(Qp + (16 * ti + c) * 72 + 8 * q), qf1 = *(const LAS bf16x8*)(Qp + (16 * ti + c) * 72 + 8 * q + 32);
#pragma unroll
            for (int u = 0; u < 2; ++u) { const int si = 2 * (w >> 2) + u; f32x4 acc = (f32x4){0.f, 0.f, 0.f, 0.f};
                if (si <= ti) { const bf16x8 k0 = *(const LAS bf16x8*)(Kp + (16 * si + c) * 72 + 8 * q), k1 = *(const LAS bf16x8*)(Kp + (16 * si + c) * 72 + 8 * q + 32);
                    acc = MFMA16(k0, qf0, acc); acc = MFMA16(k1, qf1, acc);
#pragma unroll
                    for (int j = 0; j < 4; ++j) if (16 * si + 4 * q + j > 16 * ti + c) acc[j] = 0.f; }
                u32x2 pw; pw.x = pkbf(acc[0], acc[1]); pw.y = pkbf(acc[2], acc[3]);
                *(LAS u32x2*)(Pm + (16 * ti + c) * 72 + 16 * si + 4 * q) = pw; }
            if (w < 4) {
#pragma unroll
                for (int vi = 0; vi < 4; ++vi) { const bf16x8 s0 = *(const LAS bf16x8*)(St + (16 * vi + c) * 72 + 8 * q), s1 = *(const LAS bf16x8*)(St + (16 * vi + c) * 72 + 8 * q + 32);
                    f32x4 acc = (f32x4){0.f, 0.f, 0.f, 0.f}; acc = MFMA16(s0, qf0, acc); acc = MFMA16(s1, qf1, acc); oacc[vi] = acc; } }
        }
        BAR_LDS();
        if (w < 4) {
            const bf16x8 p0 = *(const LAS bf16x8*)(Pm + (16 * w + c) * 72 + 8 * q), p1 = *(const LAS bf16x8*)(Pm + (16 * w + c) * 72 + 8 * q + 32);
            float ssq = 0.f;
#pragma unroll
            for (int vi = 0; vi < 4; ++vi) { const bf16x8 v0 = *(const LAS bf16x8*)(Vt + (16 * vi + c) * 72 + 8 * q), v1 = *(const LAS bf16x8*)(Vt + (16 * vi + c) * 72 + 8 * q + 32);
                oacc[vi] = MFMA16(v0, p0, oacc[vi]); oacc[vi] = MFMA16(v1, p1, oacc[vi]);
#pragma unroll
                for (int j = 0; j < 4; ++j) ssq += oacc[vi][j] * oacc[vi][j]; }
            ssq += __shfl_xor(ssq, 16); ssq += __shfl_xor(ssq, 32);
            const float r = rsqrtf(ssq * (1.0f / 64.0f) + EPS);
            const size_t m = rowbase + 64 * ch + 16 * w + c;
#pragma unroll
            for (int vi = 0; vi < 4; ++vi) { const u32x2 gw = gcur[vi];
                const float g0 = bflo(gw.x), g1 = bfhi(gw.x), g2 = bflo(gw.y), g3 = bfhi(gw.y);
                u32x2 ow; ow.x = pkbf(oacc[vi][0] * r * gain[vi * 4 + 0] * siluf_(g0), oacc[vi][1] * r * gain[vi * 4 + 1] * siluf_(g1));
                ow.y = pkbf(oacc[vi][2] * r * gain[vi * 4 + 2] * siluf_(g2), oacc[vi][3] * r * gain[vi * 4 + 3] * siluf_(g3));
                *(GAS u32x2*)(MIX + m * D + 64 * h + 16 * vi + 4 * q) = ow; }
        } else {
            const int ki = w - 4;
            const f32x4 d4 = *(const LAS f32x4*)(dec + 16 * ki + 4 * q);
            const bf16x8 k0 = *(const LAS bf16x8*)(Kt + (16 * ki + c) * 72 + 8 * q), k1 = *(const LAS bf16x8*)(Kt + (16 * ki + c) * 72 + 8 * q + 32);
#pragma unroll
            for (int vi = 0; vi < 4; ++vi) { const bf16x8 v0 = *(const LAS bf16x8*)(Vt + (16 * vi + c) * 72 + 8 * q), v1 = *(const LAS bf16x8*)(Vt + (16 * vi + c) * 72 + 8 * q + 32);
                f32x4 s = sacc[vi] * d4; s = MFMA16(k0, v0, s); s = MFMA16(k1, v1, s); sacc[vi] = s;
                u32x2 sw; sw.x = pkbf(s[0], s[1]); sw.y = pkbf(s[2], s[3]);
                *(LAS u32x2*)(St + (16 * vi + c) * 72 + 16 * ki + 4 * q) = sw; }
        }
        BAR_LDS();
    }
}

#undef GLA_LOAD
__device__ __forceinline__ void fox_item(unsigned char* ws, LAS unsigned char* lds, int b, int h, int qg) {
    const int tid = otid(), lane = tid & 63, w = __builtin_amdgcn_readfirstlane(tid >> 6), c = lane & 15, q = lane >> 4;
    const GAS bf16_t* P0 = (const GAS bf16_t*)(ws + WS_BIG); GAS bf16_t* MIX = (GAS bf16_t*)(ws + WS_MIX);
    const GAS float* cumb = (const GAS float*)(ws + WS_CUM) + (size_t)(b * 8 + h) * SEQ;
    LAS bf16_t* Kn = (LAS bf16_t*)(lds); LAS bf16_t* Vt = (LAS bf16_t*)(lds + 9216); LAS float* cumk = (LAS float*)(lds + 18432);
    const GAS float* gq = (const GAS float*)(ws + WS_PRM) + PR_QG + h * 64; const GAS float* gk = (const GAS float*)(ws + WS_PRM) + PR_KG + h * 64;
    float mq = fabsf(gq[lane]), mk = fabsf(gk[lane]);
#pragma unroll
    for (int o = 1; o < 64; o <<= 1) { mq = fmaxf(mq, __shfl_xor(mq, o)); mk = fmaxf(mk, __shfl_xor(mk, o)); }
    const float B2 = 16.0f * mq * mk * 1.001f;
    const int srow = tid >> 3, dc = tid & 7;
    float gkr[8], gqr[16];
#pragma unroll
    for (int e2 = 0; e2 < 8; ++e2) { gkr[e2] = gk[8 * dc + e2]; gqr[e2] = gq[8 * q + e2]; gqr[8 + e2] = gq[8 * q + 32 + e2]; }
    const size_t rowbase = (size_t)b * SEQ;
    for (int qi = 2 * qg; qi < 2 * qg + 2; ++qi) {
        const int t0 = 128 * qi, t = t0 + 16 * w + c; const size_t m = rowbase + t;
        int j = 2 * qi + 1;
        const u32x4 r0 = *(const GAS u32x4*)(P0 + m * LD0 + C_FQ + 64 * h + 8 * q), r1 = *(const GAS u32x4*)(P0 + m * LD0 + C_FQ + 64 * h + 8 * q + 32);
        const float cum_t0 = cumb[t0], cum_t = cumb[t];
        const int jl0 = 2 * qi - 1 - lane; const float ce0 = (jl0 >= 0) ? cumb[64 * jl0 + 63] : 0.f;
        u32x4 rk, rv; float rc;
        { const size_t ms = rowbase + 64 * j + srow; rk = *(const GAS u32x4*)(P0 + ms * LD0 + C_FK + 64 * h + 8 * dc); rv = *(const GAS u32x4*)(P0 + ms * LD0 + C_FV + 64 * h + 8 * dc); rc = cumb[64 * j + srow]; }
        int nbelow = 0;
        { const bool skp = (jl0 < 0) || ((B2 + cum_t0 - ce0) < -110.0f); const unsigned long long mk0 = __ballot(skp);
          if (mk0) nbelow = __ffsll((long long)mk0) - 1;
          else { nbelow = 64;
              for (int basej = 2 * qi - 1 - 64; basej >= 0; basej -= 64) { const int jl = basej - lane; const float ce = (jl >= 0) ? cumb[64 * jl + 63] : 0.f;
                  const bool sk2 = (jl < 0) || ((B2 + cum_t0 - ce) < -110.0f); const unsigned long long mk2 = __ballot(sk2);
                  if (mk2) { nbelow += __ffsll((long long)mk2) - 1; break; } nbelow += 64; } } }
        const int jlo = 2 * qi - nbelow;
        bf16x8 qf[2];
        { float f[16]; unpack8(r0, f); unpack8(r1, f + 8); float ss = 0.f;
#pragma unroll
          for (int e2 = 0; e2 < 16; ++e2) ss += f[e2] * f[e2];
          ss += __shfl_xor(ss, 16); ss += __shfl_xor(ss, 32);
          const float r = rsqrtf(ss * (1.0f / 64.0f) + EPS) * 0.125f;
#pragma unroll
          for (int kk = 0; kk < 2; ++kk) { float g[8];
#pragma unroll
              for (int e2 = 0; e2 < 8; ++e2) g[e2] = f[8 * kk + e2] * r * gqr[8 * kk + e2];
              u32x4 pw; pw.x = pkbf(g[0], g[1]); pw.y = pkbf(g[2], g[3]); pw.z = pkbf(g[4], g[5]); pw.w = pkbf(g[6], g[7]); qf[kk] = as_bf16x8(pw); } }
        f32x4 oacc[4];
#pragma unroll
        for (int di = 0; di < 4; ++di) oacc[di] = (f32x4){0.f, 0.f, 0.f, 0.f};
        float mrun = -1e30f, lpart = 0.f;
        for (;;) {
            { float f[8]; unpack8(rk, f); float ss = 0.f;
#pragma unroll
              for (int e2 = 0; e2 < 8; ++e2) ss += f[e2] * f[e2];
              ss += __shfl_xor(ss, 1); ss += __shfl_xor(ss, 2); ss += __shfl_xor(ss, 4);
              const float r = rsqrtf(ss * (1.0f / 64.0f) + EPS);
#pragma unroll
              for (int e2 = 0; e2 < 8; ++e2) f[e2] = f[e2] * r * gkr[e2];
              u32x4 pw; pw.x = pkbf(f[0], f[1]); pw.y = pkbf(f[2], f[3]); pw.z = pkbf(f[4], f[5]); pw.w = pkbf(f[6], f[7]);
              *(LAS u32x4*)(Kn + srow * 72 + 8 * dc) = pw;
              const unsigned vv[4] = {rv.x, rv.y, rv.z, rv.w};
#pragma unroll
              for (int e2 = 0; e2 < 8; ++e2) Vt[(8 * dc + e2) * 72 + srow] = (bf16_t)((e2 & 1) ? (vv[e2 >> 1] >> 16) : (vv[e2 >> 1] & 0xffffu));
              if (dc == 0) cumk[srow] = rc; }
            const int jn = j - 1;
            const bool cont = jn >= jlo;
            if (cont) { const size_t ms = rowbase + 64 * jn + srow; rk = *(const GAS u32x4*)(P0 + ms * LD0 + C_FK + 64 * h + 8 * dc); rv = *(const GAS u32x4*)(P0 + ms * LD0 + C_FV + 64 * h + 8 * dc); rc = cumb[64 * jn + srow]; }
            BAR_LDS();
            if (!(j == 2 * qi + 1 && w < 4)) {
                float sv[4][4]; float mx = -1e30f;
#pragma unroll
                for (int si = 0; si < 4; ++si) { f32x4 acc = (f32x4){0.f, 0.f, 0.f, 0.f};
                    const bf16x8 k0 = *(const LAS bf16x8*)(Kn + (16 * si + c) * 72 + 8 * q), k1 = *(const LAS bf16x8*)(Kn + (16 * si + c) * 72 + 8 * q + 32);
                    acc = MFMA16(k0, qf[0], acc); acc = MFMA16(k1, qf[1], acc);
                    const f32x4 ck = *(const LAS f32x4*)(cumk + 16 * si + 4 * q);
#pragma unroll
                    for (int jj = 0; jj < 4; ++jj) { float lg = acc[jj] + (cum_t - ck[jj]); if (j >= 2 * qi && (64 * j + 16 * si + 4 * q + jj) > t) lg = -1e30f; sv[si][jj] = lg; mx = fmaxf(mx, lg); } }
                mx = fmaxf(mx, __shfl_xor(mx, 16)); mx = fmaxf(mx, __shfl_xor(mx, 32));
                const float mnew = fmaxf(mrun, mx), alpha = __expf(mrun - mnew); mrun = mnew;
                float ps = 0.f;
#pragma unroll
                for (int si = 0; si < 4; ++si)
#pragma unroll
                    for (int jj = 0; jj < 4; ++jj) { sv[si][jj] = __expf(sv[si][jj] - mnew); ps += sv[si][jj]; }
                lpart = lpart * alpha + ps;
#pragma unroll
                for (int di = 0; di < 4; ++di) oacc[di] *= alpha;
#pragma unroll
                for (int kk = 0; kk < 2; ++kk) { u32x4 pw; pw.x = pkbf(sv[2 * kk][0], sv[2 * kk][1]); pw.y = pkbf(sv[2 * kk][2], sv[2 * kk][3]); pw.z = pkbf(sv[2 * kk + 1][0], sv[2 * kk + 1][1]); pw.w = pkbf(sv[2 * kk + 1][2], sv[2 * kk + 1][3]);
                    const bf16x8 pf = as_bf16x8(pw);
#pragma unroll
                    for (int di = 0; di < 4; ++di) { const u32x2 va = *(const LAS u32x2*)(Vt + (16 * di + c) * 72 + 32 * kk + 4 * q), vb = *(const LAS u32x2*)(Vt + (16 * di + c) * 72 + 32 * kk + 16 + 4 * q);
                        u32x4 vw; vw.x = va.x; vw.y = va.y; vw.z = vb.x; vw.w = vb.y; oacc[di] = MFMA16(as_bf16x8(vw), pf, oacc[di]); } }
            }
            BAR_LDS();
            if (!cont) break;
            j = jn;
        }
        float l = lpart; l += __shfl_xor(l, 16); l += __shfl_xor(l, 32);
        const float inv = 1.0f / l;
#pragma unroll
        for (int di = 0; di < 4; ++di) { u32x2 ow; ow.x = pkbf(oacc[di][0] * inv, oacc[di][1] * inv); ow.y = pkbf(oacc[di][2] * inv, oacc[di][3] * inv);
            *(GAS u32x2*)(MIX + m * D + 512 + 64 * h + 16 * di + 4 * q) = ow; }
    }
}

__device__ __forceinline__ void s5_item(unsigned char* ws, LAS unsigned char* lds, int b, int g) {
    const int tid = otid(), lane = tid & 63, w = __builtin_amdgcn_readfirstlane(tid >> 6), c = lane & 15, q = lane >> 4;
    const GAS bf16_t* P1 = (const GAS bf16_t*)(ws + WS_BIG); GAS bf16_t* YS = (GAS bf16_t*)(ws + WS_YS5);
    const GAS float* abar = (const GAS float*)(ws + WS_S5P + S5_ABAR); const GAS bf16_t* Bb = (const GAS bf16_t*)(ws + WS_S5P + S5_BB); const GAS bf16_t* Cm = (const GAS bf16_t*)(ws + WS_S5P + S5_CM);
    LAS float* bu = (LAS float*)(lds + w * 12800); LAS bf16_t* xs = (LAS bf16_t*)(lds + w * 12800 + 8448); LAS float* E = (LAS float*)(lds + 102400);
    const float ar = abar[(g * 64 + lane) * 2], ai = abar[(g * 64 + lane) * 2 + 1];
    float pr = ar, pi = ai;
#pragma unroll
    for (int i = 0; i < 10; ++i) { const float nr = pr * pr - pi * pi, ni = 2.0f * pr * pi; pr = nr; pi = ni; }
    bf16x8 bfr[8], cfr[4];
    const bf16x8 zero8 = (bf16x8){0, 0, 0, 0, 0, 0, 0, 0};
#pragma unroll
    for (int pt = 0; pt < 8; ++pt) bfr[pt] = (q < 2) ? *(const GAS bf16x8*)(Bb + ((size_t)(g * 128 + 16 * pt + c)) * 16 + 8 * q) : zero8;
#pragma unroll
    for (int kk = 0; kk < 4; ++kk) cfr[kk] = *(const GAS bf16x8*)(Cm + (size_t)(g * 16 + c) * 128 + 32 * kk + 8 * q);
    float dsk[4];
#pragma unroll
    for (int j = 0; j < 4; ++j) dsk[j] = ((const GAS float*)(ws + WS_PRM))[PR_S5D + g * 16 + 4 * q + j];
    f32x2 x2 = {0.f, 0.f}; const f32x2 a1 = {ar, ar}, a2 = {-ai, ai};
    LAS bf16_t* xs1 = (LAS bf16_t*)(lds + 106496 + w * 4352);
    for (int pass = 0; pass < 2; ++pass) {
        const size_t mbase = (size_t)b * SEQ + 1024 * w + c;
        bf16x8 uf_a = (q < 2) ? *(const GAS bf16x8*)(P1 + mbase * LD1 + 16 * g + 8 * q) : zero8;
        bf16x8 uf_b = (q < 2) ? *(const GAS bf16x8*)(P1 + (mbase + 16) * LD1 + 16 * g + 8 * q) : zero8;
        u32x2 uw_cur = *(const GAS u32x2*)(P1 + mbase * LD1 + 16 * g + 4 * q), uw_nxt = *(const GAS u32x2*)(P1 + (mbase + 16) * LD1 + 16 * g + 4 * q), uw_prev = uw_cur;
        f32x4 abu[8];
#pragma unroll
        for (int pt = 0; pt < 8; ++pt) abu[pt] = MFMA16(bfr[pt], uf_a, ((f32x4){0.f, 0.f, 0.f, 0.f}));
        for (int sc = 0; sc < 64; ++sc) {
            const size_t m = mbase + 16 * sc;
            LAS bf16_t* xw = (sc & 1) ? xs1 : xs; LAS bf16_t* xr = (sc & 1) ? xs : xs1;
#pragma unroll
            for (int pt = 0; pt < 8; ++pt) *(LAS f32x4*)(bu + c * 132 + 16 * pt + 4 * q) = abu[pt];
            const bf16x8 uf_use = uf_b;
            if (sc + 2 < 64) { uf_b = (q < 2) ? *(const GAS bf16x8*)(P1 + (m + 32) * LD1 + 16 * g + 8 * q) : zero8; }
            u32x2 uw_n2 = uw_nxt; if (sc + 2 < 64) uw_n2 = *(const GAS u32x2*)(P1 + (m + 32) * LD1 + 16 * g + 4 * q);
#pragma unroll
            for (int pt = 0; pt < 8; ++pt) abu[pt] = MFMA16(bfr[pt], uf_use, ((f32x4){0.f, 0.f, 0.f, 0.f}));
            bf16x8 xf[4];
            if (pass && sc > 0) {
#pragma unroll
                for (int kk = 0; kk < 4; ++kk) xf[kk] = *(const LAS bf16x8*)(xr + c * 136 + 32 * kk + 8 * q); }
            LDS_WAIT();
#pragma unroll
            for (int tt = 0; tt < 16; ++tt) { const f32x2 bb = *(const LAS f32x2*)(bu + tt * 132 + 2 * lane);
                const f32x2 t2 = a1 * x2 + bb; const f32x2 xsw = {x2.y, x2.x}; x2 = a2 * xsw + t2;
                if (pass) *(LAS unsigned*)(xw + tt * 136 + 2 * lane) = pkbf(x2.x, x2.y); }
            if (pass && sc > 0) {
                f32x4 acc = (f32x4){0.f, 0.f, 0.f, 0.f};
#pragma unroll
                for (int kk = 0; kk < 4; ++kk) acc = MFMA16(cfr[kk], xf[kk], acc);
                const float y0 = gelu_tanh(acc[0] + dsk[0] * bflo(uw_prev.x)), y1 = gelu_tanh(acc[1] + dsk[1] * bfhi(uw_prev.x)), y2 = gelu_tanh(acc[2] + dsk[2] * bflo(uw_prev.y)), y3 = gelu_tanh(acc[3] + dsk[3] * bfhi(uw_prev.y));
                u32x2 ow; ow.x = pkbf(y0, y1); ow.y = pkbf(y2, y3);
                *(GAS u32x2*)(YS + (m - 16) * 512 + 16 * g + 4 * q) = ow;
            }
            uw_prev = uw_cur; uw_cur = uw_nxt; uw_nxt = uw_n2;
        }
        if (pass) {
            LDS_WAIT();
            f32x4 acc = (f32x4){0.f, 0.f, 0.f, 0.f};
#pragma unroll
            for (int kk = 0; kk < 4; ++kk) { const bf16x8 xf = *(const LAS bf16x8*)(xs1 + c * 136 + 32 * kk + 8 * q); acc = MFMA16(cfr[kk], xf, acc); }
            const float y0 = gelu_tanh(acc[0] + dsk[0] * bflo(uw_prev.x)), y1 = gelu_tanh(acc[1] + dsk[1] * bfhi(uw_prev.x)), y2 = gelu_tanh(acc[2] + dsk[2] * bflo(uw_prev.y)), y3 = gelu_tanh(acc[3] + dsk[3] * bfhi(uw_prev.y));
            u32x2 ow; ow.x = pkbf(y0, y1); ow.y = pkbf(y2, y3);
            *(GAS u32x2*)(YS + (mbase + 16 * 63) * 512 + 16 * g + 4 * q) = ow;
            LDS_WAIT();
        }
        if (pass == 0) {
            E[w * 128 + lane] = x2.x; E[w * 128 + 64 + lane] = x2.y;
            __syncthreads();
            float cr = 0.f, ci = 0.f;
            for (int w2 = 0; w2 < w; ++w2) { const float er = E[w2 * 128 + lane], ei = E[w2 * 128 + 64 + lane]; const float nr = pr * cr - pi * ci + er, ni = pr * ci + pi * cr + ei; cr = nr; ci = ni; }
            x2.x = cr; x2.y = ci;
        }
    }
}

__device__ __forceinline__ void sgu_item(unsigned char* ws, LAS unsigned char* lds, int b, int n) {
    const int tid = otid(), lane = tid & 63, w = __builtin_amdgcn_readfirstlane(tid >> 6), c = lane & 15, q = lane >> 4;
    const GAS bf16_t* P1 = (const GAS bf16_t*)(ws + WS_BIG); GAS bf16_t* MIX = (GAS bf16_t*)(ws + WS_MIX); const GAS bf16_t* wsb = (const GAS bf16_t*)(ws + WS_WSB);
    LAS bf16_t* Vt = (LAS bf16_t*)lds;
    const size_t m0 = (size_t)b * SEQ + 128 * n;
    {
        const int s = tid >> 2, qq = tid & 3; const GAS bf16_t* vp = P1 + (m0 + s) * LD1 + 1024 + 128 * qq;
        u32x4 rv[16]; float sum = 0.f, ssq = 0.f;
#pragma unroll
        for (int i = 0; i < 16; ++i) { rv[i] = *(const GAS u32x4*)(vp + 8 * i); float f[8]; unpack8(rv[i], f);
#pragma unroll
            for (int e = 0; e < 8; ++e) { sum += f[e]; ssq += f[e] * f[e]; } }
        sum += __shfl_xor(sum, 1); sum += __shfl_xor(sum, 2); ssq += __shfl_xor(ssq, 1); ssq += __shfl_xor(ssq, 2);
        const float mu = sum * (1.0f / 512.0f), var = fmaxf(ssq * (1.0f / 512.0f) - mu * mu, 0.f), rstd = rsqrtf(var + EPS);
        const GAS float* lg = (const GAS float*)(ws + WS_PRM) + PR_LNG + 128 * qq; const GAS float* lb = (const GAS float*)(ws + WS_PRM) + PR_LNB + 128 * qq;
#pragma unroll
        for (int i = 0; i < 16; ++i) { float f[8]; unpack8(rv[i], f);
            const f32x4 g0 = *(const GAS f32x4*)(lg + 8 * i), g1 = *(const GAS f32x4*)(lg + 8 * i + 4), b0 = *(const GAS f32x4*)(lb + 8 * i), b1 = *(const GAS f32x4*)(lb + 8 * i + 4);
#pragma unroll
            for (int e = 0; e < 8; ++e) { const float gg = e < 4 ? g0[e & 3] : g1[e & 3], bb = e < 4 ? b0[e & 3] : b1[e & 3]; const float y = (f[e] - mu) * rstd * gg + bb;
                Vt[(128 * qq + 8 * i + e) * 136 + s] = (bf16_t)(pkbf(y, 0.f) & 0xffffu); } }
    }
    __syncthreads();
    const int nk = (w >> 1) + 1; const int trow = 16 * w + c; const size_t m = m0 + trow;
    bf16x8 wfn[4]; u32x2 uwn[4]; float bsn;
#define SGU_LOAD(g_) do { _Pragma("unroll") for (int kk_ = 0; kk_ < 4; ++kk_) if (kk_ < nk) wfn[kk_] = *(const GAS bf16x8*)(wsb + ((size_t)(g_) * 128 + trow) * 128 + 32 * kk_ + 8 * q); \
        _Pragma("unroll") for (int ct_ = 0; ct_ < 4; ++ct_) uwn[ct_] = *(const GAS u32x2*)(P1 + m * LD1 + 512 + 64 * (g_) + 16 * ct_ + 4 * q); \
        bsn = ((const GAS float*)(ws + WS_PRM))[PR_BS + (g_) * 128 + trow]; } while (0)
    SGU_LOAD(0);
    for (int g = 0; g < 8; ++g) {
        bf16x8 wf[4]; u32x2 uw[4];
#pragma unroll
        for (int kk = 0; kk < 4; ++kk) wf[kk] = wfn[kk];
#pragma unroll
        for (int ct = 0; ct < 4; ++ct) uw[ct] = uwn[ct];
        const float bs = bsn;
        if (g + 1 < 8) SGU_LOAD(g + 1);
        f32x4 acc[4];
#pragma unroll
        for (int ct = 0; ct < 4; ++ct) acc[ct] = (f32x4){0.f, 0.f, 0.f, 0.f};
#pragma unroll
        for (int kk = 0; kk < 4; ++kk) if (kk < nk) {
#pragma unroll
            for (int ct = 0; ct < 4; ++ct) { const bf16x8 vf = *(const LAS bf16x8*)(Vt + (64 * g + 16 * ct + c) * 136 + 32 * kk + 8 * q); acc[ct] = MFMA16(vf, wf[kk], acc[ct]); } }
#pragma unroll
        for (int ct = 0; ct < 4; ++ct) {
            u32x2 ow; ow.x = pkbf(bflo(uw[ct].x) * (acc[ct][0] + bs), bfhi(uw[ct].x) * (acc[ct][1] + bs)); ow.y = pkbf(bflo(uw[ct].y) * (acc[ct][2] + bs), bfhi(uw[ct].y) * (acc[ct][3] + bs));
            *(GAS u32x2*)(MIX + m * D + 512 + 64 * g + 16 * ct + 4 * q) = ow; }
    }
#undef SGU_LOAD
}

#define XB_TMO      128
#define XB_XCNT(j)  (256  + 64 * (j))
#define XB_XSUB(j)  (1280 + 64 * (j))
#define XB_XGEN(j)  (2304 + 64 * (j))
#define XB_TOP      3328
#define XB_TOPGEN   3392
#define XCD_BAR_WORDS 3456
#define XB_SPIN_CAP (1u << 22)
__device__ __forceinline__ unsigned xb_ld(unsigned* p)              { return __hip_atomic_load(p, __ATOMIC_RELAXED, __HIP_MEMORY_SCOPE_AGENT); }
__device__ __forceinline__ unsigned xb_add(unsigned* p, unsigned v) { return __hip_atomic_fetch_add(p, v, __ATOMIC_RELAXED, __HIP_MEMORY_SCOPE_AGENT); }
__device__ __forceinline__ unsigned xb_xcc_id() { return (unsigned)__builtin_amdgcn_s_getreg((3 << 11) | 20) & 0xFu; }
#define XB_SPIN(cond, bar) do { unsigned _sp = 0; while (cond) { __builtin_amdgcn_s_sleep(1); \
    if ((++_sp & 255u) == 0u) { if (xb_ld(&(bar)[XB_TMO])) break; if (_sp > XB_SPIN_CAP) { atomicAdd(&(bar)[XB_TMO], 1u); break; } } } } while (0)
struct XcdBarrier { unsigned* bar; unsigned x; volatile LAS unsigned* st; };
__device__ __forceinline__ XcdBarrier xcd_barrier_post(unsigned* bar, volatile LAS unsigned* st) {
    XcdBarrier b; b.bar = bar; b.x = xb_xcc_id(); b.st = st;
    if (threadIdx.x == 0) st[2] = xb_add(&bar[XB_XCNT(b.x)], 1u);
    return b;
}
__device__ __forceinline__ void xcd_barrier_complete(unsigned* bar, unsigned x, unsigned& nloc, unsigned& nx) {
    const unsigned G = gridDim.x * gridDim.y * gridDim.z;
    unsigned sum, cnt, mine, sp = 0u;
    for (;;) {
        sum = 0u; cnt = 0u; mine = 0u;
#pragma unroll
        for (unsigned j = 0; j < 16; ++j) { const unsigned c = xb_ld(&bar[XB_XCNT(j)]); sum += c; cnt += (c > 0u) ? 1u : 0u; mine = (j == x) ? c : mine; }
        if (sum == G) break;
        __builtin_amdgcn_s_sleep(1);
        if ((++sp & 255u) == 0u) { if (xb_ld(&bar[XB_TMO])) break; if (sp > XB_SPIN_CAP) { atomicAdd(&bar[XB_TMO], 1u); break; } }
    }
    nloc = mine > 0u ? mine : 1u; nx = cnt > 0u ? cnt : 1u;
}
__device__ __forceinline__ void xcd_barrier(const XcdBarrier& b) {
    asm volatile("s_waitcnt vmcnt(0) lgkmcnt(0)" ::: "memory");
    __syncthreads();
    if (threadIdx.x == 0) {
        unsigned* bar = b.bar;
        __builtin_amdgcn_s_waitcnt(0);
        unsigned nloc = b.st[0], nx = b.st[1];
        if (nloc == 0u) { xcd_barrier_complete(bar, b.x, nloc, nx); b.st[0] = nloc; b.st[1] = nx; }
        const unsigned old = xb_add(&bar[XB_XSUB(b.x)], 1u);
        const unsigned gen = old / nloc;
        if (old + 1u == (gen + 1u) * nloc) {
            __builtin_amdgcn_fence(__ATOMIC_RELEASE, "agent");
            asm volatile("s_waitcnt vmcnt(0)" ::: "memory");
            const unsigned og = xb_add(&bar[XB_TOP], 1u);
            const unsigned tg = og / nx;
            if (og + 1u == (tg + 1u) * nx) xb_add(&bar[XB_TOPGEN], 1u);
            else XB_SPIN(xb_ld(&bar[XB_TOPGEN]) == tg, bar);
            __builtin_amdgcn_fence(__ATOMIC_ACQUIRE, "agent");
            xb_add(&bar[XB_XGEN(b.x)], 1u);
            asm volatile("s_waitcnt vmcnt(0)" ::: "memory");
        } else {
            XB_SPIN(xb_ld(&bar[XB_XGEN(b.x)]) == gen, bar);
            __builtin_amdgcn_fence(__ATOMIC_ACQUIRE, "agent");
            asm volatile("s_waitcnt vmcnt(0)" ::: "memory");
        }
    }
    __syncthreads();
}
#define GSYNC(k) xcd_barrier(xbar)
__global__ void __launch_bounds__(NT, 2) mega_fwd(Args a) {
    extern __shared__ __attribute__((aligned(16))) unsigned char lds_raw[];
    LAS unsigned char* lds = (LAS unsigned char*)lds_raw;
    cg::grid_group grid = cg::this_grid();
    LAS int* slot = (LAS int*)(lds + LDS_BYTES - 64);
    volatile LAS unsigned* xst = (volatile LAS unsigned*)(lds + LDS_BYTES - 32);
    if (threadIdx.x < 4) xst[threadIdx.x] = 0u;
    __syncthreads();
    XcdBarrier xbar = xcd_barrier_post((unsigned*)(a.ws + WS_CTL) + 1024, xst);
    grid.sync();
#ifndef NO_P0
    p0_prologue(a, lds);
#endif
    GSYNC(0);
    int vcu = blockIdx.x;
    { unsigned* bw = (unsigned*)(a.ws + WS_CTL) + 1024; bool ok = (gridDim.x % 8u) == 0u;
      for (int j = 0; j < 16; ++j) { const unsigned cj = xb_ld(&bw[XB_XCNT(j)]); if (cj != (j < 8 ? gridDim.x / 8u : 0u)) ok = false; }
      if (ok) vcu = (int)(xbar.x + 8u * xst[2]); }
    unsigned char* const ws0 = a.ws; const float* const x00 = a.in[0]; float* const xout0 = a.out;
    unsigned kb = 1;
    for (int ph = 1; ph <= 16; ++ph) {
        if (ph == 6 || ph == 9 || ph == 14) continue;
        unsigned char* ws = ws0; const float* x0 = x00; float* xout = xout0;
        asm volatile("" : "+s"(ws), "+s"(x0), "+s"(xout));

        const float* mod = (const float*)(ws + WS_MOD);
        bf16_t* H = (bf16_t*)(ws + WS_H); bf16_t* MIX = (bf16_t*)(ws + WS_MIX); bf16_t* BIG = (bf16_t*)(ws + WS_BIG);
        unsigned* ctl = (unsigned*)(ws + WS_CTL);
        const int layer = ph >= 9;
        const GAS float* modl = (const GAS float*)mod + (size_t)layer * 8 * 6144;
        GAS float* rowss = (GAS float*)(ws + WS_ROWSS); const GAS float* shw = (const GAS float*)(ws + WS_SHW);
#ifndef REPEAT_PH
#define REPEAT_PH -1
#endif
        for (int rep = 0; rep < ((ph == REPEAT_PH) ? 2 : 1); ++rep) {
        pg8::Gemm g{nullptr, nullptr, T, 0, 0, 0}; pg8::Epi E{0, 0, nullptr, 0, nullptr, nullptr, nullptr, nullptr, nullptr, nullptr, nullptr, 0};
        switch (ph) {
        case 1: norm_phase(x0, mod, 0, 1024, H); break;
        case 3: cum_phase(ws, lds); break;
        case 4:
            for (;;) { const int it = q_next(ctl + 256 * rep, slot); if (it >= 64 * GLA_NSEG + 2048 + 152) break;
                if (it < 64 * GLA_NSEG) gla_item(ws, lds, (it & 63) >> 3, it & 7, it >> 6); else if (it < 64 * GLA_NSEG + 2048) { const int f = it - 64 * GLA_NSEG; fox_item(ws, lds, f >> 8, (f >> 5) & 7, f & 31); }
                else prep_item(ws, lds, it - 64 * GLA_NSEG - 2048); }
            break;
        case 11:
            for (;;) { const int it = q_next(ctl + 64 + 256 * rep, slot); if (it >= 256 + 512) break;
                if (it < 256) s5_item(ws, lds, it >> 5, it & 31); else { const int f = it - 256; sgu_item(ws, lds, f >> 6, f & 63); } }
            break;
        case 2: g.A = H; g.Bt = (const bf16_t*)(ws + WS_WIN0); g.N = LD0; g.K = D; E.mode = 0; E.O = (GAS bf16_t*)BIG; E.ldc = LD0; break;
        case 5: g.A = MIX; g.Bt = (const bf16_t*)(ws + WS_WOUT0); g.N = D; g.K = D; E.mode = 6; E.O = (GAS bf16_t*)H; E.base32 = (const GAS float*)x0; E.gate = modl + 2048; E.rowss = rowss; break;
        case 7: g.A = H; g.Bt = (const bf16_t*)(ws + WS_WB0); g.bbatch = (size_t)FFD * D * 2; g.N = FFD; g.K = D; E.mode = 5; E.sub = 1; E.O = (GAS bf16_t*)BIG; E.ldc = FFD; E.rowss = rowss; E.shw = shw; E.ldsh = FFD; break;
        case 8: g.A = BIG; g.Bt = (const bf16_t*)(ws + WS_W2_0); g.N = D; g.K = FFD; E.mode = 7; E.O = (GAS bf16_t*)H; E.gate = modl + 5120; E.rowss = rowss; break;
        case 10: g.A = H; g.Bt = (const bf16_t*)(ws + WS_WB1); g.bbatch = (size_t)LD1 * D * 2; g.N = LD1; g.K = D; E.mode = 5; E.sub = 2; E.O = (GAS bf16_t*)BIG; E.ldc = LD1; E.rowss = rowss; E.shw = shw + 8 * 4096; E.ldsh = LD1; break;
        case 12: g.A = (const bf16_t*)(ws + WS_YS5); g.Bt = (const bf16_t*)(ws + WS_WGLU); g.N = 512; g.K = 512; E.mode = 3; E.O = (GAS bf16_t*)MIX; E.Y = (const GAS bf16_t*)(ws + WS_YS5); E.bias = (const GAS float*)(ws + WS_PRM) + PR_BGLU; break;
        case 13: g.A = MIX; g.Bt = (const bf16_t*)(ws + WS_WOUT1); g.N = D; g.K = D; E.mode = 7; E.O = (GAS bf16_t*)H; E.gate = modl + 2048; E.rowss = rowss; break;
        case 15: g.A = H; g.Bt = (const bf16_t*)(ws + WS_WB2); g.bbatch = (size_t)FFD * D * 2; g.N = FFD; g.K = D; E.mode = 5; E.sub = 1; E.O = (GAS bf16_t*)BIG; E.ldc = FFD; E.rowss = rowss; E.shw = shw + 16 * 4096; E.ldsh = FFD; break;
        case 16: g.A = BIG; g.Bt = (const bf16_t*)(ws + WS_W2_1); g.N = D; g.K = FFD; E.mode = 8; E.O = (GAS bf16_t*)H; E.out32 = (GAS float*)xout; E.gate = modl + 5120; break;
        default: break;
        }
        if (g.K != 0) { pg8::StaticOrder S; S.init(T, g.N, gridDim.x, vcu);
            switch (E.mode) {
            case 0: pg8::gemm_phase<0>(lds, g, S, E); break; case 3: pg8::gemm_phase<3>(lds, g, S, E); break; case 5: pg8::gemm_phase<5>(lds, g, S, E); break;
            case 6: pg8::gemm_phase<6>(lds, g, S, E); break; case 7: pg8::gemm_phase<7>(lds, g, S, E); break; default: pg8::gemm_phase<8>(lds, g, S, E); break; } }
        }
        if (ph != 16) { GSYNC(kb); ++kb; }
    }
}

extern "C" void kernel_launch(void* const* d_in, const int* in_sizes, int n_in, void* d_out, int out_size, void* d_ws, size_t ws_size, hipStream_t stream) {
    static int grid = 0;
    if (grid == 0) {
        if (n_in != 30 || out_size != T * D || ws_size < WS_END) { fprintf(stderr, "kernel_launch: unexpected shapes (n_in %d out %d ws %zu)\n", n_in, out_size, ws_size); grid = -1; return; }
        int dev = 0, cus = 0, per_cu = 0;
        hipGetDevice(&dev); hipDeviceGetAttribute(&cus, hipDeviceAttributeMultiprocessorCount, dev);
        hipFuncSetAttribute((const void*)mega_fwd, hipFuncAttributeMaxDynamicSharedMemorySize, LDS_BYTES);
        hipOccupancyMaxActiveBlocksPerMultiprocessor(&per_cu, (const void*)mega_fwd, NT, LDS_BYTES);
        if (per_cu < 1) { fprintf(stderr, "kernel_launch: occupancy query says %d blocks/CU\n", per_cu); per_cu = 1; }
        grid = cus * 1;
        (void)hipGetLastError();
    }
    if (grid < 0) return;
    (void)hipMemsetAsync((char*)d_ws + WS_CTL, 0, 65536, stream);
    Args a{};
    for (int i = 0; i < 30; ++i) a.in[i] = (const float*)d_in[i];
    a.out = (float*)d_out; a.ws = (unsigned char*)d_ws;
    void* args[] = {&a};
    hipError_t e = hipLaunchCooperativeKernel((const void*)mega_fwd, dim3(grid), dim3(NT), args, LDS_BYTES, stream);
    if (e != hipSuccess) fprintf(stderr, "cooperative launch failed: %s (grid %d)\n", hipGetErrorString(e), grid);
}
```

```cpp
#include <hip/hip_runtime.h>
#include <hip/hip_cooperative_groups.h>
#include <cstdio>
namespace cg = cooperative_groups;

#define LAS __attribute__((address_space(3)))
#define GAS __attribute__((address_space(1)))
typedef unsigned short bf16_t;
typedef short bf16x8 __attribute__((ext_vector_type(8)));
typedef short bf16x4 __attribute__((ext_vector_type(4)));
typedef float f32x4 __attribute__((ext_vector_type(4)));
typedef float f32x2 __attribute__((ext_vector_type(2)));
typedef unsigned u32x4 __attribute__((ext_vector_type(4)));
typedef unsigned u32x2 __attribute__((ext_vector_type(2)));
typedef _Float16 f16x8 __attribute__((ext_vector_type(8)));

constexpr int T = 65536, SEQ = 8192, D = 1024, FFD = 4096;
constexpr int LD0 = 3840, LD1 = 1536;
constexpr int C_GQ = 0, C_GK = 512, C_GV = 1024, C_GG = 1536, C_FQ = 2048, C_FK = 2560, C_FV = 3072, C_LR = 3584, C_FF = 3600;
constexpr float EPS = 1e-6f;
constexpr size_t MiB = 1u << 20;
constexpr size_t WS_CTL = 0, WS_WIN0 = 2 * MiB, WS_WOUT0 = 10 * MiB, WS_W1_0 = 12 * MiB, WS_W2_0 = 20 * MiB, WS_WIN1 = 28 * MiB, WS_WOUT1 = 31 * MiB,
                 WS_WGLU = 33 * MiB, WS_W1_1 = 34 * MiB, WS_W2_1 = 42 * MiB, WS_WSB = 50 * MiB, WS_MOD = 51 * MiB, WS_S5P = 52 * MiB, WS_CUM = 53 * MiB,
                 WS_H = 64 * MiB, WS_MIX = 192 * MiB, WS_BIG = 320 * MiB, WS_WB0 = 832 * MiB, WS_WB1 = 896 * MiB, WS_WB2 = 920 * MiB, WS_GLAE = 984 * MiB  , WS_GLAD = 990 * MiB  , WS_END = 992 * MiB;
constexpr size_t WS_PRM = 56 * MiB, WS_ROWSS = 57 * MiB  , WS_SHW = 61 * MiB  , WS_YS5 = WS_BIG + 256 * MiB;
constexpr int PR_WLR = 0, PR_BLR = 8192, PR_GGAIN = 8704, PR_BF = 9216, PR_QG = 9280, PR_KG = 9792, PR_S5D = 10304, PR_BGLU = 10816, PR_LNG = 11328, PR_LNB = 11840, PR_BS = 12352;
constexpr size_t S5_ABAR = 0, S5_BB = 16384, S5_CM = 16384 + 131072;
constexpr int LDS_BYTES = 147456;
constexpr int NT = 512;

struct Args { const float* in[30]; float* out; unsigned char* ws; };

typedef __bf16 bf16x2_t __attribute__((ext_vector_type(2)));
__device__ __forceinline__ unsigned pkbf(float lo, float hi) { f32x2 v = {lo, hi}; bf16x2_t b = __builtin_convertvector(v, bf16x2_t); return __builtin_bit_cast(unsigned, b); }
__device__ __forceinline__ float bflo(unsigned w) { return __uint_as_float(w << 16); }
__device__ __forceinline__ float bfhi(unsigned w) { return __uint_as_float(w & 0xffff0000u); }
__device__ __forceinline__ void unpack8(u32x4 w, float* f) { f[0] = bflo(w.x); f[1] = bfhi(w.x); f[2] = bflo(w.y); f[3] = bfhi(w.y); f[4] = bflo(w.z); f[5] = bfhi(w.z); f[6] = bflo(w.w); f[7] = bfhi(w.w); }
__device__ __forceinline__ float sigmoidf_(float x) { return 1.0f / (1.0f + __expf(-x)); }
__device__ __forceinline__ float siluf_(float x) { return x * sigmoidf_(x); }
__device__ __forceinline__ float gelu_tanh(float x) { const float u = 1.5957691216057308f * (x + 0.044715f * x * x * x); return x * sigmoidf_(u); }
__device__ __forceinline__ float logsig(float x) { return fminf(x, 0.f) - __logf(1.0f + __expf(-fabsf(x))); }
__device__ __forceinline__ int otid() { int t = threadIdx.x; asm volatile("" : "+v"(t)); return t; }
#define LDS_WAIT() asm volatile("s_waitcnt lgkmcnt(0)" ::: "memory")
#define BAR_LDS() do { asm volatile("s_waitcnt lgkmcnt(0)" ::: "memory"); __builtin_amdgcn_s_barrier(); asm volatile("" ::: "memory"); } while (0)
#define MFMA16(a, b, c) __builtin_amdgcn_mfma_f32_16x16x32_bf16((a), (b), (c), 0, 0, 0)
__device__ __forceinline__ bf16x8 as_bf16x8(u32x4 v) { return __builtin_bit_cast(bf16x8, v); }

namespace pg8 {
constexpr int BM = 256, BK = 64, HALF = 128, HTB = HALF * BK * 2, STAGE_BYTES = 8 * HTB, NXCD = 8, WGM = 8;
__device__ __forceinline__ int lds_byte(int r, int c) { const int st = (r >> 4) * 2 + (c >> 5), rr = r & 15, cc = c & 31, ob = rr * 64 + cc * 2; return st * 1024 + (ob ^ (((ob >> 9) & 1) << 5)); }
__device__ __forceinline__ void stage_rc(int b, int& R, int& C) { const int st = b / 1024, sb = b % 1024, swz = sb ^ (((sb >> 9) & 1) << 5); R = (st >> 1) * 16 + swz / 64; C = (st & 1) * 32 + (swz % 64) / 2; }
__device__ __forceinline__ int perm32(int rho) { const int n = rho >> 4, i = rho & 15; return 8 * (i >> 2) + 4 * n + (i & 3); }
struct Unit { int pm, pn; };
struct Gemm { const bf16_t* A; const bf16_t* Bt; int M, N, K; size_t bbatch; };
struct StaticOrder {
    int nM, nN, nwg, G, c;
    __device__ void init(int M, int N, int G_, int c_) { nM = M / BM; nN = N / BM; nwg = nM * nN; G = G_; c = c_; }
    __device__ bool next(int i, Unit& u) const {
        const long L = (long)i * G + c; if (L >= nwg) return false;
        int wgid = (int)L; { const int q = nwg / NXCD, r = nwg % NXCD, xcd = wgid % NXCD, off = wgid / NXCD; wgid = (xcd < r ? xcd * (q + 1) : r * (q + 1) + (xcd - r) * q) + off; }
        const int nig = WGM * nN, gid = wgid / nig, fm = gid * WGM, gsz = (nM - fm) < WGM ? (nM - fm) : WGM;
        u.pm = fm + ((wgid % nig) % gsz); u.pn = (wgid % nig) / gsz; return true;
    }
};

struct Epi {
    int mode, sub; GAS bf16_t* O; int ldc; const GAS float* base32; GAS float* out32; const GAS float* gate; const GAS bf16_t* Y; const GAS float* bias; GAS float* rowss; const GAS float* shw; int ldsh;
    template <int MODE> __device__ __forceinline__ void run(const f32x4 (&acc)[2][2][4][2], const Unit& u, int wr, int wc, int fr, int fq) const {
        constexpr int mode = MODE;
        const int row0 = u.pm * BM + wr * 64 + fr, col0 = u.pn * BM + wc * 32 + 8 * fq, bidx = (u.pm * BM) >> 13;
        if (mode >= 6) {
            const GAS float* gp = gate + (size_t)bidx * 6144 + col0;
            f32x4 gg[2][2];
#pragma unroll
            for (int bj = 0; bj < 2; ++bj) { gg[bj][0] = *(const GAS f32x4*)(gp + bj * HALF); gg[bj][1] = *(const GAS f32x4*)(gp + bj * HALF + 4); }
            if (mode == 6) {
#pragma unroll
                for (int ai = 0; ai < 2; ++ai)
#pragma unroll
                    for (int mh = 0; mh < 2; ++mh) { f32x4 bb[2][2][2];
#pragma unroll
                        for (int ml = 0; ml < 2; ++ml) { const size_t off = (size_t)(row0 + ai * HALF + (2 * mh + ml) * 16) * D + col0;
#pragma unroll
                            for (int bj = 0; bj < 2; ++bj) { bb[ml][bj][0] = __builtin_nontemporal_load((const GAS f32x4*)(base32 + off + bj * HALF)); bb[ml][bj][1] = __builtin_nontemporal_load((const GAS f32x4*)(base32 + off + bj * HALF + 4)); } }
#pragma unroll
                        for (int ml = 0; ml < 2; ++ml) { const int m = 2 * mh + ml; const size_t row = (size_t)(row0 + ai * HALF + m * 16), off = row * D + col0; float ss = 0.f;
#pragma unroll
                            for (int bj = 0; bj < 2; ++bj) { const f32x4 x0 = bb[ml][bj][0] + gg[bj][0] * acc[ai][bj][m][0], x1 = bb[ml][bj][1] + gg[bj][1] * acc[ai][bj][m][1];
                                ss += (x0[0] * x0[0] + x0[1] * x0[1]) + (x0[2] * x0[2] + x0[3] * x0[3]) + (x1[0] * x1[0] + x1[1] * x1[1]) + (x1[2] * x1[2] + x1[3] * x1[3]);
                                u32x4 w; w.x = pkbf(x0[0], x0[1]); w.y = pkbf(x0[2], x0[3]); w.z = pkbf(x1[0], x1[1]); w.w = pkbf(x1[2], x1[3]); *(GAS u32x4*)(O + off + bj * HALF) = w; }
                            ss += __shfl_xor(ss, 16); ss += __shfl_xor(ss, 32); if (fq == 0) rowss[row * 16 + u.pn * 4 + wc] = ss; }
                        asm volatile("" ::: "memory"); }
            } else {
#pragma unroll
                for (int ai = 0; ai < 2; ++ai) { u32x4 bw[4][2];
#pragma unroll
                    for (int m = 0; m < 4; ++m) { const size_t off = (size_t)(row0 + ai * HALF + m * 16) * D + col0;
#pragma unroll
                        for (int bj = 0; bj < 2; ++bj) bw[m][bj] = *(const GAS u32x4*)(O + off + bj * HALF); }
#pragma unroll
                    for (int m = 0; m < 4; ++m) { const size_t row = (size_t)(row0 + ai * HALF + m * 16), off = row * D + col0; float ss = 0.f;
#pragma unroll
                        for (int bj = 0; bj < 2; ++bj) { const u32x4 t = bw[m][bj];
                            const f32x4 b0 = (f32x4){bflo(t.x), bfhi(t.x), bflo(t.y), bfhi(t.y)}, b1 = (f32x4){bflo(t.z), bfhi(t.z), bflo(t.w), bfhi(t.w)};
                            const f32x4 x0 = b0 + gg[bj][0] * acc[ai][bj][m][0], x1 = b1 + gg[bj][1] * acc[ai][bj][m][1];
                            if (mode == 8) { __builtin_nontemporal_store(x0, (GAS f32x4*)(out32 + off + bj * HALF)); __builtin_nontemporal_store(x1, (GAS f32x4*)(out32 + off + bj * HALF + 4)); }
                            else { ss += (x0[0] * x0[0] + x0[1] * x0[1]) + (x0[2] * x0[2] + x0[3] * x0[3]) + (x1[0] * x1[0] + x1[1] * x1[1]) + (x1[2] * x1[2] + x1[3] * x1[3]);
                                u32x4 w; w.x = pkbf(x0[0], x0[1]); w.y = pkbf(x0[2], x0[3]); w.z = pkbf(x1[0], x1[1]); w.w = pkbf(x1[2], x1[3]); *(GAS u32x4*)(O + off + bj * HALF) = w; } }
                        if (mode != 8) { ss += __shfl_xor(ss, 16); ss += __shfl_xor(ss, 32); if (fq == 0) rowss[row * 16 + u.pn * 4 + wc] = ss; } }
                    asm volatile("" ::: "memory"); }
            }
        } else if (mode == 3) {
#pragma unroll
            for (int bj = 0; bj < 2; ++bj) {
                const f32x4 b0 = *(const GAS f32x4*)(bias + col0 + bj * HALF), b1 = *(const GAS f32x4*)(bias + col0 + bj * HALF + 4);
#pragma unroll
                for (int ai = 0; ai < 2; ++ai)
#pragma unroll
                    for (int m = 0; m < 4; ++m) { const size_t row = (size_t)(row0 + ai * HALF + m * 16);
                        const u32x4 yw = *(const GAS u32x4*)(Y + row * 512 + col0 + bj * HALF); float y[8]; unpack8(yw, y);
                        const f32x4 v0 = acc[ai][bj][m][0] + b0, v1 = acc[ai][bj][m][1] + b1; float o[8];
#pragma unroll
                        for (int j = 0; j < 4; ++j) { o[j] = y[j] * sigmoidf_(v0[j]); o[4 + j] = y[4 + j] * sigmoidf_(v1[j]); }
                        u32x4 w; w.x = pkbf(o[0], o[1]); w.y = pkbf(o[2], o[3]); w.z = pkbf(o[4], o[5]); w.w = pkbf(o[6], o[7]);
                        *(GAS u32x4*)(O + row * D + col0 + bj * HALF) = w; asm volatile("" ::: "memory"); } }
        } else {
            const bool act2 = (sub == 2) && (u.pn >= 2);
            float rr[8]; f32x4 sb[2][2];
#pragma unroll
            for (int j = 0; j < 8; ++j) rr[j] = 1.0f;
#pragma unroll
            for (int bj = 0; bj < 2; ++bj) { sb[bj][0] = (f32x4){0.f, 0.f, 0.f, 0.f}; sb[bj][1] = sb[bj][0]; }
            if (mode == 5) {
                const int lane = fq * 16 + fr; float slot[2];
                f32x4 pp[2][4];
#pragma unroll
                for (int h = 0; h < 2; ++h) { const int li = lane + 64 * h, am = li >> 4; const size_t row = (size_t)(u.pm * BM + (am >> 2) * HALF + wr * 64 + (am & 3) * 16 + (li & 15));
                    const GAS f32x4* rp = (const GAS f32x4*)(rowss + row * 16);
#pragma unroll
                    for (int k = 0; k < 4; ++k) pp[h][k] = rp[k]; }
                const GAS float* sp = shw + (size_t)bidx * ldsh + col0;
#pragma unroll
                for (int bj = 0; bj < 2; ++bj) { sb[bj][0] = *(const GAS f32x4*)(sp + bj * HALF); sb[bj][1] = *(const GAS f32x4*)(sp + bj * HALF + 4); }
#pragma unroll
                for (int h = 0; h < 2; ++h) { const f32x4 s = (pp[h][0] + pp[h][1]) + (pp[h][2] + pp[h][3]); slot[h] = rsqrtf(((s[0] + s[1]) + (s[2] + s[3])) * (1.0f / D) + EPS); }
#pragma unroll
                for (int j = 0; j < 8; ++j) rr[j] = __shfl(slot[j >> 2], (j & 3) * 16 + fr);
            }
#pragma unroll
            for (int ai = 0; ai < 2; ++ai)
#pragma unroll
                for (int m = 0; m < 4; ++m) { const size_t row = (size_t)(row0 + ai * HALF + m * 16); GAS bf16_t* rowp = O + row * ldc + col0; const float r = rr[ai * 4 + m];
#pragma unroll
                    for (int bj = 0; bj < 2; ++bj) { f32x4 v0 = acc[ai][bj][m][0], v1 = acc[ai][bj][m][1];
                        if (mode == 5) { v0 = v0 * r + sb[bj][0]; v1 = v1 * r + sb[bj][1]; }
                        if (sub == 1) {
#pragma unroll
                            for (int j = 0; j < 4; ++j) { const float a0 = fmaxf(v0[j], 0.f), a1 = fmaxf(v1[j], 0.f); v0[j] = a0 * a0; v1[j] = a1 * a1; } }
                        if (act2) {
#pragma unroll
                            for (int j = 0; j < 4; ++j) { v0[j] = gelu_tanh(v0[j]); v1[j] = gelu_tanh(v1[j]); } }
                        u32x4 w; w.x = pkbf(v0[0], v0[1]); w.y = pkbf(v0[2], v0[3]); w.z = pkbf(v1[0], v1[1]); w.w = pkbf(v1[2], v1[3]);
                        __builtin_nontemporal_store(w, (GAS u32x4*)(rowp + bj * HALF)); }
                    asm volatile("" ::: "memory"); }
        }
    }
};

template <int MODE>
__device__ __forceinline__ void gemm_phase(LAS unsigned char* lds, const Gemm g, const StaticOrder& S, const Epi& E) {

    const int tid = otid(), wid = __builtin_amdgcn_readfirstlane(tid >> 6), lane = tid & 63, wr = wid >> 2, wc = wid & 3, fr = lane & 15, fq = lane >> 4;
    const int K = g.K, nt = K / BK;
    unsigned voffA[2], voffB[2];
#pragma unroll
    for (int i = 0; i < 2; ++i) { int R, C; stage_rc(tid * 16 + i * 8192, R, C); const int Rb = (R & ~31) + perm32(R & 31);
        voffA[i] = (unsigned)(R * K + C) * 2u; voffB[i] = (unsigned)(Rb * K + C) * 2u; }
    const size_t kstep = (size_t)(BK * 2);
    const size_t hstep = (size_t)HALF * K * 2;
    const size_t tstep = 2 * hstep;
    const unsigned ldsw = (unsigned)wid * 1024u;
    const int aoff = lds_byte(wr * 64 + fr, fq * 8), boff = lds_byte(wc * 32 + fr, fq * 8);
    const unsigned ldsbase = (unsigned)(unsigned long)lds;
#define PG8_SA(b, h) (((b) * 2 + (h)) * HTB)
#define PG8_SB(b, h) ((4 + (b) * 2 + (h)) * HTB)
#define PG8_STAGE(bufoff, gbase, voff) do { _Pragma("unroll") for (int _i = 0; _i < 2; ++_i) \
        __builtin_amdgcn_global_load_lds((const unsigned*)((const char*)(gbase) + (voff)[_i]), (LAS unsigned*)(lds + (bufoff) + ldsw + _i * 8192), 16, 0, 0); } while (0)
#define PG8_LDA(dst, b, h) do { _Pragma("unroll") for (int m = 0; m < 4; ++m) _Pragma("unroll") for (int k = 0; k < 2; ++k) dst[m][k] = *(const LAS bf16x8*)(lds + PG8_SA(b, h) + aoff + m * 2048 + k * 1024); } while (0)
#define PG8_LDB(dst, b, h) do { _Pragma("unroll") for (int n = 0; n < 2; ++n) _Pragma("unroll") for (int k = 0; k < 2; ++k) dst[n][k] = *(const LAS bf16x8*)(lds + PG8_SB(b, h) + boff + n * 2048 + k * 1024); } while (0)
#define PG8_MMA(ai, bj, At, Bt) do { __builtin_amdgcn_s_setprio(1); _Pragma("unroll") for (int m = 0; m < 4; ++m) _Pragma("unroll") for (int n = 0; n < 2; ++n) _Pragma("unroll") for (int k = 0; k < 2; ++k) \
        acc[ai][bj][m][n] = __builtin_amdgcn_mfma_f32_16x16x32_bf16(Bt[n][k], At[m][k], acc[ai][bj][m][n], 0, 0, 0); __builtin_amdgcn_s_setprio(0); } while (0)
#define PG8_WAIT_V(n) asm volatile("s_waitcnt vmcnt(" #n ")" ::: "memory")
#define PG8_WAIT_L(n) asm volatile("s_waitcnt lgkmcnt(" #n ")" ::: "memory")
#define PG8_BAR __builtin_amdgcn_s_barrier()
#define PG8_SCHED __builtin_amdgcn_sched_barrier(0)
    Unit cur, nxt; int ui = 0;
    if (!S.next(0, cur)) return;
#ifdef STAGGER_US
    if ((blockIdx.x >> 3) & 1) {
        const unsigned long long t0 = __builtin_amdgcn_s_memrealtime();
        while (__builtin_amdgcn_s_memrealtime() - t0 < (unsigned long long)(STAGGER_US * 100)) __builtin_amdgcn_s_sleep(8);
    }
#endif
    f32x4 acc[2][2][4][2];
#pragma unroll
    for (int a = 0; a < 2; ++a)
#pragma unroll
        for (int b = 0; b < 2; ++b)
#pragma unroll
            for (int m = 0; m < 4; ++m)
#pragma unroll
                for (int n = 0; n < 2; ++n) acc[a][b][m][n] = (f32x4){0.f, 0.f, 0.f, 0.f};
    bf16x8 At[4][2], B0[2][2], B1[2][2];
    const char* cA = (const char*)g.A + (size_t)cur.pm * tstep; const char* cB = (const char*)g.Bt + (size_t)cur.pn * tstep + (size_t)(cur.pm >> 5) * g.bbatch;
    PG8_STAGE(PG8_SB(0, 0), cB, voffB); PG8_STAGE(PG8_SA(0, 0), cA, voffA); PG8_STAGE(PG8_SB(0, 1), cB + hstep, voffB); PG8_STAGE(PG8_SA(0, 1), cA + hstep, voffA);
    if (wr == 1) PG8_BAR;
    PG8_WAIT_V(4); PG8_BAR;
    PG8_STAGE(PG8_SB(1, 0), cB + kstep, voffB); PG8_STAGE(PG8_SA(1, 0), cA + kstep, voffA); PG8_STAGE(PG8_SB(1, 1), cB + hstep + kstep, voffB);
    PG8_WAIT_V(6); PG8_BAR;
    for (;;) {
        const bool has_next = S.next(ui + 1, nxt);
        const char* nA = has_next ? (const char*)g.A + (size_t)nxt.pm * tstep : cA; const char* nB = has_next ? (const char*)g.Bt + (size_t)nxt.pn * tstep + (size_t)(nxt.pm >> 5) * g.bbatch : cB;
        for (int t = 0; t < nt; t += 2) {
            const bool last = (t == nt - 2);
            const char* a1 = cA + (size_t)(t + 1) * kstep;
            const char* a2 = last ? nA : cA + (size_t)(t + 2) * kstep; const char* b2 = last ? nB : cB + (size_t)(t + 2) * kstep;
            const char* a3 = a2 + kstep; const char* b3 = b2 + kstep;
            PG8_LDB(B0, 0, 0); PG8_SCHED; PG8_LDA(At, 0, 0); PG8_STAGE(PG8_SA(1, 1), a1 + hstep, voffA);
            PG8_WAIT_L(8); PG8_BAR; PG8_WAIT_L(0); PG8_MMA(0, 0, At, B0); PG8_BAR; PG8_SCHED;
            PG8_LDB(B1, 0, 1); PG8_STAGE(PG8_SB(0, 0), b2, voffB);
            PG8_BAR; PG8_WAIT_L(0); PG8_MMA(0, 1, At, B1); PG8_BAR;
            PG8_LDA(At, 0, 1); PG8_STAGE(PG8_SA(0, 0), a2, voffA);
            PG8_BAR; PG8_WAIT_L(0); PG8_MMA(1, 0, At, B0); PG8_BAR; PG8_SCHED;
            PG8_STAGE(PG8_SB(0, 1), b2 + hstep, voffB);
            PG8_WAIT_V(6); PG8_BAR; PG8_MMA(1, 1, At, B1); PG8_BAR;
            PG8_LDB(B0, 1, 0); PG8_SCHED; PG8_LDA(At, 1, 0); PG8_STAGE(PG8_SA(0, 1), a2 + hstep, voffA);
            PG8_WAIT_L(8); PG8_BAR; PG8_WAIT_L(0); PG8_MMA(0, 0, At, B0); PG8_BAR; PG8_SCHED;
            PG8_LDB(B1, 1, 1); PG8_STAGE(PG8_SB(1, 0), b3, voffB);
            PG8_BAR; PG8_WAIT_L(0); PG8_MMA(0, 1, At, B1); PG8_BAR;
            PG8_LDA(At, 1, 1); PG8_STAGE(PG8_SA(1, 0), a3, voffA);
            PG8_BAR; PG8_WAIT_L(0); PG8_MMA(1, 0, At, B0); PG8_BAR; PG8_SCHED;
            PG8_STAGE(PG8_SB(1, 1), b3 + hstep, voffB);
            PG8_WAIT_V(6); PG8_BAR; PG8_MMA(1, 1, At, B1); PG8_BAR;
        }
        E.template run<MODE>(acc, cur, wr, wc, fr, fq);
        if (!has_next) break;
#pragma unroll
        for (int a = 0; a < 2; ++a)
#pragma unroll
            for (int b = 0; b < 2; ++b)
#pragma unroll
                for (int m = 0; m < 4; ++m)
#pragma unroll
                    for (int n = 0; n < 2; ++n) acc[a][b][m][n] = (f32x4){0.f, 0.f, 0.f, 0.f};
        cur = nxt; cA = nA; cB = nB; ++ui;
    }
    PG8_WAIT_V(0);
    if (wr == 0) PG8_BAR;
    PG8_BAR;
#undef PG8_SA
#undef PG8_SB
#undef PG8_STAGE
#undef PG8_LDA
#undef PG8_LDB
#undef PG8_MMA
#undef PG8_WAIT_V
#undef PG8_WAIT_L
#undef PG8_BAR
#undef PG8_SCHED
}

}

__device__ __forceinline__ void tr_item(const float* W, int ldw, int ncol0, int K, int nblk, bf16_t* WT, int row_off, LAS float* scr, int item, int lane) {
    const int kb = item / nblk, nb = item % nblk, k0 = 64 * kb, n0 = 32 * nb;
    float tv[32];
#pragma unroll
    for (int i = 0; i < 32; ++i) tv[i] = W[(size_t)(k0 + 2 * i + (lane >> 5)) * ldw + ncol0 + n0 + (lane & 31)];
#pragma unroll
    for (int i = 0; i < 32; ++i) scr[(2 * i + (lane >> 5)) * 33 + (lane & 31)] = tv[i];
    LDS_WAIT();
    const int c = lane & 7;
#pragma unroll
    for (int j = 0; j < 4; ++j) { const int n = (lane >> 3) + 8 * j; const LAS float* s = scr + (8 * c) * 33 + n;
        u32x4 o; o.x = pkbf(s[0 * 33], s[1 * 33]); o.y = pkbf(s[2 * 33], s[3 * 33]); o.z = pkbf(s[4 * 33], s[5 * 33]); o.w = pkbf(s[6 * 33], s[7 * 33]);
        *(u32x4*)(WT + (size_t)(row_off + n0 + n) * K + k0 + 8 * c) = o; }
    LDS_WAIT();
}

__device__ __forceinline__ void p0_prologue(const Args& a, LAS unsigned char* lds) {
    const int tid = otid(), lane = tid & 63, wave = __builtin_amdgcn_readfirstlane(tid >> 6);
    unsigned char* ws = a.ws;
    if (blockIdx.x < 192) {
        LAS float* cact = (LAS float*)lds;
        LAS float* red = (LAS float*)(lds + 32768);
        const float* c = a.in[1];
        for (int i = tid; i < 8192; i += NT) cact[i] = siluf_(c[i]);
        __syncthreads();
        const int item = blockIdx.x, layer = item / 96, e = 64 * (item % 96) + lane;
        const float* wp = a.in[2] + (size_t)layer * D * 6144 + e;
        float acc[8];
#pragma unroll
        for (int b = 0; b < 8; ++b) acc[b] = 0.f;
        for (int k0 = wave * 128; k0 < wave * 128 + 128; k0 += 32) {
            float wv[32];
#pragma unroll
            for (int i = 0; i < 32; ++i) wv[i] = wp[(size_t)(k0 + i) * 6144];
#pragma unroll
            for (int i = 0; i < 32; ++i)
#pragma unroll
                for (int b = 0; b < 8; ++b) acc[b] += cact[b * 1024 + k0 + i] * wv[i];
        }
#pragma unroll
        for (int b = 0; b < 8; ++b) red[(wave * 8 + b) * 64 + lane] = acc[b];
        __syncthreads();
        { const int b = tid >> 6; float s = 0.f;
#pragma unroll
          for (int w = 0; w < 8; ++w) s += red[(w * 8 + b) * 64 + lane];
          ((float*)(ws + WS_MOD))[(size_t)(layer * 8 + b) * 6144 + e] = s + a.in[3][layer * 6144 + e]; }
        __syncthreads();
    }
    {
        LAS float* scr = (LAS float*)(lds + wave * 16384);
        const int gw = blockIdx.x * 8 + wave, NGW = gridDim.x * 8;
        constexpr int I0 = 16 * 64, I1 = 16 * 48, I2 = 16 * 32, I3 = 16 * 128, I4 = 64 * 32, I5 = 16 * 48, I6 = 16 * 32, I7 = 8 * 16, I8 = I3, I9 = I4;
        constexpr int NIT = I0 + I1 + I2 + I3 + I4 + I5 + I6 + I7 + I8 + I9;
        for (int it = gw; it < NIT; it += NGW) {
            int r = it;
            if (r < I0) { tr_item(a.in[4], 3608, 0, 1024, 64, (bf16_t*)(ws + WS_WIN0), 0, scr, r, lane); continue; } r -= I0;
            if (r < I1) { tr_item(a.in[4], 3608, 2064, 1024, 48, (bf16_t*)(ws + WS_WIN0), 2048, scr, r, lane); continue; } r -= I1;
            if (r < I2) { tr_item(a.in[5], 1024, 0, 1024, 32, (bf16_t*)(ws + WS_WOUT0), 0, scr, r, lane); continue; } r -= I2;
            if (r < I3) { tr_item(a.in[28], 4096, 0, 1024, 128, (bf16_t*)(ws + WS_W1_0), 0, scr, r, lane); continue; } r -= I3;
            if (r < I4) { tr_item(a.in[29], 1024, 0, 4096, 32, (bf16_t*)(ws + WS_W2_0), 0, scr, r, lane); continue; } r -= I4;
            if (r < I5) { tr_item(a.in[12], 1536, 0, 1024, 48, (bf16_t*)(ws + WS_WIN1), 0, scr, r, lane); continue; } r -= I5;
            if (r < I6) { tr_item(a.in[13], 1024, 0, 1024, 32, (bf16_t*)(ws + WS_WOUT1), 0, scr, r, lane); continue; } r -= I6;
            if (r < I7) { tr_item(a.in[22], 512, 0, 512, 16, (bf16_t*)(ws + WS_WGLU), 0, scr, r, lane); continue; } r -= I7;
            if (r < I8) { tr_item(a.in[28] + (size_t)D * FFD, 4096, 0, 1024, 128, (bf16_t*)(ws + WS_W1_1), 0, scr, r, lane); continue; } r -= I8;
            tr_item(a.in[29] + (size_t)D * FFD, 1024, 0, 4096, 32, (bf16_t*)(ws + WS_W2_1), 0, scr, r, lane);
        }
    }
    {
        if (blockIdx.x == 0 && tid == 0) { unsigned* ctl = (unsigned*)(ws + WS_CTL); __hip_atomic_store(ctl, 0u, __ATOMIC_RELAXED, __HIP_MEMORY_SCOPE_AGENT); __hip_atomic_store(ctl + 64, 0u, __ATOMIC_RELAXED, __HIP_MEMORY_SCOPE_AGENT); }
        const int gt = blockIdx.x * NT + tid, NGT = gridDim.x * NT;
        bf16_t* win0 = (bf16_t*)(ws + WS_WIN0);
        for (int i = gt; i < 256 * 1024; i += NGT) { const int n = i >> 10, k = i & 1023; float v = 0.f;
            if (n < 16) v = a.in[4][(size_t)k * 3608 + 2048 + n]; else if (n < 24) v = a.in[4][(size_t)k * 3608 + 3600 + (n - 16)];
            win0[(size_t)(3584 + n) * 1024 + k] = (bf16_t)(pkbf(v, 0.f) & 0xffffu); }
        bf16_t* wsb = (bf16_t*)(ws + WS_WSB);
        for (int i = gt; i < 8 * 128 * 128; i += NGT) { const int t = (i >> 7) & 127, s = i & 127; const float v = (s <= t) ? a.in[26][i] : 0.f; wsb[i] = (bf16_t)(pkbf(v, 0.f) & 0xffffu); }
        { float* prm = (float*)(ws + WS_PRM);
          for (int i = gt; i < 8192; i += NGT) prm[PR_WLR + i] = a.in[6][i];
          for (int i = gt; i < 1024; i += NGT) prm[PR_BS + i] = a.in[27][i];
          for (int i = gt; i < 512; i += NGT) { prm[PR_BLR + i] = a.in[7][i]; prm[PR_GGAIN + i] = a.in[8][i]; prm[PR_QG + i] = a.in[10][i]; prm[PR_KG + i] = a.in[11][i]; prm[PR_S5D + i] = a.in[21][i];
              prm[PR_BGLU + i] = a.in[23][i]; prm[PR_LNG + i] = a.in[24][i]; prm[PR_LNB + i] = a.in[25][i]; }
          for (int i = gt; i < 8; i += NGT) prm[PR_BF + i] = a.in[9][i]; }
        float* abar = (float*)(ws + WS_S5P + S5_ABAR); bf16_t* Bb = (bf16_t*)(ws + WS_S5P + S5_BB); bf16_t* Cm = (bf16_t*)(ws + WS_S5P + S5_CM);
        for (int i = gt; i < 32 * 64; i += NGT) { const int g = i >> 6, p = i & 63;
            const float lr = a.in[14][i], li = a.in[15][i], dt = expf(a.in[16][g]);
            const float mag = expf(lr * dt), ang = li * dt, ar = mag * cosf(ang), ai = mag * sinf(ang), den = lr * lr + li * li;
            const float cr = ((ar - 1.0f) * lr + ai * li) / den, ci = (ai * lr - (ar - 1.0f) * li) / den;
            abar[2 * i] = ar; abar[2 * i + 1] = ai;
            for (int k = 0; k < 16; ++k) { const float br = a.in[17][(size_t)i * 16 + k], bi = a.in[18][(size_t)i * 16 + k];
                Bb[((size_t)g * 128 + 2 * p) * 16 + k] = (bf16_t)(pkbf(cr * br - ci * bi, 0.f) & 0xffffu);
                Bb[((size_t)g * 128 + 2 * p + 1) * 16 + k] = (bf16_t)(pkbf(cr * bi + ci * br, 0.f) & 0xffffu); } }
        for (int i = gt; i < 32 * 16 * 64; i += NGT) { const int gi = i >> 6, p = i & 63;
            Cm[(size_t)gi * 128 + 2 * p] = (bf16_t)(pkbf(a.in[19][i], 0.f) & 0xffffu); Cm[(size_t)gi * 128 + 2 * p + 1] = (bf16_t)(pkbf(-a.in[20][i], 0.f) & 0xffffu); }
    }
}

__device__ __forceinline__ void norm_phase(const float* x, const float* mod, int off_sh, int off_sc, bf16_t* H) {
    const int tid_ = otid(); const int lane = tid_ & 63, gw = blockIdx.x * 8 + (tid_ >> 6), NGW = gridDim.x * 8;
    constexpr int R = 4;
    for (int m0 = gw; m0 < T; m0 += R * NGW) {
        int mr[R]; f32x4 v[R][4]; float s[R];
#pragma unroll
        for (int r = 0; r < R; ++r) { mr[r] = (m0 + r * NGW < T) ? m0 + r * NGW : m0;
            const GAS f32x4* xr = (const GAS f32x4*)(x + (size_t)mr[r] * D) + lane;
#pragma unroll
            for (int j = 0; j < 4; ++j) v[r][j] = __builtin_nontemporal_load(xr + 64 * j); }
#pragma unroll
        for (int r = 0; r < R; ++r) { float a = 0.f;
#pragma unroll
            for (int j = 0; j < 4; ++j) a += (v[r][j].x * v[r][j].x + v[r][j].y * v[r][j].y) + (v[r][j].z * v[r][j].z + v[r][j].w * v[r][j].w);
            s[r] = a; }
#pragma unroll
        for (int o = 1; o < 64; o <<= 1) {
#pragma unroll
            for (int r = 0; r < R; ++r) s[r] += __shfl_xor(s[r], o); }
#pragma unroll
        for (int r = 0; r < R; ++r) { const float rs = rsqrtf(s[r] * (1.0f / D) + EPS);
            const GAS float* mp = (const GAS float*)mod + (size_t)(mr[r] >> 13) * 6144; GAS u32x2* o8 = (GAS u32x2*)(H + (size_t)mr[r] * D) + lane;
#pragma unroll
            for (int j = 0; j < 4; ++j) { const f32x4 sc = *((const GAS f32x4*)(mp + off_sc) + lane + 64 * j), sh = *((const GAS f32x4*)(mp + off_sh) + lane + 64 * j);
                const f32x4 y = v[r][j] * rs * (sc + 1.0f) + sh; u32x2 w; w.x = pkbf(y.x, y.y); w.y = pkbf(y.z, y.w); o8[64 * j] = w; } }
    }
}

__device__ __forceinline__ void prep_item(unsigned char* ws, LAS unsigned char* lds, int item) {
    const int tid = otid(), lane = tid & 63, wave = tid >> 6;
    const GAS float* mod = (const GAS float*)(ws + WS_MOD);
    LAS float* sc = (LAS float*)lds; LAS float* sh = (LAS float*)(lds + 32768);
    const int site = item < 64 ? 0 : (item < 88 ? 1 : 2), rb = item < 64 ? item : (item < 88 ? item - 64 : item - 88);
    const int N = (site == 1) ? LD1 : FFD, layer = site ? 1 : 0, osc = (site == 1) ? 1024 : 4096, osh = (site == 1) ? 0 : 3072;
    const GAS bf16_t* Wt = (const GAS bf16_t*)(ws + (site == 0 ? WS_W1_0 : site == 1 ? WS_WIN1 : WS_W1_1));
    GAS bf16_t* WB = (GAS bf16_t*)(ws + (site == 0 ? WS_WB0 : site == 1 ? WS_WB1 : WS_WB2));
    GAS float* shw = (GAS float*)(ws + WS_SHW) + (size_t)site * 8 * 4096;
    for (int i = tid; i < 8192; i += NT) { const int b = i >> 10, k = i & 1023; const GAS float* mp = mod + (size_t)(layer * 8 + b) * 6144; sc[i] = 1.0f + mp[osc + k]; sh[i] = mp[osh + k]; }
    __syncthreads();
    for (int n = 64 * rb + wave; n < 64 * rb + 64; n += 8) {
        const u32x4 w0 = *(const GAS u32x4*)(Wt + (size_t)n * D + 16 * lane), w1 = *(const GAS u32x4*)(Wt + (size_t)n * D + 16 * lane + 8);
        float wv[16]; unpack8(w0, wv); unpack8(w1, wv + 8);
#pragma unroll 1
        for (int b = 0; b < 8; ++b) { float o[16]; float dot = 0.f;
#pragma unroll
            for (int i4 = 0; i4 < 4; ++i4) { const f32x4 s4 = *(const LAS f32x4*)(sc + b * 1024 + 16 * lane + 4 * i4), h4 = *(const LAS f32x4*)(sh + b * 1024 + 16 * lane + 4 * i4);
#pragma unroll
                for (int j = 0; j < 4; ++j) { o[4 * i4 + j] = wv[4 * i4 + j] * s4[j]; dot += wv[4 * i4 + j] * h4[j]; } }
            u32x4 p0, p1; p0.x = pkbf(o[0], o[1]); p0.y = pkbf(o[2], o[3]); p0.z = pkbf(o[4], o[5]); p0.w = pkbf(o[6], o[7]); p1.x = pkbf(o[8], o[9]); p1.y = pkbf(o[10], o[11]); p1.z = pkbf(o[12], o[13]); p1.w = pkbf(o[14], o[15]);
            GAS bf16_t* dst = WB + ((size_t)b * N + n) * D + 16 * lane; *(GAS u32x4*)dst = p0; *(GAS u32x4*)(dst + 8) = p1;
#pragma unroll
            for (int o2 = 1; o2 < 64; o2 <<= 1) dot += __shfl_xor(dot, o2);
            if (lane == 0) shw[(size_t)b * N + n] = dot; }
    }
}

__device__ __forceinline__ void cum_phase(unsigned char* ws, LAS unsigned char* lds) {
    if (blockIdx.x >= 8) {
        const int tid = otid(), lane = tid & 63, w = __builtin_amdgcn_readfirstlane(tid >> 6);
        const GAS bf16_t* P0 = (const GAS bf16_t*)(ws + WS_BIG); GAS _Float16* BC = (GAS _Float16*)(ws + WS_H); const GAS float* prm = (const GAS float*)(ws + WS_PRM);
        LAS float* wl = (LAS float*)lds; LAS float* blr = (LAS float*)(lds + 32768);
        for (int i = tid; i < 8192; i += NT) wl[i] = prm[PR_WLR + i];
        blr[tid] = prm[PR_BLR + tid];
        __syncthreads();
        for (int item = blockIdx.x - 8; item < T / 64; item += gridDim.x - 8) {
            const size_t m = (size_t)item * 64 + lane;
            const u32x4 rl0 = *(const GAS u32x4*)(P0 + m * LD0 + C_LR), rl1 = *(const GAS u32x4*)(P0 + m * LD0 + C_LR + 8);
            float glr[16]; unpack8(rl0, glr); unpack8(rl1, glr + 8);
#pragma unroll 1
            for (int h = 0; h < 8; ++h) {
                f32x4 z0 = *(const LAS f32x4*)(blr + 64 * h + 8 * w), z1 = *(const LAS f32x4*)(blr + 64 * h + 8 * w + 4);
#pragma unroll
                for (int r = 0; r < 16; ++r) { const f32x4 w0 = *(const LAS f32x4*)(wl + r * 512 + 64 * h + 8 * w), w1 = *(const LAS f32x4*)(wl + r * 512 + 64 * h + 8 * w + 4); z0 += w0 * glr[r]; z1 += w1 * glr[r]; }
                float bc[8];
#pragma unroll
                for (int j = 0; j < 4; ++j) { bc[j] = logsig(z0[j]) * 0.0625f; bc[4 + j] = logsig(z1[j]) * 0.0625f; }
#pragma unroll
                for (int d = 1; d < 64; d <<= 1) {
#pragma unroll
                    for (int j = 0; j < 8; ++j) { const float o = __shfl_up(bc[j], d); if (lane >= d) bc[j] += o; } }
                f16x8 hb;
#pragma unroll
                for (int j = 0; j < 8; ++j) hb[j] = (_Float16)bc[j];
                *(GAS f16x8*)(BC + m * 512 + 64 * h + 8 * w) = hb;
            }
        }
        return;
    }
    const int b = blockIdx.x, tid = otid(), lane = tid & 63, wave = tid >> 6;
    const bf16_t* P0 = (const bf16_t*)(ws + WS_BIG); float* cum = (float*)(ws + WS_CUM);
    LAS float* wt = (LAS float*)lds;
    float bf[8];
#pragma unroll
    for (int h = 0; h < 8; ++h) bf[h] = ((const float*)(ws + WS_PRM))[PR_BF + h];
    float run[8];
#pragma unroll
    for (int h = 0; h < 8; ++h) run[h] = 0.f;
    const size_t m0 = (size_t)b * SEQ + 16 * tid;
    for (int i = 0; i < 16; ++i) { const u32x4 w = *(const u32x4*)(P0 + (m0 + i) * LD0 + C_FF); float f[8]; unpack8(w, f);
#pragma unroll
        for (int h = 0; h < 8; ++h) run[h] += logsig(f[h] + bf[h]); }
    float incl[8];
#pragma unroll
    for (int h = 0; h < 8; ++h) { float v = run[h];
#pragma unroll
        for (int d = 1; d < 64; d <<= 1) { const float o = __shfl_up(v, d); if (lane >= d) v += o; }
        incl[h] = v; }
    if (lane == 63) {
#pragma unroll
        for (int h = 0; h < 8; ++h) wt[wave * 8 + h] = incl[h]; }
    __syncthreads();
    float off[8];
#pragma unroll
    for (int h = 0; h < 8; ++h) { float o = incl[h] - run[h]; for (int w = 0; w < wave; ++w) o += wt[w * 8 + h]; off[h] = o; }
    for (int i = 0; i < 16; ++i) { const u32x4 w = *(const u32x4*)(P0 + (m0 + i) * LD0 + C_FF); float f[8]; unpack8(w, f);
#pragma unroll
        for (int h = 0; h < 8; ++h) { off[h] += logsig(f[h] + bf[h]); cum[(size_t)(b * 8 + h) * SEQ + 16 * tid + i] = off[h]; } }
}

__device__ __forceinline__ int q_next(unsigned* ctr, LAS int* slot) {
    __syncthreads();
    if (threadIdx.x == 0) *slot = (int)atomicAdd(ctr, 1u);
    __syncthreads();
    return *slot;
}

#ifndef GLA_NSEG
#define GLA_NSEG 2
#endif
#define GLA_CPS (128 / GLA_NSEG)
__device__ __forceinline__ void gla_item(unsigned char* ws, LAS unsigned char* lds, int b, int h, int seg) {
    const int tid = otid(), lane = tid & 63, w = __builtin_amdgcn_readfirstlane(tid >> 6), c = lane & 15, q = lane >> 4;
    const GAS bf16_t* P0 = (const GAS bf16_t*)(ws + WS_BIG); GAS bf16_t* MIX = (GAS bf16_t*)(ws + WS_MIX); const GAS _Float16* BC = (const GAS _Float16*)(ws + WS_H); const GAS float* prm = (const GAS float*)(ws + WS_PRM);
    LAS bf16_t* Qp = (LAS bf16_t*)(lds); LAS bf16_t* Kp = (LAS bf16_t*)(lds + 9216); LAS bf16_t* Kt = (LAS bf16_t*)(lds + 18432); LAS bf16_t* Vt = (LAS bf16_t*)(lds + 27648);
    LAS bf16_t* Pm = (LAS bf16_t*)(lds + 36864); LAS bf16_t* St = (LAS bf16_t*)(lds + 46080); LAS float* dec = (LAS float*)(lds + 55296);
    LAS float* wl = (LAS float*)(lds + 55552); LAS float* blr = (LAS float*)(lds + 59648);
    for (int i = tid; i < 2304; i += NT) ((LAS unsigned*)St)[i] = 0u;
    float gain[16];
#pragma unroll
    for (int vi = 0; vi < 4; ++vi)
#pragma unroll
        for (int j = 0; j < 4; ++j) gain[vi * 4 + j] = prm[PR_GGAIN + h * 64 + 16 * vi + 4 * q + j];
    f32x4 sacc[4];
#pragma unroll
    for (int vi = 0; vi < 4; ++vi) sacc[vi] = (f32x4){0.f, 0.f, 0.f, 0.f};
    const size_t rowbase = (size_t)b * SEQ;
    u32x4 rq, rk, rv; f16x8 rbh, reh; u32x2 rg[4];
#define GLA_LOAD(ch_) do { const size_t m_ = rowbase + 64 * (ch_) + lane; const GAS bf16_t* p = P0 + m_ * LD0; \
        rq = *(const GAS u32x4*)(p + C_GQ + 64 * h + 8 * w); rk = *(const GAS u32x4*)(p + C_GK + 64 * h + 8 * w); rv = *(const GAS u32x4*)(p + C_GV + 64 * h + 8 * w); \
        rbh = *(const GAS f16x8*)(BC + m_ * 512 + 64 * h + 8 * w); reh = *(const GAS f16x8*)(BC + (rowbase + 64 * (ch_) + 63) * 512 + 64 * h + 8 * w); \
        if (w < 4) { const GAS bf16_t* pg = P0 + (rowbase + 64 * (ch_) + 16 * w + c) * LD0 + C_GG + 64 * h + 4 * q; _Pragma("unroll") for (int vi_ = 0; vi_ < 4; ++vi_) rg[vi_] = *(const GAS u32x2*)(pg + 16 * vi_); } } while (0)
    const int c0 = GLA_CPS * seg, item = (b * 8 + h) * 4 + seg;
    GAS float* EG = (GAS float*)(ws + WS_GLAE); GAS float* DG = (GAS float*)(ws + WS_GLAD); unsigned* flags = (unsigned*)(ws + WS_CTL) + 8192;
    __syncthreads();
    if (seg < GLA_NSEG - 1) {
        float sumbl[8];
#pragma unroll
        for (int j = 0; j < 8; ++j) sumbl[j] = 0.f;
        GLA_LOAD(c0);
        for (int ch = c0; ch < c0 + GLA_CPS; ++ch) {
            {
                const float bc[8] = {(float)rbh[0], (float)rbh[1], (float)rbh[2], (float)rbh[3], (float)rbh[4], (float)rbh[5], (float)rbh[6], (float)rbh[7]};
                const float bl[8] = {(float)reh[0], (float)reh[1], (float)reh[2], (float)reh[3], (float)reh[4], (float)reh[5], (float)reh[6], (float)reh[7]};
                float kf[8]; unpack8(rk, kf);
                const unsigned vv[4] = {rv.x, rv.y, rv.z, rv.w};
#pragma unroll
                for (int j = 0; j < 8; ++j) { sumbl[j] += bl[j]; Kt[(8 * w + j) * 72 + lane] = (bf16_t)(pkbf(kf[j] * __expf(bl[j] - bc[j]), 0.f) & 0xffffu); Vt[(8 * w + j) * 72 + lane] = (bf16_t)((j & 1) ? (vv[j >> 1] >> 16) : (vv[j >> 1] & 0xffffu)); }
                if (lane == 63) {
#pragma unroll
                    for (int j = 0; j < 8; ++j) dec[8 * w + j] = __expf(bl[j]); }
            }
            if (ch + 1 < c0 + GLA_CPS) GLA_LOAD(ch + 1);
            BAR_LDS();
            if (w >= 4) {
                const int ki = w - 4;
                const f32x4 d4 = *(const LAS f32x4*)(dec + 16 * ki + 4 * q);
                const bf16x8 k0 = *(const LAS bf16x8*)(Kt + (16 * ki + c) * 72 + 8 * q), k1 = *(const LAS bf16x8*)(Kt + (16 * ki + c) * 72 + 8 * q + 32);
#pragma unroll
                for (int vi = 0; vi < 4; ++vi) { const bf16x8 v0 = *(const LAS bf16x8*)(Vt + (16 * vi + c) * 72 + 8 * q), v1 = *(const LAS bf16x8*)(Vt + (16 * vi + c) * 72 + 8 * q + 32);
                    f32x4 s2 = sacc[vi] * d4; s2 = MFMA16(k0, v0, s2); s2 = MFMA16(k1, v1, s2); sacc[vi] = s2; }
            }
            BAR_LDS();
        }
        if (w >= 4) { const int ki = w - 4; GAS float* ep = EG + (size_t)item * 4096;
#pragma unroll
            for (int vi = 0; vi < 4; ++vi)
#pragma unroll
                for (int j = 0; j < 4; ++j) ep[(16 * ki + 4 * q + j) * 64 + 16 * vi + c] = sacc[vi][j]; }
        if (lane == 0) {
#pragma unroll
            for (int j = 0; j < 8; ++j) DG[(size_t)item * 64 + 8 * w + j] = sumbl[j]; }
        asm volatile("s_waitcnt vmcnt(0)" ::: "memory");
        __syncthreads();
        if (tid == 0) { __builtin_amdgcn_fence(__ATOMIC_RELEASE, "agent"); asm volatile("s_waitcnt vmcnt(0)" ::: "memory"); __hip_atomic_store(flags + item, 1u, __ATOMIC_RELAXED, __HIP_MEMORY_SCOPE_AGENT); }
    }
    GLA_LOAD(c0);
#pragma unroll
    for (int vi = 0; vi < 4; ++vi) sacc[vi] = (f32x4){0.f, 0.f, 0.f, 0.f};
    if (seg > 0) {
        if (tid == 0) {
            for (int s2 = 0; s2 < seg; ++s2) { unsigned sp = 0; while (__hip_atomic_load(flags + item - seg + s2, __ATOMIC_RELAXED, __HIP_MEMORY_SCOPE_AGENT) == 0u) { __builtin_amdgcn_s_sleep(2); if (++sp > (1u << 22)) break; } }
            __builtin_amdgcn_fence(__ATOMIC_ACQUIRE, "agent"); asm volatile("s_waitcnt vmcnt(0)" ::: "memory");
        }
        __syncthreads();
        if (w >= 4) { const int ki = w - 4;
            for (int s2 = 0; s2 < seg; ++s2) { const GAS float* ep = EG + (size_t)(item - seg + s2) * 4096; const GAS float* dp = DG + (size_t)(item - seg + s2) * 64 + 16 * ki + 4 * q;
                float dv[4];
#pragma unroll
                for (int j = 0; j < 4; ++j) dv[j] = __expf(__hip_atomic_load(dp + j, __ATOMIC_RELAXED, __HIP_MEMORY_SCOPE_AGENT));
#pragma unroll
                for (int vi = 0; vi < 4; ++vi)
#pragma unroll
                    for (int j = 0; j < 4; ++j) sacc[vi][j] = dv[j] * sacc[vi][j] + __hip_atomic_load(ep + (16 * ki + 4 * q + j) * 64 + 16 * vi + c, __ATOMIC_RELAXED, __HIP_MEMORY_SCOPE_AGENT); }
#pragma unroll
            for (int vi = 0; vi < 4; ++vi) { u32x2 sw; sw.x = pkbf(sacc[vi][0], sacc[vi][1]); sw.y = pkbf(sacc[vi][2], sacc[vi][3]); *(LAS u32x2*)(St + (16 * vi + c) * 72 + 16 * ki + 4 * q) = sw; }
        }
    }
    __syncthreads();
    for (int ch = c0; ch < c0 + GLA_CPS; ++ch) {
        u32x2 gcur[4];
#pragma unroll
        for (int vi = 0; vi < 4; ++vi) gcur[vi] = rg[vi];
        {
            const float bc[8] = {(float)rbh[0], (float)rbh[1], (float)rbh[2], (float)rbh[3], (float)rbh[4], (float)rbh[5], (float)rbh[6], (float)rbh[7]};
            const float ble[8] = {(float)reh[0], (float)reh[1], (float)reh[2], (float)reh[3], (float)reh[4], (float)reh[5], (float)reh[6], (float)reh[7]};
            float qf[8], kf[8]; unpack8(rq, qf); unpack8(rk, kf);
            float qp[8], kp[8], kpp[8], bl[8];
#pragma unroll
            for (int j = 0; j < 8; ++j) { bl[j] = ble[j]; qp[j] = qf[j] * 0.125f * __expf(bc[j]); kp[j] = kf[j] * __expf(-bc[j]); kpp[j] = kf[j] * __expf(bl[j] - bc[j]); }
            u32x4 wq, wk; wq.x = pkbf(qp[0], qp[1]); wq.y = pkbf(qp[2], qp[3]); wq.z = pkbf(qp[4], qp[5]); wq.w = pkbf(qp[6], qp[7]);
            wk.x = pkbf(kp[0], kp[1]); wk.y = pkbf(kp[2], kp[3]); wk.z = pkbf(kp[4], kp[5]); wk.w = pkbf(kp[6], kp[7]);
            *(LAS u32x4*)(Qp + lane * 72 + 8 * w) = wq; *(LAS u32x4*)(Kp + lane * 72 + 8 * w) = wk;
            const unsigned vv[4] = {rv.x, rv.y, rv.z, rv.w};
#pragma unroll
            for (int j = 0; j < 8; ++j) { Kt[(8 * w + j) * 72 + lane] = (bf16_t)(pkbf(kpp[j], 0.f) & 0xffffu); Vt[(8 * w + j) * 72 + lane] = (bf16_t)((j & 1) ? (vv[j >> 1] >> 16) : (vv[j >> 1] & 0xffffu)); }
            if (lane == 63) {
#pragma unroll
                for (int j = 0; j < 8; ++j) dec[8 * w + j] = __expf(bl[j]); }
        }
        if (ch + 1 < c0 + GLA_CPS) GLA_LOAD(ch + 1);
        BAR_LDS();
        f32x4 oacc[4];
        {
            const int ti = w & 3;
            const bf16x8 qf0 = *(const LAS bf16x8*)(Qp + (16 * ti + c) * 72 + 8 * q), qf1 = *(const LAS bf16x8*)(Qp + (16 * ti + c) * 72 + 8 * q + 32);
#pragma unroll
            for (int u = 0; u < 2; ++u) { const int si = 2 * (w >> 2) + u; f32x4 acc = (f32x4){0.f, 0.f, 0.f, 0.f};
                if (si <= ti) { const bf16x8 k0 = *(const LAS bf16x8*)(Kp + (16 * si + c) * 72 + 8 * q), k1 = *(const LAS bf16x8*)(Kp + (16 * si + c) * 72 + 8 * q + 32);
                    acc = MFMA16(k0, qf0, acc); acc = MFMA16(k1, qf1, acc);
#pragma unroll
                    for (int j = 0; j < 4; ++j) if (16 * si + 4 * q + j > 16 * ti + c) acc[j] = 0.f; }
                u32x2 pw; pw.x = pkbf(acc[0], acc[1]); pw.y = pkbf(acc[2], acc[3]);
                *(LAS u32x2*)(Pm + (16 * ti + c) * 72 + 16 * si + 4 * q) = pw; }
            if (w < 4) {
#pragma unroll
                for (int vi = 0; vi < 4; ++vi) { const bf16x8 s0 = *(const LAS bf16x8*)(St + (16 * vi + c) * 72 + 8 * q), s1 = *(const LAS bf16x8*)(St + (16 * vi + c) * 72 + 8 * q + 32);
                    f32x4 acc = (f32x4){0.f, 0.f, 0.f, 0.f}; acc = MFMA16(s0, qf0, acc); acc = MFMA16(s1, qf1, acc); oacc[vi] = acc; } }
        }
        BAR_LDS();
        if (w < 4) {
            const bf16x8 p0 = *(const LAS bf16x8*)(Pm + (16 * w + c) * 72 + 8 * q), p1 = *(const LAS bf16x8*)(Pm + (16 * w + c) * 72 + 8 * q + 32);
            float ssq = 0.f;
#pragma unroll
            for (int vi = 0; vi < 4; ++vi) { const bf16x8 v0 = *(const LAS bf16x8*)(Vt + (16 * vi + c) * 72 + 8 * q), v1 = *(const LAS bf16x8*)(Vt + (16 * vi + c) * 72 + 8 * q + 32);
                oacc[vi] = MFMA16(v0, p0, oacc[vi]); oacc[vi] = MFMA16(v1, p1, oacc[vi]);
#pragma unroll
                for (int j = 0; j < 4; ++j) ssq += oacc[vi][j] * oacc[vi][j]; }
            ssq += __shfl_xor(ssq, 16); ssq += __shfl_xor(ssq, 32);
            const float r = rsqrtf(ssq * (1.0f / 64.0f) + EPS);
            const size_t m = rowbase + 64 * ch + 16 * w + c;
#pragma unroll
            for (int vi = 0; vi < 4; ++vi) { const u32x2 gw = gcur[vi];
                const float g0 = bflo(gw.x), g1 = bfhi(gw.x), g2 = bflo(gw.y), g3 = bfhi(gw.y);
                u32x2 ow; ow.x = pkbf(oacc[vi][0] * r * gain[vi * 4 + 0] * siluf_(g0), oacc[vi][1] * r * gain[vi * 4 + 1] * siluf_(g1));
                ow.y = pkbf(oacc[vi][2] * r * gain[vi * 4 + 2] * siluf_(g2), oacc[vi][3] * r * gain[vi * 4 + 3] * siluf_(g3));
                *(GAS u32x2*)(MIX + m * D + 64 * h + 16 * vi + 4 * q) = ow; }
        } else {
            const int ki = w - 4;
            const f32x4 d4 = *(const LAS f32x4*)(dec + 16 * ki + 4 * q);
            const bf16x8 k0 = *(const LAS bf16x8*)(Kt + (16 * ki + c) * 72 + 8 * q), k1 = *(const LAS bf16x8*)(Kt + (16 * ki + c) * 72 + 8 * q + 32);
#pragma unroll
            for (int vi = 0; vi < 4; ++vi) { const bf16x8 v0 = *(const LAS bf16x8*)(Vt + (16 * vi + c) * 72 + 8 * q), v1 = *(const LAS bf16x8*)(Vt + (16 * vi + c) * 72 + 8 * q + 32);
                f32x4 s = sacc[vi] * d4; s = MFMA16(k0, v0, s); s = MFMA16(k1, v1, s); sacc[vi] = s;
                u32x2 sw; sw.x = pkbf(s[0], s[1]); sw.y = pkbf(s[2], s[3]);
                *(LAS u32x2*)(St + (16 * vi + c) * 72 + 16 * ki + 4 * q) = sw; }
        }
        BAR_LDS();
    }
}

#undef GLA_LOAD
__device__ __forceinline__ void fox_item(unsigned char* ws, LAS unsigned char* lds, int b, int h, int qg) {
    const int tid = otid(), lane = tid & 63, w = __builtin_amdgcn_readfirstlane(tid >> 6), c = lane & 15, q = lane >> 4;
    const GAS bf16_t* P0 = (const GAS bf16_t*)(ws + WS_BIG); GAS bf16_t* MIX = (GAS bf16_t*)(ws + WS_MIX);
    const GAS float* cumb = (const GAS float*)(ws + WS_CUM) + (size_t)(b * 8 + h) * SEQ;
    LAS bf16_t* Kn = (LAS bf16_t*)(lds); LAS bf16_t* Vt = (LAS bf16_t*)(lds + 9216); LAS float* cumk = (LAS float*)(lds + 18432);
    const GAS float* gq = (const GAS float*)(ws + WS_PRM) + PR_QG + h * 64; const GAS float* gk = (const GAS float*)(ws + WS_PRM) + PR_KG + h * 64;
    float mq = fabsf(gq[lane]), mk = fabsf(gk[lane]);
#pragma unroll
    for (int o = 1; o < 64; o <<= 1) { mq = fmaxf(mq, __shfl_xor(mq, o)); mk = fmaxf(mk, __shfl_xor(mk, o)); }
    const float B2 = 16.0f * mq * mk * 1.001f;
    const int srow = tid >> 3, dc = tid & 7;
    float gkr[8], gqr[16];
#pragma unroll
    for (int e2 = 0; e2 < 8; ++e2) { gkr[e2] = gk[8 * dc + e2]; gqr[e2] = gq[8 * q + e2]; gqr[8 + e2] = gq[8 * q + 32 + e2]; }
    const size_t rowbase = (size_t)b * SEQ;
    for (int qi = 2 * qg; qi < 2 * qg + 2; ++qi) {
        const int t0 = 128 * qi, t = t0 + 16 * w + c; const size_t m = rowbase + t;
        int j = 2 * qi + 1;
        const u32x4 r0 = *(const GAS u32x4*)(P0 + m * LD0 + C_FQ + 64 * h + 8 * q), r1 = *(const GAS u32x4*)(P0 + m * LD0 + C_FQ + 64 * h + 8 * q + 32);
        const float cum_t0 = cumb[t0], cum_t = cumb[t];
        const int jl0 = 2 * qi - 1 - lane; const float ce0 = (jl0 >= 0) ? cumb[64 * jl0 + 63] : 0.f;
        u32x4 rk, rv; float rc;
        { const size_t ms = rowbase + 64 * j + srow; rk = *(const GAS u32x4*)(P0 + ms * LD0 + C_FK + 64 * h + 8 * dc); rv = *(const GAS u32x4*)(P0 + ms * LD0 + C_FV + 64 * h + 8 * dc); rc = cumb[64 * j + srow]; }
        int nbelow = 0;
        { const bool skp = (jl0 < 0) || ((B2 + cum_t0 - ce0) < -110.0f); const unsigned long long mk0 = __ballot(skp);
          if (mk0) nbelow = __ffsll((long long)mk0) - 1;
          else { nbelow = 64;
              for (int basej = 2 * qi - 1 - 64; basej >= 0; basej -= 64) { const int jl = basej - lane; const float ce = (jl >= 0) ? cumb[64 * jl + 63] : 0.f;
                  const bool sk2 = (jl < 0) || ((B2 + cum_t0 - ce) < -110.0f); const unsigned long long mk2 = __ballot(sk2);
                  if (mk2) { nbelow += __ffsll((long long)mk2) - 1; break; } nbelow += 64; } } }
        const int jlo = 2 * qi - nbelow;
        bf16x8 qf[2];
        { float f[16]; unpack8(r0, f); unpack8(r1, f + 8); float ss = 0.f;
#pragma unroll
          for (int e2 = 0; e2 < 16; ++e2) ss += f[e2] * f[e2];
          ss += __shfl_xor(ss, 16); ss += __shfl_xor(ss, 32);
          const float r = rsqrtf(ss * (1.0f / 64.0f) + EPS) * 0.125f;
#pragma unroll
          for (int kk = 0; kk < 2; ++kk) { float g[8];
#pragma unroll
              for (int e2 = 0; e2 < 8; ++e2) g[e2] = f[8 * kk + e2] * r * gqr[8 * kk + e2];
              u32x4 pw; pw.x = pkbf(g[0], g[1]); pw.y = pkbf(g[2], g[3]); pw.z = pkbf(g[4], g[5]); pw.w = pkbf(g[6], g[7]); qf[kk] = as_bf16x8(pw); } }
        f32x4 oacc[4];
#pragma unroll
        for (int di = 0; di < 4; ++di) oacc[di] = (f32x4){0.f, 0.f, 0.f, 0.f};
        float mrun = -1e30f, lpart = 0.f;
        for (;;) {
            { float f[8]; unpack8(rk, f); float ss = 0.f;
#pragma unroll
              for (int e2 = 0; e2 < 8; ++e2) ss += f[e2] * f[e2];
              ss += __shfl_xor(ss, 1); ss += __shfl_xor(ss, 2); ss += __shfl_xor(ss, 4);
              const float r = rsqrtf(ss * (1.0f / 64.0f) + EPS);
#pragma unroll
              for (int e2 = 0; e2 < 8; ++e2) f[e2] = f[e2] * r * gkr[e2];
              u32x4 pw; pw.x = pkbf(f[0], f[1]); pw.y = pkbf(f[2], f[3]); pw.z = pkbf(f[4], f[5]); pw.w = pkbf(f[6], f[7]);
              *(LAS u32x4*)(Kn + srow * 72 + 8 * dc) = pw;
              const unsigned vv[4] = {rv.x, rv.y, rv.z, rv.w};
#pragma unroll
              for (int e2 = 0; e2 < 8; ++e2) Vt[(8 * dc + e2) * 72 + srow] = (bf16_t)((e2 & 1) ? (vv[e2 >> 1] >> 16) : (vv[e2 >> 1] & 0xffffu));
              if (dc == 0) cumk[srow] = rc; }
            const int jn = j - 1;
            const bool cont = jn >= jlo;
            if (cont) { const size_t ms = rowbase + 64 * jn + srow; rk = *(const GAS u32x4*)(P0 + ms * LD0 + C_FK + 64 * h + 8 * dc); rv = *(const GAS u32x4*)(P0 + ms * LD0 + C_FV + 64 * h + 8 * dc); rc = cumb[64 * jn + srow]; }
            BAR_LDS();
            if (!(j == 2 * qi + 1 && w < 4)) {
                float sv[4][4]; float mx = -1e30f;
#pragma unroll
                for (int si = 0; si < 4; ++si) { f32x4 acc = (f32x4){0.f, 0.f, 0.f, 0.f};
                    const bf16x8 k0 = *(const LAS bf16x8*)(Kn + (16 * si + c) * 72 + 8 * q), k1 = *(const LAS bf16x8*)(Kn + (16 * si + c) * 72 + 8 * q + 32);
                    acc = MFMA16(k0, qf[0], acc); acc = MFMA16(k1, qf[1], acc);
                    const f32x4 ck = *(const LAS f32x4*)(cumk + 16 * si + 4 * q);
#pragma unroll
                    for (int jj = 0; jj < 4; ++jj) { float lg = acc[jj] + (cum_t - ck[jj]); if (j >= 2 * qi && (64 * j + 16 * si + 4 * q + jj) > t) lg = -1e30f; sv[si][jj] = lg; mx = fmaxf(mx, lg); } }
                mx = fmaxf(mx, __shfl_xor(mx, 16)); mx = fmaxf(mx, __shfl_xor(mx, 32));
                const float mnew = fmaxf(mrun, mx), alpha = __expf(mrun - mnew); mrun = mnew;
                float ps = 0.f;
#pragma unroll
                for (int si = 0; si < 4; ++si)
#pragma unroll
                    for (int jj = 0; jj < 4; ++jj) { sv[si][jj] = __expf(sv[si][jj] - mnew); ps += sv[si][jj]; }
                lpart = lpart * alpha + ps;
#pragma unroll
                for (int di = 0; di < 4; ++di) oacc[di] *= alpha;
#pragma unroll
                for (int kk = 0; kk < 2; ++kk) { u32x4 pw; pw.x = pkbf(sv[2 * kk][0], sv[2 * kk][1]); pw.y = pkbf(sv[2 * kk][2], sv[2 * kk][3]); pw.z = pkbf(sv[2 * kk + 1][0], sv[2 * kk + 1][1]); pw.w = pkbf(sv[2 * kk + 1][2], sv[2 * kk + 1][3]);
                    const bf16x8 pf = as_bf16x8(pw);
#pragma unroll
                    for (int di = 0; di < 4; ++di) { const u32x2 va = *(const LAS u32x2*)(Vt + (16 * di + c) * 72 + 32 * kk + 4 * q), vb = *(const LAS u32x2*)(Vt + (16 * di + c) * 72 + 32 * kk + 16 + 4 * q);
                        u32x4 vw; vw.x = va.x; vw.y = va.y; vw.z = vb.x; vw.w = vb.y; oacc[di] = MFMA16(as_bf16x8(vw), pf, oacc[di]); } }
            }
            BAR_LDS();
            if (!cont) break;
            j = jn;
        }
        float l = lpart; l += __shfl_xor(l, 16); l += __shfl_xor(l, 32);
        const float inv = 1.0f / l;
#pragma unroll
        for (int di = 0; di < 4; ++di) { u32x2 ow; ow.x = pkbf(oacc[di][0] * inv, oacc[di][1] * inv); ow.y = pkbf(oacc[di][2] * inv, oacc[di][3] * inv);
            *(GAS u32x2*)(MIX + m * D + 512 + 64 * h + 16 * di + 4 * q) = ow; }
    }
}

__device__ __forceinline__ void s5_item(unsigned char* ws, LAS unsigned char* lds, int b, int g) {
    const int tid = otid(), lane = tid & 63, w = __builtin_amdgcn_readfirstlane(tid >> 6), c = lane & 15, q = lane >> 4;
    const GAS bf16_t* P1 = (const GAS bf16_t*)(ws + WS_BIG); GAS bf16_t* YS = (GAS bf16_t*)(ws + WS_YS5);
    const GAS float* abar = (const GAS float*)(ws + WS_S5P + S5_ABAR); const GAS bf16_t* Bb = (const GAS bf16_t*)(ws + WS_S5P + S5_BB); const GAS bf16_t* Cm = (const GAS bf16_t*)(ws + WS_S5P + S5_CM);
    LAS float* bu = (LAS float*)(lds + w * 12800); LAS bf16_t* xs = (LAS bf16_t*)(lds + w * 12800 + 8448); LAS float* E = (LAS float*)(lds + 102400);
    const float ar = abar[(g * 64 + lane) * 2], ai = abar[(g * 64 + lane) * 2 + 1];
    float pr = ar, pi = ai;
#pragma unroll
    for (int i = 0; i < 10; ++i) { const float nr = pr * pr - pi * pi, ni = 2.0f * pr * pi; pr = nr; pi = ni; }
    bf16x8 bfr[8], cfr[4];
    const bf16x8 zero8 = (bf16x8){0, 0, 0, 0, 0, 0, 0, 0};
#pragma unroll
    for (int pt = 0; pt < 8; ++pt) bfr[pt] = (q < 2) ? *(const GAS bf16x8*)(Bb + ((size_t)(g * 128 + 16 * pt + c)) * 16 + 8 * q) : zero8;
#pragma unroll
    for (int kk = 0; kk < 4; ++kk) cfr[kk] = *(const GAS bf16x8*)(Cm + (size_t)(g * 16 + c) * 128 + 32 * kk + 8 * q);
    float dsk[4];
#pragma unroll
    for (int j = 0; j < 4; ++j) dsk[j] = ((const GAS float*)(ws + WS_PRM))[PR_S5D + g * 16 + 4 * q + j];
    f32x2 x2 = {0.f, 0.f}; const f32x2 a1 = {ar, ar}, a2 = {-ai, ai};
    LAS bf16_t* xs1 = (LAS bf16_t*)(lds + 106496 + w * 4352);
    for (int pass = 0; pass < 2; ++pass) {
        const size_t mbase = (size_t)b * SEQ + 1024 * w + c;
        bf16x8 uf_a = (q < 2) ? *(const GAS bf16x8*)(P1 + mbase * LD1 + 16 * g + 8 * q) : zero8;
        bf16x8 uf_b = (q < 2) ? *(const GAS bf16x8*)(P1 + (mbase + 16) * LD1 + 16 * g + 8 * q) : zero8;
        u32x2 uw_cur = *(const GAS u32x2*)(P1 + mbase * LD1 + 16 * g + 4 * q), uw_nxt = *(const GAS u32x2*)(P1 + (mbase + 16) * LD1 + 16 * g + 4 * q), uw_prev = uw_cur;
        f32x4 abu[8];
#pragma unroll
        for (int pt = 0; pt < 8; ++pt) abu[pt] = MFMA16(bfr[pt], uf_a, ((f32x4){0.f, 0.f, 0.f, 0.f}));
        for (int sc = 0; sc < 64; ++sc) {
            const size_t m = mbase + 16 * sc;
            LAS bf16_t* xw = (sc & 1) ? xs1 : xs; LAS bf16_t* xr = (sc & 1) ? xs : xs1;
#pragma unroll
            for (int pt = 0; pt < 8; ++pt) *(LAS f32x4*)(bu + c * 132 + 16 * pt + 4 * q) = abu[pt];
            const bf16x8 uf_use = uf_b;
            if (sc + 2 < 64) { uf_b = (q < 2) ? *(const GAS bf16x8*)(P1 + (m + 32) * LD1 + 16 * g + 8 * q) : zero8; }
            u32x2 uw_n2 = uw_nxt; if (sc + 2 < 64) uw_n2 = *(const GAS u32x2*)(P1 + (m + 32) * LD1 + 16 * g + 4 * q);
#pragma unroll
            for (int pt = 0; pt < 8; ++pt) abu[pt] = MFMA16(bfr[pt], uf_use, ((f32x4){0.f, 0.f, 0.f, 0.f}));
            bf16x8 xf[4];
            if (pass && sc > 0) {
#pragma unroll
                for (int kk = 0; kk < 4; ++kk) xf[kk] = *(const LAS bf16x8*)(xr + c * 136 + 32 * kk + 8 * q); }
            LDS_WAIT();
#pragma unroll
            for (int tt = 0; tt < 16; ++tt) { const f32x2 bb = *(const LAS f32x2*)(bu + tt * 132 + 2 * lane);
                const f32x2 t2 = a1 * x2 + bb; const f32x2 xsw = {x2.y, x2.x}; x2 = a2 * xsw + t2;
                if (pass) *(LAS unsigned*)(xw + tt * 136 + 2 * lane) = pkbf(x2.x, x2.y); }
            if (pass && sc > 0) {
                f32x4 acc = (f32x4){0.f, 0.f, 0.f, 0.f};
#pragma unroll
                for (int kk = 0; kk < 4; ++kk) acc = MFMA16(cfr[kk], xf[kk], acc);
                const float y0 = gelu_tanh(acc[0] + dsk[0] * bflo(uw_prev.x)), y1 = gelu_tanh(acc[1] + dsk[1] * bfhi(uw_prev.x)), y2 = gelu_tanh(acc[2] + dsk[2] * bflo(uw_prev.y)), y3 = gelu_tanh(acc[3] + dsk[3] * bfhi(uw_prev.y));
                u32x2 ow; ow.x = pkbf(y0, y1); ow.y = pkbf(y2, y3);
                *(GAS u32x2*)(YS + (m - 16) * 512 + 16 * g + 4 * q) = ow;
            }
            uw_prev = uw_cur; uw_cur = uw_nxt; uw_nxt = uw_n2;
        }
        if (pass) {
            LDS_WAIT();
            f32x4 acc = (f32x4){0.f, 0.f, 0.f, 0.f};
#pragma unroll
            for (int kk = 0; kk < 4; ++kk) { const bf16x8 xf = *(const LAS bf16x8*)(xs1 + c * 136 + 32 * kk + 8 * q); acc = MFMA16(cfr[kk], xf, acc); }
            const float y0 = gelu_tanh(acc[0] + dsk[0] * bflo(uw_prev.x)), y1 = gelu_tanh(acc[1] + dsk[1] * bfhi(uw_prev.x)), y2 = gelu_tanh(acc[2] + dsk[2] * bflo(uw_prev.y)), y3 = gelu_tanh(acc[3] + dsk[3] * bfhi(uw_prev.y));
            u32x2 ow; ow.x = pkbf(y0, y1); ow.y = pkbf(y2, y3);
            *(GAS u32x2*)(YS + (mbase + 16 * 63) * 512 + 16 * g + 4 * q) = ow;
            LDS_WAIT();
        }
        if (pass == 0) {
            E[w * 128 + lane] = x2.x; E[w * 128 + 64 + lane] = x2.y;
            __syncthreads();
            float cr = 0.f, ci = 0.f;
            for (int w2 = 0; w2 < w; ++w2) { const float er = E[w2 * 128 + lane], ei = E[w2 * 128 + 64 + lane]; const float nr = pr * cr - pi * ci + er, ni = pr * ci + pi * cr + ei; cr = nr; ci = ni; }
            x2.x = cr; x2.y = ci;
        }
    }
}

__device__ __forceinline__ void sgu_item(unsigned char* ws, LAS unsigned char* lds, int b, int n) {
    const int tid = otid(), lane = tid & 63, w = __builtin_amdgcn_readfirstlane(tid >> 6), c = lane & 15, q = lane >> 4;
    const GAS bf16_t* P1 = (const GAS bf16_t*)(ws + WS_BIG); GAS bf16_t* MIX = (GAS bf16_t*)(ws + WS_MIX); const GAS bf16_t* wsb = (const GAS bf16_t*)(ws + WS_WSB);
    LAS bf16_t* Vt = (LAS bf16_t*)lds;
    const size_t m0 = (size_t)b * SEQ + 128 * n;
    {
        const int s = tid >> 2, qq = tid & 3; const GAS bf16_t* vp = P1 + (m0 + s) * LD1 + 1024 + 128 * qq;
        u32x4 rv[16]; float sum = 0.f, ssq = 0.f;
#pragma unroll
        for (int i = 0; i < 16; ++i) { rv[i] = *(const GAS u32x4*)(vp + 8 * i); float f[8]; unpack8(rv[i], f);
#pragma unroll
            for (int e = 0; e < 8; ++e) { sum += f[e]; ssq += f[e] * f[e]; } }
        sum += __shfl_xor(sum, 1); sum += __shfl_xor(sum, 2); ssq += __shfl_xor(ssq, 1); ssq += __shfl_xor(ssq, 2);
        const float mu = sum * (1.0f / 512.0f), var = fmaxf(ssq * (1.0f / 512.0f) - mu * mu, 0.f), rstd = rsqrtf(var + EPS);
        const GAS float* lg = (const GAS float*)(ws + WS_PRM) + PR_LNG + 128 * qq; const GAS float* lb = (const GAS float*)(ws + WS_PRM) + PR_LNB + 128 * qq;
#pragma unroll
        for (int i = 0; i < 16; ++i) { float f[8]; unpack8(rv[i], f);
            const f32x4 g0 = *(const GAS f32x4*)(lg + 8 * i), g1 = *(const GAS f32x4*)(lg + 8 * i + 4), b0 = *(const GAS f32x4*)(lb + 8 * i), b1 = *(const GAS f32x4*)(lb + 8 * i + 4);
#pragma unroll
            for (int e = 0; e < 8; ++e) { const float gg = e < 4 ? g0[e & 3] : g1[e & 3], bb = e < 4 ? b0[e & 3] : b1[e & 3]; const float y = (f[e] - mu) * rstd * gg + bb;
                Vt[(128 * qq + 8 * i + e) * 136 + s] = (bf16_t)(pkbf(y, 0.f) & 0xffffu); } }
    }
    __syncthreads();
    const int nk = (w >> 1) + 1; const int trow = 16 * w + c; const size_t m = m0 + trow;
    bf16x8 wfn[4]; u32x2 uwn[4]; float bsn;
#define SGU_LOAD(g_) do { _Pragma("unroll") for (int kk_ = 0; kk_ < 4; ++kk_) if (kk_ < nk) wfn[kk_] = *(const GAS bf16x8*)(wsb + ((size_t)(g_) * 128 + trow) * 128 + 32 * kk_ + 8 * q); \
        _Pragma("unroll") for (int ct_ = 0; ct_ < 4; ++ct_) uwn[ct_] = *(const GAS u32x2*)(P1 + m * LD1 + 512 + 64 * (g_) + 16 * ct_ + 4 * q); \
        bsn = ((const GAS float*)(ws + WS_PRM))[PR_BS + (g_) * 128 + trow]; } while (0)
    SGU_LOAD(0);
    for (int g = 0; g < 8; ++g) {
        bf16x8 wf[4]; u32x2 uw[4];
#pragma unroll
        for (int kk = 0; kk < 4; ++kk) wf[kk] = wfn[kk];
#pragma unroll
        for (int ct = 0; ct < 4; ++ct) uw[ct] = uwn[ct];
        const float bs = bsn;
        if (g + 1 < 8) SGU_LOAD(g + 1);
        f32x4 acc[4];
#pragma unroll
        for (int ct = 0; ct < 4; ++ct) acc[ct] = (f32x4){0.f, 0.f, 0.f, 0.f};
#pragma unroll
        for (int kk = 0; kk < 4; ++kk) if (kk < nk) {
#pragma unroll
            for (int ct = 0; ct < 4; ++ct) { const bf16x8 vf = *(const LAS bf16x8*)(Vt + (64 * g + 16 * ct + c) * 136 + 32 * kk + 8 * q); acc[ct] = MFMA16(vf, wf[kk], acc[ct]); } }
#pragma unroll
        for (int ct = 0; ct < 4; ++ct) {
            u32x2 ow; ow.x = pkbf(bflo(uw[ct].x) * (acc[ct][0] + bs), bfhi(uw[ct].x) * (acc[ct][1] + bs)); ow.y = pkbf(bflo(uw[ct].y) * (acc[ct][2] + bs), bfhi(uw[ct].y) * (acc[ct][3] + bs));
            *(GAS u32x2*)(MIX + m * D + 512 + 64 * g + 16 * ct + 4 * q) = ow; }
    }
#undef SGU_LOAD
}

#define XB_TMO      128
#define XB_XCNT(j)  (256  + 64 * (j))
#define XB_XSUB(j)  (1280 + 64 * (j))
#define XB_XGEN(j)  (2304 + 64 * (j))
#define XB_TOP      3328
#define XB_TOPGEN   3392
#define XCD_BAR_WORDS 3456
#define XB_SPIN_CAP (1u << 22)
__device__ __forceinline__ unsigned xb_ld(unsigned* p)              { return __hip_atomic_load(p, __ATOMIC_RELAXED, __HIP_MEMORY_SCOPE_AGENT); }
__device__ __forceinline__ unsigned xb_add(unsigned* p, unsigned v) { return __hip_atomic_fetch_add(p, v, __ATOMIC_RELAXED, __HIP_MEMORY_SCOPE_AGENT); }
__device__ __forceinline__ unsigned xb_xcc_id() { return (unsigned)__builtin_amdgcn_s_getreg((3 << 11) | 20) & 0xFu; }
#define XB_SPIN(cond, bar) do { unsigned _sp = 0; while (cond) { __builtin_amdgcn_s_sleep(1); \
    if ((++_sp & 255u) == 0u) { if (xb_ld(&(bar)[XB_TMO])) break; if (_sp > XB_SPIN_CAP) { atomicAdd(&(bar)[XB_TMO], 1u); break; } } } } while (0)
struct XcdBarrier { unsigned* bar; unsigned x; volatile LAS unsigned* st; };
__device__ __forceinline__ XcdBarrier xcd_barrier_post(unsigned* bar, volatile LAS unsigned* st) {
    XcdBarrier b; b.bar = bar; b.x = xb_xcc_id(); b.st = st;
    if (threadIdx.x == 0) st[2] = xb_add(&bar[XB_XCNT(b.x)], 1u);
    return b;
}
__device__ __forceinline__ void xcd_barrier_complete(unsigned* bar, unsigned x, unsigned& nloc, unsigned& nx) {
    const unsigned G = gridDim.x * gridDim.y * gridDim.z;
    unsigned sum, cnt, mine, sp = 0u;
    for (;;) {
        sum = 0u; cnt = 0u; mine = 0u;
#pragma unroll
        for (unsigned j = 0; j < 16; ++j) { const unsigned c = xb_ld(&bar[XB_XCNT(j)]); sum += c; cnt += (c > 0u) ? 1u : 0u; mine = (j == x) ? c : mine; }
        if (sum == G) break;
        __builtin_amdgcn_s_sleep(1);
        if ((++sp & 255u) == 0u) { if (xb_ld(&bar[XB_TMO])) break; if (sp > XB_SPIN_CAP) { atomicAdd(&bar[XB_TMO], 1u); break; } }
    }
    nloc = mine > 0u ? mine : 1u; nx = cnt > 0u ? cnt : 1u;
}
__device__ __forceinline__ void xcd_barrier(const XcdBarrier& b) {
    asm volatile("s_waitcnt vmcnt(0) lgkmcnt(0)" ::: "memory");
    __syncthreads();
    if (threadIdx.x == 0) {
        unsigned* bar = b.bar;
        __builtin_amdgcn_s_waitcnt(0);
        unsigned nloc = b.st[0], nx = b.st[1];
        if (nloc == 0u) { xcd_barrier_complete(bar, b.x, nloc, nx); b.st[0] = nloc; b.st[1] = nx; }
        const unsigned old = xb_add(&bar[XB_XSUB(b.x)], 1u);
        const unsigned gen = old / nloc;
        if (old + 1u == (gen + 1u) * nloc) {
            __builtin_amdgcn_fence(__ATOMIC_RELEASE, "agent");
            asm volatile("s_waitcnt vmcnt(0)" ::: "memory");
            const unsigned og = xb_add(&bar[XB_TOP], 1u);
            const unsigned tg = og / nx;
            if (og + 1u == (tg + 1u) * nx) xb_add(&bar[XB_TOPGEN], 1u);
            else XB_SPIN(xb_ld(&bar[XB_TOPGEN]) == tg, bar);
            __builtin_amdgcn_fence(__ATOMIC_ACQUIRE, "agent");
            xb_add(&bar[XB_XGEN(b.x)], 1u);
            asm volatile("s_waitcnt vmcnt(0)" ::: "memory");
        } else {
            XB_SPIN(xb_ld(&bar[XB_XGEN(b.x)]) == gen, bar);
            __builtin_amdgcn_fence(__ATOMIC_ACQUIRE, "agent");
            asm volatile("s_waitcnt vmcnt(0)" ::: "memory");
        }
    }
    __syncthreads();
}
#define GSYNC(k) xcd_barrier(xbar)
__global__ void __launch_bounds__(NT, 2) mega_fwd(Args a) {
    extern __shared__ __attribute__((aligned(16))) unsigned char lds_raw[];
    LAS unsigned char* lds = (LAS unsigned char*)lds_raw;
    cg::grid_group grid = cg::this_grid();
    LAS int* slot = (LAS int*)(lds + LDS_BYTES - 64);
    volatile LAS unsigned* xst = (volatile LAS unsigned*)(lds + LDS_BYTES - 32);
    if (threadIdx.x < 4) xst[threadIdx.x] = 0u;
    __syncthreads();
    XcdBarrier xbar = xcd_barrier_post((unsigned*)(a.ws + WS_CTL) + 1024, xst);
    grid.sync();
#ifndef NO_P0
    p0_prologue(a, lds);
#endif
    GSYNC(0);
    int vcu = blockIdx.x;
    { unsigned* bw = (unsigned*)(a.ws + WS_CTL) + 1024; bool ok = (gridDim.x % 8u) == 0u;
      for (int j = 0; j < 16; ++j) { const unsigned cj = xb_ld(&bw[XB_XCNT(j)]); if (cj != (j < 8 ? gridDim.x / 8u : 0u)) ok = false; }
      if (ok) vcu = (int)(xbar.x + 8u * xst[2]); }
    unsigned char* const ws0 = a.ws; const float* const x00 = a.in[0]; float* const xout0 = a.out;
    unsigned kb = 1;
    for (int ph = 1; ph <= 16; ++ph) {
        if (ph == 6 || ph == 9 || ph == 14) continue;
        unsigned char* ws = ws0; const float* x0 = x00; float* xout = xout0;
        asm volatile("" : "+s"(ws), "+s"(x0), "+s"(xout));

        const float* mod = (const float*)(ws + WS_MOD);
        bf16_t* H = (bf16_t*)(ws + WS_H); bf16_t* MIX = (bf16_t*)(ws + WS_MIX); bf16_t* BIG = (bf16_t*)(ws + WS_BIG);
        unsigned* ctl = (unsigned*)(ws + WS_CTL);
        const int layer = ph >= 9;
        const GAS float* modl = (const GAS float*)mod + (size_t)layer * 8 * 6144;
        GAS float* rowss = (GAS float*)(ws + WS_ROWSS); const GAS float* shw = (const GAS float*)(ws + WS_SHW);
#ifndef REPEAT_PH
#define REPEAT_PH -1
#endif
        for (int rep = 0; rep < ((ph == REPEAT_PH) ? 2 : 1); ++rep) {
        pg8::Gemm g{nullptr, nullptr, T, 0, 0, 0}; pg8::Epi E{0, 0, nullptr, 0, nullptr, nullptr, nullptr, nullptr, nullptr, nullptr, nullptr, 0};
        switch (ph) {
        case 1: norm_phase(x0, mod, 0, 1024, H); break;
        case 3: cum_phase(ws, lds); break;
        case 4:
            for (;;) { const int it = q_next(ctl + 256 * rep, slot); if (it >= 64 * GLA_NSEG + 2048 + 152) break;
                if (it < 64 * GLA_NSEG) gla_item(ws, lds, (it & 63) >> 3, it & 7, it >> 6); else if (it < 64 * GLA_NSEG + 2048) { const int f = it - 64 * GLA_NSEG; fox_item(ws, lds, f >> 8, (f >> 5) & 7, f & 31); }
                else prep_item(ws, lds, it - 64 * GLA_NSEG - 2048); }
            break;
        case 11:
            for (;;) { const int it = q_next(ctl + 64 + 256 * rep, slot); if (it >= 256 + 512) break;
                if (it < 256) s5_item(ws, lds, it >> 5, it & 31); else { const int f = it - 256; sgu_item(ws, lds, f >> 6, f & 63); } }
            break;
        case 2: g.A = H; g.Bt = (const bf16_t*)(ws + WS_WIN0); g.N = LD0; g.K = D; E.mode = 0; E.O = (GAS bf16_t*)BIG; E.ldc = LD0; break;
        case 5: g.A = MIX; g.Bt = (const bf16_t*)(ws + WS_WOUT0); g.N = D; g.K = D; E.mode = 6; E.O = (GAS bf16_t*)H; E.base32 = (const GAS float*)x0; E.gate = modl + 2048; E.rowss = rowss; break;
        case 7: g.A = H; g.Bt = (const bf16_t*)(ws + WS_WB0); g.bbatch = (size_t)FFD * D * 2; g.N = FFD; g.K = D; E.mode = 5; E.sub = 1; E.O = (GAS bf16_t*)BIG; E.ldc = FFD; E.rowss = rowss; E.shw = shw; E.ldsh = FFD; break;
        case 8: g.A = BIG; g.Bt = (const bf16_t*)(ws + WS_W2_0); g.N = D; g.K = FFD; E.mode = 7; E.O = (GAS bf16_t*)H; E.gate = modl + 5120; E.rowss = rowss; break;
        case 10: g.A = H; g.Bt = (const bf16_t*)(ws + WS_WB1); g.bbatch = (size_t)LD1 * D * 2; g.N = LD1; g.K = D; E.mode = 5; E.sub = 2; E.O = (GAS bf16_t*)BIG; E.ldc = LD1; E.rowss = rowss; E.shw = shw + 8 * 4096; E.ldsh = LD1; break;
        case 12: g.A = (const bf16_t*)(ws + WS_YS5); g.Bt = (const bf16_t*)(ws + WS_WGLU); g.N = 512; g.K = 512; E.mode = 3; E.O = (GAS bf16_t*)MIX; E.Y = (const GAS bf16_t*)(ws + WS_YS5); E.bias = (const GAS float*)(ws + WS_PRM) + PR_BGLU; break;
        case 13: g.A = MIX; g.Bt = (const bf16_t*)(ws + WS_WOUT1); g.N = D; g.K = D; E.mode = 7; E.O = (GAS bf16_t*)H; E.gate = modl + 2048; E.rowss = rowss; break;
        case 15: g.A = H; g.Bt = (const bf16_t*)(ws + WS_WB2); g.bbatch = (size_t)FFD * D * 2; g.N = FFD; g.K = D; E.mode = 5; E.sub = 1; E.O = (GAS bf16_t*)BIG; E.ldc = FFD; E.rowss = rowss; E.shw = shw + 16 * 4096; E.ldsh = FFD; break;
        case 16: g.A = BIG; g.Bt = (const bf16_t*)(ws + WS_W2_1); g.N = D; g.K = FFD; E.mode = 8; E.O = (GAS bf16_t*)H; E.out32 = (GAS float*)xout; E.gate = modl + 5120; break;
        default: break;
        }
        if (g.K != 0) { pg8::StaticOrder S; S.init(T, g.N, gridDim.x, vcu);
            switch (E.mode) {
            case 0: pg8::gemm_phase<0>(lds, g, S, E); break; case 3: pg8::gemm_phase<3>(lds, g, S, E); break; case 5: pg8::gemm_phase<5>(lds, g, S, E); break;
            case 6: pg8::gemm_phase<6>(lds, g, S, E); break; case 7: pg8::gemm_phase<7>(lds, g, S, E); break; default: pg8::gemm_phase<8>(lds, g, S, E); break; } }
        }
        if (ph != 16) { GSYNC(kb); ++kb; }
    }
}

extern "C" void kernel_launch(void* const* d_in, const int* in_sizes, int n_in, void* d_out, int out_size, void* d_ws, size_t ws_size, hipStream_t stream) {
    static int grid = 0;
    if (grid == 0) {
        if (n_in != 30 || out_size != T * D || ws_size < WS_END) { fprintf(stderr, "kernel_launch: unexpected shapes (n_in %d out %d ws %zu)\n", n_in, out_size, ws_size); grid = -1; return; }
        int dev = 0, cus = 0, per_cu = 0;
        hipGetDevice(&dev); hipDeviceGetAttribute(&cus, hipDeviceAttributeMultiprocessorCount, dev);
        hipFuncSetAttribute((const void*)mega_fwd, hipFuncAttributeMaxDynamicSharedMemorySize, LDS_BYTES);
        hipOccupancyMaxActiveBlocksPerMultiprocessor(&per_cu, (const void*)mega_fwd, NT, LDS_BYTES);
        if (per_cu < 1) { fprintf(stderr, "kernel_launch: occupancy query says %d blocks/CU\n", per_cu); per_cu = 1; }
        grid = cus * 1;
        (void)hipGetLastError();
    }
    if (grid < 0) return;
    (void)hipMemsetAsync((char*)d_ws + WS_CTL, 0, 65536, stream);
    Args a{};
    for (int i = 0; i < 30; ++i) a.in[i] = (const float*)d_in[i];
    a.out = (float*)d_out; a.ws = (unsigned char*)d_ws;
    void* args[] = {&a};
    hipError_t e = hipLaunchCooperativeKernel((const void*)mega_fwd, dim3(grid), dim3(NT), args, LDS_BYTES, stream);
    if (e != hipSuccess) fprintf(stderr, "cooperative launch failed: %s (grid %d)\n", hipGetErrorString(e), grid);
}
```
